# Optimizing an MI355X kernel written in HIP

```python
import math
import jax, jax.numpy as jnp
from jax import lax
import numpy as np

D_MODEL = 1024
BATCH = 8
SEQ = 4096
DEPTH = 2

N_HEADS = 16
HEAD_DIM = D_MODEL // N_HEADS
Q_BLOCK = 128
POOL_WINDOWS = (2, 4, 8, 16)
N_POOL_GROUPS = len(POOL_WINDOWS)
POOL_CH = D_MODEL // N_POOL_GROUPS
N_EXPERTS = 32
N_EXPERT_GROUPS = 4
EXPERTS_PER_GROUP = N_EXPERTS // N_EXPERT_GROUPS
TOPK_GROUPS = 1
TOP_K = 2
D_FF_EXPERT = D_MODEL // 2
EXPERT_BLOCK = 256
N_MIXERS = 2
N_ATTN = (DEPTH + 1) // 2
N_POOL = DEPTH // 2
RMS_EPS = 1e-6

kernel_name = "fox_pool_interleaved_grouped_moe_adaln"


def rmsnorm(x, g):
    xf = x.astype(jnp.float32)
    xf = xf * lax.rsqrt(jnp.mean(xf * xf, axis=-1, keepdims=True) + RMS_EPS)
    return (xf * g.astype(jnp.float32)).astype(x.dtype)


def modulate(h, shift, scale):
    return h * (1.0 + scale[:, None, :]) + shift[:, None, :]


def fox_attention(h, w_in, f_bias, w_o):
    B, S, D = h.shape
    proj = h @ w_in
    q, k, v, f = jnp.split(proj, [D, 2 * D, 3 * D], axis=-1)
    to_heads = lambda t: t.reshape(B, S, N_HEADS, HEAD_DIM).transpose(0, 2, 1, 3)
    q, k, v = to_heads(q), to_heads(k), to_heads(v)
    log_f = jax.nn.log_sigmoid(f.astype(jnp.float32) + f_bias.astype(jnp.float32))
    F = jnp.cumsum(log_f, axis=1).transpose(0, 2, 1)
    scale = 1.0 / math.sqrt(HEAD_DIM)
    kpos = jnp.arange(S)
    n_blocks = S // Q_BLOCK

    def q_block(i):
        start = i * Q_BLOCK
        qb = lax.dynamic_slice_in_dim(q, start, Q_BLOCK, axis=2)
        Fq = lax.dynamic_slice_in_dim(F, start, Q_BLOCK, axis=2)
        logits = jnp.einsum('bhqd,bhkd->bhqk', qb, k).astype(jnp.float32) * scale
        logits = logits + Fq[..., :, None] - F[:, :, None, :]
        qpos = start + jnp.arange(Q_BLOCK)
        causal = kpos[None, :] <= qpos[:, None]
        logits = jnp.where(causal[None, None], logits, -jnp.inf)
        p = jax.nn.softmax(logits, axis=-1)
        return jnp.einsum('bhqk,bhkd->bhqd', p.astype(v.dtype), v)

    o = lax.map(q_block, jnp.arange(n_blocks))
    o = o.transpose(1, 0, 3, 2, 4).reshape(B, S, D)
    return (o @ w_o).astype(h.dtype)


def pool_mixer(h, w_pool, ch_scale):
    B, S, D = h.shape
    hf = h.astype(jnp.float32)
    cs = jnp.cumsum(hf, axis=1)
    t = jnp.arange(S)
    outs = []
    for g, win in enumerate(POOL_WINDOWS):
        sl = slice(g * POOL_CH, (g + 1) * POOL_CH)
        csg = cs[..., sl]
        shifted = jnp.pad(csg, ((0, 0), (win, 0), (0, 0)))[:, :S]
        count = jnp.minimum(t + 1, win).astype(jnp.float32)[None, :, None]
        outs.append((csg - shifted) / count - hf[..., sl])
    pooled = jnp.stack(outs, axis=2).astype(h.dtype)
    y = jnp.einsum('bsgc,gce->bsge', pooled, w_pool).reshape(B, S, D)
    return (y * ch_scale).astype(h.dtype)


def grouped_moe(h, router_w, router_bias, w1, w3, w2):
    B, S, D = h.shape
    T = B * S
    hf = h.reshape(T, D)
    scores = jax.nn.sigmoid((hf @ router_w).astype(jnp.float32))
    sel = scores + router_bias.astype(jnp.float32)
    sel_g = sel.reshape(T, N_EXPERT_GROUPS, EXPERTS_PER_GROUP)
    group_score = lax.top_k(sel_g, TOP_K)[0].sum(-1)
    _, g_idx = lax.top_k(group_score, TOPK_GROUPS)
    g_mask = jnp.any(g_idx[..., None] == jnp.arange(N_EXPERT_GROUPS), axis=1)
    e_mask = jnp.repeat(g_mask, EXPERTS_PER_GROUP, axis=1)
    _, e_idx = lax.top_k(jnp.where(e_mask, sel, -jnp.inf), TOP_K)
    gate = jnp.take_along_axis(scores, e_idx, axis=1)
    gate = gate / jnp.sum(gate, axis=-1, keepdims=True)

    A = T * TOP_K
    e_flat = e_idx.reshape(A)
    tok_flat = jnp.repeat(jnp.arange(T, dtype=jnp.int32), TOP_K)
    w_flat = gate.reshape(A)
    order = jnp.argsort(e_flat)
    e_sorted = e_flat[order]
    counts = jnp.bincount(e_flat, length=N_EXPERTS)
    padded = ((counts + EXPERT_BLOCK - 1) // EXPERT_BLOCK) * EXPERT_BLOCK
    starts = jnp.cumsum(counts) - counts
    pends = jnp.cumsum(padded)
    pstarts = pends - padded
    rank = jnp.arange(A) - starts[e_sorted]
    dest = pstarts[e_sorted] + rank
    n_blocks = A // EXPERT_BLOCK + N_EXPERTS
    P = n_blocks * EXPERT_BLOCK
    row_tok = jnp.full((P,), T, dtype=jnp.int32).at[dest].set(tok_flat[order])
    row_w = jnp.zeros((P,), jnp.float32).at[dest].set(w_flat[order])
    block_e = jnp.minimum(
        jnp.searchsorted(pends, jnp.arange(n_blocks) * EXPERT_BLOCK, side='right'),
        N_EXPERTS - 1)
    x_rows = jnp.concatenate([hf, jnp.zeros((1, D), hf.dtype)], axis=0)[row_tok]
    x_rows = x_rows.reshape(n_blocks, EXPERT_BLOCK, D)

    def expert_block(args):
        xb, e = args
        return (jax.nn.silu(xb @ w1[e]) * (xb @ w3[e])) @ w2[e]

    y = lax.map(expert_block, (x_rows, block_e)).reshape(P, D)
    out = jax.ops.segment_sum(y.astype(jnp.float32) * row_w[:, None], row_tok,
                              num_segments=T + 1)[:T]
    return out.reshape(B, S, D).astype(h.dtype)


def setup_inputs(seed: int = 0) -> dict:
    key = jax.random.key(seed)
    ks = jax.random.split(key, 20)
    D, H, E, Fd = D_MODEL, N_HEADS, N_EXPERTS, D_FF_EXPERT
    nrm = lambda k, shape, s: jax.random.normal(k, shape, jnp.float32) * s
    return {
        "x": nrm(ks[0], (BATCH, SEQ, D), 1.0),
        "c": nrm(ks[1], (BATCH, D), 1.0),
        "norm_mix_g": 1.0 + nrm(ks[2], (DEPTH, D), 0.05),
        "norm_ffn_g": 1.0 + nrm(ks[3], (DEPTH, D), 0.05),
        "ada_w": nrm(ks[4], (DEPTH, D, 6 * D), 0.5 * D ** -0.5),
        "ada_b": nrm(ks[5], (DEPTH, 6 * D), 0.01),
        "attn_w_in": nrm(ks[6], (N_ATTN, D, 3 * D + H), D ** -0.5),
        "attn_f_bias": 2.0 + nrm(ks[7], (N_ATTN, H), 0.5),
        "attn_w_o": nrm(ks[8], (N_ATTN, D, D), D ** -0.5),
        "pool_w": nrm(ks[9], (N_POOL, N_POOL_GROUPS, POOL_CH, POOL_CH), POOL_CH ** -0.5),
        "pool_scale": 0.5 + nrm(ks[10], (N_POOL, D), 0.1),
        "router_w": nrm(ks[11], (D, E), D ** -0.5),
        "router_bias": nrm(ks[12], (E,), 0.01),
        "exp_w1": nrm(ks[13], (DEPTH, E, D, Fd), D ** -0.5),
        "exp_w3": nrm(ks[14], (DEPTH, E, D, Fd), D ** -0.5),
        "exp_w2": nrm(ks[15], (DEPTH, E, Fd, D), Fd ** -0.5),
        "norm_final_g": 1.0 + nrm(ks[16], (D,), 0.05),
    }


def reference(x, c, norm_mix_g, norm_ffn_g, ada_w, ada_b, attn_w_in, attn_f_bias,
              attn_w_o, pool_w, pool_scale, router_w, router_bias, exp_w1, exp_w3,
              exp_w2, norm_final_g):
    c_act = jax.nn.silu(c)
    for i in range(DEPTH):
        mod = c_act @ ada_w[i] + ada_b[i]
        sh_m, sc_m, gt_m, sh_f, sc_f, gt_f = jnp.split(mod, 6, axis=-1)
        h = modulate(rmsnorm(x, norm_mix_g[i]), sh_m, sc_m)
        if i % N_MIXERS == 0:
            j = i // N_MIXERS
            y = fox_attention(h, attn_w_in[j], attn_f_bias[j], attn_w_o[j])
        else:
            j = i // N_MIXERS
            y = pool_mixer(h, pool_w[j], pool_scale[j])
        x = x + gt_m[:, None, :] * y
        h = modulate(rmsnorm(x, norm_ffn_g[i]), sh_f, sc_f)
        y = grouped_moe(h, router_w, router_bias, exp_w1[i], exp_w3[i], exp_w2[i])
        x = x + gt_f[:, None, :] * y
    return rmsnorm(x, norm_final_g)
```

```cpp
#define MK_MULTI 0
#define MAXPH 17
#include <hip/hip_runtime.h>
#include <hip/hip_bf16.h>
#include <cstdio>
#include <cstdint>
#include <cmath>
__device__ __forceinline__ int opaque_tid(int wave0) { int w = wave0; asm volatile("" : "+s"(w)); unsigned m = ~0u; asm volatile("" : "+s"(m)); const int l = (int)__builtin_amdgcn_mbcnt_hi(m, __builtin_amdgcn_mbcnt_lo(m, 0u)); return w * 64 + l; }
namespace pg8 {
#define PG8_LAS __attribute__((address_space(3)))
typedef unsigned short bf16_t;
typedef short bf16x8 __attribute__((ext_vector_type(8)));
typedef float f32x4 __attribute__((ext_vector_type(4)));
typedef float f32x2 __attribute__((ext_vector_type(2)));
typedef unsigned u32x4 __attribute__((ext_vector_type(4)));
constexpr int BM = 256, BK = 64, HALF = 128, HTB = HALF * BK * 2  , STAGE_BYTES = 8 * HTB, NXCD = 8, WGM = 8;

__host__ __device__ __forceinline__ int lds_byte(int r, int c) { const int st = (r >> 4) * 2 + (c >> 5), rr = r & 15, cc = c & 31, ob = rr * 64 + cc * 2; return st * 1024 + (ob ^ (((ob >> 9) & 1) << 5)); }
__host__ __device__ __forceinline__ void stage_rc(int b, int& R, int& C) { const int st = b / 1024, sb = b % 1024, swz = sb ^ (((sb >> 9) & 1) << 5); R = (st >> 1) * 16 + swz / 64; C = (st & 1) * 32 + (swz % 64) / 2; }
__host__ __device__ __forceinline__ int perm32(int rho) { const int n = rho >> 4, i = rho & 15; return 8 * (i >> 2) + 4 * n + (i & 3); }

struct Unit { const char* a; const char* b; int pm, pn, x0, x1; };
struct Gemm { int lda, ldb, K; };

__device__ __forceinline__ unsigned cvt_pk_bf16(float lo, float hi) { unsigned r; asm volatile("v_cvt_pk_bf16_f32 %0, %1, %2" : "=v"(r) : "v"(lo), "v"(hi)); return r; }


struct EpiBf16 {
    static constexpr bool PERM = true, AFTER_DRAIN = false;
    bf16_t* O; int ldc; int split_cols; size_t split_stride; float scale0;
    __device__ __forceinline__ void operator()(const f32x4 (&acc)[2][2][4][2], const Unit& u, int wr, int wc, int fr, int fq) const {
        const int row0 = u.pm * BM + wr * 64 + fr; int colt = u.pn * BM; bf16_t* base = O;
        float sc = 1.f; if (split_cols) { const int t = colt / split_cols; base += (size_t)t * split_stride; colt -= t * split_cols; if (t == 0) sc = scale0; }
        const int col0 = colt + wc * 32 + 8 * fq;
#pragma unroll
        for (int ai = 0; ai < 2; ++ai)
#pragma unroll
            for (int m = 0; m < 4; ++m) { bf16_t* rowp = base + (size_t)(row0 + ai * HALF + m * 16) * ldc + col0;
#pragma unroll
                for (int bj = 0; bj < 2; ++bj) { f32x4 v0 = acc[ai][bj][m][0] * sc, v1 = acc[ai][bj][m][1] * sc;
                    u32x4 w; w.x = cvt_pk_bf16(v0[0], v0[1]); w.y = cvt_pk_bf16(v0[2], v0[3]); w.z = cvt_pk_bf16(v1[0], v1[1]); w.w = cvt_pk_bf16(v1[2], v1[3]);
                    *(u32x4*)(rowp + bj * HALF) = w; } }
    }
};
struct EpiResid {
    static constexpr bool PERM = false, AFTER_DRAIN = false;
    const float* base; float* out; const float* gate;
    __device__ __forceinline__ void operator()(const f32x4 (&acc)[2][2][4][2], const Unit& u, int wr, int wc, int fr, int fq) const {
        const int col0 = u.pn * BM + wc * 32 + 4 * fq; const int b = u.pm >> 4;
        f32x4 gv[2][2];
#pragma unroll
        for (int bj = 0; bj < 2; ++bj)
#pragma unroll
            for (int n = 0; n < 2; ++n) gv[bj][n] = *(const f32x4*)(gate + (size_t)b * 6144 + col0 + bj * HALF + n * 16);
#pragma unroll
        for (int ai = 0; ai < 2; ++ai)
#pragma unroll
            for (int m = 0; m < 4; ++m) { const size_t off = (size_t)(u.pm * BM + ai * HALF + wr * 64 + m * 16 + fr) * 1024 + col0;
#pragma unroll
                for (int bj = 0; bj < 2; ++bj)
#pragma unroll
                    for (int n = 0; n < 2; ++n) { const f32x4 bs = *(const f32x4*)(base + off + bj * HALF + n * 16); *(f32x4*)(out + off + bj * HALF + n * 16) = bs + gv[bj][n] * acc[ai][bj][m][n]; }
                if (m & 1) asm volatile("" ::: "memory"); }
    }
};
struct EpiPool {
    static constexpr bool PERM = false, AFTER_DRAIN = false;
    float* xr; const float* gate; const float* pscale;
    __device__ __forceinline__ void operator()(const f32x4 (&acc)[2][2][4][2], const Unit& u, int wr, int wc, int fr, int fq) const {
        const int col0 = u.pn * BM + wc * 32 + 4 * fq; const int b = u.pm >> 4;
        float* rbase = xr + (size_t)(u.pm * BM + wr * 64 + fr) * 1024 + col0;
#pragma unroll
        for (int bj = 0; bj < 2; ++bj)
#pragma unroll
            for (int n = 0; n < 2; ++n) { const f32x4 gv = *(const f32x4*)(gate + (size_t)b * 6144 + col0 + bj * HALF + n * 16) * *(const f32x4*)(pscale + col0 + bj * HALF + n * 16);
#pragma unroll
                for (int ai = 0; ai < 2; ++ai)
#pragma unroll
                    for (int m = 0; m < 4; ++m) { float* p = rbase + (size_t)(ai * HALF + m * 16) * 1024 + bj * HALF + n * 16; const f32x4 bs = *(const f32x4*)p; *(f32x4*)p = bs + gv * acc[ai][bj][m][n]; }
                asm volatile("" ::: "memory"); }
    }
};
__device__ __forceinline__ float silu_mul(float g, float u) { return g * u * __builtin_amdgcn_rcpf(1.0f + __builtin_amdgcn_exp2f(-1.4426950408889634f * g)); }
struct EpiUp {
    static constexpr bool PERM = true, AFTER_DRAIN = false;
    bf16_t* H;
    __device__ __forceinline__ void operator()(const f32x4 (&acc)[2][2][4][2], const Unit& u, int wr, int wc, int fr, int fq) const {
        const int row0 = u.x1 + wr * 64 + fr, col0 = u.x0 * 128 + wc * 32 + 8 * fq;
#pragma unroll
        for (int ai = 0; ai < 2; ++ai)
#pragma unroll
            for (int m = 0; m < 4; ++m) { bf16_t* rowp = H + (size_t)(row0 + ai * HALF + m * 16) * 512 + col0;
                const f32x4 g0 = acc[ai][0][m][0], g1 = acc[ai][0][m][1], u0 = acc[ai][1][m][0], u1 = acc[ai][1][m][1];
                u32x4 w; w.x = cvt_pk_bf16(silu_mul(g0[0], u0[0]), silu_mul(g0[1], u0[1])); w.y = cvt_pk_bf16(silu_mul(g0[2], u0[2]), silu_mul(g0[3], u0[3]));
                w.z = cvt_pk_bf16(silu_mul(g1[0], u1[0]), silu_mul(g1[1], u1[1])); w.w = cvt_pk_bf16(silu_mul(g1[2], u1[2]), silu_mul(g1[3], u1[3]));
                *(u32x4*)rowp = w; }
    }
};
struct EpiDown {
    static constexpr bool PERM = true, AFTER_DRAIN = false;
    bf16_t* Y; const int* tok; const float* gw;
    __device__ __forceinline__ void operator()(const f32x4 (&acc)[2][2][4][2], const Unit& u, int wr, int wc, int fr, int fq) const {
        const int col0 = u.pn * BM + wc * 32 + 8 * fq;
#pragma unroll
        for (int ai = 0; ai < 2; ++ai)
#pragma unroll
            for (int m = 0; m < 4; ++m) { const int rl = ai * HALF + wr * 64 + m * 16 + fr;
                if (rl < u.x1) { const int d = tok[u.x0 + rl]; const float w8 = gw[u.x0 + rl]; bf16_t* rowp = Y + (size_t)d * 1024 + col0;
#pragma unroll
                    for (int bj = 0; bj < 2; ++bj) { const f32x4 v0 = acc[ai][bj][m][0] * w8, v1 = acc[ai][bj][m][1] * w8;
                        u32x4 w; w.x = cvt_pk_bf16(v0[0], v0[1]); w.y = cvt_pk_bf16(v0[2], v0[3]); w.z = cvt_pk_bf16(v1[0], v1[1]); w.w = cvt_pk_bf16(v1[2], v1[3]);
                        *(u32x4*)(rowp + bj * HALF) = w; } } }
    }
};

template <class Epi, class Sched, bool ALIGN_EPI>
__device__ __forceinline__ void gemm_phase(PG8_LAS unsigned char* lds, const Gemm g, const Sched& S, const Epi& E, int wave0) {
    int tid_ = opaque_tid(wave0);
    const int tid = tid_, wid = __builtin_amdgcn_readfirstlane(tid >> 6), lane = tid & 63, wr = wid >> 2, wc = wid & 3, fr = lane & 15, fq = lane >> 4;
    const int K = g.K, nt = K / BK;
    unsigned voffA[2], voffB[2];
#pragma unroll
    for (int i = 0; i < 2; ++i) { int R, C; stage_rc(tid * 16 + i * 8192, R, C); const int Rb = Epi::PERM ? ((R & ~31) + perm32(R & 31)) : R;
        voffA[i] = (unsigned)(R * g.lda + C) * 2u; voffB[i] = (unsigned)(Rb * g.ldb + C) * 2u; }
    const size_t kstep = (size_t)(BK * 2);
    const size_t hstepA = (size_t)HALF * g.lda * 2, hstepB = (size_t)HALF * g.ldb * 2;
    const unsigned ldsw = (unsigned)wid * 1024u;
    const int aoff = lds_byte(wr * 64 + fr, fq * 8), boff = lds_byte(wc * 32 + fr, fq * 8);
#define PG8_SA(b, h) (((b) * 2 + (h)) * HTB)
#define PG8_SB(b, h) ((4 + (b) * 2 + (h)) * HTB)
#define PG8_STAGE(bufoff, gbase, voff) do { _Pragma("unroll") for (int _i = 0; _i < 2; ++_i) \
        __builtin_amdgcn_global_load_lds((const unsigned*)((const char*)(gbase) + (voff)[_i]), (PG8_LAS unsigned*)(lds + (bufoff) + ldsw + _i * 8192), 16, 0, 0); } while (0)
#define PG8_LDA(dst, b, h) do { _Pragma("unroll") for (int m = 0; m < 4; ++m) _Pragma("unroll") for (int k = 0; k < 2; ++k) dst[m][k] = *(const PG8_LAS bf16x8*)(lds + PG8_SA(b, h) + aoff + m * 2048 + k * 1024); } while (0)
#define PG8_LDB(dst, b, h) do { _Pragma("unroll") for (int n = 0; n < 2; ++n) _Pragma("unroll") for (int k = 0; k < 2; ++k) dst[n][k] = *(const PG8_LAS bf16x8*)(lds + PG8_SB(b, h) + boff + n * 2048 + k * 1024); } while (0)
#define PG8_MMA(ai, bj, At, Bt) do { __builtin_amdgcn_s_setprio(1); _Pragma("unroll") for (int m = 0; m < 4; ++m) _Pragma("unroll") for (int n = 0; n < 2; ++n) _Pragma("unroll") for (int k = 0; k < 2; ++k) \
        acc[ai][bj][m][n] = __builtin_amdgcn_mfma_f32_16x16x32_bf16(Bt[n][k], At[m][k], acc[ai][bj][m][n], 0, 0, 0); __builtin_amdgcn_s_setprio(0); } while (0)
#define PG8_WAIT_V(n) asm volatile("s_waitcnt vmcnt(" #n ")" ::: "memory")
#define PG8_WAIT_L(n) asm volatile("s_waitcnt lgkmcnt(" #n ")" ::: "memory")
#define PG8_BAR __builtin_amdgcn_s_barrier()
#define PG8_SCHED __builtin_amdgcn_sched_barrier(0)
    Unit cur, nxt; int ui = 0;
    if (!S.next(0, cur)) return;
    f32x4 acc[2][2][4][2];
#pragma unroll
    for (int a = 0; a < 2; ++a)
#pragma unroll
        for (int b = 0; b < 2; ++b)
#pragma unroll
            for (int m = 0; m < 4; ++m)
#pragma unroll
                for (int n = 0; n < 2; ++n) acc[a][b][m][n] = (f32x4){0.f, 0.f, 0.f, 0.f};
    bf16x8 At[4][2], B0[2][2], B1[2][2];
    const char* cA = cur.a; const char* cB = cur.b;
    PG8_STAGE(PG8_SB(0, 0), cB, voffB); PG8_STAGE(PG8_SB(0, 1), cB + hstepB, voffB); PG8_STAGE(PG8_SA(0, 0), cA, voffA); PG8_STAGE(PG8_SA(0, 1), cA + hstepA, voffA);
    if (wr == 1) PG8_BAR;
    PG8_WAIT_V(2); PG8_BAR;
    PG8_STAGE(PG8_SB(1, 0), cB + kstep, voffB); PG8_STAGE(PG8_SA(1, 0), cA + kstep, voffA); PG8_STAGE(PG8_SB(1, 1), cB + hstepB + kstep, voffB);
    PG8_WAIT_V(6); PG8_BAR;
    for (;;) {
        const bool has_next = S.next(ui + 1, nxt);
        const char* nA = has_next ? nxt.a : cA; const char* nB = has_next ? nxt.b : cB;
        for (int t = 0; t < nt; t += 2) {
            const bool last = (t == nt - 2);
            const char* a1 = cA + (size_t)(t + 1) * kstep;
            const char* a2 = last ? nA : cA + (size_t)(t + 2) * kstep; const char* b2 = last ? nB : cB + (size_t)(t + 2) * kstep;
            const char* a3 = a2 + kstep; const char* b3 = b2 + kstep;
            PG8_LDB(B0, 0, 0); PG8_LDB(B1, 0, 1); PG8_SCHED; PG8_LDA(At, 0, 0); PG8_STAGE(PG8_SA(1, 1), a1 + hstepA, voffA);
            PG8_WAIT_V(8); PG8_WAIT_L(0); PG8_BAR; PG8_MMA(0, 0, At, B0); PG8_MMA(0, 1, At, B1); PG8_BAR; PG8_SCHED;
            PG8_LDA(At, 0, 1); PG8_STAGE(PG8_SB(0, 0), b2, voffB); PG8_STAGE(PG8_SB(0, 1), b2 + hstepB, voffB); PG8_STAGE(PG8_SA(0, 0), a2, voffA);
            PG8_WAIT_V(8); PG8_WAIT_L(0); PG8_BAR; PG8_MMA(1, 0, At, B0); PG8_MMA(1, 1, At, B1); PG8_BAR; PG8_SCHED;
            PG8_LDB(B0, 1, 0); PG8_LDB(B1, 1, 1); PG8_SCHED; PG8_LDA(At, 1, 0); PG8_STAGE(PG8_SA(0, 1), a2 + hstepA, voffA);
            PG8_WAIT_V(8); PG8_WAIT_L(0); PG8_BAR; PG8_MMA(0, 0, At, B0); PG8_MMA(0, 1, At, B1); PG8_BAR; PG8_SCHED;
            PG8_LDA(At, 1, 1); PG8_STAGE(PG8_SB(1, 0), b3, voffB); PG8_STAGE(PG8_SB(1, 1), b3 + hstepB, voffB); PG8_STAGE(PG8_SA(1, 0), a3, voffA);
            PG8_WAIT_V(8); PG8_WAIT_L(0); PG8_BAR; PG8_MMA(1, 0, At, B0); PG8_MMA(1, 1, At, B1); PG8_BAR; PG8_SCHED;
        }
        if constexpr (ALIGN_EPI) { if (wr == 0) PG8_BAR; }
        E(acc, cur, wr, wc, fr, fq);
        if (!has_next) break;
#pragma unroll
        for (int a = 0; a < 2; ++a)
#pragma unroll
            for (int b = 0; b < 2; ++b)
#pragma unroll
                for (int m = 0; m < 4; ++m)
#pragma unroll
                    for (int n = 0; n < 2; ++n) acc[a][b][m][n] = (f32x4){0.f, 0.f, 0.f, 0.f};
        cur = nxt; cA = nA; cB = nB; ++ui;
        if constexpr (ALIGN_EPI) { if (wr == 1) PG8_BAR; }
    }
    PG8_WAIT_V(0);
    if constexpr (!ALIGN_EPI) { if (wr == 0) PG8_BAR; }
    PG8_BAR;
#undef PG8_SA
#undef PG8_SB
#undef PG8_STAGE
#undef PG8_LDA
#undef PG8_LDB
#undef PG8_MMA
#undef PG8_WAIT_V
#undef PG8_WAIT_L
#undef PG8_BAR
#undef PG8_SCHED
}
}
namespace attn_body {
using bf16=__hip_bfloat16;
using bf16x8=__attribute__((ext_vector_type(8)))short;
using s16x4=__attribute__((ext_vector_type(4)))short;
using f32x16=__attribute__((ext_vector_type(16)))float;
using f32x4=__attribute__((ext_vector_type(4)))float;
using u32x4=__attribute__((ext_vector_type(4)))unsigned;
constexpr int BATCH=8,NHEAD=16,SEQ=4096,D=64,DM=NHEAD*D;
constexpr int NW=8,QBLK=32,QB=QBLK*NW,KVBLK=64,NQB=SEQ/QB;
constexpr int ATTN_PITCH=DM, ATTN_UNIT_ROWS=QB;
__device__ __forceinline__ int crow(int r,int hi){return (r&3)+8*(r>>2)+4*hi;}
#define SBAR() __builtin_amdgcn_sched_barrier(0)
__device__ __forceinline__ void cmask(f32x16&p0,f32x16&p1,int jb,int qrel,int hi){
  const float NEG=-INFINITY; int kb=64*jb+4*hi;
  #pragma unroll
  for(int r=0;r<16;++r){int kv=kb+(r&3)+8*(r>>2); if(kv>qrel)p0[r]=NEG; if(kv+32>qrel)p1[r]=NEG;}
}

constexpr int NSLOT=3, SLOTB=8192;
constexpr int LDS_K=0, LDS_V=NSLOT*SLOTB, LDS_WS=2*NSLOT*SLOTB, LDS_OST=LDS_WS+NW*64*4, LDS_FS=LDS_OST+NW*4096, LDS_WT=LDS_FS+SEQ*4, LDS_BYTES=LDS_WT+64;
constexpr float C2=0.125f*1.4426950408889634f;
constexpr float LOG2E=1.4426950408889634f;
__device__ __forceinline__ void glds16(const void*gsrc,unsigned lds_dst){unsigned keep;
  asm volatile("s_mov_b32 %0, m0\n\ts_mov_b32 m0, %2\n\ts_nop 0\n\tglobal_load_lds_dwordx4 %1, off\n\ts_mov_b32 m0, %0":"=&s"(keep):"v"(gsrc),"s"(lds_dst):"memory");}
__device__ __forceinline__ float max3f(float a,float b,float c){float r;asm("v_max3_f32 %0, %1, %2, %3":"=v"(r):"v"(a),"v"(b),"v"(c));return r;}
__device__ __forceinline__ float max2f(float a,float b){float r;asm("v_max_f32_e32 %0, %1, %2":"=v"(r):"v"(a),"v"(b));return r;}
__device__ __forceinline__ float fadd_s(float a,float b){float r;asm("v_add_f32_e32 %0, %1, %2":"=v"(r):"v"(a),"v"(b));return r;}
__device__ __forceinline__ float fsub_s(float a,float b){float r;asm("v_sub_f32_e32 %0, %1, %2":"=v"(r):"v"(a),"v"(b));return r;}
typedef float f32x2_t __attribute__((ext_vector_type(2))); typedef __bf16 bf16x2_t __attribute__((ext_vector_type(2)));
__device__ __forceinline__ unsigned cvtpk_s(float lo,float hi){f32x2_t v={lo,hi};bf16x2_t b=__builtin_convertvector(v,bf16x2_t);return __builtin_bit_cast(unsigned,b);}
#define WAIT_BAR(N) asm volatile("s_waitcnt vmcnt(" #N ") lgkmcnt(0)\n\ts_barrier":::"memory")

typedef __attribute__((address_space(3))) const char* lds_cptr;
typedef short v4i16_t __attribute__((ext_vector_type(4)));
__device__ __forceinline__ void fbias(f32x16&c0,f32x16&c1,lds_cptr ft,float nm,int hi){
  #pragma unroll
  for(int g=0;g<4;++g){
    const f32x4 a=*(const __attribute__((address_space(3))) f32x4*)(ft+(8*g+4*hi)*4);
    const f32x4 b=*(const __attribute__((address_space(3))) f32x4*)(ft+(32+8*g+4*hi)*4);
    c0[4*g+0]=nm-a[0];c0[4*g+1]=nm-a[1];c0[4*g+2]=nm-a[2];c0[4*g+3]=nm-a[3];
    c1[4*g+0]=nm-b[0];c1[4*g+1]=nm-b[1];c1[4*g+2]=nm-b[2];c1[4*g+3]=nm-b[3];}
}
__device__ __forceinline__ void qkt(f32x16&p0,f32x16&p1,const char*Kslot,const bf16x8*qr,int r32,int hi){
  const char*kb=Kslot+hi*1024+r32*16;
  #pragma unroll
  for(int d0=0;d0<4;++d0){
    const bf16x8 b0=*reinterpret_cast<const bf16x8*>(kb+d0*2048);
    const bf16x8 b1=*reinterpret_cast<const bf16x8*>(kb+d0*2048+512);
    p0=__builtin_amdgcn_mfma_f32_32x32x16_bf16(b0,qr[d0],p0,0,0,0);p1=__builtin_amdgcn_mfma_f32_32x32x16_bf16(b1,qr[d0],p1,0,0,0);}
}
__device__ __forceinline__ void kload8(bf16x8*kf,lds_cptr kp){
  kf[0]=*(const __attribute__((address_space(3))) bf16x8*)(kp);      kf[1]=*(const __attribute__((address_space(3))) bf16x8*)(kp+512);
  kf[2]=*(const __attribute__((address_space(3))) bf16x8*)(kp+2048); kf[3]=*(const __attribute__((address_space(3))) bf16x8*)(kp+2560);
  kf[4]=*(const __attribute__((address_space(3))) bf16x8*)(kp+4096); kf[5]=*(const __attribute__((address_space(3))) bf16x8*)(kp+4608);
  kf[6]=*(const __attribute__((address_space(3))) bf16x8*)(kp+6144); kf[7]=*(const __attribute__((address_space(3))) bf16x8*)(kp+6656);
}
__device__ __forceinline__ void kload2(bf16x8*kf,lds_cptr kp,int j){ kf[2*j]=*(const __attribute__((address_space(3))) bf16x8*)(kp+j*2048); kf[2*j+1]=*(const __attribute__((address_space(3))) bf16x8*)(kp+j*2048+512); }
__device__ __forceinline__ s16x4 vtr(lds_cptr p){ return __builtin_bit_cast(s16x4,__builtin_amdgcn_ds_read_tr16_b64_v4i16((__attribute__((address_space(3))) v4i16_t*)p)); }
__device__ __forceinline__ float rowmax(const f32x16&p0,const f32x16&p1){
  float a=max3f(p0[0],p0[1],p1[0]),b=max3f(p0[2],p0[3],p1[1]);a=max3f(a,p1[2],p1[3]);
  #pragma unroll
  for(int r=4;r<16;r+=4){a=max3f(a,p0[r],p0[r+1]);b=max3f(b,p0[r+2],p0[r+3]);a=max3f(a,p1[r],p1[r+1]);b=max3f(b,p1[r+2],p1[r+3]);}
  const float m=max2f(a,b);
  auto rr=__builtin_amdgcn_permlane32_swap(__float_as_uint(m),__float_as_uint(m),false,false);
  return max2f(__uint_as_float(rr[0]),__uint_as_float(rr[1]));
}
__device__ __forceinline__ void pv(f32x16*o,int vb,bf16x8 pa0,bf16x8 pa1,bf16x8 pa2,bf16x8 pa3){
  #pragma unroll
  for(int d0=0;d0<2;++d0){s16x4 lo[4],hi[4];
    #pragma unroll
    for(int ks=0;ks<4;++ks){
      asm volatile("ds_read_b64_tr_b16 %0,%1 offset:%c2":"=&v"(lo[ks]):"v"(vb),"i"(d0*4096+ks*1024):"memory");
      asm volatile("ds_read_b64_tr_b16 %0,%1 offset:%c2":"=&v"(hi[ks]):"v"(vb),"i"(d0*4096+ks*1024+512):"memory");}
    asm volatile("s_waitcnt lgkmcnt(0)":::"memory");SBAR();
    #define PK(k) (bf16x8){lo[k][0],lo[k][1],lo[k][2],lo[k][3],hi[k][0],hi[k][1],hi[k][2],hi[k][3]}
    o[d0]=__builtin_amdgcn_mfma_f32_32x32x16_bf16(pa0,PK(0),o[d0],0,0,0);
    o[d0]=__builtin_amdgcn_mfma_f32_32x32x16_bf16(pa1,PK(1),o[d0],0,0,0);
    o[d0]=__builtin_amdgcn_mfma_f32_32x32x16_bf16(pa2,PK(2),o[d0],0,0,0);
    o[d0]=__builtin_amdgcn_mfma_f32_32x32x16_bf16(pa3,PK(3),o[d0],0,0,0);
    #undef PK
  }
}

#ifndef ATTN_STORE16
#define ATTN_STORE16(p,v) (*(u32x4*)(p)=(v))
#endif
template<int THRL> __device__ __forceinline__ void attn_unit(int b,int h,int qb,const bf16*Q,const bf16*__restrict__ K,const bf16*__restrict__ V,bf16*O,const float*LF,char*shm,int wave0){
  int tid_=opaque_tid(wave0);
  const int tid=tid_,lane=tid&63,r32=lane&31,hi=lane>>5; const int wid=__builtin_amdgcn_readfirstlane(tid>>6);
  const long rowbase=(long)b*SEQ; const int q0=qb*QB;
  const bf16*Qw=Q+(rowbase+q0+wid*QBLK)*DM+h*D;
  const bf16*Kh=K+rowbase*DM+h*D,*Vh=V+rowbase*DM+h*D;
  const unsigned lds0=(unsigned)(uintptr_t)shm;
  float*wsf=(float*)(shm+LDS_WS)+wid*64;
  const lds_cptr shm3=(lds_cptr)shm;
  { const int n=q0+QB; const float*lf=LF+((long)b*NHEAD+h)*SEQ;
    volatile __attribute__((address_space(3))) float*wt=(volatile __attribute__((address_space(3))) float*)(shm3+LDS_WT);
    f32x4 v0=(f32x4){0.f,0.f,0.f,0.f},v1=(f32x4){0.f,0.f,0.f,0.f};
    if(8*tid<n){v0=*(const f32x4*)(lf+8*tid);v1=*(const f32x4*)(lf+8*tid+4);}
    v0[1]+=v0[0];v0[2]+=v0[1];v0[3]+=v0[2];v1[0]+=v0[3];v1[1]+=v1[0];v1[2]+=v1[1];v1[3]+=v1[2];
    const float tot=v1[3]; float inc=tot;
    #pragma unroll
    for(int o_=1;o_<64;o_<<=1){const float t_=__int_as_float(__builtin_amdgcn_ds_bpermute((lane-o_)<<2,__float_as_int(inc)));if(lane>=o_)inc+=t_;}
    if(lane==63)wt[wid]=inc;
    __syncthreads();
    float base=inc-tot;
    #pragma unroll
    for(int w_=0;w_<NW;++w_){const float x_=wt[w_]; if(w_<wid)base+=x_;}
    if(tid==(q0>>3))wt[8]=base+v0[0];
    __syncthreads();
    const float anc=wt[8];
    if(8*tid<n){ __attribute__((address_space(3))) f32x4*fo=(__attribute__((address_space(3))) f32x4*)(shm3+LDS_FS)+2*tid;
      fo[0]=(v0+(base-anc))*LOG2E; fo[1]=(v1+(base-anc))*LOG2E; }
  }
  const lds_cptr fs3=shm3+LDS_FS;
  const bf16*ksrc=Kh+(long)lane*DM+wid*8;
  const bf16*vsrc=Vh+(long)(16*(wid&3)+(lane>>2))*DM+(wid>>2)*32+(lane&3)*8;
  const unsigned kdst=lds0+LDS_K+wid*1024, vdst=lds0+LDS_V+wid*1024;
  #define DMA_K(t,slot) glds16(ksrc+(long)(t)*KVBLK*DM,(unsigned)__builtin_amdgcn_readfirstlane(kdst+(slot)))
  #define DMA_V(t,slot) glds16(vsrc+(long)(t)*KVBLK*DM,(unsigned)__builtin_amdgcn_readfirstlane(vdst+(slot)))
  const int vb0=(int)(lds0+LDS_V)+((lane>>4)&1)*32+(lane&3)*8+(4*hi+((lane&15)>>2))*64;
  const char*Kbase=shm+LDS_K; bf16x8 kf[8];
  const lds_cptr kp0=shm3+LDS_K+hi*1024+r32*16; const lds_cptr vp0=shm3+LDS_V+((lane>>4)&1)*32+(lane&3)*8+(4*hi+((lane&15)>>2))*64;
  const int NT=(q0+QB)/KVBLK;
  DMA_K(0,0);DMA_V(0,0);DMA_K(1,SLOTB);
  bf16x8 qr[4];
  #pragma unroll
  for(int d0=0;d0<4;++d0)qr[d0]=*reinterpret_cast<const bf16x8*>(&Qw[(long)r32*DM+d0*16+hi*8]);
  float mhat=0.f,l_reg=0.f;f32x16 o[2];o[0]=f32x16{};o[1]=f32x16{};
  const int qrel=wid*QBLK+r32;
  #define CMASK(P0,P1,t) do{int jb_=(t)-(NT-4); if(jb_>=0)cmask(P0,P1,jb_,qrel,hi);}while(0)
  bool resc=false;
  #define START(P0,P1) do{ const float rm=rowmax(P0,P1); resc=false; \
    { const float dl=rm; mhat=fadd_s(mhat,dl); \
      _Pragma("unroll") for(int r=0;r<16;++r){P0[r]=fsub_s(P0[r],dl);P1[r]=fsub_s(P1[r],dl);} } \
    _Pragma("unroll") for(int r=0;r<16;++r)P0[r]=__builtin_amdgcn_exp2f(P0[r]); }while(0)
  #define RESC() do{ if(resc){ asm volatile("s_waitcnt lgkmcnt(0)":::"memory"); \
      _Pragma("unroll") for(int d_=0;d_<2;++d_) _Pragma("unroll") for(int r=0;r<16;++r)o[d_][r]*=wsf[crow(r,hi)]; } }while(0)
  f32x16 pA0,pA1,pB0,pB1;
  int sl_prev=0,sl_cur=0,sl_next=SLOTB;
  #define ROT() do{sl_prev=sl_cur;sl_cur=sl_next;sl_next=(sl_next==(NSLOT-1)*SLOTB)?0:sl_next+SLOTB;}while(0)
  DMA_K(2,2*SLOTB);
  WAIT_BAR(3);
  fbias(pA0,pA1,fs3,0.f,hi);
  qkt(pA0,pA1,Kbase,qr,r32,hi);asm volatile("s_nop 15\n\ts_nop 7":"+v"(pA0),"+v"(pA1));CMASK(pA0,pA1,0);
  START(pA0,pA1);
  _Pragma("unroll") for(int r=0;r<16;++r)pA1[r]=__builtin_amdgcn_exp2f(pA1[r]);
  WAIT_BAR(0);
  DMA_K(3,0);DMA_V(1,SLOTB);
  ROT();
  kload8(kf,kp0+sl_cur);
  WAIT_BAR(2);
  s16x4 vlo[8],vhi[8]; u32x4 pw0,pw1,pw2,pw3;
  #define PKW(P,B) cvtpk_s(P[B],P[B+1])
  #define PAF(k) __builtin_bit_cast(bf16x8,pw##k)
  #define VFR(i) (bf16x8){vlo[i][0],vlo[i][1],vlo[i][2],vlo[i][3],vhi[i][0],vhi[i][1],vhi[i][2],vhi[i][3]}
  #define PIN(x) asm volatile("":"+v"(x))
  #define MX3(a,b,c) __builtin_fmaxf(__builtin_fmaxf((a),(b)),(c))
  #define GAPA(MF,A0,A1,A2,A3,W0,W1,PW) do{ MF; sacc+=A0; sacc+=A1; sacc+=A2; sacc+=A3; PIN(sacc); W0; W1; PIN(PW); SBAR(); }while(0)
  #define EX(v) __builtin_amdgcn_exp2f(v)
  #define GAPB(MF,X,B) do{ MF; X[B]=EX(X[B]); X[B+1]=EX(X[B+1]); X[B+2]=EX(X[B+2]); X[B+3]=EX(X[B+3]); PIN(X); SBAR(); }while(0)
  #define VRD(i) do{ vlo[i]=vtr(vp_+(((i)>>2)*4096+((i)&3)*1024)); vhi[i]=vtr(vp_+(((i)>>2)*4096+((i)&3)*1024+512)); }while(0)
  #define KRD(G,j) do{ if(G){ kload2(kf,kp0+sl_next,j); SBAR(); } }while(0)
  #define STEP(C0,C1,P0,P1,t,GK,GV,GL) do{ SBAR(); \
    const lds_cptr vp_=vp0+sl_prev; \
    fbias(C0,C1,fs3+(t)*256,-mhat,hi); SBAR(); \
    VRD(0); SBAR(); float sacc=(P0[0]+P0[1]); \
    GAPA(C0=__builtin_amdgcn_mfma_f32_32x32x16_bf16(kf[0],qr[0],C0,0,0,0), P0[2],P0[3],P0[4],P0[5],     pw0[0]=PKW(P0,0), pw0[1]=PKW(P0,2), pw0); \
    VRD(4); SBAR(); GAPA(C1=__builtin_amdgcn_mfma_f32_32x32x16_bf16(kf[1],qr[0],C1,0,0,0), P0[6],P0[7],P0[8],P0[9],     pw0[2]=PKW(P0,4), pw0[3]=PKW(P0,6), pw0); \
    VRD(1); SBAR(); GAPA(C0=__builtin_amdgcn_mfma_f32_32x32x16_bf16(kf[2],qr[1],C0,0,0,0),   P0[10],P0[11],P0[12],P0[13], pw1[0]=PKW(P0,8), pw1[1]=PKW(P0,10), pw1); \
    VRD(5); SBAR(); GAPA(C1=__builtin_amdgcn_mfma_f32_32x32x16_bf16(kf[3],qr[1],C1,0,0,0),   P0[14],P0[15],P1[0],P1[1],   pw1[2]=PKW(P0,12),pw1[3]=PKW(P0,14), pw1); \
    VRD(2); SBAR(); GAPA(C0=__builtin_amdgcn_mfma_f32_32x32x16_bf16(kf[4],qr[2],C0,0,0,0),   P1[2],P1[3],P1[4],P1[5],     pw2[0]=PKW(P1,0), pw2[1]=PKW(P1,2), pw2); \
    VRD(6); SBAR(); GAPA(C1=__builtin_amdgcn_mfma_f32_32x32x16_bf16(kf[5],qr[2],C1,0,0,0),   P1[6],P1[7],P1[8],P1[9],     pw2[2]=PKW(P1,4), pw2[3]=PKW(P1,6), pw2); \
    VRD(3); SBAR(); GAPA(C0=__builtin_amdgcn_mfma_f32_32x32x16_bf16(kf[6],qr[3],C0,0,0,0),   P1[10],P1[11],P1[12],P1[13], pw3[0]=PKW(P1,8), pw3[1]=PKW(P1,10), pw3); \
    VRD(7); SBAR(); GAPA(C1=__builtin_amdgcn_mfma_f32_32x32x16_bf16(kf[7],qr[3],C1,0,0,0),   P1[14],P1[15],0.f,0.f,       pw3[2]=PKW(P1,12),pw3[3]=PKW(P1,14), pw3); \
    l_reg+=sacc; \
    if(GK){DMA_K((t)+3,sl_cur);} if(GV){DMA_V((t)+1,sl_next);} \
    CMASK(C0,C1,t); \
    { float a=MX3(C0[0],C0[1],C1[0]),b=MX3(C0[2],C0[3],C1[1]); a=MX3(a,C1[2],C1[3]); \
      _Pragma("unroll") for(int r=4;r<16;r+=4){a=MX3(a,C0[r],C0[r+1]);b=MX3(b,C0[r+2],C0[r+3]);a=MX3(a,C1[r],C1[r+1]);b=MX3(b,C1[r+2],C1[r+3]);} \
      float rm=__builtin_fmaxf(a,b); { auto rr=__builtin_amdgcn_permlane32_swap(__float_as_uint(rm),__float_as_uint(rm),false,false); rm=__builtin_fmaxf(__uint_as_float(rr[0]),__uint_as_float(rr[1])); } \
      resc=false; \
      if(__builtin_expect(__any(rm>(float)THRL),0)){ const float dl=__builtin_fmaxf(rm,0.f); mhat+=dl; \
        _Pragma("unroll") for(int r=0;r<16;++r){C0[r]-=dl;C1[r]-=dl;} \
        const float f=__builtin_amdgcn_exp2f(-dl); l_reg*=f; if(hi==0)wsf[r32]=f; resc=true; } } \
    SBAR(); \
    GAPB(o[0]=__builtin_amdgcn_mfma_f32_32x32x16_bf16(PAF(0),VFR(0),o[0],0,0,0), C0,0); \
    GAPB(o[1]=__builtin_amdgcn_mfma_f32_32x32x16_bf16(PAF(0),VFR(4),o[1],0,0,0), C0,4); \
    KRD(GL,0); GAPB(o[0]=__builtin_amdgcn_mfma_f32_32x32x16_bf16(PAF(1),VFR(1),o[0],0,0,0), C0,8); \
    KRD(GL,1); GAPB(o[1]=__builtin_amdgcn_mfma_f32_32x32x16_bf16(PAF(1),VFR(5),o[1],0,0,0), C0,12); \
    KRD(GL,2); GAPB(o[0]=__builtin_amdgcn_mfma_f32_32x32x16_bf16(PAF(2),VFR(2),o[0],0,0,0), C1,0); \
    KRD(GL,3); GAPB(o[1]=__builtin_amdgcn_mfma_f32_32x32x16_bf16(PAF(2),VFR(6),o[1],0,0,0), C1,4); \
    GAPB(o[0]=__builtin_amdgcn_mfma_f32_32x32x16_bf16(PAF(3),VFR(3),o[0],0,0,0), C1,8); \
    GAPB(o[1]=__builtin_amdgcn_mfma_f32_32x32x16_bf16(PAF(3),VFR(7),o[1],0,0,0), C1,12); \
    }while(0)
  int t=1;
  #undef CMASK
  #define CMASK(P0,P1,t) do{}while(0)
  for(;t+5<NT;t+=2){
    STEP(pB0,pB1,pA0,pA1,t,true,true,true);     WAIT_BAR(2); RESC(); ROT();
    STEP(pA0,pA1,pB0,pB1,t+1,true,true,true);   WAIT_BAR(2); RESC(); ROT();
  }
  #undef CMASK
  #define CMASK(P0,P1,t) do{int jb_=(t)-(NT-4); if(jb_>=0)cmask(P0,P1,jb_,qrel,hi);}while(0)
  #define ENDW(tt) do{ if((tt)+3<NT){WAIT_BAR(2);} else if((tt)+2<NT){WAIT_BAR(1);} else {WAIT_BAR(0);} }while(0)
  for(;t+1<NT;t+=2){
    STEP(pB0,pB1,pA0,pA1,t,(t+3<NT),(t+1<NT),(t+1<NT));       ENDW(t);   RESC(); ROT();
    STEP(pA0,pA1,pB0,pB1,t+1,(t+4<NT),(t+2<NT),(t+2<NT));     ENDW(t+1); RESC(); ROT();
  }
  STEP(pB0,pB1,pA0,pA1,NT-1,false,false,false); RESC();
  { float sacc=pB0[0]+pB0[1]; _Pragma("unroll") for(int r=2;r<16;++r)sacc+=pB0[r]; _Pragma("unroll") for(int r=0;r<16;++r)sacc+=pB1[r]; l_reg+=sacc;
    pw0=(u32x4){PKW(pB0,0),PKW(pB0,2),PKW(pB0,4),PKW(pB0,6)};pw1=(u32x4){PKW(pB0,8),PKW(pB0,10),PKW(pB0,12),PKW(pB0,14)};pw2=(u32x4){PKW(pB1,0),PKW(pB1,2),PKW(pB1,4),PKW(pB1,6)};pw3=(u32x4){PKW(pB1,8),PKW(pB1,10),PKW(pB1,12),PKW(pB1,14)};
    SBAR(); pv(o,vb0+sl_cur,PAF(0),PAF(1),PAF(2),PAF(3)); }
  #undef PKW
  #undef PAF
  #undef VFR
  #undef PIN
  #undef MX3
  #undef GAPA
  #undef GAPB
  #undef EX
  #undef VRD
  #undef KRD
  #undef STEP
  #undef ENDW
  {auto rr=__builtin_amdgcn_permlane32_swap(__float_as_uint(l_reg),__float_as_uint(l_reg),false,false);l_reg=__uint_as_float(rr[0])+__uint_as_float(rr[1]);}
  if(hi==0)wsf[32+r32]=l_reg;asm volatile("s_waitcnt lgkmcnt(0)":::"memory");
  float rli[16];
  #pragma unroll
  for(int r=0;r<16;++r)rli[r]=__builtin_amdgcn_rcpf(wsf[32+crow(r,hi)]);
  bf16*Ow=O+(rowbase+q0+wid*QBLK)*DM+h*D;
  { bf16*stg=(bf16*)(shm+LDS_OST)+wid*2048;
    #pragma unroll
    for(int r=0;r<16;++r){const int orow=crow(r,hi);
      #pragma unroll
      for(int d0=0;d0<2;++d0)stg[orow*64+d0*32+r32]=__float2bfloat16(o[d0][r]*rli[r]);}
    asm volatile("s_waitcnt lgkmcnt(0)":::"memory");
    #pragma unroll
    for(int i=0;i<4;++i){const int row=i*8+(lane>>3),ch=lane&7; const u32x4 v=*(const u32x4*)(stg+row*64+ch*8); ATTN_STORE16(Ow+(long)row*DM+ch*8,v);} }
  asm volatile("s_waitcnt lgkmcnt(0)\n\ts_barrier":::"memory");
  #undef DMA_K
  #undef DMA_V
  #undef CMASK
  #undef START
  #undef RESC
  #undef ROT
}
constexpr int ATTN_LDS_BYTES=LDS_BYTES;
struct AttnTensors { const bf16* Q; const bf16* K; const bf16* V; bf16* O; const float* LF; };
struct AttnUnit { int bh; int qb; };
struct StaticOrder {
  int vcu;
  __device__ __forceinline__ explicit StaticOrder(int grid,int block):vcu((block%8)*(grid/8)+block/8){}
  __device__ __forceinline__ bool next(int i,AttnUnit&u)const{ if(i>=8)return false; const int s=vcu&1, j=7-i, base=4*(j>>1); u.bh=vcu>>1; u.qb=base+((j&1)?(s?2:3):(s?1:0)); return true; }
};
template<class Sched,int THRL=8> __device__ __forceinline__ void attn_phase(char*lds,const AttnTensors&T,const Sched&S,int wave0){
  AttnUnit u;
  for(int i=0;S.next(i,u);++i){ attn_unit<THRL>(u.bh/NHEAD,u.bh%NHEAD,u.qb,T.Q,T.K,T.V,T.O,T.LF,lds,wave0); }
}
#undef SBAR
#undef WAIT_BAR
}
constexpr int NWAVES = 8;
#ifndef MK_MULTI
#define MK_MULTI 0
#endif

constexpr int BATCH = 8, SEQ = 4096, D = 1024, H = 16, HD = 64, NE = 32, FD = 512, NLAYER = 2;
constexpr int T = BATCH * SEQ;
constexpr int MODW = 6 * D;
constexpr float RMS_EPS = 1e-6f;
constexpr int WIN_LD = 3 * D + H;
constexpr int ECAP = 32768;
constexpr int PMAX = 2 * T + NE * 256;

constexpr size_t MiB = 1u << 20;
constexpr size_t WS_CTL = 0, CTL_ZERO_BYTES = 1 * MiB;
constexpr size_t WS_MOD = 1 * MiB;
constexpr size_t WS_LOGF = 2 * MiB;
constexpr size_t WS_TOK = 6 * MiB;
constexpr size_t WS_GW = 10 * MiB;
constexpr size_t WS_WQKV = 14 * MiB;
constexpr size_t WS_WO = 20 * MiB;
constexpr size_t WS_WP = 22 * MiB;
constexpr size_t WS_UP = 23 * MiB;
constexpr size_t WS_DN = 151 * MiB;
constexpr size_t WS_HB = 215 * MiB;
constexpr size_t WS_Q = 279 * MiB, WS_K = 343 * MiB, WS_V = 407 * MiB;
constexpr size_t WS_XS = 279 * MiB;
constexpr size_t WS_Y2 = 279 * MiB;
constexpr size_t WS_HH = 423 * MiB;
constexpr size_t WS_PL = 279 * MiB;
constexpr size_t WS_END = 495 * MiB;
constexpr int CW_BAR = 4096;
constexpr int CW_CNT = 16384;

constexpr int RING_OFF = 0, RING_BYTES = 131072;
constexpr int LDSCTL_OFF = RING_BYTES, MISC_OFF = LDSCTL_OFF + 320;
constexpr int ETAB_OFF = LDSCTL_OFF + 1024;
constexpr int LDS_BYTES = 147456;
static_assert(ETAB_OFF + (64 + 960) * 4 <= LDS_BYTES && attn_body::ATTN_LDS_BYTES <= RING_BYTES, "LDS map");

#define GAS __attribute__((address_space(1)))
#define LAS __attribute__((address_space(3)))
typedef unsigned short bf16;
typedef unsigned v4u __attribute__((ext_vector_type(4)));
typedef float f32x4 __attribute__((ext_vector_type(4)));
typedef short bf16x8 __attribute__((ext_vector_type(8)));
typedef GAS unsigned gu32;
#define RLX_AGENT __ATOMIC_RELAXED, __HIP_MEMORY_SCOPE_AGENT
#define LDS_WAIT() asm volatile("s_waitcnt lgkmcnt(0)" ::: "memory")
#define VM_WAIT() asm volatile("s_waitcnt vmcnt(0)" ::: "memory")
__device__ __forceinline__ unsigned f2bf(float f) { unsigned u = __builtin_bit_cast(unsigned, f); return (u + 0x7fffu + ((u >> 16) & 1u)) >> 16; }
__device__ __forceinline__ unsigned pk2(float lo, float hi) { return f2bf(lo) | (f2bf(hi) << 16); }
__device__ __forceinline__ float bflo(unsigned w) { return __uint_as_float(w << 16); }
__device__ __forceinline__ float bfhi(unsigned w) { return __uint_as_float(w & 0xffff0000u); }

#define XB_TMO      128
#define XB_XCNT(j)  (256  + 64 * (j))
#define XB_XSUB(j)  (1280 + 64 * (j))
#define XB_XGEN(j)  (2304 + 64 * (j))
#define XB_TOP      3328
#define XB_TOPGEN   3392
#define XCD_BAR_WORDS 3456
#define XB_SPIN_CAP (1u << 18)
__device__ __forceinline__ unsigned xb_ld(unsigned* p)              { return __hip_atomic_load(p, __ATOMIC_RELAXED, __HIP_MEMORY_SCOPE_AGENT); }
__device__ __forceinline__ unsigned xb_add(unsigned* p, unsigned v) { return __hip_atomic_fetch_add(p, v, __ATOMIC_RELAXED, __HIP_MEMORY_SCOPE_AGENT); }
__device__ __forceinline__ unsigned xb_xcc_id() { return (unsigned)__builtin_amdgcn_s_getreg((3 << 11) | 20) & 0xFu; }
#define XB_SPIN(cond, bar) do { unsigned _sp = 0; while (cond) { __builtin_amdgcn_s_sleep(1); \
    if ((++_sp & 255u) == 0u) { if (xb_ld(&(bar)[XB_TMO])) break; if (_sp > XB_SPIN_CAP) { atomicAdd(&(bar)[XB_TMO], 1u); break; } } } } while (0)
struct XcdBarrier { unsigned* bar; unsigned x; volatile LAS unsigned* st; };
__device__ __forceinline__ XcdBarrier xcd_barrier_post(unsigned* bar, volatile LAS unsigned* st) {
    XcdBarrier b; b.bar = bar; b.x = xb_xcc_id(); b.st = st;
    if (threadIdx.x == 0) (void)xb_add(&bar[XB_XCNT(b.x)], 1u);
    return b;
}
__device__ __forceinline__ void xcd_barrier_complete(unsigned* bar, unsigned x, unsigned& nloc, unsigned& nx) {
    const unsigned G = gridDim.x * gridDim.y * gridDim.z;
    unsigned sum, cnt, mine, sp = 0u;
    for (;;) {
        sum = 0u; cnt = 0u; mine = 0u;
#pragma unroll
        for (unsigned j = 0; j < 16; ++j) { const unsigned c = xb_ld(&bar[XB_XCNT(j)]); sum += c; cnt += (c > 0u) ? 1u : 0u; }
        mine = xb_ld(&bar[XB_XCNT(x)]);
        if (sum == G) break;
        __builtin_amdgcn_s_sleep(1);
        if ((++sp & 255u) == 0u) { if (xb_ld(&bar[XB_TMO])) break; if (sp > XB_SPIN_CAP) { atomicAdd(&bar[XB_TMO], 1u); break; } }
    }
    nloc = mine > 0u ? mine : 1u; nx = cnt > 0u ? cnt : 1u;
}
__device__ __forceinline__ void xcd_barrier(const XcdBarrier& b) {
    asm volatile("s_waitcnt vmcnt(0)" ::: "memory");
    __syncthreads();
    if (threadIdx.x == 0) {
        unsigned* bar = b.bar; unsigned bx = b.x;
        asm volatile("" : "+s"(bar), "+s"(bx));
        __builtin_amdgcn_s_waitcnt(0);
        unsigned nloc = b.st[0], nx = b.st[1];
        if (nloc == 0u) { xcd_barrier_complete(bar, bx, nloc, nx); b.st[0] = nloc; b.st[1] = nx; }
        const unsigned old = xb_add(&bar[XB_XSUB(bx)], 1u);
        const unsigned gen = old / nloc;
        if (old + 1u == (gen + 1u) * nloc) {
            __builtin_amdgcn_fence(__ATOMIC_RELEASE, "agent");
            asm volatile("s_waitcnt vmcnt(0)" ::: "memory");
            const unsigned og = xb_add(&bar[XB_TOP], 1u);
            const unsigned tg = og / nx;
            if (og + 1u == (tg + 1u) * nx) xb_add(&bar[XB_TOPGEN], 1u);
            else XB_SPIN(xb_ld(&bar[XB_TOPGEN]) == tg, bar);
            __builtin_amdgcn_fence(__ATOMIC_ACQUIRE, "agent");
            xb_add(&bar[XB_XGEN(bx)], 1u);
            asm volatile("s_waitcnt vmcnt(0)" ::: "memory");
        } else {
            XB_SPIN(xb_ld(&bar[XB_XGEN(bx)]) == gen, bar);
            __builtin_amdgcn_fence(__ATOMIC_ACQUIRE, "agent");
            asm volatile("s_waitcnt vmcnt(0)" ::: "memory");
        }
    }
    __syncthreads();
}

struct Frame {
    LAS unsigned char* lds;
    volatile LAS unsigned* MISC;
    gu32* ctl;
    int tid, lane, wave, wave0;
    int vcu, G;
    const __attribute__((address_space(4))) char* ka;
    float* out;
    unsigned char* ws;
    const __attribute__((address_space(4))) char* ka0; float* out0; unsigned char* ws0;
};
__device__ __forceinline__ void phase_enter(Frame& F) {
    int t_ = opaque_tid(F.wave0); F.tid = t_; F.lane = t_ & 63; F.wave = __builtin_amdgcn_readfirstlane(t_ >> 6);
    unsigned char* w = F.ws0; float* o = F.out0; const __attribute__((address_space(4))) char* k = F.ka0;
    asm volatile("" : "+s"(w), "+s"(o), "+s"(k));
    F.ws = w; F.out = o; F.ka = k; F.ctl = (gu32*)w;
}
#define WSP(T_, off) ((T_*)(F.ws + (off)))
#define FIN(i) (*(const float* const __attribute__((address_space(4)))*)(F.ka + 8 * (i)))
enum { IN_X = 0, IN_C, IN_NMG, IN_NFG, IN_ADAW, IN_ADAB, IN_WIN, IN_FBIAS, IN_WO, IN_POOLW, IN_POOLS, IN_RW, IN_RB, IN_W1, IN_W3, IN_W2, IN_NFIN };

__device__ __forceinline__ void transpose_item(const float* W, int ld, int k0, bf16* WT, int Kd, int dst_row0, LAS float* scr, int lane) {
#pragma unroll 8
    for (int i = 0; i < 32; ++i) { const int kk = 2 * i + (lane >> 5); scr[kk * 33 + (lane & 31)] = W[(size_t)(k0 + kk) * ld + (lane & 31)]; }
    LDS_WAIT(); asm volatile("" ::: "memory");
    const int c = lane & 7;
#pragma unroll
    for (int j = 0; j < 4; ++j) { const int n = (lane >> 3) + 8 * j; const LAS float* s = scr + (8 * c) * 33 + n;
        v4u o; o.x = pk2(s[0 * 33], s[1 * 33]); o.y = pk2(s[2 * 33], s[3 * 33]); o.z = pk2(s[4 * 33], s[5 * 33]); o.w = pk2(s[6 * 33], s[7 * 33]);
        *(GAS v4u*)(WT + (size_t)(dst_row0 + n) * Kd + k0 + 8 * c) = o; }
    LDS_WAIT(); asm volatile("" ::: "memory");
}
__device__ __forceinline__ void p0_prologue(Frame& F) {
    if (F.vcu < 192) {
        const float* cin = FIN(IN_C); const float* adaw = FIN(IN_ADAW); const float* adab = FIN(IN_ADAB);
        LAS float* cact = (LAS float*)(F.lds);
        LAS float* red = (LAS float*)(F.lds + 32768);
        for (int i = F.tid; i < 8 * 1024; i += 512) { const int bb = i >> 10, k = i & 1023; const float v = cin[i]; cact[k * 8 + bb] = v / (1.0f + __expf(-v)); }
        __syncthreads();
        const int l = F.vcu / 96, col0 = (F.vcu % 96) * 64;
        const float* wp = adaw + (size_t)l * D * MODW + col0 + F.lane;
        float a0 = 0.f, a1 = 0.f, a2 = 0.f, a3 = 0.f, a4 = 0.f, a5 = 0.f, a6 = 0.f, a7 = 0.f;
        const int kb = F.wave * 128;
#pragma unroll 8
        for (int k = 0; k < 128; ++k) { const float wv = wp[(size_t)(kb + k) * MODW]; const f32x4 c0 = *(const LAS f32x4*)(cact + (kb + k) * 8), c1 = *(const LAS f32x4*)(cact + (kb + k) * 8 + 4);
            a0 += c0[0] * wv; a1 += c0[1] * wv; a2 += c0[2] * wv; a3 += c0[3] * wv; a4 += c1[0] * wv; a5 += c1[1] * wv; a6 += c1[2] * wv; a7 += c1[3] * wv; }
        LAS float* rw = red + F.wave * 512 + F.lane;
        rw[0] = a0; rw[64] = a1; rw[128] = a2; rw[192] = a3; rw[256] = a4; rw[320] = a5; rw[384] = a6; rw[448] = a7;
        __syncthreads();
        { const int bb = F.tid >> 6, col = F.tid & 63; float s = 0.f;
#pragma unroll
          for (int w = 0; w < 8; ++w) s += red[w * 512 + bb * 64 + col];
          WSP(float, WS_MOD)[((size_t)l * 8 + bb) * MODW + col0 + col] = s + adab[l * MODW + col0 + col]; }
        __syncthreads();
    }
    LAS float* scr = (LAS float*)(F.lds + RING_OFF + F.wave * 16384);
    const int gw = F.vcu * NWAVES + F.wave, NGW = F.G * NWAVES;
    constexpr int I_QKV = 16 * 96, I_O = 16 * 32, I_P = 4 * 4 * 8, I_W13 = 16 * 16, I_W2 = 8 * 32;
    constexpr int I_EXP = NLAYER * NE * (2 * I_W13 + I_W2);
    constexpr int NITEMS = I_QKV + I_O + I_P + I_EXP;
    for (int it = gw; it < NITEMS; it += NGW) {
        int r = it;
        if (r < I_QKV) { const int kb = r / 96, nb = r % 96; transpose_item(FIN(IN_WIN) + 32 * nb, WIN_LD, 64 * kb, WSP(bf16, WS_WQKV), D, 32 * nb, scr, F.lane); continue; } r -= I_QKV;
        if (r < I_O) { const int kb = r / 32, nb = r % 32; transpose_item(FIN(IN_WO) + 32 * nb, D, 64 * kb, WSP(bf16, WS_WO), D, 32 * nb, scr, F.lane); continue; } r -= I_O;
        if (r < I_P) { const int g = r / 32, q = r % 32, kb = q / 8, nb = q % 8; transpose_item(FIN(IN_POOLW) + (size_t)g * 65536 + 32 * nb, 256, 64 * kb, WSP(bf16, WS_WP) + (size_t)g * 65536, 256, 32 * nb, scr, F.lane); continue; } r -= I_P;
        { const int per = 2 * I_W13 + I_W2; const int le = r / per; int q = r % per;
          if (q < 2 * I_W13) { const int which = q / I_W13; q %= I_W13; const int kb = q / 16, nb = q % 16, n0 = 32 * nb;
              const float* src = (which ? FIN(IN_W3) : FIN(IN_W1)) + (size_t)le * D * FD + n0;
              transpose_item(src, FD, 64 * kb, WSP(bf16, WS_UP) + (size_t)le * 1024 * 1024, D, 256 * (n0 >> 7) + (n0 & 127) + 128 * which, scr, F.lane); }
          else { q -= 2 * I_W13; const int kb = q / 32, nb = q % 32;
              transpose_item(FIN(IN_W2) + (size_t)le * FD * D + 32 * nb, D, 64 * kb, WSP(bf16, WS_DN) + (size_t)le * 1024 * 512, FD, 32 * nb, scr, F.lane); } }
    }
}

struct RowArgs { const float* src; float* dst; const float* g; const float* shp; const float* scp; const float* gtp; const bf16* y2; bf16* hb;
                 const float* W; const float* bias; float* logf; gu32* cnt; int* tok; float* gw; };
template <int MODE>
__device__ __forceinline__ void rowpass(Frame& F, const RowArgs& A) {
    constexpr int NT = (MODE == 0) ? 1 : (MODE == 1 ? 2 : 0);
    const int lane = F.lane, w = F.wave, r = lane & 15, q = lane >> 4, tid = F.tid;
    const int R0 = F.vcu * 128, b = R0 >> 12;
    const int kb = 128 * w + 8 * q;
    LAS float* red = (LAS float*)(F.lds);
    LAS f32x4* part = (LAS f32x4*)(F.lds + 1024);
    LAS float* scS = (LAS float*)(F.lds + 1024 + 32768);
    LAS float* selS = scS + 512;
    LAS float* GM = (LAS float*)(F.lds + 65536); LAS float* SH = GM + 1024; LAS float* GT = SH + 1024;
    for (int k = tid; k < D; k += 512) { const float g1 = A.g[k];
        if (MODE < 3) { GM[k] = g1 * (1.0f + A.scp[(size_t)b * MODW + k]); SH[k] = A.shp[(size_t)b * MODW + k]; } else { GM[k] = g1; SH[k] = 0.f; }
        GT[k] = (MODE >= 2) ? A.gtp[(size_t)b * MODW + k] : 0.f; }
    __syncthreads();
    bf16x8 Bh[NT > 0 ? NT : 1][4], Bl[NT > 0 ? NT : 1][4];
    constexpr int LDW = (MODE == 0) ? WIN_LD : NE, COFF = (MODE == 0) ? 3 * D : 0;
    if (NT > 0) { const float* wbase = A.W + (size_t)kb * LDW + COFF + r;
#pragma unroll
        for (int nt = 0; nt < NT; ++nt)
#pragma unroll
            for (int c = 0; c < 4; ++c) { float wv[8];
#pragma unroll
                for (int j = 0; j < 8; ++j) wv[j] = wbase[(32 * c + j) * LDW + 16 * nt];
                v4u hw, lw;
                hw.x = pk2(wv[0], wv[1]); hw.y = pk2(wv[2], wv[3]); hw.z = pk2(wv[4], wv[5]); hw.w = pk2(wv[6], wv[7]);
                lw.x = pk2(wv[0] - bflo(hw.x), wv[1] - bfhi(hw.x)); lw.y = pk2(wv[2] - bflo(hw.y), wv[3] - bfhi(hw.y));
                lw.z = pk2(wv[4] - bflo(hw.z), wv[5] - bfhi(hw.z)); lw.w = pk2(wv[6] - bflo(hw.w), wv[7] - bfhi(hw.w));
                Bh[nt][c] = __builtin_bit_cast(bf16x8, hw); Bl[nt][c] = __builtin_bit_cast(bf16x8, lw); }
    }
    for (int it = 0; it < 8; ++it) {
        const int row = R0 + 16 * it + r, buf = it & 1;
        const float* xs = A.src + (size_t)row * D + kb;
        f32x4 xv[4][2];
#pragma unroll
        for (int c = 0; c < 4; ++c) { xv[c][0] = *(const f32x4*)(xs + 32 * c); xv[c][1] = *(const f32x4*)(xs + 32 * c + 4); }
        if (MODE >= 2) {
            const bf16* yp = A.y2 + (size_t)row * 2 * D + kb;
#pragma unroll
            for (int c = 0; c < 4; ++c) { const v4u ya = *(const v4u*)(yp + 32 * c), yb = *(const v4u*)(yp + D + 32 * c);
                f32x4 s0, s1;
                s0[0] = bflo(ya.x) + bflo(yb.x); s0[1] = bfhi(ya.x) + bfhi(yb.x); s0[2] = bflo(ya.y) + bflo(yb.y); s0[3] = bfhi(ya.y) + bfhi(yb.y);
                s1[0] = bflo(ya.z) + bflo(yb.z); s1[1] = bfhi(ya.z) + bfhi(yb.z); s1[2] = bflo(ya.w) + bflo(yb.w); s1[3] = bfhi(ya.w) + bfhi(yb.w);
                xv[c][0] += *(const LAS f32x4*)(GT + kb + 32 * c) * s0; xv[c][1] += *(const LAS f32x4*)(GT + kb + 32 * c + 4) * s1; }
            if (MODE == 2) { float* xd = A.dst + (size_t)row * D + kb;
#pragma unroll
                for (int c = 0; c < 4; ++c) { *(f32x4*)(xd + 32 * c) = xv[c][0]; *(f32x4*)(xd + 32 * c + 4) = xv[c][1]; } }
        }
        float ss = 0.f;
#pragma unroll
        for (int c = 0; c < 4; ++c)
#pragma unroll
            for (int hf = 0; hf < 2; ++hf) { const f32x4 v = xv[c][hf]; ss += (v[0] * v[0] + v[1] * v[1]) + (v[2] * v[2] + v[3] * v[3]); }
        ss += __int_as_float(__builtin_amdgcn_ds_bpermute((lane ^ 16) << 2, __float_as_int(ss))); ss += __int_as_float(__builtin_amdgcn_ds_bpermute((lane ^ 32) << 2, __float_as_int(ss)));
        if (q == 0) red[buf * 128 + w * 16 + r] = ss;
        __syncthreads();
        float tot = 0.f;
#pragma unroll
        for (int ww = 0; ww < 8; ++ww) tot += red[buf * 128 + ww * 16 + r];
        const float rstd = 1.0f / sqrtf(tot * (1.0f / D) + RMS_EPS);
        if (MODE == 3) { float* xd = A.dst + (size_t)row * D + kb;
#pragma unroll
            for (int c = 0; c < 4; ++c) { *(f32x4*)(xd + 32 * c) = xv[c][0] * rstd * *(const LAS f32x4*)(GM + kb + 32 * c); *(f32x4*)(xd + 32 * c + 4) = xv[c][1] * rstd * *(const LAS f32x4*)(GM + kb + 32 * c + 4); }
            continue; }
        f32x4 acc[NT > 0 ? NT : 1];
#pragma unroll
        for (int nt = 0; nt < (NT > 0 ? NT : 1); ++nt) acc[nt] = (f32x4){0.f, 0.f, 0.f, 0.f};
        bf16* hp = A.hb + (size_t)row * D + kb;
#pragma unroll
        for (int c = 0; c < 4; ++c) {
            const f32x4 h0 = xv[c][0] * rstd * *(const LAS f32x4*)(GM + kb + 32 * c) + *(const LAS f32x4*)(SH + kb + 32 * c), h1 = xv[c][1] * rstd * *(const LAS f32x4*)(GM + kb + 32 * c + 4) + *(const LAS f32x4*)(SH + kb + 32 * c + 4);
            v4u hw; hw.x = pk2(h0[0], h0[1]); hw.y = pk2(h0[2], h0[3]); hw.z = pk2(h1[0], h1[1]); hw.w = pk2(h1[2], h1[3]);
            *(v4u*)(hp + 32 * c) = hw;
            if (NT > 0) {
                v4u lw; lw.x = pk2(h0[0] - bflo(hw.x), h0[1] - bfhi(hw.x)); lw.y = pk2(h0[2] - bflo(hw.y), h0[3] - bfhi(hw.y));
                lw.z = pk2(h1[0] - bflo(hw.z), h1[1] - bfhi(hw.z)); lw.w = pk2(h1[2] - bflo(hw.w), h1[3] - bfhi(hw.w));
                const bf16x8 ah = __builtin_bit_cast(bf16x8, hw), al = __builtin_bit_cast(bf16x8, lw);
#pragma unroll
                for (int nt = 0; nt < NT; ++nt) {
                    acc[nt] = __builtin_amdgcn_mfma_f32_16x16x32_bf16(ah, Bh[nt][c], acc[nt], 0, 0, 0);
                    acc[nt] = __builtin_amdgcn_mfma_f32_16x16x32_bf16(ah, Bl[nt][c], acc[nt], 0, 0, 0);
                    acc[nt] = __builtin_amdgcn_mfma_f32_16x16x32_bf16(al, Bh[nt][c], acc[nt], 0, 0, 0); }
            }
        }
        if (NT > 0) {
#pragma unroll
            for (int nt = 0; nt < NT; ++nt) part[((buf * 8 + w) * 2 + nt) * 64 + lane] = acc[nt];
            __syncthreads();
            if (MODE == 0) {
                if (tid < 256) { const int t = tid & 15, n = tid >> 4; float f = 0.f;
#pragma unroll
                    for (int ww = 0; ww < 8; ++ww) f += ((const LAS float*)&part[((buf * 8 + ww) * 2 + 0) * 64 + n + 16 * (t >> 2)])[t & 3];
                    const float z = f + A.bias[n]; const float lf = fminf(z, 0.f) - log1pf(__expf(-fabsf(z)));
                    const int rt = R0 + 16 * it + t; A.logf[((size_t)b * H + n) * SEQ + (rt & (SEQ - 1))] = lf; }
            } else {
                { const int t = tid & 15, n = tid >> 4; float f = 0.f;
#pragma unroll
                  for (int ww = 0; ww < 8; ++ww) f += ((const LAS float*)&part[((buf * 8 + ww) * 2 + (n >> 4)) * 64 + (n & 15) + 16 * (t >> 2)])[t & 3];
                  const float sc = 1.0f / (1.0f + expf(-f)); scS[t * 32 + n] = sc; selS[t * 32 + n] = sc + A.bias[n]; }
                __syncthreads();
                if (tid < 16) { const LAS float* sl = selS + tid * 32; float bg = -INFINITY; int gi = 0;
                    for (int g = 0; g < 4; ++g) { float m1 = -INFINITY, m2 = -INFINITY;
                        for (int i = 0; i < 8; ++i) { const float v = sl[8 * g + i]; if (v > m1) { m2 = m1; m1 = v; } else if (v > m2) m2 = v; }
                        const float gs = m1 + m2; if (gs > bg) { bg = gs; gi = g; } }
                    int i1 = 0, i2 = 0; float v1 = -INFINITY, v2 = -INFINITY;
                    for (int i = 0; i < 8; ++i) { const float v = sl[8 * gi + i]; if (v > v1) { v1 = v; i1 = i; } }
                    for (int i = 0; i < 8; ++i) { const float v = sl[8 * gi + i]; if (i != i1 && v > v2) { v2 = v; i2 = i; } }
                    const int e0 = 8 * gi + i1, e1 = 8 * gi + i2; const float s0 = scS[tid * 32 + e0], s1 = scS[tid * 32 + e1], inv = 1.0f / (s0 + s1);
                    const int rt = R0 + 16 * it + tid;
                    const unsigned p0 = __hip_atomic_fetch_add(A.cnt + e0 * 64, 1u, RLX_AGENT), p1 = __hip_atomic_fetch_add(A.cnt + e1 * 64, 1u, RLX_AGENT);
                    A.tok[e0 * ECAP + p0] = rt * 2; A.gw[e0 * ECAP + p0] = s0 * inv; A.tok[e1 * ECAP + p1] = rt * 2 + 1; A.gw[e1 * ECAP + p1] = s1 * inv; }
            }
        }
    }
    __syncthreads();
}

constexpr int UT_E = 64, UT_X = 64 + 320, UT_V = 64 + 640;
__device__ __forceinline__ void build_etab(Frame& F, int layer) {
    LAS int* et = (LAS int*)(F.lds + ETAB_OFF);
    if (F.tid == 0) { int ts = 0;
        for (int e = 0; e < NE; ++e) { const int c = (int)__hip_atomic_load(F.ctl + CW_CNT + (layer * 32 + e) * 64, RLX_AGENT); const int nt = (c + 255) >> 8;
            for (int j = 0; j < nt; ++j) { et[UT_E + ts] = e; et[UT_X + ts] = e * ECAP + 256 * j; const int rem = c - 256 * j; et[UT_V + ts] = rem < 256 ? rem : 256; ++ts; } }
        et[0] = ts; }
    __syncthreads();
}
__device__ __forceinline__ void gather_rows(Frame& F) {
    const LAS int* et = (const LAS int*)(F.lds + ETAB_OFF);
    const int ptot = et[0] * 256; const int* tok = WSP(int, WS_TOK);
    const int gw = F.vcu * NWAVES + F.wave, NGW = F.G * NWAVES;
    for (int p = gw; p < ptot; p += NGW) { const int tile = p >> 8, rl = p & 255;
        if (rl < et[UT_V + tile]) { const int tk = tok[et[UT_X + tile] + rl] >> 1;
            const GAS v4u* s = (const GAS v4u*)(WSP(bf16, WS_HB) + (size_t)tk * D) + F.lane; GAS v4u* d = (GAS v4u*)(WSP(bf16, WS_XS) + (size_t)p * D) + F.lane;
            const v4u a = s[0], bq = s[64]; d[0] = a; d[64] = bq; } }
}
__device__ __forceinline__ void pool_rows(Frame& F) {
    const int ch = F.tid & 127, rs = F.tid >> 7; const int t0 = F.vcu * 128 + rs * 32; const int win = 2 << (ch >> 5);
    const bf16* hb = WSP(bf16, WS_HB) + ch * 8; bf16* pl = WSP(bf16, WS_PL) + ch * 8;
    float s[8];
#pragma unroll
    for (int j = 0; j < 8; ++j) s[j] = 0.f;
    const int s0 = t0 & (SEQ - 1);
    for (int i = 1; i < win; ++i) if (s0 - i >= 0) { const v4u a = *(const v4u*)(hb + (size_t)(t0 - i) * D);
        s[0] += bflo(a.x); s[1] += bfhi(a.x); s[2] += bflo(a.y); s[3] += bfhi(a.y); s[4] += bflo(a.z); s[5] += bfhi(a.z); s[6] += bflo(a.w); s[7] += bfhi(a.w); }
    for (int i = 0; i < 32; ++i) { const int t = t0 + i, sq = s0 + i;
        const v4u a = *(const v4u*)(hb + (size_t)t * D);
        float h[8]; h[0] = bflo(a.x); h[1] = bfhi(a.x); h[2] = bflo(a.y); h[3] = bfhi(a.y); h[4] = bflo(a.z); h[5] = bfhi(a.z); h[6] = bflo(a.w); h[7] = bfhi(a.w);
#pragma unroll
        for (int j = 0; j < 8; ++j) s[j] += h[j];
        const float ic = 1.0f / (float)((sq + 1 < win) ? (sq + 1) : win);
        v4u w; w.x = pk2(s[0] * ic - h[0], s[1] * ic - h[1]); w.y = pk2(s[2] * ic - h[2], s[3] * ic - h[3]); w.z = pk2(s[4] * ic - h[4], s[5] * ic - h[5]); w.w = pk2(s[6] * ic - h[6], s[7] * ic - h[7]);
        if (sq - win + 1 >= 0) { const v4u o = *(const v4u*)(hb + (size_t)(t - win + 1) * D);
            s[0] -= bflo(o.x); s[1] -= bfhi(o.x); s[2] -= bflo(o.y); s[3] -= bfhi(o.y); s[4] -= bflo(o.z); s[5] -= bfhi(o.z); s[6] -= bflo(o.w); s[7] -= bfhi(o.w); }
        *(v4u*)(pl + (size_t)t * D) = w; }
}

struct DenseSched {
    const char* A; const char* Bt; size_t strideA, strideB; int nM, nN, nwg, G, c;
    __device__ __forceinline__ bool next(int i, pg8::Unit& u) const {
        const long L = (long)i * G + c; if (L >= nwg) return false;
        int wgid = (int)L; { const int q = nwg / 8, r = nwg % 8, xcd = wgid % 8, off = wgid / 8; wgid = (xcd < r ? xcd * (q + 1) : r * (q + 1) + (xcd - r) * q) + off; }
        const int nig = 8 * nN, gid = wgid / nig, fm = gid * 8, gsz = (nM - fm) < 8 ? (nM - fm) : 8;
        u.pm = fm + ((wgid % nig) % gsz); u.pn = (wgid % nig) / gsz; u.a = A + (size_t)u.pm * strideA; u.b = Bt + (size_t)u.pn * strideB; u.x0 = 0; u.x1 = 0; return true;
    }
};
struct PoolSched {
    const char* A; const char* Bt; int G, v;
    __device__ __forceinline__ bool next(int i, pg8::Unit& u) const {
        const int L = i * G + v; if (L >= 512) return false;
        u.pm = L >> 2; u.pn = L & 3; u.a = A + (size_t)u.pm * 256 * D * 2 + (size_t)u.pn * 256 * 2; u.b = Bt + (size_t)u.pn * 65536 * 2; u.x0 = 0; u.x1 = 0; return true;
    }
};
template <bool DOWN> struct MoeSched {
    const LAS int* et; const char* A; const char* Bt; int G, v;
    static constexpr size_t rowA = DOWN ? (size_t)FD * 2 : (size_t)D * 2, strideE = DOWN ? (size_t)1024 * 512 * 2 : (size_t)1024 * 1024 * 2, stridePn = DOWN ? (size_t)256 * 512 * 2 : (size_t)256 * 1024 * 2;
    __device__ __forceinline__ bool next(int i, pg8::Unit& u) const {
        const int L = i * G + v; const int ntile = et[0]; if (L >= ntile * 4) return false;
        const int tile = L >> 2, pn = L & 3; const int e = et[UT_E + tile];
        u.pm = tile; u.pn = pn; u.a = A + (size_t)tile * 256 * rowA; u.b = Bt + (size_t)e * strideE + (size_t)pn * stridePn;
        if (DOWN) { u.x0 = et[UT_X + tile]; u.x1 = et[UT_V + tile]; } else { u.x0 = pn; u.x1 = tile * 256; }
        return true;
    }
};
constexpr int N_PHASES = 17;
struct Args { const float* in[17]; float* out; unsigned char* ws; int ph_lo, ph_hi; };
__global__ void __launch_bounds__(NWAVES * 64, 2) fwd_megakernel(Args args) {
    extern __shared__ __attribute__((aligned(16))) unsigned char lds[];
    Frame F;
    F.lds = (LAS unsigned char*)lds;
    F.MISC = (volatile LAS unsigned*)(F.lds + MISC_OFF);
    F.wave0 = __builtin_amdgcn_readfirstlane((int)threadIdx.x >> 6); F.tid = threadIdx.x; F.lane = F.tid & 63; F.wave = F.wave0;
    F.G = gridDim.x; { const int bx = blockIdx.x; F.vcu = (F.G % 8 == 0) ? (bx % 8) * (F.G / 8) + bx / 8 : bx; }
    F.ws0 = args.ws; F.out0 = args.out;
    F.ka0 = (const __attribute__((address_space(4))) char*)__builtin_amdgcn_kernarg_segment_ptr();
    phase_enter(F);
    for (int u = F.tid; u < (LDS_BYTES - LDSCTL_OFF) / 4; u += NWAVES * 64) ((LAS unsigned*)(F.lds + LDSCTL_OFF))[u] = 0u;
    __syncthreads();
    XcdBarrier bar; bar.bar = (unsigned*)(F.ctl + CW_BAR); bar.x = 0; bar.st = nullptr;
    if (!MK_MULTI) bar = xcd_barrier_post((unsigned*)(F.ctl + CW_BAR), F.MISC + 8);
    int lo = args.ph_lo, hi = args.ph_hi;
#ifndef PHMASK
#define PHMASK 0xFFFFFFFFu
#endif
#define IN(k) (((PHMASK >> (k)) & 1u) && lo <= (k) && (k) < hi)
#define SEAM(k) do { if (IN(k) && IN((k) + 1)) xcd_barrier(bar); asm volatile("" : "+s"(lo), "+s"(hi)); } while (0)
#define mod WSP(float, WS_MOD)
#define HB WSP(bf16, WS_HB)

    if (IN(0)) { phase_enter(F); p0_prologue(F); } SEAM(0);
    if (IN(1)) { phase_enter(F); RowArgs A{}; A.src = FIN(IN_X); A.g = FIN(IN_NMG); A.shp = mod + 0; A.scp = mod + D; A.hb = HB; A.W = FIN(IN_WIN); A.bias = FIN(IN_FBIAS); A.logf = WSP(float, WS_LOGF);
        rowpass<0>(F, A); } SEAM(1);
    if (IN(2)) { phase_enter(F); pg8::Gemm g{D, D, D}; DenseSched S{(const char*)HB, (const char*)WSP(bf16, WS_WQKV), (size_t)256 * D * 2, (size_t)256 * D * 2, T / 256, 3 * D / 256, (T / 256) * (3 * D / 256), F.G, (int)blockIdx.x};
        pg8::EpiBf16 E{WSP(bf16, WS_Q), D, D, (size_t)(WS_K - WS_Q) / 2, attn_body::C2};
        pg8::gemm_phase<pg8::EpiBf16, DenseSched, true>(F.lds + RING_OFF, g, S, E, F.wave0); } SEAM(2);
    if (IN(3)) { phase_enter(F); const attn_body::AttnTensors AT{(const attn_body::bf16*)WSP(bf16, WS_Q), (const attn_body::bf16*)WSP(bf16, WS_K), (const attn_body::bf16*)WSP(bf16, WS_V), (attn_body::bf16*)WSP(bf16, WS_Q), WSP(float, WS_LOGF)};
        const attn_body::StaticOrder S((int)F.G, (int)blockIdx.x);
        attn_body::attn_phase<attn_body::StaticOrder>((char*)lds + RING_OFF, AT, S, F.wave0); } SEAM(3);
    if (IN(4)) { phase_enter(F); pg8::Gemm g{D, D, D}; DenseSched S{(const char*)WSP(bf16, WS_Q), (const char*)WSP(bf16, WS_WO), (size_t)256 * D * 2, (size_t)256 * D * 2, T / 256, D / 256, (T / 256) * (D / 256), F.G, (int)blockIdx.x};
        pg8::EpiResid E{FIN(IN_X), F.out, mod + 2 * D};
        pg8::gemm_phase<pg8::EpiResid, DenseSched, true>(F.lds + RING_OFF, g, S, E, F.wave0); } SEAM(4);
        if (IN(5)) { phase_enter(F); RowArgs A{}; A.src = F.out; A.g = FIN(IN_NFG) + 0 * D; A.shp = mod + (size_t)0 * 8 * MODW + 3 * D; A.scp = mod + (size_t)0 * 8 * MODW + 4 * D; A.hb = HB;
            A.W = FIN(IN_RW); A.bias = FIN(IN_RB); A.cnt = F.ctl + CW_CNT + 0 * 32 * 64; A.tok = WSP(int, WS_TOK); A.gw = WSP(float, WS_GW);
            rowpass<1>(F, A); } SEAM(5);
        if (IN(6)) { phase_enter(F); build_etab(F, 0); gather_rows(F); } SEAM(6);
        if (IN(7)) { phase_enter(F); build_etab(F, 0); pg8::Gemm g{D, D, D};
            MoeSched<false> S{(const LAS int*)(F.lds + ETAB_OFF), (const char*)WSP(bf16, WS_XS), (const char*)(WSP(bf16, WS_UP) + (size_t)0 * NE * 1024 * 1024), F.G, F.vcu};
            pg8::EpiUp E{WSP(bf16, WS_HH)};
            pg8::gemm_phase<pg8::EpiUp, MoeSched<false>, true>(F.lds + RING_OFF, g, S, E, F.wave0); } SEAM(7);
        if (IN(8)) { phase_enter(F); build_etab(F, 0); pg8::Gemm g{FD, FD, FD};
            MoeSched<true> S{(const LAS int*)(F.lds + ETAB_OFF), (const char*)WSP(bf16, WS_HH), (const char*)(WSP(bf16, WS_DN) + (size_t)0 * NE * 1024 * 512), F.G, F.vcu};
            pg8::EpiDown E{WSP(bf16, WS_Y2), WSP(int, WS_TOK), WSP(float, WS_GW)};
            pg8::gemm_phase<pg8::EpiDown, MoeSched<true>, true>(F.lds + RING_OFF, g, S, E, F.wave0); } SEAM(8);

            if (IN(9)) { phase_enter(F); RowArgs A{}; A.src = F.out; A.dst = F.out; A.g = FIN(IN_NMG) + D; A.shp = mod + 8 * MODW + 0; A.scp = mod + 8 * MODW + D; A.gtp = mod + 5 * D; A.y2 = WSP(bf16, WS_Y2); A.hb = HB;
                rowpass<2>(F, A); } SEAM(9);
            if (IN(10)) { phase_enter(F); pool_rows(F); } SEAM(10);
            if (IN(11)) { phase_enter(F); pg8::Gemm g{D, 256, 256}; PoolSched S{(const char*)WSP(bf16, WS_PL), (const char*)WSP(bf16, WS_WP), F.G, F.vcu};
                pg8::EpiPool E{F.out, mod + 8 * MODW + 2 * D, FIN(IN_POOLS)};
                pg8::gemm_phase<pg8::EpiPool, PoolSched, true>(F.lds + RING_OFF, g, S, E, F.wave0); } SEAM(11);
        if (IN(12)) { phase_enter(F); RowArgs A{}; A.src = F.out; A.g = FIN(IN_NFG) + 1 * D; A.shp = mod + (size_t)1 * 8 * MODW + 3 * D; A.scp = mod + (size_t)1 * 8 * MODW + 4 * D; A.hb = HB;
            A.W = FIN(IN_RW); A.bias = FIN(IN_RB); A.cnt = F.ctl + CW_CNT + 1 * 32 * 64; A.tok = WSP(int, WS_TOK); A.gw = WSP(float, WS_GW);
            rowpass<1>(F, A); } SEAM(12);
        if (IN(13)) { phase_enter(F); build_etab(F, 1); gather_rows(F); } SEAM(13);
        if (IN(14)) { phase_enter(F); build_etab(F, 1); pg8::Gemm g{D, D, D};
            MoeSched<false> S{(const LAS int*)(F.lds + ETAB_OFF), (const char*)WSP(bf16, WS_XS), (const char*)(WSP(bf16, WS_UP) + (size_t)1 * NE * 1024 * 1024), F.G, F.vcu};
            pg8::EpiUp E{WSP(bf16, WS_HH)};
            pg8::gemm_phase<pg8::EpiUp, MoeSched<false>, true>(F.lds + RING_OFF, g, S, E, F.wave0); } SEAM(14);
        if (IN(15)) { phase_enter(F); build_etab(F, 1); pg8::Gemm g{FD, FD, FD};
            MoeSched<true> S{(const LAS int*)(F.lds + ETAB_OFF), (const char*)WSP(bf16, WS_HH), (const char*)(WSP(bf16, WS_DN) + (size_t)1 * NE * 1024 * 512), F.G, F.vcu};
            pg8::EpiDown E{WSP(bf16, WS_Y2), WSP(int, WS_TOK), WSP(float, WS_GW)};
            pg8::gemm_phase<pg8::EpiDown, MoeSched<true>, true>(F.lds + RING_OFF, g, S, E, F.wave0); } SEAM(15);
    if (IN(16)) { phase_enter(F); RowArgs A{}; A.src = F.out; A.dst = F.out; A.g = FIN(IN_NFIN); A.gtp = mod + 8 * MODW + 5 * D; A.y2 = WSP(bf16, WS_Y2);
        rowpass<3>(F, A); }
#undef IN
#undef SEAM
#undef mod
#undef HB
}

extern "C" void kernel_launch(void* const* d_in, const int* in_sizes, int n_in, void* d_out, int out_size, void* d_ws, size_t ws_size, hipStream_t stream) {
    static int grid = 0;
    if (grid == 0) {
        if (n_in != 17 || in_sizes[0] != T * D || out_size != T * D || ws_size < WS_END) { fprintf(stderr, "kernel_launch: unexpected shapes (n_in %d, in0 %d, out %d, ws %zu)\n", n_in, n_in > 0 ? in_sizes[0] : -1, out_size, ws_size); grid = -1; return; }
        int dev = 0, cus = 0, per_cu = 0;
        if (hipGetDevice(&dev) != hipSuccess || hipDeviceGetAttribute(&cus, hipDeviceAttributeMultiprocessorCount, dev) != hipSuccess) { grid = -1; return; }
        if (hipFuncSetAttribute((const void*)fwd_megakernel, hipFuncAttributeMaxDynamicSharedMemorySize, LDS_BYTES) != hipSuccess) { fprintf(stderr, "kernel_launch: hipFuncSetAttribute failed\n"); grid = -1; return; }
        if (hipOccupancyMaxActiveBlocksPerMultiprocessor(&per_cu, (const void*)fwd_megakernel, NWAVES * 64, LDS_BYTES) != hipSuccess || per_cu < 1) { fprintf(stderr, "kernel_launch: occupancy query says %d\n", per_cu); (void)hipGetLastError(); grid = -1; return; }
        grid = cus;
        if (grid != 256) fprintf(stderr, "kernel_launch: %d CUs; this kernel's static work split expects 256\n", grid);
    }
    if (grid < 0) return;
    (void)hipMemsetAsync((char*)d_ws + WS_CTL, 0, CTL_ZERO_BYTES, stream);
    Args a{};
    for (int i = 0; i < 17; ++i) a.in[i] = (const float*)d_in[i];
    a.out = (float*)d_out; a.ws = (unsigned char*)d_ws;
#if MK_MULTI
#ifndef MAXPH
#define MAXPH 17
#endif
    for (int p = 0; p < MAXPH; ++p) { a.ph_lo = p; a.ph_hi = p + 1; hipLaunchKernelGGL(fwd_megakernel, dim3(grid), dim3(NWAVES * 64), LDS_BYTES, stream, a); }
#else
    a.ph_lo = 0; a.ph_hi = 17;
    void* kargs[] = {&a};
    hipError_t e = hipLaunchCooperativeKernel((const void*)fwd_megakernel, dim3(grid), dim3(NWAVES * 64), kargs, LDS_BYTES, stream);
    if (e != hipSuccess) fprintf(stderr, "kernel_launch: cooperative launch failed: %s\n", hipGetErrorString(e));
#endif
}
```

```cpp
#define MK_MULTI 0
#define MAXPH 17
#include <hip/hip_runtime.h>
#include <hip/hip_bf16.h>
#include <cstdio>
#include <cstdint>
#include <cmath>
__device__ __forceinline__ int opaque_tid(int wave0) { int w = wave0; asm volatile("" : "+s"(w)); unsigned m = ~0u; asm volatile("" : "+s"(m)); const int l = (int)__builtin_amdgcn_mbcnt_hi(m, __builtin_amdgcn_mbcnt_lo(m, 0u)); return w * 64 + l; }
namespace pg8 {
#define PG8_LAS __attribute__((address_space(3)))
typedef unsigned short bf16_t;
typedef short bf16x8 __attribute__((ext_vector_type(8)));
typedef float f32x4 __attribute__((ext_vector_type(4)));
typedef float f32x2 __attribute__((ext_vector_type(2)));
typedef unsigned u32x4 __attribute__((ext_vector_type(4)));
constexpr int BM = 256, BK = 64, HALF = 128, HTB = HALF * BK * 2  , STAGE_BYTES = 8 * HTB, NXCD = 8, WGM = 8;

__host__ __device__ __forceinline__ int lds_byte(int r, int c) { const int st = (r >> 4) * 2 + (c >> 5), rr = r & 15, cc = c & 31, ob = rr * 64 + cc * 2; return st * 1024 + (ob ^ (((ob >> 9) & 1) << 5)); }
__host__ __device__ __forceinline__ void stage_rc(int b, int& R, int& C) { const int st = b / 1024, sb = b % 1024, swz = sb ^ (((sb >> 9) & 1) << 5); R = (st >> 1) * 16 + swz / 64; C = (st & 1) * 32 + (swz % 64) / 2; }
__host__ __device__ __forceinline__ int perm32(int rho) { const int n = rho >> 4, i = rho & 15; return 8 * (i >> 2) + 4 * n + (i & 3); }

struct Unit { const char* a; const char* b; int pm, pn, x0, x1; };
struct Gemm { int lda, ldb, K; };

__device__ __forceinline__ unsigned cvt_pk_bf16(float lo, float hi) { unsigned r; asm volatile("v_cvt_pk_bf16_f32 %0, %1, %2" : "=v"(r) : "v"(lo), "v"(hi)); return r; }


struct EpiBf16 {
    static constexpr bool PERM = true, AFTER_DRAIN = false;
    bf16_t* O; int ldc; int split_cols; size_t split_stride; float scale0;
    __device__ __forceinline__ void operator()(const f32x4 (&acc)[2][2][4][2], const Unit& u, int wr, int wc, int fr, int fq) const {
        const int row0 = u.pm * BM + wr * 64 + fr; int colt = u.pn * BM; bf16_t* base = O;
        float sc = 1.f; if (split_cols) { const int t = colt / split_cols; base += (size_t)t * split_stride; colt -= t * split_cols; if (t == 0) sc = scale0; }
        const int col0 = colt + wc * 32 + 8 * fq;
#pragma unroll
        for (int ai = 0; ai < 2; ++ai)
#pragma unroll
            for (int m = 0; m < 4; ++m) { bf16_t* rowp = base + (size_t)(row0 + ai * HALF + m * 16) * ldc + col0;
#pragma unroll
                for (int bj = 0; bj < 2; ++bj) { f32x4 v0 = acc[ai][bj][m][0] * sc, v1 = acc[ai][bj][m][1] * sc;
                    u32x4 w; w.x = cvt_pk_bf16(v0[0], v0[1]); w.y = cvt_pk_bf16(v0[2], v0[3]); w.z = cvt_pk_bf16(v1[0], v1[1]); w.w = cvt_pk_bf16(v1[2], v1[3]);
                    *(u32x4*)(rowp + bj * HALF) = w; } }
    }
};
struct EpiQKV {
    static constexpr bool PERM = true, AFTER_DRAIN = false;
    bf16_t* O; size_t stride; float scale0; unsigned* qkm;
    __device__ __forceinline__ void operator()(const f32x4 (&acc)[2][2][4][2], const Unit& u, int wr, int wc, int fr, int fq) const {
        const int t = u.pn >> 2, colt = (u.pn & 3) * BM, b = u.pm >> 4; bf16_t* base = O + (size_t)t * stride;
        const float sc = (t == 0) ? scale0 : 1.f;
        const int row0 = u.pm * BM + wr * 64 + fr, col0 = colt + wc * 32 + 8 * fq, lane = fr + 16 * fq;
        float mx0 = 0.f, mx1 = 0.f;
#pragma unroll
        for (int ai = 0; ai < 2; ++ai)
#pragma unroll
            for (int m = 0; m < 4; ++m) { bf16_t* rowp = base + (size_t)(row0 + ai * HALF + m * 16) * 1024 + col0;
#pragma unroll
                for (int bj = 0; bj < 2; ++bj) { const f32x4 v0 = acc[ai][bj][m][0] * sc, v1 = acc[ai][bj][m][1] * sc;
                    u32x4 w; w.x = cvt_pk_bf16(v0[0], v0[1]); w.y = cvt_pk_bf16(v0[2], v0[3]); w.z = cvt_pk_bf16(v1[0], v1[1]); w.w = cvt_pk_bf16(v1[2], v1[3]);
                    *(u32x4*)(rowp + bj * HALF) = w;
                    if (t < 2) { float ss = (v0[0] * v0[0] + v0[1] * v0[1]) + (v0[2] * v0[2] + v0[3] * v0[3]) + (v1[0] * v1[0] + v1[1] * v1[1]) + (v1[2] * v1[2] + v1[3] * v1[3]);
                        ss += __int_as_float(__builtin_amdgcn_ds_bpermute((lane ^ 16) << 2, __float_as_int(ss))); ss += __int_as_float(__builtin_amdgcn_ds_bpermute((lane ^ 32) << 2, __float_as_int(ss)));
                        if (bj == 0) mx0 = fmaxf(mx0, ss); else mx1 = fmaxf(mx1, ss); } } }
        if (t < 2) {
#pragma unroll
            for (int o = 1; o < 16; o <<= 1) { mx0 = fmaxf(mx0, __int_as_float(__builtin_amdgcn_ds_bpermute((lane ^ o) << 2, __float_as_int(mx0)))); mx1 = fmaxf(mx1, __int_as_float(__builtin_amdgcn_ds_bpermute((lane ^ o) << 2, __float_as_int(mx1)))); }
            if (lane == 0) { unsigned* w = qkm + (t * 8 + b) * 32 + (u.pn & 3) * 8 + wc; atomicMax(w, __float_as_uint(mx0)); atomicMax(w + 4, __float_as_uint(mx1)); } }
    }
};
struct EpiResid {
    static constexpr bool PERM = false, AFTER_DRAIN = false;
    const float* base; float* out; const float* gate;
    __device__ __forceinline__ void operator()(const f32x4 (&acc)[2][2][4][2], const Unit& u, int wr, int wc, int fr, int fq) const {
        const int col0 = u.pn * BM + wc * 32 + 4 * fq; const int b = u.pm >> 4;
        f32x4 gv[2][2];
#pragma unroll
        for (int bj = 0; bj < 2; ++bj)
#pragma unroll
            for (int n = 0; n < 2; ++n) gv[bj][n] = *(const f32x4*)(gate + (size_t)b * 6144 + col0 + bj * HALF + n * 16);
#pragma unroll
        for (int ai = 0; ai < 2; ++ai)
#pragma unroll
            for (int m = 0; m < 4; ++m) { const size_t off = (size_t)(u.pm * BM + ai * HALF + wr * 64 + m * 16 + fr) * 1024 + col0;
#pragma unroll
                for (int bj = 0; bj < 2; ++bj)
#pragma unroll
                    for (int n = 0; n < 2; ++n) { const f32x4 bs = *(const f32x4*)(base + off + bj * HALF + n * 16); *(f32x4*)(out + off + bj * HALF + n * 16) = bs + gv[bj][n] * acc[ai][bj][m][n]; }
                if (m & 1) asm volatile("" ::: "memory"); }
    }
};
struct EpiPool {
    static constexpr bool PERM = false, AFTER_DRAIN = false;
    float* xr; const float* gate; const float* pscale;
    __device__ __forceinline__ void operator()(const f32x4 (&acc)[2][2][4][2], const Unit& u, int wr, int wc, int fr, int fq) const {
        const int col0 = u.pn * BM + wc * 32 + 4 * fq; const int b = u.pm >> 4;
        float* rbase = xr + (size_t)(u.pm * BM + wr * 64 + fr) * 1024 + col0;
#pragma unroll
        for (int bj = 0; bj < 2; ++bj)
#pragma unroll
            for (int n = 0; n < 2; ++n) { const f32x4 gv = *(const f32x4*)(gate + (size_t)b * 6144 + col0 + bj * HALF + n * 16) * *(const f32x4*)(pscale + col0 + bj * HALF + n * 16);
#pragma unroll
                for (int ai = 0; ai < 2; ++ai)
#pragma unroll
                    for (int m = 0; m < 4; ++m) { float* p = rbase + (size_t)(ai * HALF + m * 16) * 1024 + bj * HALF + n * 16; const f32x4 bs = *(const f32x4*)p; *(f32x4*)p = bs + gv * acc[ai][bj][m][n]; }
                asm volatile("" ::: "memory"); }
    }
};
__device__ __forceinline__ float silu_mul(float g, float u) { return g * u * __builtin_amdgcn_rcpf(1.0f + __builtin_amdgcn_exp2f(-1.4426950408889634f * g)); }
struct EpiUp {
    static constexpr bool PERM = true, AFTER_DRAIN = false;
    bf16_t* H;
    __device__ __forceinline__ void operator()(const f32x4 (&acc)[2][2][4][2], const Unit& u, int wr, int wc, int fr, int fq) const {
        const int row0 = u.x1 + wr * 64 + fr, col0 = u.x0 * 128 + wc * 32 + 8 * fq;
#pragma unroll
        for (int ai = 0; ai < 2; ++ai)
#pragma unroll
            for (int m = 0; m < 4; ++m) { bf16_t* rowp = H + (size_t)(row0 + ai * HALF + m * 16) * 512 + col0;
                const f32x4 g0 = acc[ai][0][m][0], g1 = acc[ai][0][m][1], u0 = acc[ai][1][m][0], u1 = acc[ai][1][m][1];
                u32x4 w; w.x = cvt_pk_bf16(silu_mul(g0[0], u0[0]), silu_mul(g0[1], u0[1])); w.y = cvt_pk_bf16(silu_mul(g0[2], u0[2]), silu_mul(g0[3], u0[3]));
                w.z = cvt_pk_bf16(silu_mul(g1[0], u1[0]), silu_mul(g1[1], u1[1])); w.w = cvt_pk_bf16(silu_mul(g1[2], u1[2]), silu_mul(g1[3], u1[3]));
                *(u32x4*)rowp = w; }
    }
};
struct EpiDown {
    static constexpr bool PERM = true, AFTER_DRAIN = false;
    bf16_t* Y; const int* tok; const float* gw;
    __device__ __forceinline__ void operator()(const f32x4 (&acc)[2][2][4][2], const Unit& u, int wr, int wc, int fr, int fq) const {
        const int col0 = u.pn * BM + wc * 32 + 8 * fq;
#pragma unroll
        for (int ai = 0; ai < 2; ++ai)
#pragma unroll
            for (int m = 0; m < 4; ++m) { const int rl = ai * HALF + wr * 64 + m * 16 + fr;
                if (rl < u.x1) { const int d = tok[u.x0 + rl]; const float w8 = gw[u.x0 + rl]; bf16_t* rowp = Y + (size_t)d * 1024 + col0;
#pragma unroll
                    for (int bj = 0; bj < 2; ++bj) { const f32x4 v0 = acc[ai][bj][m][0] * w8, v1 = acc[ai][bj][m][1] * w8;
                        u32x4 w; w.x = cvt_pk_bf16(v0[0], v0[1]); w.y = cvt_pk_bf16(v0[2], v0[3]); w.z = cvt_pk_bf16(v1[0], v1[1]); w.w = cvt_pk_bf16(v1[2], v1[3]);
                        *(u32x4*)(rowp + bj * HALF) = w; } } }
    }
};

template <class Epi, class Sched, bool ALIGN_EPI>
__device__ __forceinline__ void gemm_phase(PG8_LAS unsigned char* lds, const Gemm g, const Sched& S, const Epi& E, int wave0) {
    int tid_ = opaque_tid(wave0);
    const int tid = tid_, wid = __builtin_amdgcn_readfirstlane(tid >> 6), lane = tid & 63, wr = wid >> 2, wc = wid & 3, fr = lane & 15, fq = lane >> 4;
    const int K = g.K, nt = K / BK;
    unsigned voffA[2], voffB[2];
#pragma unroll
    for (int i = 0; i < 2; ++i) { int R, C; stage_rc(tid * 16 + i * 8192, R, C); const int Rb = Epi::PERM ? ((R & ~31) + perm32(R & 31)) : R;
        voffA[i] = (unsigned)(R * g.lda + C) * 2u; voffB[i] = (unsigned)(Rb * g.ldb + C) * 2u; }
    const size_t kstep = (size_t)(BK * 2);
    const size_t hstepA = (size_t)HALF * g.lda * 2, hstepB = (size_t)HALF * g.ldb * 2;
    const unsigned ldsw = (unsigned)wid * 1024u;
    const int aoff = lds_byte(wr * 64 + fr, fq * 8), boff = lds_byte(wc * 32 + fr, fq * 8);
#define PG8_SA(b, h) (((b) * 2 + (h)) * HTB)
#define PG8_SB(b, h) ((4 + (b) * 2 + (h)) * HTB)
#define PG8_STAGE(bufoff, gbase, voff) do { _Pragma("unroll") for (int _i = 0; _i < 2; ++_i) \
        __builtin_amdgcn_global_load_lds((const unsigned*)((const char*)(gbase) + (voff)[_i]), (PG8_LAS unsigned*)(lds + (bufoff) + ldsw + _i * 8192), 16, 0, 0); } while (0)
#define PG8_LDA(dst, b, h) do { _Pragma("unroll") for (int m = 0; m < 4; ++m) _Pragma("unroll") for (int k = 0; k < 2; ++k) dst[m][k] = *(const PG8_LAS bf16x8*)(lds + PG8_SA(b, h) + aoff + m * 2048 + k * 1024); } while (0)
#define PG8_LDB(dst, b, h) do { _Pragma("unroll") for (int n = 0; n < 2; ++n) _Pragma("unroll") for (int k = 0; k < 2; ++k) dst[n][k] = *(const PG8_LAS bf16x8*)(lds + PG8_SB(b, h) + boff + n * 2048 + k * 1024); } while (0)
#define PG8_MMA(ai, bj, At, Bt) do { __builtin_amdgcn_s_setprio(1); _Pragma("unroll") for (int m = 0; m < 4; ++m) _Pragma("unroll") for (int n = 0; n < 2; ++n) _Pragma("unroll") for (int k = 0; k < 2; ++k) \
        acc[ai][bj][m][n] = __builtin_amdgcn_mfma_f32_16x16x32_bf16(Bt[n][k], At[m][k], acc[ai][bj][m][n], 0, 0, 0); __builtin_amdgcn_s_setprio(0); } while (0)
#define PG8_WAIT_V(n) asm volatile("s_waitcnt vmcnt(" #n ")" ::: "memory")
#define PG8_WAIT_L(n) asm volatile("s_waitcnt lgkmcnt(" #n ")" ::: "memory")
#define PG8_BAR __builtin_amdgcn_s_barrier()
#define PG8_SCHED __builtin_amdgcn_sched_barrier(0)
    Unit cur, nxt; int ui = 0;
    if (!S.next(0, cur)) return;
    f32x4 acc[2][2][4][2];
#pragma unroll
    for (int a = 0; a < 2; ++a)
#pragma unroll
        for (int b = 0; b < 2; ++b)
#pragma unroll
            for (int m = 0; m < 4; ++m)
#pragma unroll
                for (int n = 0; n < 2; ++n) acc[a][b][m][n] = (f32x4){0.f, 0.f, 0.f, 0.f};
    bf16x8 At[4][2], B0[2][2], B1[2][2];
    const char* cA = cur.a; const char* cB = cur.b;
    PG8_STAGE(PG8_SB(0, 0), cB, voffB); PG8_STAGE(PG8_SB(0, 1), cB + hstepB, voffB); PG8_STAGE(PG8_SA(0, 0), cA, voffA); PG8_STAGE(PG8_SA(0, 1), cA + hstepA, voffA);
    if (wr == 1) PG8_BAR;
    PG8_WAIT_V(2); PG8_BAR;
    PG8_STAGE(PG8_SB(1, 0), cB + kstep, voffB); PG8_STAGE(PG8_SA(1, 0), cA + kstep, voffA); PG8_STAGE(PG8_SB(1, 1), cB + hstepB + kstep, voffB);
    PG8_WAIT_V(6); PG8_BAR;
    for (;;) {
        const bool has_next = S.next(ui + 1, nxt);
        const char* nA = has_next ? nxt.a : cA; const char* nB = has_next ? nxt.b : cB;
        for (int t = 0; t < nt; t += 2) {
            const bool last = (t == nt - 2);
            const char* a1 = cA + (size_t)(t + 1) * kstep;
            const char* a2 = last ? nA : cA + (size_t)(t + 2) * kstep; const char* b2 = last ? nB : cB + (size_t)(t + 2) * kstep;
            const char* a3 = a2 + kstep; const char* b3 = b2 + kstep;
            PG8_LDB(B0, 0, 0); PG8_LDB(B1, 0, 1); PG8_SCHED; PG8_LDA(At, 0, 0); PG8_STAGE(PG8_SA(1, 1), a1 + hstepA, voffA);
            PG8_WAIT_V(8); PG8_WAIT_L(0); PG8_BAR; PG8_MMA(0, 0, At, B0); PG8_MMA(0, 1, At, B1); PG8_BAR; PG8_SCHED;
            PG8_LDA(At, 0, 1); PG8_STAGE(PG8_SB(0, 0), b2, voffB); PG8_STAGE(PG8_SB(0, 1), b2 + hstepB, voffB); PG8_STAGE(PG8_SA(0, 0), a2, voffA);
            PG8_WAIT_V(8); PG8_WAIT_L(0); PG8_BAR; PG8_MMA(1, 0, At, B0); PG8_MMA(1, 1, At, B1); PG8_BAR; PG8_SCHED;
            PG8_LDB(B0, 1, 0); PG8_LDB(B1, 1, 1); PG8_SCHED; PG8_LDA(At, 1, 0); PG8_STAGE(PG8_SA(0, 1), a2 + hstepA, voffA);
            PG8_WAIT_V(8); PG8_WAIT_L(0); PG8_BAR; PG8_MMA(0, 0, At, B0); PG8_MMA(0, 1, At, B1); PG8_BAR; PG8_SCHED;
            PG8_LDA(At, 1, 1); PG8_STAGE(PG8_SB(1, 0), b3, voffB); PG8_STAGE(PG8_SB(1, 1), b3 + hstepB, voffB); PG8_STAGE(PG8_SA(1, 0), a3, voffA);
            PG8_WAIT_V(8); PG8_WAIT_L(0); PG8_BAR; PG8_MMA(1, 0, At, B0); PG8_MMA(1, 1, At, B1); PG8_BAR; PG8_SCHED;
        }
        if constexpr (ALIGN_EPI) { if (wr == 0) PG8_BAR; }
        E(acc, cur, wr, wc, fr, fq);
        if (!has_next) break;
#pragma unroll
        for (int a = 0; a < 2; ++a)
#pragma unroll
            for (int b = 0; b < 2; ++b)
#pragma unroll
                for (int m = 0; m < 4; ++m)
#pragma unroll
                    for (int n = 0; n < 2; ++n) acc[a][b][m][n] = (f32x4){0.f, 0.f, 0.f, 0.f};
        cur = nxt; cA = nA; cB = nB; ++ui;
        if constexpr (ALIGN_EPI) { if (wr == 1) PG8_BAR; }
    }
    PG8_WAIT_V(0);
    if constexpr (!ALIGN_EPI) { if (wr == 0) PG8_BAR; }
    PG8_BAR;
#undef PG8_SA
#undef PG8_SB
#undef PG8_STAGE
#undef PG8_LDA
#undef PG8_LDB
#undef PG8_MMA
#undef PG8_WAIT_V
#undef PG8_WAIT_L
#undef PG8_BAR
#undef PG8_SCHED
}
}
namespace attn_body {
using bf16=__hip_bfloat16;
using bf16x8=__attribute__((ext_vector_type(8)))short;
using s16x4=__attribute__((ext_vector_type(4)))short;
using f32x16=__attribute__((ext_vector_type(16)))float;
using f32x4=__attribute__((ext_vector_type(4)))float;
using u32x4=__attribute__((ext_vector_type(4)))unsigned;
constexpr int BATCH=8,NHEAD=16,SEQ=4096,D=64,DM=NHEAD*D;
constexpr int NW=8,QBLK=32,QB=QBLK*NW,KVBLK=64,NQB=SEQ/QB;
constexpr int ATTN_PITCH=DM, ATTN_UNIT_ROWS=QB;
__device__ __forceinline__ int crow(int r,int hi){return (r&3)+8*(r>>2)+4*hi;}
#define SBAR() __builtin_amdgcn_sched_barrier(0)
__device__ __forceinline__ void cmask(f32x16&p0,f32x16&p1,int jb,int qrel,int hi){
  const float NEG=-INFINITY; int kb=64*jb+4*hi;
  #pragma unroll
  for(int r=0;r<16;++r){int kv=kb+(r&3)+8*(r>>2); if(kv>qrel)p0[r]=NEG; if(kv+32>qrel)p1[r]=NEG;}
}

constexpr int NSLOT=3, SLOTB=8192;
constexpr int LDS_K=0, LDS_V=NSLOT*SLOTB, LDS_WS=2*NSLOT*SLOTB, LDS_OST=LDS_WS+NW*64*4, LDS_FS=LDS_OST+NW*4096, LDS_WT=LDS_FS+SEQ*4, LDS_BYTES=LDS_WT+64;
constexpr float C2=0.125f*1.4426950408889634f;
constexpr float LOG2E=1.4426950408889634f;
__device__ __forceinline__ void glds16(const void*gsrc,unsigned lds_dst){unsigned keep;
  asm volatile("s_mov_b32 %0, m0\n\ts_mov_b32 m0, %2\n\ts_nop 0\n\tglobal_load_lds_dwordx4 %1, off\n\ts_mov_b32 m0, %0":"=&s"(keep):"v"(gsrc),"s"(lds_dst):"memory");}
__device__ __forceinline__ void glds16s(const void*sbase,unsigned voff,unsigned lds_dst){unsigned keep;
  asm volatile("s_mov_b32 %0, m0\n\ts_mov_b32 m0, %3\n\ts_nop 4\n\tglobal_load_lds_dwordx4 %1, %2\n\ts_mov_b32 m0, %0":"=&s"(keep):"v"(voff),"s"(sbase),"s"(lds_dst):"memory");}
__device__ __forceinline__ float max3f(float a,float b,float c){float r;asm("v_max3_f32 %0, %1, %2, %3":"=v"(r):"v"(a),"v"(b),"v"(c));return r;}
__device__ __forceinline__ float max2f(float a,float b){float r;asm("v_max_f32_e32 %0, %1, %2":"=v"(r):"v"(a),"v"(b));return r;}
__device__ __forceinline__ float fadd_s(float a,float b){float r;asm("v_add_f32_e32 %0, %1, %2":"=v"(r):"v"(a),"v"(b));return r;}
__device__ __forceinline__ float fsub_s(float a,float b){float r;asm("v_sub_f32_e32 %0, %1, %2":"=v"(r):"v"(a),"v"(b));return r;}
typedef float f32x2_t __attribute__((ext_vector_type(2))); typedef __bf16 bf16x2_t __attribute__((ext_vector_type(2)));
__device__ __forceinline__ unsigned cvtpk_s(float lo,float hi){f32x2_t v={lo,hi};bf16x2_t b=__builtin_convertvector(v,bf16x2_t);return __builtin_bit_cast(unsigned,b);}
#define WAIT_BAR(N) asm volatile("s_waitcnt vmcnt(" #N ") lgkmcnt(0)\n\ts_barrier":::"memory")

typedef __attribute__((address_space(3))) const char* lds_cptr;
typedef short v4i16_t __attribute__((ext_vector_type(4)));
__device__ __forceinline__ void fbias(f32x16&c0,f32x16&c1,lds_cptr ft,float nm,int hi){
  #pragma unroll
  for(int g=0;g<4;++g){
    const f32x4 a=*(const __attribute__((address_space(3))) f32x4*)(ft+(8*g+4*hi)*4);
    const f32x4 b=*(const __attribute__((address_space(3))) f32x4*)(ft+(32+8*g+4*hi)*4);
    c0[4*g+0]=nm-a[0];c0[4*g+1]=nm-a[1];c0[4*g+2]=nm-a[2];c0[4*g+3]=nm-a[3];
    c1[4*g+0]=nm-b[0];c1[4*g+1]=nm-b[1];c1[4*g+2]=nm-b[2];c1[4*g+3]=nm-b[3];}
}
__device__ __forceinline__ void qkt(f32x16&p0,f32x16&p1,const char*Kslot,const bf16x8*qr,int r32,int hi){
  const char*kb=Kslot+hi*1024+r32*16;
  #pragma unroll
  for(int d0=0;d0<4;++d0){
    const bf16x8 b0=*reinterpret_cast<const bf16x8*>(kb+d0*2048);
    const bf16x8 b1=*reinterpret_cast<const bf16x8*>(kb+d0*2048+512);
    p0=__builtin_amdgcn_mfma_f32_32x32x16_bf16(b0,qr[d0],p0,0,0,0);p1=__builtin_amdgcn_mfma_f32_32x32x16_bf16(b1,qr[d0],p1,0,0,0);}
}
__device__ __forceinline__ void kload8(bf16x8*kf,lds_cptr kp){
  kf[0]=*(const __attribute__((address_space(3))) bf16x8*)(kp);      kf[1]=*(const __attribute__((address_space(3))) bf16x8*)(kp+512);
  kf[2]=*(const __attribute__((address_space(3))) bf16x8*)(kp+2048); kf[3]=*(const __attribute__((address_space(3))) bf16x8*)(kp+2560);
  kf[4]=*(const __attribute__((address_space(3))) bf16x8*)(kp+4096); kf[5]=*(const __attribute__((address_space(3))) bf16x8*)(kp+4608);
  kf[6]=*(const __attribute__((address_space(3))) bf16x8*)(kp+6144); kf[7]=*(const __attribute__((address_space(3))) bf16x8*)(kp+6656);
}
__device__ __forceinline__ void kload2(bf16x8*kf,lds_cptr kp,int j){ kf[2*j]=*(const __attribute__((address_space(3))) bf16x8*)(kp+j*2048); kf[2*j+1]=*(const __attribute__((address_space(3))) bf16x8*)(kp+j*2048+512); }
__device__ __forceinline__ s16x4 vtr(lds_cptr p){ return __builtin_bit_cast(s16x4,__builtin_amdgcn_ds_read_tr16_b64_v4i16((__attribute__((address_space(3))) v4i16_t*)p)); }
__device__ __forceinline__ float rowmax(const f32x16&p0,const f32x16&p1){
  float a=max3f(p0[0],p0[1],p1[0]),b=max3f(p0[2],p0[3],p1[1]);a=max3f(a,p1[2],p1[3]);
  #pragma unroll
  for(int r=4;r<16;r+=4){a=max3f(a,p0[r],p0[r+1]);b=max3f(b,p0[r+2],p0[r+3]);a=max3f(a,p1[r],p1[r+1]);b=max3f(b,p1[r+2],p1[r+3]);}
  const float m=max2f(a,b);
  auto rr=__builtin_amdgcn_permlane32_swap(__float_as_uint(m),__float_as_uint(m),false,false);
  return max2f(__uint_as_float(rr[0]),__uint_as_float(rr[1]));
}
__device__ __forceinline__ void pv(f32x16*o,int vb,bf16x8 pa0,bf16x8 pa1,bf16x8 pa2,bf16x8 pa3){
  #pragma unroll
  for(int d0=0;d0<2;++d0){s16x4 lo[4],hi[4];
    #pragma unroll
    for(int ks=0;ks<4;++ks){
      asm volatile("ds_read_b64_tr_b16 %0,%1 offset:%c2":"=&v"(lo[ks]):"v"(vb),"i"(d0*4096+ks*1024):"memory");
      asm volatile("ds_read_b64_tr_b16 %0,%1 offset:%c2":"=&v"(hi[ks]):"v"(vb),"i"(d0*4096+ks*1024+512):"memory");}
    asm volatile("s_waitcnt lgkmcnt(0)":::"memory");SBAR();
    #define PK(k) (bf16x8){lo[k][0],lo[k][1],lo[k][2],lo[k][3],hi[k][0],hi[k][1],hi[k][2],hi[k][3]}
    o[d0]=__builtin_amdgcn_mfma_f32_32x32x16_bf16(pa0,PK(0),o[d0],0,0,0);
    o[d0]=__builtin_amdgcn_mfma_f32_32x32x16_bf16(pa1,PK(1),o[d0],0,0,0);
    o[d0]=__builtin_amdgcn_mfma_f32_32x32x16_bf16(pa2,PK(2),o[d0],0,0,0);
    o[d0]=__builtin_amdgcn_mfma_f32_32x32x16_bf16(pa3,PK(3),o[d0],0,0,0);
    #undef PK
  }
}

#ifndef ATTN_STORE16
#define ATTN_STORE16(p,v) (*(u32x4*)(p)=(v))
#endif
template<int THRL> __device__ __forceinline__ void attn_unit(int b,int h,int qb,const bf16*Q,const bf16*__restrict__ K,const bf16*__restrict__ V,bf16*O,const float*LF,char*shm,int wave0){
  int tid_=opaque_tid(wave0);
  const int tid=tid_,lane=tid&63,r32=lane&31,hi=lane>>5; const int wid=__builtin_amdgcn_readfirstlane(tid>>6);
  const long rowbase=(long)b*SEQ; const int q0=qb*QB;
  const bf16*Qw=Q+(rowbase+q0+wid*QBLK)*DM+h*D;
  const bf16*Kh=K+rowbase*DM+h*D,*Vh=V+rowbase*DM+h*D;
  const unsigned lds0=(unsigned)(uintptr_t)shm;
  float*wsf=(float*)(shm+LDS_WS)+wid*64;
  const lds_cptr shm3=(lds_cptr)shm;
  { const int n=q0+QB; const float*lf=LF+((long)b*NHEAD+h)*SEQ;
    volatile __attribute__((address_space(3))) float*wt=(volatile __attribute__((address_space(3))) float*)(shm3+LDS_WT);
    f32x4 v0=(f32x4){0.f,0.f,0.f,0.f},v1=(f32x4){0.f,0.f,0.f,0.f};
    if(8*tid<n){v0=*(const f32x4*)(lf+8*tid);v1=*(const f32x4*)(lf+8*tid+4);}
    v0[1]+=v0[0];v0[2]+=v0[1];v0[3]+=v0[2];v1[0]+=v0[3];v1[1]+=v1[0];v1[2]+=v1[1];v1[3]+=v1[2];
    const float tot=v1[3]; float inc=tot;
    #pragma unroll
    for(int o_=1;o_<64;o_<<=1){const float t_=__int_as_float(__builtin_amdgcn_ds_bpermute((lane-o_)<<2,__float_as_int(inc)));if(lane>=o_)inc+=t_;}
    if(lane==63)wt[wid]=inc;
    __syncthreads();
    float base=inc-tot;
    #pragma unroll
    for(int w_=0;w_<NW;++w_){const float x_=wt[w_]; if(w_<wid)base+=x_;}
    if(tid==(q0>>3))wt[8]=base+v0[0];
    __syncthreads();
    const float anc=wt[8];
    if(8*tid<n){ __attribute__((address_space(3))) f32x4*fo=(__attribute__((address_space(3))) f32x4*)(shm3+LDS_FS)+2*tid;
      fo[0]=(v0+(base-anc))*LOG2E; fo[1]=(v1+(base-anc))*LOG2E; }
  }
  const lds_cptr fs3=shm3+LDS_FS;
  const bf16*ksrc=Kh+(long)lane*DM+wid*8;
  const bf16*vsrc=Vh+(long)(16*(wid&3)+(lane>>2))*DM+(wid>>2)*32+(lane&3)*8;
  const unsigned kdst=lds0+LDS_K+wid*1024, vdst=lds0+LDS_V+wid*1024;
  #define DMA_K(t,slot) glds16(ksrc+(long)(t)*KVBLK*DM,(unsigned)__builtin_amdgcn_readfirstlane(kdst+(slot)))
  #define DMA_V(t,slot) glds16(vsrc+(long)(t)*KVBLK*DM,(unsigned)__builtin_amdgcn_readfirstlane(vdst+(slot)))
  const int vb0=(int)(lds0+LDS_V)+((lane>>4)&1)*32+(lane&3)*8+(4*hi+((lane&15)>>2))*64;
  const char*Kbase=shm+LDS_K; bf16x8 kf[8];
  const lds_cptr kp0=shm3+LDS_K+hi*1024+r32*16; const lds_cptr vp0=shm3+LDS_V+((lane>>4)&1)*32+(lane&3)*8+(4*hi+((lane&15)>>2))*64;
  const int NT=(q0+QB)/KVBLK;
  DMA_K(0,0);DMA_V(0,0);DMA_K(1,SLOTB);
  bf16x8 qr[4];
  #pragma unroll
  for(int d0=0;d0<4;++d0)qr[d0]=*reinterpret_cast<const bf16x8*>(&Qw[(long)r32*DM+d0*16+hi*8]);
  float mhat=0.f,l_reg=0.f;f32x16 o[2];o[0]=f32x16{};o[1]=f32x16{};
  const int qrel=wid*QBLK+r32;
  #define CMASK(P0,P1,t) do{int jb_=(t)-(NT-4); if(jb_>=0)cmask(P0,P1,jb_,qrel,hi);}while(0)
  bool resc=false;
  #define START(P0,P1) do{ const float rm=rowmax(P0,P1); resc=false; \
    { const float dl=rm; mhat=fadd_s(mhat,dl); \
      _Pragma("unroll") for(int r=0;r<16;++r){P0[r]=fsub_s(P0[r],dl);P1[r]=fsub_s(P1[r],dl);} } \
    _Pragma("unroll") for(int r=0;r<16;++r)P0[r]=__builtin_amdgcn_exp2f(P0[r]); }while(0)
  #define RESC() do{ if(resc){ asm volatile("s_waitcnt lgkmcnt(0)":::"memory"); \
      _Pragma("unroll") for(int d_=0;d_<2;++d_) _Pragma("unroll") for(int r=0;r<16;++r)o[d_][r]*=wsf[crow(r,hi)]; } }while(0)
  f32x16 pA0,pA1,pB0,pB1;
  int sl_prev=0,sl_cur=0,sl_next=SLOTB;
  #define ROT() do{sl_prev=sl_cur;sl_cur=sl_next;sl_next=(sl_next==(NSLOT-1)*SLOTB)?0:sl_next+SLOTB;}while(0)
  DMA_K(2,2*SLOTB);
  WAIT_BAR(3);
  fbias(pA0,pA1,fs3,0.f,hi);
  qkt(pA0,pA1,Kbase,qr,r32,hi);asm volatile("s_nop 15\n\ts_nop 7":"+v"(pA0),"+v"(pA1));CMASK(pA0,pA1,0);
  START(pA0,pA1);
  _Pragma("unroll") for(int r=0;r<16;++r)pA1[r]=__builtin_amdgcn_exp2f(pA1[r]);
  WAIT_BAR(0);
  DMA_K(3,0);DMA_V(1,SLOTB);
  ROT();
  kload8(kf,kp0+sl_cur);
  WAIT_BAR(2);
  s16x4 vlo[8],vhi[8]; u32x4 pw0,pw1,pw2,pw3;
  #define PKW(P,B) cvtpk_s(P[B],P[B+1])
  #define PAF(k) __builtin_bit_cast(bf16x8,pw##k)
  #define VFR(i) (bf16x8){vlo[i][0],vlo[i][1],vlo[i][2],vlo[i][3],vhi[i][0],vhi[i][1],vhi[i][2],vhi[i][3]}
  #define PIN(x) asm volatile("":"+v"(x))
  #define MX3(a,b,c) __builtin_fmaxf(__builtin_fmaxf((a),(b)),(c))
  #define GAPA(MF,A0,A1,A2,A3,W0,W1,PW) do{ MF; sacc+=A0; sacc+=A1; sacc+=A2; sacc+=A3; PIN(sacc); W0; W1; PIN(PW); SBAR(); }while(0)
  #define EX(v) __builtin_amdgcn_exp2f(v)
  #define GAPB(MF,X,B) do{ MF; X[B]=EX(X[B]); X[B+1]=EX(X[B+1]); X[B+2]=EX(X[B+2]); X[B+3]=EX(X[B+3]); PIN(X); SBAR(); }while(0)
  #define VRD(i) do{ vlo[i]=vtr(vp_+(((i)>>2)*4096+((i)&3)*1024)); vhi[i]=vtr(vp_+(((i)>>2)*4096+((i)&3)*1024+512)); }while(0)
  #define KRD(G,j) do{ if(G){ kload2(kf,kp0+sl_next,j); SBAR(); } }while(0)
  #define STEP(C0,C1,P0,P1,t,GK,GV,GL) do{ SBAR(); \
    const lds_cptr vp_=vp0+sl_prev; \
    fbias(C0,C1,fs3+(t)*256,-mhat,hi); SBAR(); \
    VRD(0); SBAR(); float sacc=(P0[0]+P0[1]); \
    GAPA(C0=__builtin_amdgcn_mfma_f32_32x32x16_bf16(kf[0],qr[0],C0,0,0,0), P0[2],P0[3],P0[4],P0[5],     pw0[0]=PKW(P0,0), pw0[1]=PKW(P0,2), pw0); \
    VRD(4); SBAR(); GAPA(C1=__builtin_amdgcn_mfma_f32_32x32x16_bf16(kf[1],qr[0],C1,0,0,0), P0[6],P0[7],P0[8],P0[9],     pw0[2]=PKW(P0,4), pw0[3]=PKW(P0,6), pw0); \
    VRD(1); SBAR(); GAPA(C0=__builtin_amdgcn_mfma_f32_32x32x16_bf16(kf[2],qr[1],C0,0,0,0),   P0[10],P0[11],P0[12],P0[13], pw1[0]=PKW(P0,8), pw1[1]=PKW(P0,10), pw1); \
    VRD(5); SBAR(); GAPA(C1=__builtin_amdgcn_mfma_f32_32x32x16_bf16(kf[3],qr[1],C1,0,0,0),   P0[14],P0[15],P1[0],P1[1],   pw1[2]=PKW(P0,12),pw1[3]=PKW(P0,14), pw1); \
    VRD(2); SBAR(); GAPA(C0=__builtin_amdgcn_mfma_f32_32x32x16_bf16(kf[4],qr[2],C0,0,0,0),   P1[2],P1[3],P1[4],P1[5],     pw2[0]=PKW(P1,0), pw2[1]=PKW(P1,2), pw2); \
    VRD(6); SBAR(); GAPA(C1=__builtin_amdgcn_mfma_f32_32x32x16_bf16(kf[5],qr[2],C1,0,0,0),   P1[6],P1[7],P1[8],P1[9],     pw2[2]=PKW(P1,4), pw2[3]=PKW(P1,6), pw2); \
    VRD(3); SBAR(); GAPA(C0=__builtin_amdgcn_mfma_f32_32x32x16_bf16(kf[6],qr[3],C0,0,0,0),   P1[10],P1[11],P1[12],P1[13], pw3[0]=PKW(P1,8), pw3[1]=PKW(P1,10), pw3); \
    VRD(7); SBAR(); GAPA(C1=__builtin_amdgcn_mfma_f32_32x32x16_bf16(kf[7],qr[3],C1,0,0,0),   P1[14],P1[15],0.f,0.f,       pw3[2]=PKW(P1,12),pw3[3]=PKW(P1,14), pw3); \
    l_reg+=sacc; \
    if(GK){DMA_K((t)+3,sl_cur);} if(GV){DMA_V((t)+1,sl_next);} \
    CMASK(C0,C1,t); \
    { float a=MX3(C0[0],C0[1],C1[0]),b=MX3(C0[2],C0[3],C1[1]); a=MX3(a,C1[2],C1[3]); \
      _Pragma("unroll") for(int r=4;r<16;r+=4){a=MX3(a,C0[r],C0[r+1]);b=MX3(b,C0[r+2],C0[r+3]);a=MX3(a,C1[r],C1[r+1]);b=MX3(b,C1[r+2],C1[r+3]);} \
      float rm=__builtin_fmaxf(a,b); { auto rr=__builtin_amdgcn_permlane32_swap(__float_as_uint(rm),__float_as_uint(rm),false,false); rm=__builtin_fmaxf(__uint_as_float(rr[0]),__uint_as_float(rr[1])); } \
      resc=false; \
      if(__builtin_expect(__any(rm>(float)THRL),0)){ const float dl=__builtin_fmaxf(rm,0.f); mhat+=dl; \
        _Pragma("unroll") for(int r=0;r<16;++r){C0[r]-=dl;C1[r]-=dl;} \
        const float f=__builtin_amdgcn_exp2f(-dl); l_reg*=f; if(hi==0)wsf[r32]=f; resc=true; } } \
    SBAR(); \
    GAPB(o[0]=__builtin_amdgcn_mfma_f32_32x32x16_bf16(PAF(0),VFR(0),o[0],0,0,0), C0,0); \
    GAPB(o[1]=__builtin_amdgcn_mfma_f32_32x32x16_bf16(PAF(0),VFR(4),o[1],0,0,0), C0,4); \
    KRD(GL,0); GAPB(o[0]=__builtin_amdgcn_mfma_f32_32x32x16_bf16(PAF(1),VFR(1),o[0],0,0,0), C0,8); \
    KRD(GL,1); GAPB(o[1]=__builtin_amdgcn_mfma_f32_32x32x16_bf16(PAF(1),VFR(5),o[1],0,0,0), C0,12); \
    KRD(GL,2); GAPB(o[0]=__builtin_amdgcn_mfma_f32_32x32x16_bf16(PAF(2),VFR(2),o[0],0,0,0), C1,0); \
    KRD(GL,3); GAPB(o[1]=__builtin_amdgcn_mfma_f32_32x32x16_bf16(PAF(2),VFR(6),o[1],0,0,0), C1,4); \
    GAPB(o[0]=__builtin_amdgcn_mfma_f32_32x32x16_bf16(PAF(3),VFR(3),o[0],0,0,0), C1,8); \
    GAPB(o[1]=__builtin_amdgcn_mfma_f32_32x32x16_bf16(PAF(3),VFR(7),o[1],0,0,0), C1,12); \
    }while(0)
  int t=1;
  #undef CMASK
  #define CMASK(P0,P1,t) do{}while(0)
  for(;t+5<NT;t+=2){
    STEP(pB0,pB1,pA0,pA1,t,true,true,true);     WAIT_BAR(2); RESC(); ROT();
    STEP(pA0,pA1,pB0,pB1,t+1,true,true,true);   WAIT_BAR(2); RESC(); ROT();
  }
  #undef CMASK
  #define CMASK(P0,P1,t) do{int jb_=(t)-(NT-4); if(jb_>=0)cmask(P0,P1,jb_,qrel,hi);}while(0)
  #define ENDW(tt) do{ if((tt)+3<NT){WAIT_BAR(2);} else if((tt)+2<NT){WAIT_BAR(1);} else {WAIT_BAR(0);} }while(0)
  for(;t+1<NT;t+=2){
    STEP(pB0,pB1,pA0,pA1,t,(t+3<NT),(t+1<NT),(t+1<NT));       ENDW(t);   RESC(); ROT();
    STEP(pA0,pA1,pB0,pB1,t+1,(t+4<NT),(t+2<NT),(t+2<NT));     ENDW(t+1); RESC(); ROT();
  }
  STEP(pB0,pB1,pA0,pA1,NT-1,false,false,false); RESC();
  { float sacc=pB0[0]+pB0[1]; _Pragma("unroll") for(int r=2;r<16;++r)sacc+=pB0[r]; _Pragma("unroll") for(int r=0;r<16;++r)sacc+=pB1[r]; l_reg+=sacc;
    pw0=(u32x4){PKW(pB0,0),PKW(pB0,2),PKW(pB0,4),PKW(pB0,6)};pw1=(u32x4){PKW(pB0,8),PKW(pB0,10),PKW(pB0,12),PKW(pB0,14)};pw2=(u32x4){PKW(pB1,0),PKW(pB1,2),PKW(pB1,4),PKW(pB1,6)};pw3=(u32x4){PKW(pB1,8),PKW(pB1,10),PKW(pB1,12),PKW(pB1,14)};
    SBAR(); pv(o,vb0+sl_cur,PAF(0),PAF(1),PAF(2),PAF(3)); }
  #undef PKW
  #undef PAF
  #undef VFR
  #undef PIN
  #undef MX3
  #undef GAPA
  #undef GAPB
  #undef EX
  #undef VRD
  #undef KRD
  #undef STEP
  #undef ENDW
  {auto rr=__builtin_amdgcn_permlane32_swap(__float_as_uint(l_reg),__float_as_uint(l_reg),false,false);l_reg=__uint_as_float(rr[0])+__uint_as_float(rr[1]);}
  if(hi==0)wsf[32+r32]=l_reg;asm volatile("s_waitcnt lgkmcnt(0)":::"memory");
  float rli[16];
  #pragma unroll
  for(int r=0;r<16;++r)rli[r]=__builtin_amdgcn_rcpf(wsf[32+crow(r,hi)]);
  bf16*Ow=O+(rowbase+q0+wid*QBLK)*DM+h*D;
  { bf16*stg=(bf16*)(shm+LDS_OST)+wid*2048;
    #pragma unroll
    for(int r=0;r<16;++r){const int orow=crow(r,hi);
      #pragma unroll
      for(int d0=0;d0<2;++d0)stg[orow*64+d0*32+r32]=__float2bfloat16(o[d0][r]*rli[r]);}
    asm volatile("s_waitcnt lgkmcnt(0)":::"memory");
    #pragma unroll
    for(int i=0;i<4;++i){const int row=i*8+(lane>>3),ch=lane&7; const u32x4 v=*(const u32x4*)(stg+row*64+ch*8); ATTN_STORE16(Ow+(long)row*DM+ch*8,v);} }
  asm volatile("s_waitcnt lgkmcnt(0)\n\ts_barrier":::"memory");
  #undef DMA_K
  #undef DMA_V
  #undef CMASK
  #undef START
  #undef RESC
  #undef ROT
}

constexpr float T_UNDER=150.f;
template<int DUMMY> __device__ __forceinline__ void attn_unit_fast(int b,int h,int qb,float M,const bf16*Q,const bf16*__restrict__ K,const bf16*__restrict__ V,bf16*O,const float*LF,char*shm,int wave0){
  int tid_=opaque_tid(wave0);
  const int tid=tid_,lane=tid&63,r32=lane&31,hi=lane>>5; const int wid=__builtin_amdgcn_readfirstlane(tid>>6);
  const long rowbase=(long)b*SEQ; const int q0=qb*QB;
  const bf16*Qw=Q+(rowbase+q0+wid*QBLK)*DM+h*D;
  const bf16*Kh=K+rowbase*DM+h*D,*Vh=V+rowbase*DM+h*D;
  const unsigned lds0=(unsigned)(uintptr_t)shm;
  const lds_cptr shm3=(lds_cptr)shm;
  { const int n=q0+QB; const float*lf=LF+((long)b*NHEAD+h)*SEQ;
    volatile __attribute__((address_space(3))) float*wt=(volatile __attribute__((address_space(3))) float*)(shm3+LDS_WT);
    f32x4 v0=(f32x4){0.f,0.f,0.f,0.f},v1=(f32x4){0.f,0.f,0.f,0.f};
    if(8*tid<n){v0=*(const f32x4*)(lf+8*tid);v1=*(const f32x4*)(lf+8*tid+4);}
    v0[1]+=v0[0];v0[2]+=v0[1];v0[3]+=v0[2];v1[0]+=v0[3];v1[1]+=v1[0];v1[2]+=v1[1];v1[3]+=v1[2];
    const float tot=v1[3]; float inc=tot;
    #pragma unroll
    for(int o_=1;o_<64;o_<<=1){const float t_=__int_as_float(__builtin_amdgcn_ds_bpermute((lane-o_)<<2,__float_as_int(inc)));if(lane>=o_)inc+=t_;}
    if(lane==63)wt[wid]=inc;
    __syncthreads();
    float base=inc-tot;
    #pragma unroll
    for(int w_=0;w_<NW;++w_){const float x_=wt[w_]; if(w_<wid)base+=x_;}
    if(tid==(q0>>3))wt[8]=base+v0[0];
    __syncthreads();
    const float anc=wt[8];
    if(8*tid<n){ __attribute__((address_space(3))) f32x4*fo=(__attribute__((address_space(3))) f32x4*)(shm3+LDS_FS)+2*tid;
      fo[0]=(v0+(base-anc))*LOG2E; fo[1]=(v1+(base-anc))*LOG2E; }
  }
  const lds_cptr fs3=shm3+LDS_FS;
  const int NT=(q0+QB)/KVBLK;
  const char*kbase=(const char*)(Kh+(long)(NT-1)*KVBLK*DM),*vbase=(const char*)(Vh+(long)(NT-1)*KVBLK*DM);
  const unsigned koff=(unsigned)((lane*DM+wid*8)*2), voff=(unsigned)(((16*(wid&3)+(lane>>2))*DM+(wid>>2)*32+(lane&3)*8)*2);
  const unsigned kdst=lds0+LDS_K+wid*1024, vdst=lds0+LDS_V+wid*1024;
  #define DMA_K(t,slot) glds16s(kbase-(long)(t)*(KVBLK*DM*2),koff,(unsigned)__builtin_amdgcn_readfirstlane(kdst+(slot)))
  #define DMA_V(t,slot) glds16s(vbase-(long)(t)*(KVBLK*DM*2),voff,(unsigned)__builtin_amdgcn_readfirstlane(vdst+(slot)))
  const char*Kbase=shm+LDS_K; bf16x8 kf[8];
  const lds_cptr kp0=shm3+LDS_K+hi*1024+r32*16; const lds_cptr vp0=shm3+LDS_V+((lane>>4)&1)*32+(lane&3)*8+(4*hi+((lane&15)>>2))*64;
  DMA_K(0,0);DMA_V(0,0);DMA_K(1,SLOTB);
  bf16x8 qr[4];
  #pragma unroll
  for(int d0=0;d0<4;++d0)qr[d0]=*reinterpret_cast<const bf16x8*>(&Qw[(long)r32*DM+d0*16+hi*8]);
  float l_reg=0.f;f32x16 o[2];o[0]=f32x16{};o[1]=f32x16{};
  const int qrel=wid*QBLK+r32;
  #define CMASK(P0,P1,t) do{int jb_=3-(t); if(jb_>=0)cmask(P0,P1,jb_,qrel,hi);}while(0)
  f32x16 pA0,pA1,pB0,pB1;
  int sl_prev=0,sl_cur=0,sl_next=SLOTB;
  #define ROT() do{sl_prev=sl_cur;sl_cur=sl_next;sl_next=(sl_next==(NSLOT-1)*SLOTB)?0:sl_next+SLOTB;}while(0)
  DMA_K(2,2*SLOTB);
  WAIT_BAR(3);
  const float nm=*(const __attribute__((address_space(3))) float*)(fs3+(q0+qrel)*4)-M;
  int NP;
  { const float fv=(lane<NT)?*(const __attribute__((address_space(3))) float*)(fs3+(64*lane+63)*4):0.f;
    const unsigned long long bal=__ballot((lane<NT)&&(fv>2.f*M+T_UNDER));
    const int tstop=__builtin_popcountll(bal); int np=NT-tstop; np=(np+1)&~1; NP=np<4?4:np; NP=__builtin_amdgcn_readfirstlane(NP); }
  fbias(pA0,pA1,fs3+(NT-1)*256,nm,hi);
  qkt(pA0,pA1,Kbase,qr,r32,hi);asm volatile("s_nop 15\n\ts_nop 7":"+v"(pA0),"+v"(pA1));CMASK(pA0,pA1,0);
  _Pragma("unroll") for(int r=0;r<16;++r){pA0[r]=__builtin_amdgcn_exp2f(pA0[r]);pA1[r]=__builtin_amdgcn_exp2f(pA1[r]);}
  WAIT_BAR(0);
  DMA_K(3,0);DMA_V(1,SLOTB);
  ROT();
  kload8(kf,kp0+sl_cur);
  fbias(pB0,pB1,fs3+(NT-2)*256,nm,hi);
  WAIT_BAR(2);
  s16x4 vlo[8],vhi[8]; u32x4 pw0,pw1,pw2,pw3;
  #define PKW(P,B) cvtpk_s(P[B],P[B+1])
  #define PAF(k) __builtin_bit_cast(bf16x8,pw##k)
  #define VFR(i) (bf16x8){vlo[i][0],vlo[i][1],vlo[i][2],vlo[i][3],vhi[i][0],vhi[i][1],vhi[i][2],vhi[i][3]}
  #define PIN(x) asm volatile("":"+v"(x))
  #define GAPA(MF,A0,A1,A2,A3,W0,W1,PW) do{ MF; sacc+=A0; sacc+=A1; sacc+=A2; sacc+=A3; PIN(sacc); W0; W1; PIN(PW); SBAR(); }while(0)
  #define EX(v) __builtin_amdgcn_exp2f(v)
  #define GAPB(MF,X,B,Y,GL) do{ MF; X[B]=EX(X[B]); X[B+1]=EX(X[B+1]); X[B+2]=EX(X[B+2]); X[B+3]=EX(X[B+3]); PIN(X); \
      if(GL){ Y[B]=nm-Y[B]; Y[B+1]=nm-Y[B+1]; Y[B+2]=nm-Y[B+2]; Y[B+3]=nm-Y[B+3]; PIN(Y); } SBAR(); }while(0)
  #define VRD(i) do{ vlo[i]=vtr(vp_+(((i)>>2)*4096+((i)&3)*1024)); vhi[i]=vtr(vp_+(((i)>>2)*4096+((i)&3)*1024+512)); }while(0)
  #define KRD(G,j) do{ if(G){ kload2(kf,kp0+sl_next,j); SBAR(); } }while(0)
  #define FLD(Y0,Y1,t) do{ const lds_cptr ft_=fs3+(NT-2-(t))*256+hi*16; \
      _Pragma("unroll") for(int g_=0;g_<4;++g_){ const f32x4 a_=*(const __attribute__((address_space(3))) f32x4*)(ft_+g_*32); const f32x4 b_=*(const __attribute__((address_space(3))) f32x4*)(ft_+128+g_*32); \
        Y0[4*g_]=a_[0];Y0[4*g_+1]=a_[1];Y0[4*g_+2]=a_[2];Y0[4*g_+3]=a_[3]; Y1[4*g_]=b_[0];Y1[4*g_+1]=b_[1];Y1[4*g_+2]=b_[2];Y1[4*g_+3]=b_[3]; } }while(0)
  #define STEP(C0,C1,P0,P1,t,GK,GV,GL) do{ SBAR(); \
    const lds_cptr vp_=vp0+sl_prev; \
    VRD(0); SBAR(); float sacc=(P0[0]+P0[1]); \
    GAPA(C0=__builtin_amdgcn_mfma_f32_32x32x16_bf16(kf[0],qr[0],C0,0,0,0), P0[2],P0[3],P0[4],P0[5],     pw0[0]=PKW(P0,0), pw0[1]=PKW(P0,2), pw0); \
    VRD(4); SBAR(); GAPA(C1=__builtin_amdgcn_mfma_f32_32x32x16_bf16(kf[1],qr[0],C1,0,0,0), P0[6],P0[7],P0[8],P0[9],     pw0[2]=PKW(P0,4), pw0[3]=PKW(P0,6), pw0); \
    VRD(1); SBAR(); GAPA(C0=__builtin_amdgcn_mfma_f32_32x32x16_bf16(kf[2],qr[1],C0,0,0,0),   P0[10],P0[11],P0[12],P0[13], pw1[0]=PKW(P0,8), pw1[1]=PKW(P0,10), pw1); \
    VRD(5); SBAR(); GAPA(C1=__builtin_amdgcn_mfma_f32_32x32x16_bf16(kf[3],qr[1],C1,0,0,0),   P0[14],P0[15],P1[0],P1[1],   pw1[2]=PKW(P0,12),pw1[3]=PKW(P0,14), pw1); \
    VRD(2); SBAR(); GAPA(C0=__builtin_amdgcn_mfma_f32_32x32x16_bf16(kf[4],qr[2],C0,0,0,0),   P1[2],P1[3],P1[4],P1[5],     pw2[0]=PKW(P1,0), pw2[1]=PKW(P1,2), pw2); \
    VRD(6); SBAR(); GAPA(C1=__builtin_amdgcn_mfma_f32_32x32x16_bf16(kf[5],qr[2],C1,0,0,0),   P1[6],P1[7],P1[8],P1[9],     pw2[2]=PKW(P1,4), pw2[3]=PKW(P1,6), pw2); \
    VRD(3); SBAR(); GAPA(C0=__builtin_amdgcn_mfma_f32_32x32x16_bf16(kf[6],qr[3],C0,0,0,0),   P1[10],P1[11],P1[12],P1[13], pw3[0]=PKW(P1,8), pw3[1]=PKW(P1,10), pw3); \
    VRD(7); SBAR(); GAPA(C1=__builtin_amdgcn_mfma_f32_32x32x16_bf16(kf[7],qr[3],C1,0,0,0),   P1[14],P1[15],0.f,0.f,       pw3[2]=PKW(P1,12),pw3[3]=PKW(P1,14), pw3); \
    l_reg+=sacc; \
    if(GK){DMA_K((t)+3,sl_cur);} if(GV){DMA_V((t)+1,sl_next);} \
    CMASK(C0,C1,t); \
    if(GL){ FLD(P0,P1,t); } \
    SBAR(); \
    GAPB(o[0]=__builtin_amdgcn_mfma_f32_32x32x16_bf16(PAF(0),VFR(0),o[0],0,0,0), C0,0,P0,GL); \
    GAPB(o[1]=__builtin_amdgcn_mfma_f32_32x32x16_bf16(PAF(0),VFR(4),o[1],0,0,0), C0,4,P0,GL); \
    KRD(GL,0); GAPB(o[0]=__builtin_amdgcn_mfma_f32_32x32x16_bf16(PAF(1),VFR(1),o[0],0,0,0), C0,8,P0,GL); \
    KRD(GL,1); GAPB(o[1]=__builtin_amdgcn_mfma_f32_32x32x16_bf16(PAF(1),VFR(5),o[1],0,0,0), C0,12,P0,GL); \
    KRD(GL,2); GAPB(o[0]=__builtin_amdgcn_mfma_f32_32x32x16_bf16(PAF(2),VFR(2),o[0],0,0,0), C1,0,P1,GL); \
    KRD(GL,3); GAPB(o[1]=__builtin_amdgcn_mfma_f32_32x32x16_bf16(PAF(2),VFR(6),o[1],0,0,0), C1,4,P1,GL); \
    GAPB(o[0]=__builtin_amdgcn_mfma_f32_32x32x16_bf16(PAF(3),VFR(3),o[0],0,0,0), C1,8,P1,GL); \
    GAPB(o[1]=__builtin_amdgcn_mfma_f32_32x32x16_bf16(PAF(3),VFR(7),o[1],0,0,0), C1,12,P1,GL); \
    }while(0)
  #define ENDW(tt) do{ if((tt)+3<NP){WAIT_BAR(2);} else if((tt)+2<NP){WAIT_BAR(1);} else {WAIT_BAR(0);} }while(0)
  int t=1;
  for(;t<5&&t+1<NP;t+=2){
    STEP(pB0,pB1,pA0,pA1,t,(t+3<NP),(t+1<NP),(t+1<NP));       ENDW(t);   ROT();
    STEP(pA0,pA1,pB0,pB1,t+1,(t+4<NP),(t+2<NP),(t+2<NP));     ENDW(t+1); ROT();
  }
  #undef CMASK
  #define CMASK(P0,P1,t) do{}while(0)
  for(;t+5<NP;t+=2){
    STEP(pB0,pB1,pA0,pA1,t,true,true,true);     WAIT_BAR(2); ROT();
    STEP(pA0,pA1,pB0,pB1,t+1,true,true,true);   WAIT_BAR(2); ROT();
  }
  for(;t+1<NP;t+=2){
    STEP(pB0,pB1,pA0,pA1,t,(t+3<NP),(t+1<NP),(t+1<NP));       ENDW(t);   ROT();
    STEP(pA0,pA1,pB0,pB1,t+1,(t+4<NP),(t+2<NP),(t+2<NP));     ENDW(t+1); ROT();
  }
  #undef CMASK
  #define CMASK(P0,P1,t) do{int jb_=3-(t); if(jb_>=0)cmask(P0,P1,jb_,qrel,hi);}while(0)
  STEP(pB0,pB1,pA0,pA1,NP-1,false,false,false);
  const int tidE=opaque_tid(wave0),laneE=tidE&63,r32E=laneE&31,hiE=laneE>>5; const int widE=__builtin_amdgcn_readfirstlane(tidE>>6);
  const int vb0=(int)(lds0+LDS_V)+((laneE>>4)&1)*32+(laneE&3)*8+(4*hiE+((laneE&15)>>2))*64;
  float*wsf=(float*)(shm+LDS_WS)+widE*64;
  { float sacc=pB0[0]+pB0[1]; _Pragma("unroll") for(int r=2;r<16;++r)sacc+=pB0[r]; _Pragma("unroll") for(int r=0;r<16;++r)sacc+=pB1[r]; l_reg+=sacc;
    pw0=(u32x4){PKW(pB0,0),PKW(pB0,2),PKW(pB0,4),PKW(pB0,6)};pw1=(u32x4){PKW(pB0,8),PKW(pB0,10),PKW(pB0,12),PKW(pB0,14)};pw2=(u32x4){PKW(pB1,0),PKW(pB1,2),PKW(pB1,4),PKW(pB1,6)};pw3=(u32x4){PKW(pB1,8),PKW(pB1,10),PKW(pB1,12),PKW(pB1,14)};
    SBAR(); pv(o,vb0+sl_cur,PAF(0),PAF(1),PAF(2),PAF(3)); }
  #undef PKW
  #undef PAF
  #undef VFR
  #undef PIN
  #undef GAPA
  #undef GAPB
  #undef EX
  #undef VRD
  #undef KRD
  #undef FLD
  #undef STEP
  #undef ENDW
  {auto rr=__builtin_amdgcn_permlane32_swap(__float_as_uint(l_reg),__float_as_uint(l_reg),false,false);l_reg=__uint_as_float(rr[0])+__uint_as_float(rr[1]);}
  if(hiE==0)wsf[32+r32E]=l_reg;asm volatile("s_waitcnt lgkmcnt(0)":::"memory");
  float rli[16];
  #pragma unroll
  for(int r=0;r<16;++r)rli[r]=__builtin_amdgcn_rcpf(wsf[32+crow(r,hiE)]);
  bf16*Ow=O+(rowbase+q0+widE*QBLK)*DM+h*D;
  { bf16*stg=(bf16*)(shm+LDS_OST)+widE*2048;
    #pragma unroll
    for(int r=0;r<16;++r){const int orow=crow(r,hiE);
      #pragma unroll
      for(int d0=0;d0<2;++d0)stg[orow*64+d0*32+r32E]=__float2bfloat16(o[d0][r]*rli[r]);}
    asm volatile("s_waitcnt lgkmcnt(0)":::"memory");
    #pragma unroll
    for(int i=0;i<4;++i){const int row=i*8+(laneE>>3),ch=laneE&7; const u32x4 v=*(const u32x4*)(stg+row*64+ch*8); ATTN_STORE16(Ow+(long)row*DM+ch*8,v);} }
  asm volatile("s_waitcnt lgkmcnt(0)\n\ts_barrier":::"memory");
  #undef DMA_K
  #undef DMA_V
  #undef CMASK
  #undef ROT
}
constexpr int ATTN_LDS_BYTES=LDS_BYTES;
struct AttnTensors { const bf16* Q; const bf16* K; const bf16* V; bf16* O; const float* LF; const unsigned* QKM; };
struct AttnUnit { int bh; int qb; };
struct StaticOrder {
  int vcu;
  __device__ __forceinline__ explicit StaticOrder(int grid,int block):vcu((block%8)*(grid/8)+block/8){}
  __device__ __forceinline__ bool next(int i,AttnUnit&u)const{ if(i>=8)return false; const int s=vcu&1, j=7-i, base=4*(j>>1); u.bh=vcu>>1; u.qb=base+((j&1)?(s?2:3):(s?1:0)); return true; }
};
template<class Sched,int THRL=8> __device__ __forceinline__ void attn_phase(char*lds,const AttnTensors&T,const Sched&S,int wave0){
  AttnUnit u;
  for(int i=0;S.next(i,u);++i){ const int b=u.bh/NHEAD,h=u.bh%NHEAD;
    const unsigned* qm=T.QKM+(0*8+b)*32+2*h; const unsigned* km=T.QKM+(1*8+b)*32+2*h;
    const float q2=__uint_as_float(__builtin_amdgcn_readfirstlane(qm[0]))+__uint_as_float(__builtin_amdgcn_readfirstlane(qm[1])), k2=__uint_as_float(__builtin_amdgcn_readfirstlane(km[0]))+__uint_as_float(__builtin_amdgcn_readfirstlane(km[1]));
    const float M=1.02f*sqrtf(q2*k2)+1e-3f;
    if(M<55.f) attn_unit_fast<0>(b,h,u.qb,M,T.Q,T.K,T.V,T.O,T.LF,lds,wave0);
    else attn_unit<THRL>(b,h,u.qb,T.Q,T.K,T.V,T.O,T.LF,lds,wave0); }
}
#undef SBAR
#undef WAIT_BAR
}
constexpr int NWAVES = 8;
#ifndef MK_MULTI
#define MK_MULTI 0
#endif

constexpr int BATCH = 8, SEQ = 4096, D = 1024, H = 16, HD = 64, NE = 32, FD = 512, NLAYER = 2;
constexpr int T = BATCH * SEQ;
constexpr int MODW = 6 * D;
constexpr float RMS_EPS = 1e-6f;
constexpr int WIN_LD = 3 * D + H;
constexpr int ECAP = 32768;
constexpr int PMAX = 2 * T + NE * 256;

constexpr size_t MiB = 1u << 20;
constexpr size_t WS_CTL = 0, CTL_ZERO_BYTES = 1 * MiB;
constexpr size_t WS_MOD = 1 * MiB;
constexpr size_t WS_LOGF = 2 * MiB;
constexpr size_t WS_TOK = 6 * MiB;
constexpr size_t WS_GW = 10 * MiB;
constexpr size_t WS_WQKV = 14 * MiB;
constexpr size_t WS_WO = 20 * MiB;
constexpr size_t WS_WP = 22 * MiB;
constexpr size_t WS_UP = 23 * MiB;
constexpr size_t WS_DN = 151 * MiB;
constexpr size_t WS_HB = 215 * MiB;
constexpr size_t WS_Q = 279 * MiB, WS_K = 343 * MiB, WS_V = 407 * MiB;
constexpr size_t WS_XS = 279 * MiB;
constexpr size_t WS_Y2 = 279 * MiB;
constexpr size_t WS_HH = 423 * MiB;
constexpr size_t WS_PL = 279 * MiB;
constexpr size_t WS_END = 495 * MiB;
constexpr int CW_BAR = 4096;
constexpr int CW_QKM = 32768;
constexpr int CW_CNT = 16384;

constexpr int RING_OFF = 0, RING_BYTES = 131072;
constexpr int LDSCTL_OFF = RING_BYTES, MISC_OFF = LDSCTL_OFF + 320;
constexpr int ETAB_OFF = LDSCTL_OFF + 1024;
constexpr int LDS_BYTES = 147456;
static_assert(ETAB_OFF + (64 + 960) * 4 <= LDS_BYTES && attn_body::ATTN_LDS_BYTES <= RING_BYTES, "LDS map");

#define GAS __attribute__((address_space(1)))
#define LAS __attribute__((address_space(3)))
typedef unsigned short bf16;
typedef unsigned v4u __attribute__((ext_vector_type(4)));
typedef float f32x4 __attribute__((ext_vector_type(4)));
typedef short bf16x8 __attribute__((ext_vector_type(8)));
typedef GAS unsigned gu32;
#define RLX_AGENT __ATOMIC_RELAXED, __HIP_MEMORY_SCOPE_AGENT
#define LDS_WAIT() asm volatile("s_waitcnt lgkmcnt(0)" ::: "memory")
#define VM_WAIT() asm volatile("s_waitcnt vmcnt(0)" ::: "memory")
__device__ __forceinline__ unsigned f2bf(float f) { unsigned u = __builtin_bit_cast(unsigned, f); return (u + 0x7fffu + ((u >> 16) & 1u)) >> 16; }
__device__ __forceinline__ unsigned pk2(float lo, float hi) { return f2bf(lo) | (f2bf(hi) << 16); }
__device__ __forceinline__ float bflo(unsigned w) { return __uint_as_float(w << 16); }
__device__ __forceinline__ float bfhi(unsigned w) { return __uint_as_float(w & 0xffff0000u); }

#define XB_TMO      128
#define XB_XCNT(j)  (256  + 64 * (j))
#define XB_XSUB(j)  (1280 + 64 * (j))
#define XB_XGEN(j)  (2304 + 64 * (j))
#define XB_TOP      3328
#define XB_TOPGEN   3392
#define XCD_BAR_WORDS 3456
#define XB_SPIN_CAP (1u << 18)
__device__ __forceinline__ unsigned xb_ld(unsigned* p)              { return __hip_atomic_load(p, __ATOMIC_RELAXED, __HIP_MEMORY_SCOPE_AGENT); }
__device__ __forceinline__ unsigned xb_add(unsigned* p, unsigned v) { return __hip_atomic_fetch_add(p, v, __ATOMIC_RELAXED, __HIP_MEMORY_SCOPE_AGENT); }
__device__ __forceinline__ unsigned xb_xcc_id() { return (unsigned)__builtin_amdgcn_s_getreg((3 << 11) | 20) & 0xFu; }
#define XB_SPIN(cond, bar) do { unsigned _sp = 0; while (cond) { __builtin_amdgcn_s_sleep(1); \
    if ((++_sp & 255u) == 0u) { if (xb_ld(&(bar)[XB_TMO])) break; if (_sp > XB_SPIN_CAP) { atomicAdd(&(bar)[XB_TMO], 1u); break; } } } } while (0)
struct XcdBarrier { unsigned* bar; unsigned x; volatile LAS unsigned* st; };
__device__ __forceinline__ XcdBarrier xcd_barrier_post(unsigned* bar, volatile LAS unsigned* st) {
    XcdBarrier b; b.bar = bar; b.x = xb_xcc_id(); b.st = st;
    if (threadIdx.x == 0) (void)xb_add(&bar[XB_XCNT(b.x)], 1u);
    return b;
}
__device__ __forceinline__ void xcd_barrier_complete(unsigned* bar, unsigned x, unsigned& nloc, unsigned& nx) {
    const unsigned G = gridDim.x * gridDim.y * gridDim.z;
    unsigned sum, cnt, mine, sp = 0u;
    for (;;) {
        sum = 0u; cnt = 0u; mine = 0u;
#pragma unroll
        for (unsigned j = 0; j < 16; ++j) { const unsigned c = xb_ld(&bar[XB_XCNT(j)]); sum += c; cnt += (c > 0u) ? 1u : 0u; }
        mine = xb_ld(&bar[XB_XCNT(x)]);
        if (sum == G) break;
        __builtin_amdgcn_s_sleep(1);
        if ((++sp & 255u) == 0u) { if (xb_ld(&bar[XB_TMO])) break; if (sp > XB_SPIN_CAP) { atomicAdd(&bar[XB_TMO], 1u); break; } }
    }
    nloc = mine > 0u ? mine : 1u; nx = cnt > 0u ? cnt : 1u;
}
__device__ __forceinline__ void xcd_barrier(const XcdBarrier& b) {
    asm volatile("s_waitcnt vmcnt(0)" ::: "memory");
    __syncthreads();
    if (threadIdx.x == 0) {
        unsigned* bar = b.bar; unsigned bx = b.x;
        asm volatile("" : "+s"(bar), "+s"(bx));
        __builtin_amdgcn_s_waitcnt(0);
        unsigned nloc = b.st[0], nx = b.st[1];
        if (nloc == 0u) { xcd_barrier_complete(bar, bx, nloc, nx); b.st[0] = nloc; b.st[1] = nx; }
        const unsigned old = xb_add(&bar[XB_XSUB(bx)], 1u);
        const unsigned gen = old / nloc;
        if (old + 1u == (gen + 1u) * nloc) {
            __builtin_amdgcn_fence(__ATOMIC_RELEASE, "agent");
            asm volatile("s_waitcnt vmcnt(0)" ::: "memory");
            const unsigned og = xb_add(&bar[XB_TOP], 1u);
            const unsigned tg = og / nx;
            if (og + 1u == (tg + 1u) * nx) xb_add(&bar[XB_TOPGEN], 1u);
            else XB_SPIN(xb_ld(&bar[XB_TOPGEN]) == tg, bar);
            __builtin_amdgcn_fence(__ATOMIC_ACQUIRE, "agent");
            xb_add(&bar[XB_XGEN(bx)], 1u);
            asm volatile("s_waitcnt vmcnt(0)" ::: "memory");
        } else {
            XB_SPIN(xb_ld(&bar[XB_XGEN(bx)]) == gen, bar);
            __builtin_amdgcn_fence(__ATOMIC_ACQUIRE, "agent");
            asm volatile("s_waitcnt vmcnt(0)" ::: "memory");
        }
    }
    __syncthreads();
}

struct Frame {
    LAS unsigned char* lds;
    volatile LAS unsigned* MISC;
    gu32* ctl;
    int tid, lane, wave, wave0;
    int vcu, G;
    const __attribute__((address_space(4))) char* ka;
    float* out;
    unsigned char* ws;
    const __attribute__((address_space(4))) char* ka0; float* out0; unsigned char* ws0;
};
__device__ __forceinline__ void phase_enter(Frame& F) {
    int t_ = opaque_tid(F.wave0); F.tid = t_; F.lane = t_ & 63; F.wave = __builtin_amdgcn_readfirstlane(t_ >> 6);
    unsigned char* w = F.ws0; float* o = F.out0; const __attribute__((address_space(4))) char* k = F.ka0;
    asm volatile("" : "+s"(w), "+s"(o), "+s"(k));
    F.ws = w; F.out = o; F.ka = k; F.ctl = (gu32*)w;
}
#define WSP(T_, off) ((T_*)(F.ws + (off)))
#define FIN(i) (*(const float* const __attribute__((address_space(4)))*)(F.ka + 8 * (i)))
enum { IN_X = 0, IN_C, IN_NMG, IN_NFG, IN_ADAW, IN_ADAB, IN_WIN, IN_FBIAS, IN_WO, IN_POOLW, IN_POOLS, IN_RW, IN_RB, IN_W1, IN_W3, IN_W2, IN_NFIN };

__device__ __forceinline__ void transpose_item(const float* W, int ld, int k0, bf16* WT, int Kd, int dst_row0, LAS float* scr, int lane) {
#pragma unroll 8
    for (int i = 0; i < 32; ++i) { const int kk = 2 * i + (lane >> 5); scr[kk * 33 + (lane & 31)] = W[(size_t)(k0 + kk) * ld + (lane & 31)]; }
    LDS_WAIT(); asm volatile("" ::: "memory");
    const int c = lane & 7;
#pragma unroll
    for (int j = 0; j < 4; ++j) { const int n = (lane >> 3) + 8 * j; const LAS float* s = scr + (8 * c) * 33 + n;
        v4u o; o.x = pk2(s[0 * 33], s[1 * 33]); o.y = pk2(s[2 * 33], s[3 * 33]); o.z = pk2(s[4 * 33], s[5 * 33]); o.w = pk2(s[6 * 33], s[7 * 33]);
        *(GAS v4u*)(WT + (size_t)(dst_row0 + n) * Kd + k0 + 8 * c) = o; }
    LDS_WAIT(); asm volatile("" ::: "memory");
}
__device__ __forceinline__ void p0_prologue(Frame& F) {
    if (F.vcu < 192) {
        const float* cin = FIN(IN_C); const float* adaw = FIN(IN_ADAW); const float* adab = FIN(IN_ADAB);
        LAS float* cact = (LAS float*)(F.lds);
        LAS float* red = (LAS float*)(F.lds + 32768);
        for (int i = F.tid; i < 8 * 1024; i += 512) { const int bb = i >> 10, k = i & 1023; const float v = cin[i]; cact[k * 8 + bb] = v / (1.0f + __expf(-v)); }
        __syncthreads();
        const int l = F.vcu / 96, col0 = (F.vcu % 96) * 64;
        const float* wp = adaw + (size_t)l * D * MODW + col0 + F.lane;
        float a0 = 0.f, a1 = 0.f, a2 = 0.f, a3 = 0.f, a4 = 0.f, a5 = 0.f, a6 = 0.f, a7 = 0.f;
        const int kb = F.wave * 128;
#pragma unroll 8
        for (int k = 0; k < 128; ++k) { const float wv = wp[(size_t)(kb + k) * MODW]; const f32x4 c0 = *(const LAS f32x4*)(cact + (kb + k) * 8), c1 = *(const LAS f32x4*)(cact + (kb + k) * 8 + 4);
            a0 += c0[0] * wv; a1 += c0[1] * wv; a2 += c0[2] * wv; a3 += c0[3] * wv; a4 += c1[0] * wv; a5 += c1[1] * wv; a6 += c1[2] * wv; a7 += c1[3] * wv; }
        LAS float* rw = red + F.wave * 512 + F.lane;
        rw[0] = a0; rw[64] = a1; rw[128] = a2; rw[192] = a3; rw[256] = a4; rw[320] = a5; rw[384] = a6; rw[448] = a7;
        __syncthreads();
        { const int bb = F.tid >> 6, col = F.tid & 63; float s = 0.f;
#pragma unroll
          for (int w = 0; w < 8; ++w) s += red[w * 512 + bb * 64 + col];
          WSP(float, WS_MOD)[((size_t)l * 8 + bb) * MODW + col0 + col] = s + adab[l * MODW + col0 + col]; }
        __syncthreads();
    }
    LAS float* scr = (LAS float*)(F.lds + RING_OFF + F.wave * 16384);
    const int gw = F.vcu * NWAVES + F.wave, NGW = F.G * NWAVES;
    constexpr int I_QKV = 16 * 96, I_O = 16 * 32, I_P = 4 * 4 * 8, I_W13 = 16 * 16, I_W2 = 8 * 32;
    constexpr int I_EXP = NLAYER * NE * (2 * I_W13 + I_W2);
    constexpr int NITEMS = I_QKV + I_O + I_P + I_EXP;
    for (int it = gw; it < NITEMS; it += NGW) {
        int r = it;
        if (r < I_QKV) { const int kb = r / 96, nb = r % 96; transpose_item(FIN(IN_WIN) + 32 * nb, WIN_LD, 64 * kb, WSP(bf16, WS_WQKV), D, 32 * nb, scr, F.lane); continue; } r -= I_QKV;
        if (r < I_O) { const int kb = r / 32, nb = r % 32; transpose_item(FIN(IN_WO) + 32 * nb, D, 64 * kb, WSP(bf16, WS_WO), D, 32 * nb, scr, F.lane); continue; } r -= I_O;
        if (r < I_P) { const int g = r / 32, q = r % 32, kb = q / 8, nb = q % 8; transpose_item(FIN(IN_POOLW) + (size_t)g * 65536 + 32 * nb, 256, 64 * kb, WSP(bf16, WS_WP) + (size_t)g * 65536, 256, 32 * nb, scr, F.lane); continue; } r -= I_P;
        { const int per = 2 * I_W13 + I_W2; const int le = r / per; int q = r % per;
          if (q < 2 * I_W13) { const int which = q / I_W13; q %= I_W13; const int kb = q / 16, nb = q % 16, n0 = 32 * nb;
              const float* src = (which ? FIN(IN_W3) : FIN(IN_W1)) + (size_t)le * D * FD + n0;
              transpose_item(src, FD, 64 * kb, WSP(bf16, WS_UP) + (size_t)le * 1024 * 1024, D, 256 * (n0 >> 7) + (n0 & 127) + 128 * which, scr, F.lane); }
          else { q -= 2 * I_W13; const int kb = q / 32, nb = q % 32;
              transpose_item(FIN(IN_W2) + (size_t)le * FD * D + 32 * nb, D, 64 * kb, WSP(bf16, WS_DN) + (size_t)le * 1024 * 512, FD, 32 * nb, scr, F.lane); } }
    }
    __syncthreads();
}

struct RowArgs { const float* src; float* dst; const float* g; const float* shp; const float* scp; const float* gtp; const bf16* y2; bf16* hb;
                 const float* W; const float* bias; float* logf; gu32* cnt; int* tok; float* gw; };
template <int MODE>
__device__ __forceinline__ void rowpass(Frame& F, const RowArgs& A) {
    constexpr int NT = (MODE == 0) ? 1 : (MODE == 1 ? 2 : 0);
    const int lane = F.lane, w = F.wave, r = lane & 15, q = lane >> 4, tid = F.tid;
    const int R0 = F.vcu * 128, b = R0 >> 12;
    const int kb = 128 * w + 8 * q;
    LAS float* red = (LAS float*)(F.lds);
    LAS f32x4* part = (LAS f32x4*)(F.lds + 1024);
    LAS float* scS = (LAS float*)(F.lds + 1024 + 32768);
    LAS float* selS = scS + 512;
    LAS float* GM = (LAS float*)(F.lds + 65536); LAS float* SH = GM + 1024; LAS float* GT = SH + 1024;
    for (int k = tid; k < D; k += 512) { const float g1 = A.g[k];
        if (MODE < 3) { GM[k] = g1 * (1.0f + A.scp[(size_t)b * MODW + k]); SH[k] = A.shp[(size_t)b * MODW + k]; } else { GM[k] = g1; SH[k] = 0.f; }
        GT[k] = (MODE >= 2) ? A.gtp[(size_t)b * MODW + k] : 0.f; }
    __syncthreads();
    bf16x8 Bh[NT > 0 ? NT : 1][4], Bl[NT > 0 ? NT : 1][4];
    constexpr int LDW = (MODE == 0) ? WIN_LD : NE, COFF = (MODE == 0) ? 3 * D : 0;
    if (NT > 0) { const float* wbase = A.W + (size_t)kb * LDW + COFF + r;
#pragma unroll
        for (int nt = 0; nt < NT; ++nt)
#pragma unroll
            for (int c = 0; c < 4; ++c) { float wv[8];
#pragma unroll
                for (int j = 0; j < 8; ++j) wv[j] = wbase[(32 * c + j) * LDW + 16 * nt];
                v4u hw, lw;
                hw.x = pk2(wv[0], wv[1]); hw.y = pk2(wv[2], wv[3]); hw.z = pk2(wv[4], wv[5]); hw.w = pk2(wv[6], wv[7]);
                lw.x = pk2(wv[0] - bflo(hw.x), wv[1] - bfhi(hw.x)); lw.y = pk2(wv[2] - bflo(hw.y), wv[3] - bfhi(hw.y));
                lw.z = pk2(wv[4] - bflo(hw.z), wv[5] - bfhi(hw.z)); lw.w = pk2(wv[6] - bflo(hw.w), wv[7] - bfhi(hw.w));
                Bh[nt][c] = __builtin_bit_cast(bf16x8, hw); Bl[nt][c] = __builtin_bit_cast(bf16x8, lw); }
    }
    for (int it = 0; it < 8; ++it) {
        const int row = R0 + 16 * it + r, buf = it & 1;
        const float* xs = A.src + (size_t)row * D + kb;
        f32x4 xv[4][2];
#pragma unroll
        for (int c = 0; c < 4; ++c) { xv[c][0] = *(const f32x4*)(xs + 32 * c); xv[c][1] = *(const f32x4*)(xs + 32 * c + 4); }
        if (MODE >= 2) {
            const bf16* yp = A.y2 + (size_t)row * 2 * D + kb;
#pragma unroll
            for (int c = 0; c < 4; ++c) { const v4u ya = *(const v4u*)(yp + 32 * c), yb = *(const v4u*)(yp + D + 32 * c);
                f32x4 s0, s1;
                s0[0] = bflo(ya.x) + bflo(yb.x); s0[1] = bfhi(ya.x) + bfhi(yb.x); s0[2] = bflo(ya.y) + bflo(yb.y); s0[3] = bfhi(ya.y) + bfhi(yb.y);
                s1[0] = bflo(ya.z) + bflo(yb.z); s1[1] = bfhi(ya.z) + bfhi(yb.z); s1[2] = bflo(ya.w) + bflo(yb.w); s1[3] = bfhi(ya.w) + bfhi(yb.w);
                xv[c][0] += *(const LAS f32x4*)(GT + kb + 32 * c) * s0; xv[c][1] += *(const LAS f32x4*)(GT + kb + 32 * c + 4) * s1; }
            if (MODE == 2) { float* xd = A.dst + (size_t)row * D + kb;
#pragma unroll
                for (int c = 0; c < 4; ++c) { *(f32x4*)(xd + 32 * c) = xv[c][0]; *(f32x4*)(xd + 32 * c + 4) = xv[c][1]; } }
        }
        float ss = 0.f;
#pragma unroll
        for (int c = 0; c < 4; ++c)
#pragma unroll
            for (int hf = 0; hf < 2; ++hf) { const f32x4 v = xv[c][hf]; ss += (v[0] * v[0] + v[1] * v[1]) + (v[2] * v[2] + v[3] * v[3]); }
        ss += __int_as_float(__builtin_amdgcn_ds_bpermute((lane ^ 16) << 2, __float_as_int(ss))); ss += __int_as_float(__builtin_amdgcn_ds_bpermute((lane ^ 32) << 2, __float_as_int(ss)));
        if (q == 0) red[buf * 128 + w * 16 + r] = ss;
        __syncthreads();
        float tot = 0.f;
#pragma unroll
        for (int ww = 0; ww < 8; ++ww) tot += red[buf * 128 + ww * 16 + r];
        const float rstd = 1.0f / sqrtf(tot * (1.0f / D) + RMS_EPS);
        if (MODE == 3) { float* xd = A.dst + (size_t)row * D + kb;
#pragma unroll
            for (int c = 0; c < 4; ++c) { *(f32x4*)(xd + 32 * c) = xv[c][0] * rstd * *(const LAS f32x4*)(GM + kb + 32 * c); *(f32x4*)(xd + 32 * c + 4) = xv[c][1] * rstd * *(const LAS f32x4*)(GM + kb + 32 * c + 4); }
            continue; }
        f32x4 acc[NT > 0 ? NT : 1];
#pragma unroll
        for (int nt = 0; nt < (NT > 0 ? NT : 1); ++nt) acc[nt] = (f32x4){0.f, 0.f, 0.f, 0.f};
        bf16* hp = A.hb + (size_t)row * D + kb;
#pragma unroll
        for (int c = 0; c < 4; ++c) {
            const f32x4 h0 = xv[c][0] * rstd * *(const LAS f32x4*)(GM + kb + 32 * c) + *(const LAS f32x4*)(SH + kb + 32 * c), h1 = xv[c][1] * rstd * *(const LAS f32x4*)(GM + kb + 32 * c + 4) + *(const LAS f32x4*)(SH + kb + 32 * c + 4);
            v4u hw; hw.x = pk2(h0[0], h0[1]); hw.y = pk2(h0[2], h0[3]); hw.z = pk2(h1[0], h1[1]); hw.w = pk2(h1[2], h1[3]);
            *(v4u*)(hp + 32 * c) = hw;
            if (NT > 0) {
                v4u lw; lw.x = pk2(h0[0] - bflo(hw.x), h0[1] - bfhi(hw.x)); lw.y = pk2(h0[2] - bflo(hw.y), h0[3] - bfhi(hw.y));
                lw.z = pk2(h1[0] - bflo(hw.z), h1[1] - bfhi(hw.z)); lw.w = pk2(h1[2] - bflo(hw.w), h1[3] - bfhi(hw.w));
                const bf16x8 ah = __builtin_bit_cast(bf16x8, hw), al = __builtin_bit_cast(bf16x8, lw);
#pragma unroll
                for (int nt = 0; nt < NT; ++nt) {
                    acc[nt] = __builtin_amdgcn_mfma_f32_16x16x32_bf16(ah, Bh[nt][c], acc[nt], 0, 0, 0);
                    acc[nt] = __builtin_amdgcn_mfma_f32_16x16x32_bf16(ah, Bl[nt][c], acc[nt], 0, 0, 0);
                    acc[nt] = __builtin_amdgcn_mfma_f32_16x16x32_bf16(al, Bh[nt][c], acc[nt], 0, 0, 0); }
            }
        }
        if (NT > 0) {
#pragma unroll
            for (int nt = 0; nt < NT; ++nt) part[((buf * 8 + w) * 2 + nt) * 64 + lane] = acc[nt];
            __syncthreads();
            if (MODE == 0) {
                if (tid < 256) { const int t = tid & 15, n = tid >> 4; float f = 0.f;
#pragma unroll
                    for (int ww = 0; ww < 8; ++ww) f += ((const LAS float*)&part[((buf * 8 + ww) * 2 + 0) * 64 + n + 16 * (t >> 2)])[t & 3];
                    const float z = f + A.bias[n]; const float lf = fminf(z, 0.f) - log1pf(__expf(-fabsf(z)));
                    const int rt = R0 + 16 * it + t; A.logf[((size_t)b * H + n) * SEQ + (rt & (SEQ - 1))] = lf; }
            } else {
                { const int t = tid & 15, n = tid >> 4; float f = 0.f;
#pragma unroll
                  for (int ww = 0; ww < 8; ++ww) f += ((const LAS float*)&part[((buf * 8 + ww) * 2 + (n >> 4)) * 64 + (n & 15) + 16 * (t >> 2)])[t & 3];
                  const float sc = 1.0f / (1.0f + expf(-f)); scS[t * 32 + n] = sc; selS[t * 32 + n] = sc + A.bias[n]; }
                __syncthreads();
                if (tid < 16) { const LAS float* sl = selS + tid * 32; float bg = -INFINITY; int gi = 0;
                    for (int g = 0; g < 4; ++g) { float m1 = -INFINITY, m2 = -INFINITY;
                        for (int i = 0; i < 8; ++i) { const float v = sl[8 * g + i]; if (v > m1) { m2 = m1; m1 = v; } else if (v > m2) m2 = v; }
                        const float gs = m1 + m2; if (gs > bg) { bg = gs; gi = g; } }
                    int i1 = 0, i2 = 0; float v1 = -INFINITY, v2 = -INFINITY;
                    for (int i = 0; i < 8; ++i) { const float v = sl[8 * gi + i]; if (v > v1) { v1 = v; i1 = i; } }
                    for (int i = 0; i < 8; ++i) { const float v = sl[8 * gi + i]; if (i != i1 && v > v2) { v2 = v; i2 = i; } }
                    const int e0 = 8 * gi + i1, e1 = 8 * gi + i2; const float s0 = scS[tid * 32 + e0], s1 = scS[tid * 32 + e1], inv = 1.0f / (s0 + s1);
                    const int rt = R0 + 16 * it + tid;
                    const unsigned p0 = __hip_atomic_fetch_add(A.cnt + e0 * 64, 1u, RLX_AGENT), p1 = __hip_atomic_fetch_add(A.cnt + e1 * 64, 1u, RLX_AGENT);
                    A.tok[e0 * ECAP + p0] = rt * 2; A.gw[e0 * ECAP + p0] = s0 * inv; A.tok[e1 * ECAP + p1] = rt * 2 + 1; A.gw[e1 * ECAP + p1] = s1 * inv; }
            }
        }
    }
    __syncthreads();
}

constexpr int UT_E = 64, UT_X = 64 + 320, UT_V = 64 + 640;
__device__ __forceinline__ void build_etab(Frame& F, int layer) {
    LAS int* et = (LAS int*)(F.lds + ETAB_OFF);
    if (F.tid == 0) { int ts = 0;
        for (int e = 0; e < NE; ++e) { const int c = (int)__hip_atomic_load(F.ctl + CW_CNT + (layer * 32 + e) * 64, RLX_AGENT); const int nt = (c + 255) >> 8;
            for (int j = 0; j < nt; ++j) { et[UT_E + ts] = e; et[UT_X + ts] = e * ECAP + 256 * j; const int rem = c - 256 * j; et[UT_V + ts] = rem < 256 ? rem : 256; ++ts; } }
        et[0] = ts; }
    __syncthreads();
}
__device__ __forceinline__ void gather_rows(Frame& F) {
    const LAS int* et = (const LAS int*)(F.lds + ETAB_OFF);
    const int ptot = et[0] * 256; const int* tok = WSP(int, WS_TOK);
    const int gw = F.vcu * NWAVES + F.wave, NGW = F.G * NWAVES;
    for (int p = gw; p < ptot; p += NGW) { const int tile = p >> 8, rl = p & 255;
        if (rl < et[UT_V + tile]) { const int tk = tok[et[UT_X + tile] + rl] >> 1;
            const GAS v4u* s = (const GAS v4u*)(WSP(bf16, WS_HB) + (size_t)tk * D) + F.lane; GAS v4u* d = (GAS v4u*)(WSP(bf16, WS_XS) + (size_t)p * D) + F.lane;
            const v4u a = s[0], bq = s[64]; d[0] = a; d[64] = bq; } }
}
__device__ __forceinline__ void pool_rows(Frame& F) {
    const int ch = F.tid & 127, rs = F.tid >> 7; const int t0 = F.vcu * 128 + rs * 32; const int win = 2 << (ch >> 5);
    const bf16* hb = WSP(bf16, WS_HB) + ch * 8; bf16* pl = WSP(bf16, WS_PL) + ch * 8;
    float s[8];
#pragma unroll
    for (int j = 0; j < 8; ++j) s[j] = 0.f;
    const int s0 = t0 & (SEQ - 1);
    for (int i = 1; i < win; ++i) if (s0 - i >= 0) { const v4u a = *(const v4u*)(hb + (size_t)(t0 - i) * D);
        s[0] += bflo(a.x); s[1] += bfhi(a.x); s[2] += bflo(a.y); s[3] += bfhi(a.y); s[4] += bflo(a.z); s[5] += bfhi(a.z); s[6] += bflo(a.w); s[7] += bfhi(a.w); }
    for (int i = 0; i < 32; ++i) { const int t = t0 + i, sq = s0 + i;
        const v4u a = *(const v4u*)(hb + (size_t)t * D);
        float h[8]; h[0] = bflo(a.x); h[1] = bfhi(a.x); h[2] = bflo(a.y); h[3] = bfhi(a.y); h[4] = bflo(a.z); h[5] = bfhi(a.z); h[6] = bflo(a.w); h[7] = bfhi(a.w);
#pragma unroll
        for (int j = 0; j < 8; ++j) s[j] += h[j];
        const float ic = 1.0f / (float)((sq + 1 < win) ? (sq + 1) : win);
        v4u w; w.x = pk2(s[0] * ic - h[0], s[1] * ic - h[1]); w.y = pk2(s[2] * ic - h[2], s[3] * ic - h[3]); w.z = pk2(s[4] * ic - h[4], s[5] * ic - h[5]); w.w = pk2(s[6] * ic - h[6], s[7] * ic - h[7]);
        if (sq - win + 1 >= 0) { const v4u o = *(const v4u*)(hb + (size_t)(t - win + 1) * D);
            s[0] -= bflo(o.x); s[1] -= bfhi(o.x); s[2] -= bflo(o.y); s[3] -= bfhi(o.y); s[4] -= bflo(o.z); s[5] -= bfhi(o.z); s[6] -= bflo(o.w); s[7] -= bfhi(o.w); }
        *(v4u*)(pl + (size_t)t * D) = w; }
}

struct DenseSched {
    const char* A; const char* Bt; size_t strideA, strideB; int nM, nN, nwg, G, c;
    __device__ __forceinline__ bool next(int i, pg8::Unit& u) const {
        const long L = (long)i * G + c; if (L >= nwg) return false;
        int wgid = (int)L; { const int q = nwg / 8, r = nwg % 8, xcd = wgid % 8, off = wgid / 8; wgid = (xcd < r ? xcd * (q + 1) : r * (q + 1) + (xcd - r) * q) + off; }
        const int nig = 8 * nN, gid = wgid / nig, fm = gid * 8, gsz = (nM - fm) < 8 ? (nM - fm) : 8;
        u.pm = fm + ((wgid % nig) % gsz); u.pn = (wgid % nig) / gsz; u.a = A + (size_t)u.pm * strideA; u.b = Bt + (size_t)u.pn * strideB; u.x0 = 0; u.x1 = 0; return true;
    }
};
struct PoolSched {
    const char* A; const char* Bt; int G, v;
    __device__ __forceinline__ bool next(int i, pg8::Unit& u) const {
        const int L = i * G + v; if (L >= 512) return false;
        u.pm = L >> 2; u.pn = L & 3; u.a = A + (size_t)u.pm * 256 * D * 2 + (size_t)u.pn * 256 * 2; u.b = Bt + (size_t)u.pn * 65536 * 2; u.x0 = 0; u.x1 = 0; return true;
    }
};
template <bool DOWN> struct MoeSched {
    const LAS int* et; const char* A; const char* Bt; int G, v;
    static constexpr size_t rowA = DOWN ? (size_t)FD * 2 : (size_t)D * 2, strideE = DOWN ? (size_t)1024 * 512 * 2 : (size_t)1024 * 1024 * 2, stridePn = DOWN ? (size_t)256 * 512 * 2 : (size_t)256 * 1024 * 2;
    __device__ __forceinline__ bool next(int i, pg8::Unit& u) const {
        const int L = i * G + v; const int ntile = et[0]; if (L >= ntile * 4) return false;
        const int tile = L >> 2, pn = L & 3; const int e = et[UT_E + tile];
        u.pm = tile; u.pn = pn; u.a = A + (size_t)tile * 256 * rowA; u.b = Bt + (size_t)e * strideE + (size_t)pn * stridePn;
        if (DOWN) { u.x0 = et[UT_X + tile]; u.x1 = et[UT_V + tile]; } else { u.x0 = pn; u.x1 = tile * 256; }
        return true;
    }
};
constexpr int N_PHASES = 17;
struct Args { const float* in[17]; float* out; unsigned char* ws; int ph_lo, ph_hi; };
__global__ void __launch_bounds__(NWAVES * 64, 2) fwd_megakernel(Args args) {
    extern __shared__ __attribute__((aligned(16))) unsigned char lds[];
    Frame F;
    F.lds = (LAS unsigned char*)lds;
    F.MISC = (volatile LAS unsigned*)(F.lds + MISC_OFF);
    F.wave0 = __builtin_amdgcn_readfirstlane((int)threadIdx.x >> 6); F.tid = threadIdx.x; F.lane = F.tid & 63; F.wave = F.wave0;
    F.G = gridDim.x; { const int bx = blockIdx.x; F.vcu = (F.G % 8 == 0) ? (bx % 8) * (F.G / 8) + bx / 8 : bx; }
    F.ws0 = args.ws; F.out0 = args.out;
    F.ka0 = (const __attribute__((address_space(4))) char*)__builtin_amdgcn_kernarg_segment_ptr();
    phase_enter(F);
    for (int u = F.tid; u < (LDS_BYTES - LDSCTL_OFF) / 4; u += NWAVES * 64) ((LAS unsigned*)(F.lds + LDSCTL_OFF))[u] = 0u;
    __syncthreads();
    XcdBarrier bar; bar.bar = (unsigned*)(F.ctl + CW_BAR); bar.x = 0; bar.st = nullptr;
    if (!MK_MULTI) bar = xcd_barrier_post((unsigned*)(F.ctl + CW_BAR), F.MISC + 8);
    int lo = args.ph_lo, hi = args.ph_hi;
#ifndef PHMASK
#define PHMASK 0xFFFFFFFFu
#endif
#define IN(k) (((PHMASK >> (k)) & 1u) && lo <= (k) && (k) < hi)
#ifndef DUP_PHASE
#define DUP_PHASE -1
#endif
#define REP(k) for (int rep_ = 0; rep_ < ((k) == DUP_PHASE ? 2 : 1); ++rep_)
#define SEAM(k) do { if (IN(k) && IN((k) + 1)) xcd_barrier(bar); asm volatile("" : "+s"(lo), "+s"(hi)); } while (0)
#define mod WSP(float, WS_MOD)
#define HB WSP(bf16, WS_HB)

    if (IN(0)) REP(0) { phase_enter(F); p0_prologue(F); } SEAM(0);
#ifdef EXTRA_BARS
    for (int xb_ = 0; xb_ < EXTRA_BARS; ++xb_) xcd_barrier(bar);
#endif
    if (IN(1)) REP(1) { phase_enter(F); RowArgs A{}; A.src = FIN(IN_X); A.g = FIN(IN_NMG); A.shp = mod + 0; A.scp = mod + D; A.hb = HB; A.W = FIN(IN_WIN); A.bias = FIN(IN_FBIAS); A.logf = WSP(float, WS_LOGF);
        rowpass<0>(F, A); } SEAM(1);
    if (IN(2)) REP(2) { phase_enter(F); pg8::Gemm g{D, D, D}; DenseSched S{(const char*)HB, (const char*)WSP(bf16, WS_WQKV), (size_t)256 * D * 2, (size_t)256 * D * 2, T / 256, 3 * D / 256, (T / 256) * (3 * D / 256), F.G, (int)blockIdx.x};
        pg8::EpiQKV E{WSP(bf16, WS_Q), (size_t)(WS_K - WS_Q) / 2, attn_body::C2, (unsigned*)(F.ctl + CW_QKM)};
        pg8::gemm_phase<pg8::EpiQKV, DenseSched, true>(F.lds + RING_OFF, g, S, E, F.wave0); } SEAM(2);
    if (IN(3)) REP(3) { phase_enter(F); const attn_body::AttnTensors AT{(const attn_body::bf16*)WSP(bf16, WS_Q), (const attn_body::bf16*)WSP(bf16, WS_K), (const attn_body::bf16*)WSP(bf16, WS_V), (attn_body::bf16*)HB, WSP(float, WS_LOGF), (const unsigned*)(F.ctl + CW_QKM)};
        const attn_body::StaticOrder S((int)F.G, (int)blockIdx.x);
        attn_body::attn_phase<attn_body::StaticOrder>((char*)lds + RING_OFF, AT, S, F.wave0); } SEAM(3);
    if (IN(4)) REP(4) { phase_enter(F); pg8::Gemm g{D, D, D}; DenseSched S{(const char*)HB, (const char*)WSP(bf16, WS_WO), (size_t)256 * D * 2, (size_t)256 * D * 2, T / 256, D / 256, (T / 256) * (D / 256), F.G, (int)blockIdx.x};
        pg8::EpiResid E{FIN(IN_X), F.out, mod + 2 * D};
        pg8::gemm_phase<pg8::EpiResid, DenseSched, true>(F.lds + RING_OFF, g, S, E, F.wave0); } SEAM(4);
        if (IN(5)) REP(5) { phase_enter(F); RowArgs A{}; A.src = F.out; A.g = FIN(IN_NFG) + 0 * D; A.shp = mod + (size_t)0 * 8 * MODW + 3 * D; A.scp = mod + (size_t)0 * 8 * MODW + 4 * D; A.hb = HB;
            A.W = FIN(IN_RW); A.bias = FIN(IN_RB); A.cnt = F.ctl + CW_CNT + 0 * 32 * 64; A.tok = WSP(int, WS_TOK); A.gw = WSP(float, WS_GW);
            if (rep_) { A.cnt = F.ctl + CW_CNT + 2 * 32 * 64; A.tok = WSP(int, WS_END); A.gw = WSP(float, WS_END + 4 * MiB); }
            rowpass<1>(F, A); } SEAM(5);
        if (IN(6)) REP(6) { phase_enter(F); build_etab(F, 0); gather_rows(F); } SEAM(6);
        if (IN(7)) REP(7) { phase_enter(F); build_etab(F, 0); pg8::Gemm g{D, D, D};
            MoeSched<false> S{(const LAS int*)(F.lds + ETAB_OFF), (const char*)WSP(bf16, WS_XS), (const char*)(WSP(bf16, WS_UP) + (size_t)0 * NE * 1024 * 1024), F.G, F.vcu};
            pg8::EpiUp E{WSP(bf16, WS_HH)};
            pg8::gemm_phase<pg8::EpiUp, MoeSched<false>, true>(F.lds + RING_OFF, g, S, E, F.wave0); } SEAM(7);
        if (IN(8)) REP(8) { phase_enter(F); build_etab(F, 0); pg8::Gemm g{FD, FD, FD};
            MoeSched<true> S{(const LAS int*)(F.lds + ETAB_OFF), (const char*)WSP(bf16, WS_HH), (const char*)(WSP(bf16, WS_DN) + (size_t)0 * NE * 1024 * 512), F.G, F.vcu};
            pg8::EpiDown E{WSP(bf16, WS_Y2), WSP(int, WS_TOK), WSP(float, WS_GW)};
            pg8::gemm_phase<pg8::EpiDown, MoeSched<true>, true>(F.lds + RING_OFF, g, S, E, F.wave0); } SEAM(8);

            if (IN(9)) REP(9) { phase_enter(F); RowArgs A{}; A.src = F.out; A.dst = F.out; A.g = FIN(IN_NMG) + D; A.shp = mod + 8 * MODW + 0; A.scp = mod + 8 * MODW + D; A.gtp = mod + 5 * D; A.y2 = WSP(bf16, WS_Y2); A.hb = HB;
                rowpass<2>(F, A); } SEAM(9);
            if (IN(10)) REP(10) { phase_enter(F); pool_rows(F); } SEAM(10);
            if (IN(11)) REP(11) { phase_enter(F); pg8::Gemm g{D, 256, 256}; PoolSched S{(const char*)WSP(bf16, WS_PL), (const char*)WSP(bf16, WS_WP), F.G, F.vcu};
                pg8::EpiPool E{F.out, mod + 8 * MODW + 2 * D, FIN(IN_POOLS)};
                pg8::gemm_phase<pg8::EpiPool, PoolSched, true>(F.lds + RING_OFF, g, S, E, F.wave0); } SEAM(11);
        if (IN(12)) REP(12) { phase_enter(F); RowArgs A{}; A.src = F.out; A.g = FIN(IN_NFG) + 1 * D; A.shp = mod + (size_t)1 * 8 * MODW + 3 * D; A.scp = mod + (size_t)1 * 8 * MODW + 4 * D; A.hb = HB;
            A.W = FIN(IN_RW); A.bias = FIN(IN_RB); A.cnt = F.ctl + CW_CNT + 1 * 32 * 64; A.tok = WSP(int, WS_TOK); A.gw = WSP(float, WS_GW);
            rowpass<1>(F, A); } SEAM(12);
        if (IN(13)) REP(13) { phase_enter(F); build_etab(F, 1); gather_rows(F); } SEAM(13);
        if (IN(14)) REP(14) { phase_enter(F); build_etab(F, 1); pg8::Gemm g{D, D, D};
            MoeSched<false> S{(const LAS int*)(F.lds + ETAB_OFF), (const char*)WSP(bf16, WS_XS), (const char*)(WSP(bf16, WS_UP) + (size_t)1 * NE * 1024 * 1024), F.G, F.vcu};
            pg8::EpiUp E{WSP(bf16, WS_HH)};
            pg8::gemm_phase<pg8::EpiUp, MoeSched<false>, true>(F.lds + RING_OFF, g, S, E, F.wave0); } SEAM(14);
        if (IN(15)) REP(15) { phase_enter(F); build_etab(F, 1); pg8::Gemm g{FD, FD, FD};
            MoeSched<true> S{(const LAS int*)(F.lds + ETAB_OFF), (const char*)WSP(bf16, WS_HH), (const char*)(WSP(bf16, WS_DN) + (size_t)1 * NE * 1024 * 512), F.G, F.vcu};
            pg8::EpiDown E{WSP(bf16, WS_Y2), WSP(int, WS_TOK), WSP(float, WS_GW)};
            pg8::gemm_phase<pg8::EpiDown, MoeSched<true>, true>(F.lds + RING_OFF, g, S, E, F.wave0); } SEAM(15);
    if (IN(16)) REP(16) { phase_enter(F); RowArgs A{}; A.src = F.out; A.dst = F.out; A.g = FIN(IN_NFIN); A.gtp = mod + 8 * MODW + 5 * D; A.y2 = WSP(bf16, WS_Y2);
        rowpass<3>(F, A); }
#undef IN
#undef SEAM
#undef mod
#undef HB
}

extern "C" void kernel_launch(void* const* d_in, const int* in_sizes, int n_in, void* d_out, int out_size, void* d_ws, size_t ws_size, hipStream_t stream) {
    static int grid = 0;
    if (grid == 0) {
        if (n_in != 17 || in_sizes[0] != T * D || out_size != T * D || ws_size < WS_END) { fprintf(stderr, "kernel_launch: unexpected shapes (n_in %d, in0 %d, out %d, ws %zu)\n", n_in, n_in > 0 ? in_sizes[0] : -1, out_size, ws_size); grid = -1; return; }
        int dev = 0, cus = 0, per_cu = 0;
        if (hipGetDevice(&dev) != hipSuccess || hipDeviceGetAttribute(&cus, hipDeviceAttributeMultiprocessorCount, dev) != hipSuccess) { grid = -1; return; }
        if (hipFuncSetAttribute((const void*)fwd_megakernel, hipFuncAttributeMaxDynamicSharedMemorySize, LDS_BYTES) != hipSuccess) { fprintf(stderr, "kernel_launch: hipFuncSetAttribute failed\n"); grid = -1; return; }
        if (hipOccupancyMaxActiveBlocksPerMultiprocessor(&per_cu, (const void*)fwd_megakernel, NWAVES * 64, LDS_BYTES) != hipSuccess || per_cu < 1) { fprintf(stderr, "kernel_launch: occupancy query says %d\n", per_cu); (void)hipGetLastError(); grid = -1; return; }
        grid = cus;
        if (grid != 256) fprintf(stderr, "kernel_launch: %d CUs; this kernel's static work split expects 256\n", grid);
    }
    if (grid < 0) return;
    (void)hipMemsetAsync((char*)d_ws + WS_CTL, 0, CTL_ZERO_BYTES, stream);
    Args a{};
    for (int i = 0; i < 17; ++i) a.in[i] = (const float*)d_in[i];
    a.out = (float*)d_out; a.ws = (unsigned char*)d_ws;
#if MK_MULTI
#ifndef MAXPH
#define MAXPH 17
#endif
    for (int p = 0; p < MAXPH; ++p) { a.ph_lo = p; a.ph_hi = p + 1; hipLaunchKernelGGL(fwd_megakernel, dim3(grid), dim3(NWAVES * 64), LDS_BYTES, stream, a); }
#else
    a.ph_lo = 0; a.ph_hi = 17;
    void* kargs[] = {&a};
    hipError_t e = hipLaunchCooperativeKernel((const void*)fwd_megakernel, dim3(grid), dim3(NWAVES * 64), kargs, LDS_BYTES, stream);
    if (e != hipSuccess) fprintf(stderr, "kernel_launch: cooperative launch failed: %s\n", hipGetErrorString(e));
#endif
}
```

```cpp
#define MK_MULTI 0
#define MAXPH 17
#include <hip/hip_runtime.h>
#include <hip/hip_bf16.h>
#include <cstdio>
#include <cstdint>
#include <cmath>
__device__ __forceinline__ int opaque_tid(int wave0) { int w = wave0; asm volatile("" : "+s"(w)); unsigned m = ~0u; asm volatile("" : "+s"(m)); const int l = (int)__builtin_amdgcn_mbcnt_hi(m, __builtin_amdgcn_mbcnt_lo(m, 0u)); return w * 64 + l; }
namespace pg8 {
#define PG8_LAS __attribute__((address_space(3)))
typedef unsigned short bf16_t;
typedef short bf16x8 __attribute__((ext_vector_type(8)));
typedef float f32x4 __attribute__((ext_vector_type(4)));
typedef float f32x2 __attribute__((ext_vector_type(2)));
typedef unsigned u32x4 __attribute__((ext_vector_type(4)));
constexpr int BM = 256, BK = 64, HALF = 128, HTB = HALF * BK * 2  , STAGE_BYTES = 8 * HTB, NXCD = 8, WGM = 8;

__host__ __device__ __forceinline__ int lds_byte(int r, int c) { const int st = (r >> 4) * 2 + (c >> 5), rr = r & 15, cc = c & 31, ob = rr * 64 + cc * 2; return st * 1024 + (ob ^ (((ob >> 9) & 1) << 5)); }
__host__ __device__ __forceinline__ void stage_rc(int b, int& R, int& C) { const int st = b / 1024, sb = b % 1024, swz = sb ^ (((sb >> 9) & 1) << 5); R = (st >> 1) * 16 + swz / 64; C = (st & 1) * 32 + (swz % 64) / 2; }
__host__ __device__ __forceinline__ int perm32(int rho) { const int n = rho >> 4, i = rho & 15; return 8 * (i >> 2) + 4 * n + (i & 3); }

struct Unit { const char* a; const char* b; int pm, pn, x0, x1; };
struct Gemm { int lda, ldb, K; };

__device__ __forceinline__ unsigned cvt_pk_bf16(float lo, float hi) { unsigned r; asm volatile("v_cvt_pk_bf16_f32 %0, %1, %2" : "=v"(r) : "v"(lo), "v"(hi)); return r; }


struct EpiBf16 {
    static constexpr bool PERM = true, AFTER_DRAIN = false;
    bf16_t* O; int ldc; int split_cols; size_t split_stride; float scale0;
    __device__ __forceinline__ void operator()(const f32x4 (&acc)[2][2][4][2], const Unit& u, int wr, int wc, int fr, int fq) const {
        const int row0 = u.pm * BM + wr * 64 + fr; int colt = u.pn * BM; bf16_t* base = O;
        float sc = 1.f; if (split_cols) { const int t = colt / split_cols; base += (size_t)t * split_stride; colt -= t * split_cols; if (t == 0) sc = scale0; }
        const int col0 = colt + wc * 32 + 8 * fq;
#pragma unroll
        for (int ai = 0; ai < 2; ++ai)
#pragma unroll
            for (int m = 0; m < 4; ++m) { bf16_t* rowp = base + (size_t)(row0 + ai * HALF + m * 16) * ldc + col0;
#pragma unroll
                for (int bj = 0; bj < 2; ++bj) { f32x4 v0 = acc[ai][bj][m][0] * sc, v1 = acc[ai][bj][m][1] * sc;
                    u32x4 w; w.x = cvt_pk_bf16(v0[0], v0[1]); w.y = cvt_pk_bf16(v0[2], v0[3]); w.z = cvt_pk_bf16(v1[0], v1[1]); w.w = cvt_pk_bf16(v1[2], v1[3]);
                    *(u32x4*)(rowp + bj * HALF) = w; } }
    }
};
struct EpiQKV {
    static constexpr bool PERM = true, AFTER_DRAIN = false;
    bf16_t* O; size_t stride; float scale0; unsigned* qkm;
    __device__ __forceinline__ void operator()(const f32x4 (&acc)[2][2][4][2], const Unit& u, int wr, int wc, int fr, int fq) const {
        const int t = u.pn >> 2, colt = (u.pn & 3) * BM, b = u.pm >> 4; bf16_t* base = O + (size_t)t * stride;
        const float sc = (t == 0) ? scale0 : 1.f;
        const int row0 = u.pm * BM + wr * 64 + fr, col0 = colt + wc * 32 + 8 * fq, lane = fr + 16 * fq;
        float mx0 = 0.f, mx1 = 0.f;
#pragma unroll
        for (int ai = 0; ai < 2; ++ai)
#pragma unroll
            for (int m = 0; m < 4; ++m) { bf16_t* rowp = base + (size_t)(row0 + ai * HALF + m * 16) * 1024 + col0;
#pragma unroll
                for (int bj = 0; bj < 2; ++bj) { const f32x4 v0 = acc[ai][bj][m][0] * sc, v1 = acc[ai][bj][m][1] * sc;
                    u32x4 w; w.x = cvt_pk_bf16(v0[0], v0[1]); w.y = cvt_pk_bf16(v0[2], v0[3]); w.z = cvt_pk_bf16(v1[0], v1[1]); w.w = cvt_pk_bf16(v1[2], v1[3]);
                    *(u32x4*)(rowp + bj * HALF) = w;
                    if (t < 2) { float ss = (v0[0] * v0[0] + v0[1] * v0[1]) + (v0[2] * v0[2] + v0[3] * v0[3]) + (v1[0] * v1[0] + v1[1] * v1[1]) + (v1[2] * v1[2] + v1[3] * v1[3]);
                        ss += __int_as_float(__builtin_amdgcn_ds_bpermute((lane ^ 16) << 2, __float_as_int(ss))); ss += __int_as_float(__builtin_amdgcn_ds_bpermute((lane ^ 32) << 2, __float_as_int(ss)));
                        if (bj == 0) mx0 = fmaxf(mx0, ss); else mx1 = fmaxf(mx1, ss); } } }
        if (t < 2) {
#pragma unroll
            for (int o = 1; o < 16; o <<= 1) { mx0 = fmaxf(mx0, __int_as_float(__builtin_amdgcn_ds_bpermute((lane ^ o) << 2, __float_as_int(mx0)))); mx1 = fmaxf(mx1, __int_as_float(__builtin_amdgcn_ds_bpermute((lane ^ o) << 2, __float_as_int(mx1)))); }
            if (lane == 0) { unsigned* w = qkm + (t * 8 + b) * 32 + (u.pn & 3) * 8 + wc; atomicMax(w, __float_as_uint(mx0)); atomicMax(w + 4, __float_as_uint(mx1)); } }
    }
};
struct EpiResid {
    static constexpr bool PERM = false, AFTER_DRAIN = false;
    const float* base; float* out; const float* gate;
    __device__ __forceinline__ void operator()(const f32x4 (&acc)[2][2][4][2], const Unit& u, int wr, int wc, int fr, int fq) const {
        const int col0 = u.pn * BM + wc * 32 + 4 * fq; const int b = u.pm >> 4;
        f32x4 gv[2][2];
#pragma unroll
        for (int bj = 0; bj < 2; ++bj)
#pragma unroll
            for (int n = 0; n < 2; ++n) gv[bj][n] = *(const f32x4*)(gate + (size_t)b * 6144 + col0 + bj * HALF + n * 16);
#pragma unroll
        for (int ai = 0; ai < 2; ++ai)
#pragma unroll
            for (int m = 0; m < 4; ++m) { const size_t off = (size_t)(u.pm * BM + ai * HALF + wr * 64 + m * 16 + fr) * 1024 + col0;
#pragma unroll
                for (int bj = 0; bj < 2; ++bj)
#pragma unroll
                    for (int n = 0; n < 2; ++n) { const f32x4 bs = *(const f32x4*)(base + off + bj * HALF + n * 16); *(f32x4*)(out + off + bj * HALF + n * 16) = bs + gv[bj][n] * acc[ai][bj][m][n]; }
                if (m & 1) asm volatile("" ::: "memory"); }
    }
};
struct EpiPool {
    static constexpr bool PERM = false, AFTER_DRAIN = false;
    float* xr; const float* gate; const float* pscale;
    __device__ __forceinline__ void operator()(const f32x4 (&acc)[2][2][4][2], const Unit& u, int wr, int wc, int fr, int fq) const {
        const int col0 = u.pn * BM + wc * 32 + 4 * fq; const int b = u.pm >> 4;
        float* rbase = xr + (size_t)(u.pm * BM + wr * 64 + fr) * 1024 + col0;
#pragma unroll
        for (int bj = 0; bj < 2; ++bj)
#pragma unroll
            for (int n = 0; n < 2; ++n) { const f32x4 gv = *(const f32x4*)(gate + (size_t)b * 6144 + col0 + bj * HALF + n * 16) * *(const f32x4*)(pscale + col0 + bj * HALF + n * 16);
#pragma unroll
                for (int ai = 0; ai < 2; ++ai)
#pragma unroll
                    for (int m = 0; m < 4; ++m) { float* p = rbase + (size_t)(ai * HALF + m * 16) * 1024 + bj * HALF + n * 16; const f32x4 bs = *(const f32x4*)p; *(f32x4*)p = bs + gv * acc[ai][bj][m][n]; }
                asm volatile("" ::: "memory"); }
    }
};
__device__ __forceinline__ float silu_mul(float g, float u) { return g * u * __builtin_amdgcn_rcpf(1.0f + __builtin_amdgcn_exp2f(-1.4426950408889634f * g)); }
struct EpiUp {
    static constexpr bool PERM = true, AFTER_DRAIN = false;
    bf16_t* H;
    __device__ __forceinline__ void operator()(const f32x4 (&acc)[2][2][4][2], const Unit& u, int wr, int wc, int fr, int fq) const {
        const int row0 = u.x1 + wr * 64 + fr, col0 = u.x0 * 128 + wc * 32 + 8 * fq;
#pragma unroll
        for (int ai = 0; ai < 2; ++ai)
#pragma unroll
            for (int m = 0; m < 4; ++m) { bf16_t* rowp = H + (size_t)(row0 + ai * HALF + m * 16) * 512 + col0;
                const f32x4 g0 = acc[ai][0][m][0], g1 = acc[ai][0][m][1], u0 = acc[ai][1][m][0], u1 = acc[ai][1][m][1];
                u32x4 w; w.x = cvt_pk_bf16(silu_mul(g0[0], u0[0]), silu_mul(g0[1], u0[1])); w.y = cvt_pk_bf16(silu_mul(g0[2], u0[2]), silu_mul(g0[3], u0[3]));
                w.z = cvt_pk_bf16(silu_mul(g1[0], u1[0]), silu_mul(g1[1], u1[1])); w.w = cvt_pk_bf16(silu_mul(g1[2], u1[2]), silu_mul(g1[3], u1[3]));
                *(u32x4*)rowp = w; }
    }
};
struct EpiDown {
    static constexpr bool PERM = true, AFTER_DRAIN = false;
    bf16_t* Y; const int* tok; const float* gw;
    __device__ __forceinline__ void operator()(const f32x4 (&acc)[2][2][4][2], const Unit& u, int wr, int wc, int fr, int fq) const {
        const int col0 = u.pn * BM + wc * 32 + 8 * fq;
#pragma unroll
        for (int ai = 0; ai < 2; ++ai)
#pragma unroll
            for (int m = 0; m < 4; ++m) { const int rl = ai * HALF + wr * 64 + m * 16 + fr;
                if (rl < u.x1) { const int d = tok[u.x0 + rl]; const float w8 = gw[u.x0 + rl]; bf16_t* rowp = Y + (size_t)d * 1024 + col0;
#pragma unroll
                    for (int bj = 0; bj < 2; ++bj) { const f32x4 v0 = acc[ai][bj][m][0] * w8, v1 = acc[ai][bj][m][1] * w8;
                        u32x4 w; w.x = cvt_pk_bf16(v0[0], v0[1]); w.y = cvt_pk_bf16(v0[2], v0[3]); w.z = cvt_pk_bf16(v1[0], v1[1]); w.w = cvt_pk_bf16(v1[2], v1[3]);
                        *(u32x4*)(rowp + bj * HALF) = w; } } }
    }
};

template <class Epi, class Sched, bool ALIGN_EPI>
__device__ __forceinline__ void gemm_phase(PG8_LAS unsigned char* lds, const Gemm g, const Sched& S, const Epi& E, int wave0) {
    int tid_ = opaque_tid(wave0);
    const int tid = tid_, wid = __builtin_amdgcn_readfirstlane(tid >> 6), lane = tid & 63, wr = wid >> 2, wc = wid & 3, fr = lane & 15, fq = lane >> 4;
    const int K = g.K, nt = K / BK;
    unsigned voffA[2], voffB[2];
#pragma unroll
    for (int i = 0; i < 2; ++i) { int R, C; stage_rc(tid * 16 + i * 8192, R, C); const int Rb = Epi::PERM ? ((R & ~31) + perm32(R & 31)) : R;
        voffA[i] = (unsigned)(R * g.lda + C) * 2u; voffB[i] = (unsigned)(Rb * g.ldb + C) * 2u; }
    const size_t kstep = (size_t)(BK * 2);
    const size_t hstepA = (size_t)HALF * g.lda * 2, hstepB = (size_t)HALF * g.ldb * 2;
    const unsigned ldsw = (unsigned)wid * 1024u;
    const int aoff = lds_byte(wr * 64 + fr, fq * 8), boff = lds_byte(wc * 32 + fr, fq * 8);
#define PG8_SA(b, h) (((b) * 2 + (h)) * HTB)
#define PG8_SB(b, h) ((4 + (b) * 2 + (h)) * HTB)
#define PG8_STAGE(bufoff, gbase, voff) do { _Pragma("unroll") for (int _i = 0; _i < 2; ++_i) \
        __builtin_amdgcn_global_load_lds((const unsigned*)((const char*)(gbase) + (voff)[_i]), (PG8_LAS unsigned*)(lds + (bufoff) + ldsw + _i * 8192), 16, 0, 0); } while (0)
#define PG8_LDA(dst, b, h) do { _Pragma("unroll") for (int m = 0; m < 4; ++m) _Pragma("unroll") for (int k = 0; k < 2; ++k) dst[m][k] = *(const PG8_LAS bf16x8*)(lds + PG8_SA(b, h) + aoff + m * 2048 + k * 1024); } while (0)
#define PG8_LDB(dst, b, h) do { _Pragma("unroll") for (int n = 0; n < 2; ++n) _Pragma("unroll") for (int k = 0; k < 2; ++k) dst[n][k] = *(const PG8_LAS bf16x8*)(lds + PG8_SB(b, h) + boff + n * 2048 + k * 1024); } while (0)
#define PG8_MMA(ai, bj, At, Bt) do { __builtin_amdgcn_s_setprio(1); _Pragma("unroll") for (int m = 0; m < 4; ++m) _Pragma("unroll") for (int n = 0; n < 2; ++n) _Pragma("unroll") for (int k = 0; k < 2; ++k) \
        acc[ai][bj][m][n] = __builtin_amdgcn_mfma_f32_16x16x32_bf16(Bt[n][k], At[m][k], acc[ai][bj][m][n], 0, 0, 0); __builtin_amdgcn_s_setprio(0); } while (0)
#define PG8_WAIT_V(n) asm volatile("s_waitcnt vmcnt(" #n ")" ::: "memory")
#define PG8_WAIT_L(n) asm volatile("s_waitcnt lgkmcnt(" #n ")" ::: "memory")
#define PG8_BAR __builtin_amdgcn_s_barrier()
#define PG8_SCHED __builtin_amdgcn_sched_barrier(0)
    Unit cur, nxt; int ui = 0;
    if (!S.next(0, cur)) return;
    f32x4 acc[2][2][4][2];
#pragma unroll
    for (int a = 0; a < 2; ++a)
#pragma unroll
        for (int b = 0; b < 2; ++b)
#pragma unroll
            for (int m = 0; m < 4; ++m)
#pragma unroll
                for (int n = 0; n < 2; ++n) acc[a][b][m][n] = (f32x4){0.f, 0.f, 0.f, 0.f};
    bf16x8 At[4][2], B0[2][2], B1[2][2];
    const char* cA = cur.a; const char* cB = cur.b;
    PG8_STAGE(PG8_SB(0, 0), cB, voffB); PG8_STAGE(PG8_SB(0, 1), cB + hstepB, voffB); PG8_STAGE(PG8_SA(0, 0), cA, voffA); PG8_STAGE(PG8_SA(0, 1), cA + hstepA, voffA);
    if (wr == 1) PG8_BAR;
    PG8_WAIT_V(2); PG8_BAR;
    PG8_STAGE(PG8_SB(1, 0), cB + kstep, voffB); PG8_STAGE(PG8_SA(1, 0), cA + kstep, voffA); PG8_STAGE(PG8_SB(1, 1), cB + hstepB + kstep, voffB);
    PG8_WAIT_V(6); PG8_BAR;
    for (;;) {
        const bool has_next = S.next(ui + 1, nxt);
        const char* nA = has_next ? nxt.a : cA; const char* nB = has_next ? nxt.b : cB;
        for (int t = 0; t < nt; t += 2) {
            const bool last = (t == nt - 2);
            const char* a1 = cA + (size_t)(t + 1) * kstep;
            const char* a2 = last ? nA : cA + (size_t)(t + 2) * kstep; const char* b2 = last ? nB : cB + (size_t)(t + 2) * kstep;
            const char* a3 = a2 + kstep; const char* b3 = b2 + kstep;
            PG8_LDB(B0, 0, 0); PG8_LDB(B1, 0, 1); PG8_SCHED; PG8_LDA(At, 0, 0); PG8_STAGE(PG8_SA(1, 1), a1 + hstepA, voffA);
            PG8_WAIT_V(8); PG8_WAIT_L(0); PG8_BAR; PG8_MMA(0, 0, At, B0); PG8_MMA(0, 1, At, B1); PG8_BAR; PG8_SCHED;
            PG8_LDA(At, 0, 1); PG8_STAGE(PG8_SB(0, 0), b2, voffB); PG8_STAGE(PG8_SB(0, 1), b2 + hstepB, voffB); PG8_STAGE(PG8_SA(0, 0), a2, voffA);
            PG8_WAIT_V(8); PG8_WAIT_L(0); PG8_BAR; PG8_MMA(1, 0, At, B0); PG8_MMA(1, 1, At, B1); PG8_BAR; PG8_SCHED;
            PG8_LDB(B0, 1, 0); PG8_LDB(B1, 1, 1); PG8_SCHED; PG8_LDA(At, 1, 0); PG8_STAGE(PG8_SA(0, 1), a2 + hstepA, voffA);
            PG8_WAIT_V(8); PG8_WAIT_L(0); PG8_BAR; PG8_MMA(0, 0, At, B0); PG8_MMA(0, 1, At, B1); PG8_BAR; PG8_SCHED;
            PG8_LDA(At, 1, 1); PG8_STAGE(PG8_SB(1, 0), b3, voffB); PG8_STAGE(PG8_SB(1, 1), b3 + hstepB, voffB); PG8_STAGE(PG8_SA(1, 0), a3, voffA);
            PG8_WAIT_V(8); PG8_WAIT_L(0); PG8_BAR; PG8_MMA(1, 0, At, B0); PG8_MMA(1, 1, At, B1); PG8_BAR; PG8_SCHED;
        }
        if constexpr (ALIGN_EPI) { if (wr == 0) PG8_BAR; }
        E(acc, cur, wr, wc, fr, fq);
        if (!has_next) break;
#pragma unroll
        for (int a = 0; a < 2; ++a)
#pragma unroll
            for (int b = 0; b < 2; ++b)
#pragma unroll
                for (int m = 0; m < 4; ++m)
#pragma unroll
                    for (int n = 0; n < 2; ++n) acc[a][b][m][n] = (f32x4){0.f, 0.f, 0.f, 0.f};
        cur = nxt; cA = nA; cB = nB; ++ui;
        if constexpr (ALIGN_EPI) { if (wr == 1) PG8_BAR; }
    }
    PG8_WAIT_V(0);
    if constexpr (!ALIGN_EPI) { if (wr == 0) PG8_BAR; }
    PG8_BAR;
#undef PG8_SA
#undef PG8_SB
#undef PG8_STAGE
#undef PG8_LDA
#undef PG8_LDB
#undef PG8_MMA
#undef PG8_WAIT_V
#undef PG8_WAIT_L
#undef PG8_BAR
#undef PG8_SCHED
}
}
namespace attn_body {
using bf16=__hip_bfloat16;
using bf16x8=__attribute__((ext_vector_type(8)))short;
using s16x4=__attribute__((ext_vector_type(4)))short;
using f32x16=__attribute__((ext_vector_type(16)))float;
using f32x4=__attribute__((ext_vector_type(4)))float;
using u32x4=__attribute__((ext_vector_type(4)))unsigned;
constexpr int BATCH=8,NHEAD=16,SEQ=4096,D=64,DM=NHEAD*D;
constexpr int NW=8,QBLK=32,QB=QBLK*NW,KVBLK=64,NQB=SEQ/QB;
constexpr int ATTN_PITCH=DM, ATTN_UNIT_ROWS=QB;
__device__ __forceinline__ int crow(int r,int hi){return (r&3)+8*(r>>2)+4*hi;}
#define SBAR() __builtin_amdgcn_sched_barrier(0)
__device__ __forceinline__ void cmask(f32x16&p0,f32x16&p1,int jb,int qrel,int hi){
  const float NEG=-INFINITY; int kb=64*jb+4*hi;
  #pragma unroll
  for(int r=0;r<16;++r){int kv=kb+(r&3)+8*(r>>2); if(kv>qrel)p0[r]=NEG; if(kv+32>qrel)p1[r]=NEG;}
}

constexpr int NSLOT=3, SLOTB=8192;
constexpr int LDS_K=0, LDS_V=NSLOT*SLOTB, LDS_WS=2*NSLOT*SLOTB, LDS_OST=LDS_WS+NW*64*4, LDS_FS=LDS_OST+NW*4096, LDS_WT=LDS_FS+SEQ*4, LDS_BYTES=LDS_WT+64;
constexpr float C2=0.125f*1.4426950408889634f;
constexpr float LOG2E=1.4426950408889634f;
__device__ __forceinline__ void glds16(const void*gsrc,unsigned lds_dst){unsigned keep;
  asm volatile("s_mov_b32 %0, m0\n\ts_mov_b32 m0, %2\n\ts_nop 0\n\tglobal_load_lds_dwordx4 %1, off\n\ts_mov_b32 m0, %0":"=&s"(keep):"v"(gsrc),"s"(lds_dst):"memory");}
__device__ __forceinline__ void glds16s(const void*sbase,unsigned voff,unsigned lds_dst){unsigned keep;
  asm volatile("s_mov_b32 %0, m0\n\ts_mov_b32 m0, %3\n\ts_nop 4\n\tglobal_load_lds_dwordx4 %1, %2\n\ts_mov_b32 m0, %0":"=&s"(keep):"v"(voff),"s"(sbase),"s"(lds_dst):"memory");}
__device__ __forceinline__ float max3f(float a,float b,float c){float r;asm("v_max3_f32 %0, %1, %2, %3":"=v"(r):"v"(a),"v"(b),"v"(c));return r;}
__device__ __forceinline__ float max2f(float a,float b){float r;asm("v_max_f32_e32 %0, %1, %2":"=v"(r):"v"(a),"v"(b));return r;}
__device__ __forceinline__ float fadd_s(float a,float b){float r;asm("v_add_f32_e32 %0, %1, %2":"=v"(r):"v"(a),"v"(b));return r;}
__device__ __forceinline__ float fsub_s(float a,float b){float r;asm("v_sub_f32_e32 %0, %1, %2":"=v"(r):"v"(a),"v"(b));return r;}
typedef float f32x2_t __attribute__((ext_vector_type(2))); typedef __bf16 bf16x2_t __attribute__((ext_vector_type(2)));
__device__ __forceinline__ unsigned cvtpk_s(float lo,float hi){f32x2_t v={lo,hi};bf16x2_t b=__builtin_convertvector(v,bf16x2_t);return __builtin_bit_cast(unsigned,b);}
#define WAIT_BAR(N) asm volatile("s_waitcnt vmcnt(" #N ") lgkmcnt(0)\n\ts_barrier":::"memory")

typedef __attribute__((address_space(3))) const char* lds_cptr;
typedef short v4i16_t __attribute__((ext_vector_type(4)));
__device__ __forceinline__ void fbias(f32x16&c0,f32x16&c1,lds_cptr ft,float nm,int hi){
  #pragma unroll
  for(int g=0;g<4;++g){
    const f32x4 a=*(const __attribute__((address_space(3))) f32x4*)(ft+(8*g+4*hi)*4);
    const f32x4 b=*(const __attribute__((address_space(3))) f32x4*)(ft+(32+8*g+4*hi)*4);
    c0[4*g+0]=nm-a[0];c0[4*g+1]=nm-a[1];c0[4*g+2]=nm-a[2];c0[4*g+3]=nm-a[3];
    c1[4*g+0]=nm-b[0];c1[4*g+1]=nm-b[1];c1[4*g+2]=nm-b[2];c1[4*g+3]=nm-b[3];}
}
__device__ __forceinline__ void qkt(f32x16&p0,f32x16&p1,const char*Kslot,const bf16x8*qr,int r32,int hi){
  const char*kb=Kslot+hi*1024+r32*16;
  #pragma unroll
  for(int d0=0;d0<4;++d0){
    const bf16x8 b0=*reinterpret_cast<const bf16x8*>(kb+d0*2048);
    const bf16x8 b1=*reinterpret_cast<const bf16x8*>(kb+d0*2048+512);
    p0=__builtin_amdgcn_mfma_f32_32x32x16_bf16(b0,qr[d0],p0,0,0,0);p1=__builtin_amdgcn_mfma_f32_32x32x16_bf16(b1,qr[d0],p1,0,0,0);}
}
__device__ __forceinline__ void kload8(bf16x8*kf,lds_cptr kp){
  kf[0]=*(const __attribute__((address_space(3))) bf16x8*)(kp);      kf[1]=*(const __attribute__((address_space(3))) bf16x8*)(kp+512);
  kf[2]=*(const __attribute__((address_space(3))) bf16x8*)(kp+2048); kf[3]=*(const __attribute__((address_space(3))) bf16x8*)(kp+2560);
  kf[4]=*(const __attribute__((address_space(3))) bf16x8*)(kp+4096); kf[5]=*(const __attribute__((address_space(3))) bf16x8*)(kp+4608);
  kf[6]=*(const __attribute__((address_space(3))) bf16x8*)(kp+6144); kf[7]=*(const __attribute__((address_space(3))) bf16x8*)(kp+6656);
}
__device__ __forceinline__ void kload2(bf16x8*kf,lds_cptr kp,int j){ kf[2*j]=*(const __attribute__((address_space(3))) bf16x8*)(kp+j*2048); kf[2*j+1]=*(const __attribute__((address_space(3))) bf16x8*)(kp+j*2048+512); }
__device__ __forceinline__ s16x4 vtr(lds_cptr p){ return __builtin_bit_cast(s16x4,__builtin_amdgcn_ds_read_tr16_b64_v4i16((__attribute__((address_space(3))) v4i16_t*)p)); }
__device__ __forceinline__ float rowmax(const f32x16&p0,const f32x16&p1){
  float a=max3f(p0[0],p0[1],p1[0]),b=max3f(p0[2],p0[3],p1[1]);a=max3f(a,p1[2],p1[3]);
  #pragma unroll
  for(int r=4;r<16;r+=4){a=max3f(a,p0[r],p0[r+1]);b=max3f(b,p0[r+2],p0[r+3]);a=max3f(a,p1[r],p1[r+1]);b=max3f(b,p1[r+2],p1[r+3]);}
  const float m=max2f(a,b);
  auto rr=__builtin_amdgcn_permlane32_swap(__float_as_uint(m),__float_as_uint(m),false,false);
  return max2f(__uint_as_float(rr[0]),__uint_as_float(rr[1]));
}
__device__ __forceinline__ void pv(f32x16*o,int vb,bf16x8 pa0,bf16x8 pa1,bf16x8 pa2,bf16x8 pa3){
  #pragma unroll
  for(int d0=0;d0<2;++d0){s16x4 lo[4],hi[4];
    #pragma unroll
    for(int ks=0;ks<4;++ks){
      asm volatile("ds_read_b64_tr_b16 %0,%1 offset:%c2":"=&v"(lo[ks]):"v"(vb),"i"(d0*4096+ks*1024):"memory");
      asm volatile("ds_read_b64_tr_b16 %0,%1 offset:%c2":"=&v"(hi[ks]):"v"(vb),"i"(d0*4096+ks*1024+512):"memory");}
    asm volatile("s_waitcnt lgkmcnt(0)":::"memory");SBAR();
    #define PK(k) (bf16x8){lo[k][0],lo[k][1],lo[k][2],lo[k][3],hi[k][0],hi[k][1],hi[k][2],hi[k][3]}
    o[d0]=__builtin_amdgcn_mfma_f32_32x32x16_bf16(pa0,PK(0),o[d0],0,0,0);
    o[d0]=__builtin_amdgcn_mfma_f32_32x32x16_bf16(pa1,PK(1),o[d0],0,0,0);
    o[d0]=__builtin_amdgcn_mfma_f32_32x32x16_bf16(pa2,PK(2),o[d0],0,0,0);
    o[d0]=__builtin_amdgcn_mfma_f32_32x32x16_bf16(pa3,PK(3),o[d0],0,0,0);
    #undef PK
  }
}

#ifndef ATTN_STORE16
#define ATTN_STORE16(p,v) (*(u32x4*)(p)=(v))
#endif
template<int THRL> __device__ __forceinline__ void attn_unit(int b,int h,int qb,const bf16*Q,const bf16*__restrict__ K,const bf16*__restrict__ V,bf16*O,const float*LF,char*shm,int wave0){
  int tid_=opaque_tid(wave0);
  const int tid=tid_,lane=tid&63,r32=lane&31,hi=lane>>5; const int wid=__builtin_amdgcn_readfirstlane(tid>>6);
  const long rowbase=(long)b*SEQ; const int q0=qb*QB;
  const bf16*Qw=Q+(rowbase+q0+wid*QBLK)*DM+h*D;
  const bf16*Kh=K+rowbase*DM+h*D,*Vh=V+rowbase*DM+h*D;
  const unsigned lds0=(unsigned)(uintptr_t)shm;
  float*wsf=(float*)(shm+LDS_WS)+wid*64;
  const lds_cptr shm3=(lds_cptr)shm;
  { const int n=q0+QB; const float*lf=LF+((long)b*NHEAD+h)*SEQ;
    unsigned wtb_=(unsigned)(uintptr_t)(shm3+LDS_WT); asm volatile("":"+v"(wtb_));
    volatile __attribute__((address_space(3))) float*wt=(volatile __attribute__((address_space(3))) float*)wtb_;
    f32x4 v0=(f32x4){0.f,0.f,0.f,0.f},v1=(f32x4){0.f,0.f,0.f,0.f};
    if(8*tid<n){v0=*(const f32x4*)(lf+8*tid);v1=*(const f32x4*)(lf+8*tid+4);}
    v0[1]+=v0[0];v0[2]+=v0[1];v0[3]+=v0[2];v1[0]+=v0[3];v1[1]+=v1[0];v1[2]+=v1[1];v1[3]+=v1[2];
    const float tot=v1[3]; float inc=tot;
    #pragma unroll
    for(int o_=1;o_<64;o_<<=1){const float t_=__int_as_float(__builtin_amdgcn_ds_bpermute((lane-o_)<<2,__float_as_int(inc)));if(lane>=o_)inc+=t_;}
    if(lane==63)wt[wid]=inc;
    __syncthreads();
    float base=inc-tot;
    #pragma unroll
    for(int w_=0;w_<NW;++w_){const float x_=wt[w_]; if(w_<wid)base+=x_;}
    if(tid==(q0>>3))wt[8]=base+v0[0];
    __syncthreads();
    const float anc=wt[8];
    if(8*tid<n){ __attribute__((address_space(3))) f32x4*fo=(__attribute__((address_space(3))) f32x4*)(shm3+LDS_FS)+2*tid;
      fo[0]=(v0+(base-anc))*LOG2E; fo[1]=(v1+(base-anc))*LOG2E; }
  }
  const lds_cptr fs3=shm3+LDS_FS;
  const bf16*ksrc=Kh+(long)lane*DM+wid*8;
  const bf16*vsrc=Vh+(long)(16*(wid&3)+(lane>>2))*DM+(wid>>2)*32+(lane&3)*8;
  const unsigned kdst=lds0+LDS_K+wid*1024, vdst=lds0+LDS_V+wid*1024;
  #define DMA_K(t,slot) glds16(ksrc+(long)(t)*KVBLK*DM,(unsigned)__builtin_amdgcn_readfirstlane(kdst+(slot)))
  #define DMA_V(t,slot) glds16(vsrc+(long)(t)*KVBLK*DM,(unsigned)__builtin_amdgcn_readfirstlane(vdst+(slot)))
  const int vb0=(int)(lds0+LDS_V)+((lane>>4)&1)*32+(lane&3)*8+(4*hi+((lane&15)>>2))*64;
  const char*Kbase=shm+LDS_K; bf16x8 kf[8];
  const lds_cptr kp0=shm3+LDS_K+hi*1024+r32*16; const lds_cptr vp0=shm3+LDS_V+((lane>>4)&1)*32+(lane&3)*8+(4*hi+((lane&15)>>2))*64;
  const int NT=(q0+QB)/KVBLK;
  DMA_K(0,0);DMA_V(0,0);DMA_K(1,SLOTB);
  bf16x8 qr[4];
  #pragma unroll
  for(int d0=0;d0<4;++d0)qr[d0]=*reinterpret_cast<const bf16x8*>(&Qw[(long)r32*DM+d0*16+hi*8]);
  float mhat=0.f,l_reg=0.f;f32x16 o[2];o[0]=f32x16{};o[1]=f32x16{};
  const int qrel=wid*QBLK+r32;
  #define CMASK(P0,P1,t) do{int jb_=(t)-(NT-4); if(jb_>=0)cmask(P0,P1,jb_,qrel,hi);}while(0)
  bool resc=false;
  #define START(P0,P1) do{ const float rm=rowmax(P0,P1); resc=false; \
    { const float dl=rm; mhat=fadd_s(mhat,dl); \
      _Pragma("unroll") for(int r=0;r<16;++r){P0[r]=fsub_s(P0[r],dl);P1[r]=fsub_s(P1[r],dl);} } \
    _Pragma("unroll") for(int r=0;r<16;++r)P0[r]=__builtin_amdgcn_exp2f(P0[r]); }while(0)
  #define RESC() do{ if(resc){ asm volatile("s_waitcnt lgkmcnt(0)":::"memory"); \
      _Pragma("unroll") for(int d_=0;d_<2;++d_) _Pragma("unroll") for(int r=0;r<16;++r)o[d_][r]*=wsf[crow(r,hi)]; } }while(0)
  f32x16 pA0,pA1,pB0,pB1;
  int sl_prev=0,sl_cur=0,sl_next=SLOTB;
  #define ROT() do{sl_prev=sl_cur;sl_cur=sl_next;sl_next=(sl_next==(NSLOT-1)*SLOTB)?0:sl_next+SLOTB;}while(0)
  DMA_K(2,2*SLOTB);
  WAIT_BAR(3);
  fbias(pA0,pA1,fs3,0.f,hi);
  qkt(pA0,pA1,Kbase,qr,r32,hi);asm volatile("s_nop 15\n\ts_nop 7":"+v"(pA0),"+v"(pA1));CMASK(pA0,pA1,0);
  START(pA0,pA1);
  _Pragma("unroll") for(int r=0;r<16;++r)pA1[r]=__builtin_amdgcn_exp2f(pA1[r]);
  WAIT_BAR(0);
  DMA_K(3,0);DMA_V(1,SLOTB);
  ROT();
  kload8(kf,kp0+sl_cur);
  WAIT_BAR(2);
  s16x4 vlo[8],vhi[8]; u32x4 pw0,pw1,pw2,pw3;
  #define PKW(P,B) cvtpk_s(P[B],P[B+1])
  #define PAF(k) __builtin_bit_cast(bf16x8,pw##k)
  #define VFR(i) (bf16x8){vlo[i][0],vlo[i][1],vlo[i][2],vlo[i][3],vhi[i][0],vhi[i][1],vhi[i][2],vhi[i][3]}
  #define PIN(x) asm volatile("":"+v"(x))
  #define MX3(a,b,c) __builtin_fmaxf(__builtin_fmaxf((a),(b)),(c))
  #define GAPA(MF,A0,A1,A2,A3,W0,W1,PW) do{ MF; sacc+=A0; sacc+=A1; sacc+=A2; sacc+=A3; PIN(sacc); W0; W1; PIN(PW); SBAR(); }while(0)
  #define EX(v) __builtin_amdgcn_exp2f(v)
  #define GAPB(MF,X,B) do{ MF; X[B]=EX(X[B]); X[B+1]=EX(X[B+1]); X[B+2]=EX(X[B+2]); X[B+3]=EX(X[B+3]); PIN(X); SBAR(); }while(0)
  #define VRD(i) do{ vlo[i]=vtr(vp_+(((i)>>2)*4096+((i)&3)*1024)); vhi[i]=vtr(vp_+(((i)>>2)*4096+((i)&3)*1024+512)); }while(0)
  #define KRD(G,j) do{ if(G){ kload2(kf,kp0+sl_next,j); SBAR(); } }while(0)
  #define STEP(C0,C1,P0,P1,t,GK,GV,GL) do{ SBAR(); \
    const lds_cptr vp_=vp0+sl_prev; \
    fbias(C0,C1,fs3+(t)*256,-mhat,hi); SBAR(); \
    VRD(0); SBAR(); float sacc=(P0[0]+P0[1]); \
    GAPA(C0=__builtin_amdgcn_mfma_f32_32x32x16_bf16(kf[0],qr[0],C0,0,0,0), P0[2],P0[3],P0[4],P0[5],     pw0[0]=PKW(P0,0), pw0[1]=PKW(P0,2), pw0); \
    VRD(4); SBAR(); GAPA(C1=__builtin_amdgcn_mfma_f32_32x32x16_bf16(kf[1],qr[0],C1,0,0,0), P0[6],P0[7],P0[8],P0[9],     pw0[2]=PKW(P0,4), pw0[3]=PKW(P0,6), pw0); \
    VRD(1); SBAR(); GAPA(C0=__builtin_amdgcn_mfma_f32_32x32x16_bf16(kf[2],qr[1],C0,0,0,0),   P0[10],P0[11],P0[12],P0[13], pw1[0]=PKW(P0,8), pw1[1]=PKW(P0,10), pw1); \
    VRD(5); SBAR(); GAPA(C1=__builtin_amdgcn_mfma_f32_32x32x16_bf16(kf[3],qr[1],C1,0,0,0),   P0[14],P0[15],P1[0],P1[1],   pw1[2]=PKW(P0,12),pw1[3]=PKW(P0,14), pw1); \
    VRD(2); SBAR(); GAPA(C0=__builtin_amdgcn_mfma_f32_32x32x16_bf16(kf[4],qr[2],C0,0,0,0),   P1[2],P1[3],P1[4],P1[5],     pw2[0]=PKW(P1,0), pw2[1]=PKW(P1,2), pw2); \
    VRD(6); SBAR(); GAPA(C1=__builtin_amdgcn_mfma_f32_32x32x16_bf16(kf[5],qr[2],C1,0,0,0),   P1[6],P1[7],P1[8],P1[9],     pw2[2]=PKW(P1,4), pw2[3]=PKW(P1,6), pw2); \
    VRD(3); SBAR(); GAPA(C0=__builtin_amdgcn_mfma_f32_32x32x16_bf16(kf[6],qr[3],C0,0,0,0),   P1[10],P1[11],P1[12],P1[13], pw3[0]=PKW(P1,8), pw3[1]=PKW(P1,10), pw3); \
    VRD(7); SBAR(); GAPA(C1=__builtin_amdgcn_mfma_f32_32x32x16_bf16(kf[7],qr[3],C1,0,0,0),   P1[14],P1[15],0.f,0.f,       pw3[2]=PKW(P1,12),pw3[3]=PKW(P1,14), pw3); \
    l_reg+=sacc; \
    if(GK){DMA_K((t)+3,sl_cur);} if(GV){DMA_V((t)+1,sl_next);} \
    CMASK(C0,C1,t); \
    { float a=MX3(C0[0],C0[1],C1[0]),b=MX3(C0[2],C0[3],C1[1]); a=MX3(a,C1[2],C1[3]); \
      _Pragma("unroll") for(int r=4;r<16;r+=4){a=MX3(a,C0[r],C0[r+1]);b=MX3(b,C0[r+2],C0[r+3]);a=MX3(a,C1[r],C1[r+1]);b=MX3(b,C1[r+2],C1[r+3]);} \
      float rm=__builtin_fmaxf(a,b); { auto rr=__builtin_amdgcn_permlane32_swap(__float_as_uint(rm),__float_as_uint(rm),false,false); rm=__builtin_fmaxf(__uint_as_float(rr[0]),__uint_as_float(rr[1])); } \
      resc=false; \
      if(__builtin_expect(__any(rm>(float)THRL),0)){ const float dl=__builtin_fmaxf(rm,0.f); mhat+=dl; \
        _Pragma("unroll") for(int r=0;r<16;++r){C0[r]-=dl;C1[r]-=dl;} \
        const float f=__builtin_amdgcn_exp2f(-dl); l_reg*=f; if(hi==0)wsf[r32]=f; resc=true; } } \
    SBAR(); \
    GAPB(o[0]=__builtin_amdgcn_mfma_f32_32x32x16_bf16(PAF(0),VFR(0),o[0],0,0,0), C0,0); \
    GAPB(o[1]=__builtin_amdgcn_mfma_f32_32x32x16_bf16(PAF(0),VFR(4),o[1],0,0,0), C0,4); \
    KRD(GL,0); GAPB(o[0]=__builtin_amdgcn_mfma_f32_32x32x16_bf16(PAF(1),VFR(1),o[0],0,0,0), C0,8); \
    KRD(GL,1); GAPB(o[1]=__builtin_amdgcn_mfma_f32_32x32x16_bf16(PAF(1),VFR(5),o[1],0,0,0), C0,12); \
    KRD(GL,2); GAPB(o[0]=__builtin_amdgcn_mfma_f32_32x32x16_bf16(PAF(2),VFR(2),o[0],0,0,0), C1,0); \
    KRD(GL,3); GAPB(o[1]=__builtin_amdgcn_mfma_f32_32x32x16_bf16(PAF(2),VFR(6),o[1],0,0,0), C1,4); \
    GAPB(o[0]=__builtin_amdgcn_mfma_f32_32x32x16_bf16(PAF(3),VFR(3),o[0],0,0,0), C1,8); \
    GAPB(o[1]=__builtin_amdgcn_mfma_f32_32x32x16_bf16(PAF(3),VFR(7),o[1],0,0,0), C1,12); \
    }while(0)
  int t=1;
  #undef CMASK
  #define CMASK(P0,P1,t) do{}while(0)
  for(;t+5<NT;t+=2){
    STEP(pB0,pB1,pA0,pA1,t,true,true,true);     WAIT_BAR(2); RESC(); ROT();
    STEP(pA0,pA1,pB0,pB1,t+1,true,true,true);   WAIT_BAR(2); RESC(); ROT();
  }
  #undef CMASK
  #define CMASK(P0,P1,t) do{int jb_=(t)-(NT-4); if(jb_>=0)cmask(P0,P1,jb_,qrel,hi);}while(0)
  #define ENDW(tt) do{ if((tt)+3<NT){WAIT_BAR(2);} else if((tt)+2<NT){WAIT_BAR(1);} else {WAIT_BAR(0);} }while(0)
  for(;t+1<NT;t+=2){
    STEP(pB0,pB1,pA0,pA1,t,(t+3<NT),(t+1<NT),(t+1<NT));       ENDW(t);   RESC(); ROT();
    STEP(pA0,pA1,pB0,pB1,t+1,(t+4<NT),(t+2<NT),(t+2<NT));     ENDW(t+1); RESC(); ROT();
  }
  STEP(pB0,pB1,pA0,pA1,NT-1,false,false,false); RESC();
  { float sacc=pB0[0]+pB0[1]; _Pragma("unroll") for(int r=2;r<16;++r)sacc+=pB0[r]; _Pragma("unroll") for(int r=0;r<16;++r)sacc+=pB1[r]; l_reg+=sacc;
    pw0=(u32x4){PKW(pB0,0),PKW(pB0,2),PKW(pB0,4),PKW(pB0,6)};pw1=(u32x4){PKW(pB0,8),PKW(pB0,10),PKW(pB0,12),PKW(pB0,14)};pw2=(u32x4){PKW(pB1,0),PKW(pB1,2),PKW(pB1,4),PKW(pB1,6)};pw3=(u32x4){PKW(pB1,8),PKW(pB1,10),PKW(pB1,12),PKW(pB1,14)};
    SBAR(); pv(o,vb0+sl_cur,PAF(0),PAF(1),PAF(2),PAF(3)); }
  #undef PKW
  #undef PAF
  #undef VFR
  #undef PIN
  #undef MX3
  #undef GAPA
  #undef GAPB
  #undef EX
  #undef VRD
  #undef KRD
  #undef STEP
  #undef ENDW
  {auto rr=__builtin_amdgcn_permlane32_swap(__float_as_uint(l_reg),__float_as_uint(l_reg),false,false);l_reg=__uint_as_float(rr[0])+__uint_as_float(rr[1]);}
  if(hi==0)wsf[32+r32]=l_reg;asm volatile("s_waitcnt lgkmcnt(0)":::"memory");
  float rli[16];
  #pragma unroll
  for(int r=0;r<16;++r)rli[r]=__builtin_amdgcn_rcpf(wsf[32+crow(r,hi)]);
  bf16*Ow=O+(rowbase+q0+wid*QBLK)*DM+h*D;
  { bf16*stg=(bf16*)(shm+LDS_OST)+wid*2048;
    #pragma unroll
    for(int r=0;r<16;++r){const int orow=crow(r,hi);
      #pragma unroll
      for(int d0=0;d0<2;++d0)stg[orow*64+d0*32+r32]=__float2bfloat16(o[d0][r]*rli[r]);}
    asm volatile("s_waitcnt lgkmcnt(0)":::"memory");
    #pragma unroll
    for(int i=0;i<4;++i){const int row=i*8+(lane>>3),ch=lane&7; const u32x4 v=*(const u32x4*)(stg+row*64+ch*8); ATTN_STORE16(Ow+(long)row*DM+ch*8,v);} }
  asm volatile("s_waitcnt lgkmcnt(0)\n\ts_barrier":::"memory");
  #undef DMA_K
  #undef DMA_V
  #undef CMASK
  #undef START
  #undef RESC
  #undef ROT
}

constexpr float T_UNDER=150.f;
template<int DUMMY> __device__ __forceinline__ void attn_unit_fast(int b,int h,int qb,float M,const bf16*Q,const bf16*__restrict__ K,const bf16*__restrict__ V,bf16*O,const float*LF,char*shm,int wave0){
  int tid_=opaque_tid(wave0);
  const int tid=tid_,lane=tid&63,r32=lane&31,hi=lane>>5; const int wid=__builtin_amdgcn_readfirstlane(tid>>6);
  const long rowbase=(long)b*SEQ; const int q0=qb*QB;
  const bf16*Qw=Q+(rowbase+q0+wid*QBLK)*DM+h*D;
  const bf16*Kh=K+rowbase*DM+h*D,*Vh=V+rowbase*DM+h*D;
  const unsigned lds0=(unsigned)(uintptr_t)shm;
  const lds_cptr shm3=(lds_cptr)shm;
  { const int n=q0+QB; const float*lf=LF+((long)b*NHEAD+h)*SEQ;
    unsigned wtb_=(unsigned)(uintptr_t)(shm3+LDS_WT); asm volatile("":"+v"(wtb_));
    volatile __attribute__((address_space(3))) float*wt=(volatile __attribute__((address_space(3))) float*)wtb_;
    f32x4 v0=(f32x4){0.f,0.f,0.f,0.f},v1=(f32x4){0.f,0.f,0.f,0.f};
    if(8*tid<n){v0=*(const f32x4*)(lf+8*tid);v1=*(const f32x4*)(lf+8*tid+4);}
    v0[1]+=v0[0];v0[2]+=v0[1];v0[3]+=v0[2];v1[0]+=v0[3];v1[1]+=v1[0];v1[2]+=v1[1];v1[3]+=v1[2];
    const float tot=v1[3]; float inc=tot;
    #pragma unroll
    for(int o_=1;o_<64;o_<<=1){const float t_=__int_as_float(__builtin_amdgcn_ds_bpermute((lane-o_)<<2,__float_as_int(inc)));if(lane>=o_)inc+=t_;}
    if(lane==63)wt[wid]=inc;
    __syncthreads();
    float base=inc-tot;
    #pragma unroll
    for(int w_=0;w_<NW;++w_){const float x_=wt[w_]; if(w_<wid)base+=x_;}
    if(tid==(q0>>3))wt[8]=base+v0[0];
    __syncthreads();
    const float anc=wt[8];
    if(8*tid<n){ __attribute__((address_space(3))) f32x4*fo=(__attribute__((address_space(3))) f32x4*)(shm3+LDS_FS)+2*tid;
      fo[0]=(v0+(base-anc))*LOG2E; fo[1]=(v1+(base-anc))*LOG2E; }
  }
  const lds_cptr fs3=shm3+LDS_FS;
  const int NT=(q0+QB)/KVBLK;
  const char*kbase=(const char*)(Kh+(long)(NT-1)*KVBLK*DM),*vbase=(const char*)(Vh+(long)(NT-1)*KVBLK*DM);
  const unsigned koff=(unsigned)((lane*DM+wid*8)*2), voff=(unsigned)(((16*(wid&3)+(lane>>2))*DM+(wid>>2)*32+(lane&3)*8)*2);
  const unsigned kdst=lds0+LDS_K+wid*1024, vdst=lds0+LDS_V+wid*1024;
  #define DMA_K(t,slot) glds16s(kbase-(long)(t)*(KVBLK*DM*2),koff,(unsigned)__builtin_amdgcn_readfirstlane(kdst+(slot)))
  #define DMA_V(t,slot) glds16s(vbase-(long)(t)*(KVBLK*DM*2),voff,(unsigned)__builtin_amdgcn_readfirstlane(vdst+(slot)))
  const char*Kbase=shm+LDS_K; bf16x8 kf[8];
  const lds_cptr kp0=shm3+LDS_K+hi*1024+r32*16; const lds_cptr vp0=shm3+LDS_V+((lane>>4)&1)*32+(lane&3)*8+(4*hi+((lane&15)>>2))*64;
  DMA_K(0,0);DMA_V(0,0);DMA_K(1,SLOTB);
  bf16x8 qr[4];
  #pragma unroll
  for(int d0=0;d0<4;++d0)qr[d0]=*reinterpret_cast<const bf16x8*>(&Qw[(long)r32*DM+d0*16+hi*8]);
  float l_reg=0.f;f32x16 o[2];o[0]=f32x16{};o[1]=f32x16{};
  const int qrel=wid*QBLK+r32;
  #define CMASK(P0,P1,t) do{int jb_=3-(t); if(jb_>=0)cmask(P0,P1,jb_,qrel,hi);}while(0)
  f32x16 pA0,pA1,pB0,pB1;
  int sl_prev=0,sl_cur=0,sl_next=SLOTB;
  #define ROT() do{sl_prev=sl_cur;sl_cur=sl_next;sl_next=(sl_next==(NSLOT-1)*SLOTB)?0:sl_next+SLOTB;}while(0)
  DMA_K(2,2*SLOTB);
  WAIT_BAR(3);
  const float nm=*(const __attribute__((address_space(3))) float*)(fs3+(q0+qrel)*4)-M;
  int NP;
  { const float fv=(lane<NT)?*(const __attribute__((address_space(3))) float*)(fs3+(64*lane+63)*4):0.f;
    const unsigned long long bal=__ballot((lane<NT)&&(fv>2.f*M+T_UNDER));
    const int tstop=__builtin_popcountll(bal); int np=NT-tstop; np=(np+1)&~1; NP=np<4?4:np; NP=__builtin_amdgcn_readfirstlane(NP); }
  fbias(pA0,pA1,fs3+(NT-1)*256,nm,hi);
  qkt(pA0,pA1,Kbase,qr,r32,hi);asm volatile("s_nop 15\n\ts_nop 7":"+v"(pA0),"+v"(pA1));CMASK(pA0,pA1,0);
  _Pragma("unroll") for(int r=0;r<16;++r){pA0[r]=__builtin_amdgcn_exp2f(pA0[r]);pA1[r]=__builtin_amdgcn_exp2f(pA1[r]);}
  WAIT_BAR(0);
  DMA_K(3,0);DMA_V(1,SLOTB);
  ROT();
  kload8(kf,kp0+sl_cur);
  fbias(pB0,pB1,fs3+(NT-2)*256,nm,hi);
  WAIT_BAR(2);
  s16x4 vlo[8],vhi[8]; u32x4 pw0,pw1,pw2,pw3;
  #define PKW(P,B) cvtpk_s(P[B],P[B+1])
  #define PAF(k) __builtin_bit_cast(bf16x8,pw##k)
  #define VFR(i) (bf16x8){vlo[i][0],vlo[i][1],vlo[i][2],vlo[i][3],vhi[i][0],vhi[i][1],vhi[i][2],vhi[i][3]}
  #define PIN(x) asm volatile("":"+v"(x))
  #define GAPA(MF,A0,A1,A2,A3,W0,W1,PW) do{ MF; sacc+=A0; sacc+=A1; sacc+=A2; sacc+=A3; PIN(sacc); W0; W1; PIN(PW); SBAR(); }while(0)
  #define EX(v) __builtin_amdgcn_exp2f(v)
  #define GAPB(MF,X,B,Y,GL) do{ MF; X[B]=EX(X[B]); X[B+1]=EX(X[B+1]); X[B+2]=EX(X[B+2]); X[B+3]=EX(X[B+3]); PIN(X); \
      if(GL){ Y[B]=nm-Y[B]; Y[B+1]=nm-Y[B+1]; Y[B+2]=nm-Y[B+2]; Y[B+3]=nm-Y[B+3]; PIN(Y); } SBAR(); }while(0)
  #define VRD(i) do{ vlo[i]=vtr(vp_+(((i)>>2)*4096+((i)&3)*1024)); vhi[i]=vtr(vp_+(((i)>>2)*4096+((i)&3)*1024+512)); }while(0)
  #define KRD(G,j) do{ if(G){ kload2(kf,kp0+sl_next,j); SBAR(); } }while(0)
  #define FLD(Y0,Y1,t) do{ const lds_cptr ft_=fs3+(NT-2-(t))*256+hi*16; \
      _Pragma("unroll") for(int g_=0;g_<4;++g_){ const f32x4 a_=*(const __attribute__((address_space(3))) f32x4*)(ft_+g_*32); const f32x4 b_=*(const __attribute__((address_space(3))) f32x4*)(ft_+128+g_*32); \
        Y0[4*g_]=a_[0];Y0[4*g_+1]=a_[1];Y0[4*g_+2]=a_[2];Y0[4*g_+3]=a_[3]; Y1[4*g_]=b_[0];Y1[4*g_+1]=b_[1];Y1[4*g_+2]=b_[2];Y1[4*g_+3]=b_[3]; } }while(0)
  #define STEP(C0,C1,P0,P1,t,GK,GV,GL) do{ SBAR(); \
    const lds_cptr vp_=vp0+sl_prev; \
    VRD(0); SBAR(); float sacc=(P0[0]+P0[1]); \
    GAPA(C0=__builtin_amdgcn_mfma_f32_32x32x16_bf16(kf[0],qr[0],C0,0,0,0), P0[2],P0[3],P0[4],P0[5],     pw0[0]=PKW(P0,0), pw0[1]=PKW(P0,2), pw0); \
    VRD(4); SBAR(); GAPA(C1=__builtin_amdgcn_mfma_f32_32x32x16_bf16(kf[1],qr[0],C1,0,0,0), P0[6],P0[7],P0[8],P0[9],     pw0[2]=PKW(P0,4), pw0[3]=PKW(P0,6), pw0); \
    VRD(1); SBAR(); GAPA(C0=__builtin_amdgcn_mfma_f32_32x32x16_bf16(kf[2],qr[1],C0,0,0,0),   P0[10],P0[11],P0[12],P0[13], pw1[0]=PKW(P0,8), pw1[1]=PKW(P0,10), pw1); \
    VRD(5); SBAR(); GAPA(C1=__builtin_amdgcn_mfma_f32_32x32x16_bf16(kf[3],qr[1],C1,0,0,0),   P0[14],P0[15],P1[0],P1[1],   pw1[2]=PKW(P0,12),pw1[3]=PKW(P0,14), pw1); \
    VRD(2); SBAR(); GAPA(C0=__builtin_amdgcn_mfma_f32_32x32x16_bf16(kf[4],qr[2],C0,0,0,0),   P1[2],P1[3],P1[4],P1[5],     pw2[0]=PKW(P1,0), pw2[1]=PKW(P1,2), pw2); \
    VRD(6); SBAR(); GAPA(C1=__builtin_amdgcn_mfma_f32_32x32x16_bf16(kf[5],qr[2],C1,0,0,0),   P1[6],P1[7],P1[8],P1[9],     pw2[2]=PKW(P1,4), pw2[3]=PKW(P1,6), pw2); \
    VRD(3); SBAR(); GAPA(C0=__builtin_amdgcn_mfma_f32_32x32x16_bf16(kf[6],qr[3],C0,0,0,0),   P1[10],P1[11],P1[12],P1[13], pw3[0]=PKW(P1,8), pw3[1]=PKW(P1,10), pw3); \
    VRD(7); SBAR(); GAPA(C1=__builtin_amdgcn_mfma_f32_32x32x16_bf16(kf[7],qr[3],C1,0,0,0),   P1[14],P1[15],0.f,0.f,       pw3[2]=PKW(P1,12),pw3[3]=PKW(P1,14), pw3); \
    l_reg+=sacc; \
    if(GK){DMA_K((t)+3,sl_cur);} if(GV){DMA_V((t)+1,sl_next);} \
    CMASK(C0,C1,t); \
    if(GL){ FLD(P0,P1,t); } \
    SBAR(); \
    GAPB(o[0]=__builtin_amdgcn_mfma_f32_32x32x16_bf16(PAF(0),VFR(0),o[0],0,0,0), C0,0,P0,GL); \
    GAPB(o[1]=__builtin_amdgcn_mfma_f32_32x32x16_bf16(PAF(0),VFR(4),o[1],0,0,0), C0,4,P0,GL); \
    KRD(GL,0); GAPB(o[0]=__builtin_amdgcn_mfma_f32_32x32x16_bf16(PAF(1),VFR(1),o[0],0,0,0), C0,8,P0,GL); \
    KRD(GL,1); GAPB(o[1]=__builtin_amdgcn_mfma_f32_32x32x16_bf16(PAF(1),VFR(5),o[1],0,0,0), C0,12,P0,GL); \
    KRD(GL,2); GAPB(o[0]=__builtin_amdgcn_mfma_f32_32x32x16_bf16(PAF(2),VFR(2),o[0],0,0,0), C1,0,P1,GL); \
    KRD(GL,3); GAPB(o[1]=__builtin_amdgcn_mfma_f32_32x32x16_bf16(PAF(2),VFR(6),o[1],0,0,0), C1,4,P1,GL); \
    GAPB(o[0]=__builtin_amdgcn_mfma_f32_32x32x16_bf16(PAF(3),VFR(3),o[0],0,0,0), C1,8,P1,GL); \
    GAPB(o[1]=__builtin_amdgcn_mfma_f32_32x32x16_bf16(PAF(3),VFR(7),o[1],0,0,0), C1,12,P1,GL); \
    }while(0)
  #define ENDW(tt) do{ if((tt)+3<NP){WAIT_BAR(2);} else if((tt)+2<NP){WAIT_BAR(1);} else {WAIT_BAR(0);} }while(0)
  int t=1;
  for(;t<5&&t+1<NP;t+=2){
    STEP(pB0,pB1,pA0,pA1,t,(t+3<NP),(t+1<NP),(t+1<NP));       ENDW(t);   ROT();
    STEP(pA0,pA1,pB0,pB1,t+1,(t+4<NP),(t+2<NP),(t+2<NP));     ENDW(t+1); ROT();
  }
  #undef CMASK
  #define CMASK(P0,P1,t) do{}while(0)
  for(;t+5<NP;t+=2){
    STEP(pB0,pB1,pA0,pA1,t,true,true,true);     WAIT_BAR(2); ROT();
    STEP(pA0,pA1,pB0,pB1,t+1,true,true,true);   WAIT_BAR(2); ROT();
  }
  for(;t+1<NP;t+=2){
    STEP(pB0,pB1,pA0,pA1,t,(t+3<NP),(t+1<NP),(t+1<NP));       ENDW(t);   ROT();
    STEP(pA0,pA1,pB0,pB1,t+1,(t+4<NP),(t+2<NP),(t+2<NP));     ENDW(t+1); ROT();
  }
  #undef CMASK
  #define CMASK(P0,P1,t) do{int jb_=3-(t); if(jb_>=0)cmask(P0,P1,jb_,qrel,hi);}while(0)
  STEP(pB0,pB1,pA0,pA1,NP-1,false,false,false);
  const int tidE=opaque_tid(wave0),laneE=tidE&63,r32E=laneE&31,hiE=laneE>>5; const int widE=__builtin_amdgcn_readfirstlane(tidE>>6);
  const int vb0=(int)(lds0+LDS_V)+((laneE>>4)&1)*32+(laneE&3)*8+(4*hiE+((laneE&15)>>2))*64;
  float*wsf=(float*)(shm+LDS_WS)+widE*64;
  { float sacc=pB0[0]+pB0[1]; _Pragma("unroll") for(int r=2;r<16;++r)sacc+=pB0[r]; _Pragma("unroll") for(int r=0;r<16;++r)sacc+=pB1[r]; l_reg+=sacc;
    pw0=(u32x4){PKW(pB0,0),PKW(pB0,2),PKW(pB0,4),PKW(pB0,6)};pw1=(u32x4){PKW(pB0,8),PKW(pB0,10),PKW(pB0,12),PKW(pB0,14)};pw2=(u32x4){PKW(pB1,0),PKW(pB1,2),PKW(pB1,4),PKW(pB1,6)};pw3=(u32x4){PKW(pB1,8),PKW(pB1,10),PKW(pB1,12),PKW(pB1,14)};
    SBAR(); pv(o,vb0+sl_cur,PAF(0),PAF(1),PAF(2),PAF(3)); }
  #undef PKW
  #undef PAF
  #undef VFR
  #undef PIN
  #undef GAPA
  #undef GAPB
  #undef EX
  #undef VRD
  #undef KRD
  #undef FLD
  #undef STEP
  #undef ENDW
  {auto rr=__builtin_amdgcn_permlane32_swap(__float_as_uint(l_reg),__float_as_uint(l_reg),false,false);l_reg=__uint_as_float(rr[0])+__uint_as_float(rr[1]);}
  if(hiE==0)wsf[32+r32E]=l_reg;asm volatile("s_waitcnt lgkmcnt(0)":::"memory");
  float rli[16];
  #pragma unroll
  for(int r=0;r<16;++r)rli[r]=__builtin_amdgcn_rcpf(wsf[32+crow(r,hiE)]);
  bf16*Ow=O+(rowbase+q0+widE*QBLK)*DM+h*D;
  { bf16*stg=(bf16*)(shm+LDS_OST)+widE*2048;
    #pragma unroll
    for(int r=0;r<16;++r){const int orow=crow(r,hiE);
      #pragma unroll
      for(int d0=0;d0<2;++d0)stg[orow*64+d0*32+r32E]=__float2bfloat16(o[d0][r]*rli[r]);}
    asm volatile("s_waitcnt lgkmcnt(0)":::"memory");
    #pragma unroll
    for(int i=0;i<4;++i){const int row=i*8+(laneE>>3),ch=laneE&7; const u32x4 v=*(const u32x4*)(stg+row*64+ch*8); ATTN_STORE16(Ow+(long)row*DM+ch*8,v);} }
  asm volatile("s_waitcnt lgkmcnt(0)\n\ts_barrier":::"memory");
  #undef DMA_K
  #undef DMA_V
  #undef CMASK
  #undef ROT
}
constexpr int ATTN_LDS_BYTES=LDS_BYTES;
struct AttnTensors { const bf16* Q; const bf16* K; const bf16* V; bf16* O; const float* LF; const unsigned* QKM; };
struct AttnUnit { int bh; int qb; };
struct StaticOrder {
  int vcu;
  __device__ __forceinline__ explicit StaticOrder(int grid,int block):vcu((block%8)*(grid/8)+block/8){}
  __device__ __forceinline__ bool next(int i,AttnUnit&u)const{ if(i>=8)return false; const int s=vcu&1, j=7-i, base=4*(j>>1); u.bh=vcu>>1; u.qb=base+((j&1)?(s?2:3):(s?1:0)); return true; }
};
template<int THRL=8> __device__ __forceinline__ void attn_phase(char*lds,const AttnTensors&T,unsigned*ctr,int wave0){
  for(;;){
    const int tq=opaque_tid(wave0);
    const unsigned uwb_=(unsigned)(uintptr_t)((lds_cptr)lds+LDS_WT+48)+((unsigned)tq>>9);
    volatile __attribute__((address_space(3))) unsigned*uw=(volatile __attribute__((address_space(3))) unsigned*)uwb_;
    if(tq==0)*uw=__hip_atomic_fetch_add(ctr,1u,__ATOMIC_RELAXED,__HIP_MEMORY_SCOPE_AGENT);
    __syncthreads();
    const unsigned k=__builtin_amdgcn_readfirstlane(*uw);
    if(k>=(unsigned)(BATCH*NHEAD*NQB))break;
    const int qb=NQB-1-(int)(k>>7), bh=(int)(k&127), b=bh/NHEAD,h=bh%NHEAD;
    const unsigned* qm=T.QKM+(0*8+b)*32+2*h; const unsigned* km=T.QKM+(1*8+b)*32+2*h;
    const float q2=__uint_as_float(__builtin_amdgcn_readfirstlane(qm[0]))+__uint_as_float(__builtin_amdgcn_readfirstlane(qm[1])), k2=__uint_as_float(__builtin_amdgcn_readfirstlane(km[0]))+__uint_as_float(__builtin_amdgcn_readfirstlane(km[1]));
    const float M=1.02f*sqrtf(q2*k2)+1e-3f;
    if(M<55.f) attn_unit_fast<0>(b,h,qb,M,T.Q,T.K,T.V,T.O,T.LF,lds,wave0);
    else attn_unit<THRL>(b,h,qb,T.Q,T.K,T.V,T.O,T.LF,lds,wave0);
  }
}
#undef SBAR
#undef WAIT_BAR
}
constexpr int NWAVES = 8;
#ifndef MK_MULTI
#define MK_MULTI 0
#endif

constexpr int BATCH = 8, SEQ = 4096, D = 1024, H = 16, HD = 64, NE = 32, FD = 512, NLAYER = 2;
constexpr int T = BATCH * SEQ;
constexpr int MODW = 6 * D;
constexpr float RMS_EPS = 1e-6f;
constexpr int WIN_LD = 3 * D + H;
constexpr int ECAP = 32768;
constexpr int PMAX = 2 * T + NE * 256;

constexpr size_t MiB = 1u << 20;
constexpr size_t WS_CTL = 0, CTL_ZERO_BYTES = 1 * MiB;
constexpr size_t WS_MOD = 1 * MiB;
constexpr size_t WS_LOGF = 2 * MiB;
constexpr size_t WS_TOK = 6 * MiB;
constexpr size_t WS_GW = 10 * MiB;
constexpr size_t WS_WQKV = 14 * MiB;
constexpr size_t WS_WO = 20 * MiB;
constexpr size_t WS_WP = 22 * MiB;
constexpr size_t WS_UP = 23 * MiB;
constexpr size_t WS_DN = 151 * MiB;
constexpr size_t WS_HB = 215 * MiB;
constexpr size_t WS_Q = 279 * MiB, WS_K = 343 * MiB, WS_V = 407 * MiB;
constexpr size_t WS_XS = 279 * MiB;
constexpr size_t WS_Y2 = 279 * MiB;
constexpr size_t WS_HH = 423 * MiB;
constexpr size_t WS_PL = 279 * MiB;
constexpr size_t WS_END = 495 * MiB;
constexpr int CW_BAR = 4096;
constexpr int CW_QKM = 32768;
constexpr int CW_AQ = 36864;
constexpr int CW_CNT = 16384;

constexpr int RING_OFF = 0, RING_BYTES = 131072;
constexpr int LDSCTL_OFF = RING_BYTES, MISC_OFF = LDSCTL_OFF + 320;
constexpr int ETAB_OFF = LDSCTL_OFF + 1024;
constexpr int LDS_BYTES = 147456;
static_assert(ETAB_OFF + (64 + 960) * 4 <= LDS_BYTES && attn_body::ATTN_LDS_BYTES <= RING_BYTES, "LDS map");

#define GAS __attribute__((address_space(1)))
#define LAS __attribute__((address_space(3)))
typedef unsigned short bf16;
typedef unsigned v4u __attribute__((ext_vector_type(4)));
typedef float f32x4 __attribute__((ext_vector_type(4)));
typedef short bf16x8 __attribute__((ext_vector_type(8)));
typedef GAS unsigned gu32;
#define RLX_AGENT __ATOMIC_RELAXED, __HIP_MEMORY_SCOPE_AGENT
#define LDS_WAIT() asm volatile("s_waitcnt lgkmcnt(0)" ::: "memory")
#define VM_WAIT() asm volatile("s_waitcnt vmcnt(0)" ::: "memory")
__device__ __forceinline__ unsigned f2bf(float f) { unsigned u = __builtin_bit_cast(unsigned, f); return (u + 0x7fffu + ((u >> 16) & 1u)) >> 16; }
__device__ __forceinline__ unsigned pk2(float lo, float hi) { return f2bf(lo) | (f2bf(hi) << 16); }
__device__ __forceinline__ float bflo(unsigned w) { return __uint_as_float(w << 16); }
__device__ __forceinline__ float bfhi(unsigned w) { return __uint_as_float(w & 0xffff0000u); }

#define XB_TMO      128
#define XB_XCNT(j)  (256  + 64 * (j))
#define XB_XSUB(j)  (1280 + 64 * (j))
#define XB_XGEN(j)  (2304 + 64 * (j))
#define XB_TOP      3328
#define XB_TOPGEN   3392
#define XCD_BAR_WORDS 3456
#define XB_SPIN_CAP (1u << 18)
__device__ __forceinline__ unsigned xb_ld(unsigned* p)              { return __hip_atomic_load(p, __ATOMIC_RELAXED, __HIP_MEMORY_SCOPE_AGENT); }
__device__ __forceinline__ unsigned xb_add(unsigned* p, unsigned v) { return __hip_atomic_fetch_add(p, v, __ATOMIC_RELAXED, __HIP_MEMORY_SCOPE_AGENT); }
__device__ __forceinline__ unsigned xb_xcc_id() { return (unsigned)__builtin_amdgcn_s_getreg((3 << 11) | 20) & 0xFu; }
#define XB_SPIN(cond, bar) do { unsigned _sp = 0; while (cond) { __builtin_amdgcn_s_sleep(1); \
    if ((++_sp & 255u) == 0u) { if (xb_ld(&(bar)[XB_TMO])) break; if (_sp > XB_SPIN_CAP) { atomicAdd(&(bar)[XB_TMO], 1u); break; } } } } while (0)
struct XcdBarrier { unsigned* bar; unsigned x; volatile LAS unsigned* st; };
__device__ __forceinline__ XcdBarrier xcd_barrier_post(unsigned* bar, volatile LAS unsigned* st) {
    XcdBarrier b; b.bar = bar; b.x = xb_xcc_id(); b.st = st;
    if (threadIdx.x == 0) (void)xb_add(&bar[XB_XCNT(b.x)], 1u);
    return b;
}
__device__ __forceinline__ void xcd_barrier_complete(unsigned* bar, unsigned x, unsigned& nloc, unsigned& nx) {
    const unsigned G = gridDim.x * gridDim.y * gridDim.z;
    unsigned sum, cnt, mine, sp = 0u;
    for (;;) {
        sum = 0u; cnt = 0u; mine = 0u;
#pragma unroll
        for (unsigned j = 0; j < 16; ++j) { const unsigned c = xb_ld(&bar[XB_XCNT(j)]); sum += c; cnt += (c > 0u) ? 1u : 0u; }
        mine = xb_ld(&bar[XB_XCNT(x)]);
        if (sum == G) break;
        __builtin_amdgcn_s_sleep(1);
        if ((++sp & 255u) == 0u) { if (xb_ld(&bar[XB_TMO])) break; if (sp > XB_SPIN_CAP) { atomicAdd(&bar[XB_TMO], 1u); break; } }
    }
    nloc = mine > 0u ? mine : 1u; nx = cnt > 0u ? cnt : 1u;
}
__device__ __forceinline__ void xcd_barrier(const XcdBarrier& b) {
    asm volatile("s_waitcnt vmcnt(0)" ::: "memory");
    __syncthreads();
    if (threadIdx.x == 0) {
        unsigned* bar = b.bar; unsigned bx = b.x;
        asm volatile("" : "+s"(bar), "+s"(bx));
        __builtin_amdgcn_s_waitcnt(0);
        unsigned nloc = b.st[0], nx = b.st[1];
        if (nloc == 0u) { xcd_barrier_complete(bar, bx, nloc, nx); b.st[0] = nloc; b.st[1] = nx; }
        const unsigned old = xb_add(&bar[XB_XSUB(bx)], 1u);
        const unsigned gen = old / nloc;
        if (old + 1u == (gen + 1u) * nloc) {
            __builtin_amdgcn_fence(__ATOMIC_RELEASE, "agent");
            asm volatile("s_waitcnt vmcnt(0)" ::: "memory");
            const unsigned og = xb_add(&bar[XB_TOP], 1u);
            const unsigned tg = og / nx;
            if (og + 1u == (tg + 1u) * nx) xb_add(&bar[XB_TOPGEN], 1u);
            else XB_SPIN(xb_ld(&bar[XB_TOPGEN]) == tg, bar);
            __builtin_amdgcn_fence(__ATOMIC_ACQUIRE, "agent");
            xb_add(&bar[XB_XGEN(bx)], 1u);
            asm volatile("s_waitcnt vmcnt(0)" ::: "memory");
        } else {
            XB_SPIN(xb_ld(&bar[XB_XGEN(bx)]) == gen, bar);
            __builtin_amdgcn_fence(__ATOMIC_ACQUIRE, "agent");
            asm volatile("s_waitcnt vmcnt(0)" ::: "memory");
        }
    }
    __syncthreads();
}

struct Frame {
    LAS unsigned char* lds;
    volatile LAS unsigned* MISC;
    gu32* ctl;
    int tid, lane, wave, wave0;
    int vcu, G;
    const __attribute__((address_space(4))) char* ka;
    float* out;
    unsigned char* ws;
    const __attribute__((address_space(4))) char* ka0; float* out0; unsigned char* ws0;
};
__device__ __forceinline__ void phase_enter(Frame& F) {
    int t_ = opaque_tid(F.wave0); F.tid = t_; F.lane = t_ & 63; F.wave = __builtin_amdgcn_readfirstlane(t_ >> 6);
    unsigned char* w = F.ws0; float* o = F.out0; const __attribute__((address_space(4))) char* k = F.ka0;
    asm volatile("" : "+s"(w), "+s"(o), "+s"(k));
    F.ws = w; F.out = o; F.ka = k; F.ctl = (gu32*)w;
}
#define WSP(T_, off) ((T_*)(F.ws + (off)))
#define FIN(i) (*(const float* const __attribute__((address_space(4)))*)(F.ka + 8 * (i)))
enum { IN_X = 0, IN_C, IN_NMG, IN_NFG, IN_ADAW, IN_ADAB, IN_WIN, IN_FBIAS, IN_WO, IN_POOLW, IN_POOLS, IN_RW, IN_RB, IN_W1, IN_W3, IN_W2, IN_NFIN };

__device__ __forceinline__ void transpose_item(const float* W, int ld, int k0, bf16* WT, int Kd, int dst_row0, LAS float* scr, int lane) {
#pragma unroll 8
    for (int i = 0; i < 32; ++i) { const int kk = 2 * i + (lane >> 5); scr[kk * 33 + (lane & 31)] = W[(size_t)(k0 + kk) * ld + (lane & 31)]; }
    LDS_WAIT(); asm volatile("" ::: "memory");
    const int c = lane & 7;
#pragma unroll
    for (int j = 0; j < 4; ++j) { const int n = (lane >> 3) + 8 * j; const LAS float* s = scr + (8 * c) * 33 + n;
        v4u o; o.x = pk2(s[0 * 33], s[1 * 33]); o.y = pk2(s[2 * 33], s[3 * 33]); o.z = pk2(s[4 * 33], s[5 * 33]); o.w = pk2(s[6 * 33], s[7 * 33]);
        *(GAS v4u*)(WT + (size_t)(dst_row0 + n) * Kd + k0 + 8 * c) = o; }
    LDS_WAIT(); asm volatile("" ::: "memory");
}
__device__ __forceinline__ void p0_prologue(Frame& F) {
    if (F.vcu < 192) {
        const float* cin = FIN(IN_C); const float* adaw = FIN(IN_ADAW); const float* adab = FIN(IN_ADAB);
        LAS float* cact = (LAS float*)(F.lds);
        LAS float* red = (LAS float*)(F.lds + 32768);
        for (int i = F.tid; i < 8 * 1024; i += 512) { const int bb = i >> 10, k = i & 1023; const float v = cin[i]; cact[k * 8 + bb] = v / (1.0f + __expf(-v)); }
        __syncthreads();
        const int l = F.vcu / 96, col0 = (F.vcu % 96) * 64;
        const float* wp = adaw + (size_t)l * D * MODW + col0 + F.lane;
        float a0 = 0.f, a1 = 0.f, a2 = 0.f, a3 = 0.f, a4 = 0.f, a5 = 0.f, a6 = 0.f, a7 = 0.f;
        const int kb = F.wave * 128;
#pragma unroll 8
        for (int k = 0; k < 128; ++k) { const float wv = wp[(size_t)(kb + k) * MODW]; const f32x4 c0 = *(const LAS f32x4*)(cact + (kb + k) * 8), c1 = *(const LAS f32x4*)(cact + (kb + k) * 8 + 4);
            a0 += c0[0] * wv; a1 += c0[1] * wv; a2 += c0[2] * wv; a3 += c0[3] * wv; a4 += c1[0] * wv; a5 += c1[1] * wv; a6 += c1[2] * wv; a7 += c1[3] * wv; }
        LAS float* rw = red + F.wave * 512 + F.lane;
        rw[0] = a0; rw[64] = a1; rw[128] = a2; rw[192] = a3; rw[256] = a4; rw[320] = a5; rw[384] = a6; rw[448] = a7;
        __syncthreads();
        { const int bb = F.tid >> 6, col = F.tid & 63; float s = 0.f;
#pragma unroll
          for (int w = 0; w < 8; ++w) s += red[w * 512 + bb * 64 + col];
          WSP(float, WS_MOD)[((size_t)l * 8 + bb) * MODW + col0 + col] = s + adab[l * MODW + col0 + col]; }
        __syncthreads();
    }
    LAS float* scr = (LAS float*)(F.lds + RING_OFF + F.wave * 16384);
    const int gw = F.vcu * NWAVES + F.wave, NGW = F.G * NWAVES;
    constexpr int I_QKV = 16 * 96, I_O = 16 * 32, I_P = 4 * 4 * 8, I_W13 = 16 * 16, I_W2 = 8 * 32;
    constexpr int I_EXP = NLAYER * NE * (2 * I_W13 + I_W2);
    constexpr int NITEMS = I_QKV + I_O + I_P + I_EXP;
    for (int it = gw; it < NITEMS; it += NGW) {
        int r = it;
        if (r < I_QKV) { const int kb = r / 96, nb = r % 96; transpose_item(FIN(IN_WIN) + 32 * nb, WIN_LD, 64 * kb, WSP(bf16, WS_WQKV), D, 32 * nb, scr, F.lane); continue; } r -= I_QKV;
        if (r < I_O) { const int kb = r / 32, nb = r % 32; transpose_item(FIN(IN_WO) + 32 * nb, D, 64 * kb, WSP(bf16, WS_WO), D, 32 * nb, scr, F.lane); continue; } r -= I_O;
        if (r < I_P) { const int g = r / 32, q = r % 32, kb = q / 8, nb = q % 8; transpose_item(FIN(IN_POOLW) + (size_t)g * 65536 + 32 * nb, 256, 64 * kb, WSP(bf16, WS_WP) + (size_t)g * 65536, 256, 32 * nb, scr, F.lane); continue; } r -= I_P;
        { const int per = 2 * I_W13 + I_W2; const int le = r / per; int q = r % per;
          if (q < 2 * I_W13) { const int which = q / I_W13; q %= I_W13; const int kb = q / 16, nb = q % 16, n0 = 32 * nb;
              const float* src = (which ? FIN(IN_W3) : FIN(IN_W1)) + (size_t)le * D * FD + n0;
              transpose_item(src, FD, 64 * kb, WSP(bf16, WS_UP) + (size_t)le * 1024 * 1024, D, 256 * (n0 >> 7) + (n0 & 127) + 128 * which, scr, F.lane); }
          else { q -= 2 * I_W13; const int kb = q / 32, nb = q % 32;
              transpose_item(FIN(IN_W2) + (size_t)le * FD * D + 32 * nb, D, 64 * kb, WSP(bf16, WS_DN) + (size_t)le * 1024 * 512, FD, 32 * nb, scr, F.lane); } }
    }
    __syncthreads();
}

struct RowArgs { const float* src; float* dst; const float* g; const float* shp; const float* scp; const float* gtp; const bf16* y2; bf16* hb;
                 const float* W; const float* bias; float* logf; gu32* cnt; int* tok; float* gw; };
template <int MODE>
__device__ __forceinline__ void rowpass(Frame& F, const RowArgs& A) {
    constexpr int NT = (MODE == 0) ? 1 : (MODE == 1 ? 2 : 0);
    const int lane = F.lane, w = F.wave, r = lane & 15, q = lane >> 4, tid = F.tid;
    const int R0 = F.vcu * 128, b = R0 >> 12;
    const int kb = 128 * w + 8 * q;
    LAS float* red = (LAS float*)(F.lds);
    LAS f32x4* part = (LAS f32x4*)(F.lds + 1024);
    LAS float* scS = (LAS float*)(F.lds + 1024 + 32768);
    LAS float* selS = scS + 512;
    LAS float* GM = (LAS float*)(F.lds + 65536); LAS float* SH = GM + 1024; LAS float* GT = SH + 1024;
    for (int k = tid; k < D; k += 512) { const float g1 = A.g[k];
        if (MODE < 3) { GM[k] = g1 * (1.0f + A.scp[(size_t)b * MODW + k]); SH[k] = A.shp[(size_t)b * MODW + k]; } else { GM[k] = g1; SH[k] = 0.f; }
        GT[k] = (MODE >= 2) ? A.gtp[(size_t)b * MODW + k] : 0.f; }
    __syncthreads();
    bf16x8 Bh[NT > 0 ? NT : 1][4], Bl[NT > 0 ? NT : 1][4];
    constexpr int LDW = (MODE == 0) ? WIN_LD : NE, COFF = (MODE == 0) ? 3 * D : 0;
    if (NT > 0) { const float* wbase = A.W + (size_t)kb * LDW + COFF + r;
#pragma unroll
        for (int nt = 0; nt < NT; ++nt)
#pragma unroll
            for (int c = 0; c < 4; ++c) { float wv[8];
#pragma unroll
                for (int j = 0; j < 8; ++j) wv[j] = wbase[(32 * c + j) * LDW + 16 * nt];
                v4u hw, lw;
                hw.x = pk2(wv[0], wv[1]); hw.y = pk2(wv[2], wv[3]); hw.z = pk2(wv[4], wv[5]); hw.w = pk2(wv[6], wv[7]);
                lw.x = pk2(wv[0] - bflo(hw.x), wv[1] - bfhi(hw.x)); lw.y = pk2(wv[2] - bflo(hw.y), wv[3] - bfhi(hw.y));
                lw.z = pk2(wv[4] - bflo(hw.z), wv[5] - bfhi(hw.z)); lw.w = pk2(wv[6] - bflo(hw.w), wv[7] - bfhi(hw.w));
                Bh[nt][c] = __builtin_bit_cast(bf16x8, hw); Bl[nt][c] = __builtin_bit_cast(bf16x8, lw); }
    }
    for (int it = 0; it < 8; ++it) {
        const int row = R0 + 16 * it + r, buf = it & 1;
        const float* xs = A.src + (size_t)row * D + kb;
        f32x4 xv[4][2];
#pragma unroll
        for (int c = 0; c < 4; ++c) { xv[c][0] = *(const f32x4*)(xs + 32 * c); xv[c][1] = *(const f32x4*)(xs + 32 * c + 4); }
        if (MODE >= 2) {
            const bf16* yp = A.y2 + (size_t)row * 2 * D + kb;
#pragma unroll
            for (int c = 0; c < 4; ++c) { const v4u ya = *(const v4u*)(yp + 32 * c), yb = *(const v4u*)(yp + D + 32 * c);
                f32x4 s0, s1;
                s0[0] = bflo(ya.x) + bflo(yb.x); s0[1] = bfhi(ya.x) + bfhi(yb.x); s0[2] = bflo(ya.y) + bflo(yb.y); s0[3] = bfhi(ya.y) + bfhi(yb.y);
                s1[0] = bflo(ya.z) + bflo(yb.z); s1[1] = bfhi(ya.z) + bfhi(yb.z); s1[2] = bflo(ya.w) + bflo(yb.w); s1[3] = bfhi(ya.w) + bfhi(yb.w);
                xv[c][0] += *(const LAS f32x4*)(GT + kb + 32 * c) * s0; xv[c][1] += *(const LAS f32x4*)(GT + kb + 32 * c + 4) * s1; }
            if (MODE == 2) { float* xd = A.dst + (size_t)row * D + kb;
#pragma unroll
                for (int c = 0; c < 4; ++c) { *(f32x4*)(xd + 32 * c) = xv[c][0]; *(f32x4*)(xd + 32 * c + 4) = xv[c][1]; } }
        }
        float ss = 0.f;
#pragma unroll
        for (int c = 0; c < 4; ++c)
#pragma unroll
            for (int hf = 0; hf < 2; ++hf) { const f32x4 v = xv[c][hf]; ss += (v[0] * v[0] + v[1] * v[1]) + (v[2] * v[2] + v[3] * v[3]); }
        ss += __int_as_float(__builtin_amdgcn_ds_bpermute((lane ^ 16) << 2, __float_as_int(ss))); ss += __int_as_float(__builtin_amdgcn_ds_bpermute((lane ^ 32) << 2, __float_as_int(ss)));
        if (q == 0) red[buf * 128 + w * 16 + r] = ss;
        __syncthreads();
        float tot = 0.f;
#pragma unroll
        for (int ww = 0; ww < 8; ++ww) tot += red[buf * 128 + ww * 16 + r];
        const float rstd = 1.0f / sqrtf(tot * (1.0f / D) + RMS_EPS);
        if (MODE == 3) { float* xd = A.dst + (size_t)row * D + kb;
#pragma unroll
            for (int c = 0; c < 4; ++c) { *(f32x4*)(xd + 32 * c) = xv[c][0] * rstd * *(const LAS f32x4*)(GM + kb + 32 * c); *(f32x4*)(xd + 32 * c + 4) = xv[c][1] * rstd * *(const LAS f32x4*)(GM + kb + 32 * c + 4); }
            continue; }
        f32x4 acc[NT > 0 ? NT : 1];
#pragma unroll
        for (int nt = 0; nt < (NT > 0 ? NT : 1); ++nt) acc[nt] = (f32x4){0.f, 0.f, 0.f, 0.f};
        bf16* hp = A.hb + (size_t)row * D + kb;
#pragma unroll
        for (int c = 0; c < 4; ++c) {
            const f32x4 h0 = xv[c][0] * rstd * *(const LAS f32x4*)(GM + kb + 32 * c) + *(const LAS f32x4*)(SH + kb + 32 * c), h1 = xv[c][1] * rstd * *(const LAS f32x4*)(GM + kb + 32 * c + 4) + *(const LAS f32x4*)(SH + kb + 32 * c + 4);
            v4u hw; hw.x = pk2(h0[0], h0[1]); hw.y = pk2(h0[2], h0[3]); hw.z = pk2(h1[0], h1[1]); hw.w = pk2(h1[2], h1[3]);
            *(v4u*)(hp + 32 * c) = hw;
            if (NT > 0) {
                v4u lw; lw.x = pk2(h0[0] - bflo(hw.x), h0[1] - bfhi(hw.x)); lw.y = pk2(h0[2] - bflo(hw.y), h0[3] - bfhi(hw.y));
                lw.z = pk2(h1[0] - bflo(hw.z), h1[1] - bfhi(hw.z)); lw.w = pk2(h1[2] - bflo(hw.w), h1[3] - bfhi(hw.w));
                const bf16x8 ah = __builtin_bit_cast(bf16x8, hw), al = __builtin_bit_cast(bf16x8, lw);
#pragma unroll
                for (int nt = 0; nt < NT; ++nt) {
                    acc[nt] = __builtin_amdgcn_mfma_f32_16x16x32_bf16(ah, Bh[nt][c], acc[nt], 0, 0, 0);
                    acc[nt] = __builtin_amdgcn_mfma_f32_16x16x32_bf16(ah, Bl[nt][c], acc[nt], 0, 0, 0);
                    acc[nt] = __builtin_amdgcn_mfma_f32_16x16x32_bf16(al, Bh[nt][c], acc[nt], 0, 0, 0); }
            }
        }
        if (NT > 0) {
#pragma unroll
            for (int nt = 0; nt < NT; ++nt) part[((buf * 8 + w) * 2 + nt) * 64 + lane] = acc[nt];
            __syncthreads();
            if (MODE == 0) {
                if (tid < 256) { const int t = tid & 15, n = tid >> 4; float f = 0.f;
#pragma unroll
                    for (int ww = 0; ww < 8; ++ww) f += ((const LAS float*)&part[((buf * 8 + ww) * 2 + 0) * 64 + n + 16 * (t >> 2)])[t & 3];
                    const float z = f + A.bias[n]; const float lf = fminf(z, 0.f) - log1pf(__expf(-fabsf(z)));
                    const int rt = R0 + 16 * it + t; A.logf[((size_t)b * H + n) * SEQ + (rt & (SEQ - 1))] = lf; }
            } else {
                { const int t = tid & 15, n = tid >> 4; float f = 0.f;
#pragma unroll
                  for (int ww = 0; ww < 8; ++ww) f += ((const LAS float*)&part[((buf * 8 + ww) * 2 + (n >> 4)) * 64 + (n & 15) + 16 * (t >> 2)])[t & 3];
                  const float sc = 1.0f / (1.0f + expf(-f)); scS[t * 32 + n] = sc; selS[t * 32 + n] = sc + A.bias[n]; }
                __syncthreads();
                if (tid < 16) { const LAS float* sl = selS + tid * 32; float bg = -INFINITY; int gi = 0;
                    for (int g = 0; g < 4; ++g) { float m1 = -INFINITY, m2 = -INFINITY;
                        for (int i = 0; i < 8; ++i) { const float v = sl[8 * g + i]; if (v > m1) { m2 = m1; m1 = v; } else if (v > m2) m2 = v; }
                        const float gs = m1 + m2; if (gs > bg) { bg = gs; gi = g; } }
                    int i1 = 0, i2 = 0; float v1 = -INFINITY, v2 = -INFINITY;
                    for (int i = 0; i < 8; ++i) { const float v = sl[8 * gi + i]; if (v > v1) { v1 = v; i1 = i; } }
                    for (int i = 0; i < 8; ++i) { const float v = sl[8 * gi + i]; if (i != i1 && v > v2) { v2 = v; i2 = i; } }
                    const int e0 = 8 * gi + i1, e1 = 8 * gi + i2; const float s0 = scS[tid * 32 + e0], s1 = scS[tid * 32 + e1], inv = 1.0f / (s0 + s1);
                    const int rt = R0 + 16 * it + tid;
                    const unsigned p0 = __hip_atomic_fetch_add(A.cnt + e0 * 64, 1u, RLX_AGENT), p1 = __hip_atomic_fetch_add(A.cnt + e1 * 64, 1u, RLX_AGENT);
                    A.tok[e0 * ECAP + p0] = rt * 2; A.gw[e0 * ECAP + p0] = s0 * inv; A.tok[e1 * ECAP + p1] = rt * 2 + 1; A.gw[e1 * ECAP + p1] = s1 * inv; }
            }
        }
    }
    __syncthreads();
}

constexpr int UT_E = 64, UT_X = 64 + 320, UT_V = 64 + 640;
__device__ __forceinline__ void build_etab(Frame& F, int layer) {
    LAS int* et = (LAS int*)(F.lds + ETAB_OFF);
    if (F.tid == 0) { int ts = 0;
        for (int e = 0; e < NE; ++e) { const int c = (int)__hip_atomic_load(F.ctl + CW_CNT + (layer * 32 + e) * 64, RLX_AGENT); const int nt = (c + 255) >> 8;
            for (int j = 0; j < nt; ++j) { et[UT_E + ts] = e; et[UT_X + ts] = e * ECAP + 256 * j; const int rem = c - 256 * j; et[UT_V + ts] = rem < 256 ? rem : 256; ++ts; } }
        et[0] = ts; }
    __syncthreads();
}
__device__ __forceinline__ void gather_rows(Frame& F) {
    const LAS int* et = (const LAS int*)(F.lds + ETAB_OFF);
    const int ptot = et[0] * 256; const int* tok = WSP(int, WS_TOK);
    const int gw = F.vcu * NWAVES + F.wave, NGW = F.G * NWAVES;
    for (int p = gw; p < ptot; p += NGW) { const int tile = p >> 8, rl = p & 255;
        if (rl < et[UT_V + tile]) { const int tk = tok[et[UT_X + tile] + rl] >> 1;
            const GAS v4u* s = (const GAS v4u*)(WSP(bf16, WS_HB) + (size_t)tk * D) + F.lane; GAS v4u* d = (GAS v4u*)(WSP(bf16, WS_XS) + (size_t)p * D) + F.lane;
            const v4u a = s[0], bq = s[64]; d[0] = a; d[64] = bq; } }
}
__device__ __forceinline__ void pool_rows(Frame& F) {
    const int ch = F.tid & 127, rs = F.tid >> 7; const int t0 = F.vcu * 128 + rs * 32; const int win = 2 << (ch >> 5);
    const bf16* hb = WSP(bf16, WS_HB) + ch * 8; bf16* pl = WSP(bf16, WS_PL) + ch * 8;
    float s[8];
#pragma unroll
    for (int j = 0; j < 8; ++j) s[j] = 0.f;
    const int s0 = t0 & (SEQ - 1);
    for (int i = 1; i < win; ++i) if (s0 - i >= 0) { const v4u a = *(const v4u*)(hb + (size_t)(t0 - i) * D);
        s[0] += bflo(a.x); s[1] += bfhi(a.x); s[2] += bflo(a.y); s[3] += bfhi(a.y); s[4] += bflo(a.z); s[5] += bfhi(a.z); s[6] += bflo(a.w); s[7] += bfhi(a.w); }
    for (int i = 0; i < 32; ++i) { const int t = t0 + i, sq = s0 + i;
        const v4u a = *(const v4u*)(hb + (size_t)t * D);
        float h[8]; h[0] = bflo(a.x); h[1] = bfhi(a.x); h[2] = bflo(a.y); h[3] = bfhi(a.y); h[4] = bflo(a.z); h[5] = bfhi(a.z); h[6] = bflo(a.w); h[7] = bfhi(a.w);
#pragma unroll
        for (int j = 0; j < 8; ++j) s[j] += h[j];
        const float ic = 1.0f / (float)((sq + 1 < win) ? (sq + 1) : win);
        v4u w; w.x = pk2(s[0] * ic - h[0], s[1] * ic - h[1]); w.y = pk2(s[2] * ic - h[2], s[3] * ic - h[3]); w.z = pk2(s[4] * ic - h[4], s[5] * ic - h[5]); w.w = pk2(s[6] * ic - h[6], s[7] * ic - h[7]);
        if (sq - win + 1 >= 0) { const v4u o = *(const v4u*)(hb + (size_t)(t - win + 1) * D);
            s[0] -= bflo(o.x); s[1] -= bfhi(o.x); s[2] -= bflo(o.y); s[3] -= bfhi(o.y); s[4] -= bflo(o.z); s[5] -= bfhi(o.z); s[6] -= bflo(o.w); s[7] -= bfhi(o.w); }
        *(v4u*)(pl + (size_t)t * D) = w; }
}

struct DenseSched {
    const char* A; const char* Bt; size_t strideA, strideB; int nM, nN, nwg, G, c;
    __device__ __forceinline__ bool next(int i, pg8::Unit& u) const {
        const long L = (long)i * G + c; if (L >= nwg) return false;
        int wgid = (int)L; { const int q = nwg / 8, r = nwg % 8, xcd = wgid % 8, off = wgid / 8; wgid = (xcd < r ? xcd * (q + 1) : r * (q + 1) + (xcd - r) * q) + off; }
        const int nig = 8 * nN, gid = wgid / nig, fm = gid * 8, gsz = (nM - fm) < 8 ? (nM - fm) : 8;
        u.pm = fm + ((wgid % nig) % gsz); u.pn = (wgid % nig) / gsz; u.a = A + (size_t)u.pm * strideA; u.b = Bt + (size_t)u.pn * strideB; u.x0 = 0; u.x1 = 0; return true;
    }
};
struct PoolSched {
    const char* A; const char* Bt; int G, v;
    __device__ __forceinline__ bool next(int i, pg8::Unit& u) const {
        const int L = i * G + v; if (L >= 512) return false;
        u.pm = L >> 2; u.pn = L & 3; u.a = A + (size_t)u.pm * 256 * D * 2 + (size_t)u.pn * 256 * 2; u.b = Bt + (size_t)u.pn * 65536 * 2; u.x0 = 0; u.x1 = 0; return true;
    }
};
template <bool DOWN> struct MoeSched {
    const LAS int* et; const char* A; const char* Bt; int G, v;
    static constexpr size_t rowA = DOWN ? (size_t)FD * 2 : (size_t)D * 2, strideE = DOWN ? (size_t)1024 * 512 * 2 : (size_t)1024 * 1024 * 2, stridePn = DOWN ? (size_t)256 * 512 * 2 : (size_t)256 * 1024 * 2;
    __device__ __forceinline__ bool next(int i, pg8::Unit& u) const {
        const int L = i * G + v; const int ntile = et[0]; if (L >= ntile * 4) return false;
        const int tile = L >> 2, pn = L & 3; const int e = et[UT_E + tile];
        u.pm = tile; u.pn = pn; u.a = A + (size_t)tile * 256 * rowA; u.b = Bt + (size_t)e * strideE + (size_t)pn * stridePn;
        if (DOWN) { u.x0 = et[UT_X + tile]; u.x1 = et[UT_V + tile]; } else { u.x0 = pn; u.x1 = tile * 256; }
        return true;
    }
};
constexpr int N_PHASES = 17;
struct Args { const float* in[17]; float* out; unsigned char* ws; int ph_lo, ph_hi; };
__global__ void __launch_bounds__(NWAVES * 64, 2) fwd_megakernel(Args args) {
    extern __shared__ __attribute__((aligned(16))) unsigned char lds[];
    Frame F;
    F.lds = (LAS unsigned char*)lds;
    F.MISC = (volatile LAS unsigned*)(F.lds + MISC_OFF);
    F.wave0 = __builtin_amdgcn_readfirstlane((int)threadIdx.x >> 6); F.tid = threadIdx.x; F.lane = F.tid & 63; F.wave = F.wave0;
    F.G = gridDim.x; { const int bx = blockIdx.x; F.vcu = (F.G % 8 == 0) ? (bx % 8) * (F.G / 8) + bx / 8 : bx; }
    F.ws0 = args.ws; F.out0 = args.out;
    F.ka0 = (const __attribute__((address_space(4))) char*)__builtin_amdgcn_kernarg_segment_ptr();
    phase_enter(F);
    for (int u = F.tid; u < (LDS_BYTES - LDSCTL_OFF) / 4; u += NWAVES * 64) ((LAS unsigned*)(F.lds + LDSCTL_OFF))[u] = 0u;
    __syncthreads();
    XcdBarrier bar; bar.bar = (unsigned*)(F.ctl + CW_BAR); bar.x = 0; bar.st = nullptr;
    if (!MK_MULTI) bar = xcd_barrier_post((unsigned*)(F.ctl + CW_BAR), F.MISC + 8);
    int lo = args.ph_lo, hi = args.ph_hi;
#ifndef PHMASK
#define PHMASK 0xFFFFFFFFu
#endif
#define IN(k) (((PHMASK >> (k)) & 1u) && lo <= (k) && (k) < hi)
#ifndef DUP_PHASE
#define DUP_PHASE -1
#endif
#define REP(k) for (int rep_ = 0; rep_ < ((k) == DUP_PHASE ? 2 : 1); ++rep_)
#define SEAM(k) do { if (IN(k) && IN((k) + 1)) xcd_barrier(bar); asm volatile("" : "+s"(lo), "+s"(hi)); } while (0)
#define mod WSP(float, WS_MOD)
#define HB WSP(bf16, WS_HB)

    if (IN(0)) REP(0) { phase_enter(F); p0_prologue(F); } SEAM(0);
#ifdef EXTRA_BARS
    for (int xb_ = 0; xb_ < EXTRA_BARS; ++xb_) xcd_barrier(bar);
#endif
    if (IN(1)) REP(1) { phase_enter(F); RowArgs A{}; A.src = FIN(IN_X); A.g = FIN(IN_NMG); A.shp = mod + 0; A.scp = mod + D; A.hb = HB; A.W = FIN(IN_WIN); A.bias = FIN(IN_FBIAS); A.logf = WSP(float, WS_LOGF);
        rowpass<0>(F, A); } SEAM(1);
    if (IN(2)) REP(2) { phase_enter(F); pg8::Gemm g{D, D, D}; DenseSched S{(const char*)HB, (const char*)WSP(bf16, WS_WQKV), (size_t)256 * D * 2, (size_t)256 * D * 2, T / 256, 3 * D / 256, (T / 256) * (3 * D / 256), F.G, (int)blockIdx.x};
        pg8::EpiQKV E{WSP(bf16, WS_Q), (size_t)(WS_K - WS_Q) / 2, attn_body::C2, (unsigned*)(F.ctl + CW_QKM)};
        pg8::gemm_phase<pg8::EpiQKV, DenseSched, true>(F.lds + RING_OFF, g, S, E, F.wave0); } SEAM(2);
    if (IN(3)) REP(3) { phase_enter(F); const attn_body::AttnTensors AT{(const attn_body::bf16*)WSP(bf16, WS_Q), (const attn_body::bf16*)WSP(bf16, WS_K), (const attn_body::bf16*)WSP(bf16, WS_V), (attn_body::bf16*)HB, WSP(float, WS_LOGF), (const unsigned*)(F.ctl + CW_QKM)};
        attn_body::attn_phase<8>((char*)lds + RING_OFF, AT, (unsigned*)(F.ctl + CW_AQ), F.wave0); } SEAM(3);
    if (IN(4)) REP(4) { phase_enter(F); pg8::Gemm g{D, D, D}; DenseSched S{(const char*)HB, (const char*)WSP(bf16, WS_WO), (size_t)256 * D * 2, (size_t)256 * D * 2, T / 256, D / 256, (T / 256) * (D / 256), F.G, (int)blockIdx.x};
        pg8::EpiResid E{FIN(IN_X), F.out, mod + 2 * D};
        pg8::gemm_phase<pg8::EpiResid, DenseSched, true>(F.lds + RING_OFF, g, S, E, F.wave0); } SEAM(4);
        if (IN(5)) REP(5) { phase_enter(F); RowArgs A{}; A.src = F.out; A.g = FIN(IN_NFG) + 0 * D; A.shp = mod + (size_t)0 * 8 * MODW + 3 * D; A.scp = mod + (size_t)0 * 8 * MODW + 4 * D; A.hb = HB;
            A.W = FIN(IN_RW); A.bias = FIN(IN_RB); A.cnt = F.ctl + CW_CNT + 0 * 32 * 64; A.tok = WSP(int, WS_TOK); A.gw = WSP(float, WS_GW);
            if (rep_) { A.cnt = F.ctl + CW_CNT + 2 * 32 * 64; A.tok = WSP(int, WS_END); A.gw = WSP(float, WS_END + 4 * MiB); }
            rowpass<1>(F, A); } SEAM(5);
        if (IN(6)) REP(6) { phase_enter(F); build_etab(F, 0); gather_rows(F); } SEAM(6);
        if (IN(7)) REP(7) { phase_enter(F); build_etab(F, 0); pg8::Gemm g{D, D, D};
            MoeSched<false> S{(const LAS int*)(F.lds + ETAB_OFF), (const char*)WSP(bf16, WS_XS), (const char*)(WSP(bf16, WS_UP) + (size_t)0 * NE * 1024 * 1024), F.G, F.vcu};
            pg8::EpiUp E{WSP(bf16, WS_HH)};
            pg8::gemm_phase<pg8::EpiUp, MoeSched<false>, true>(F.lds + RING_OFF, g, S, E, F.wave0); } SEAM(7);
        if (IN(8)) REP(8) { phase_enter(F); build_etab(F, 0); pg8::Gemm g{FD, FD, FD};
            MoeSched<true> S{(const LAS int*)(F.lds + ETAB_OFF), (const char*)WSP(bf16, WS_HH), (const char*)(WSP(bf16, WS_DN) + (size_t)0 * NE * 1024 * 512), F.G, F.vcu};
            pg8::EpiDown E{WSP(bf16, WS_Y2), WSP(int, WS_TOK), WSP(float, WS_GW)};
            pg8::gemm_phase<pg8::EpiDown, MoeSched<true>, true>(F.lds + RING_OFF, g, S, E, F.wave0); } SEAM(8);

            if (IN(9)) REP(9) { phase_enter(F); RowArgs A{}; A.src = F.out; A.dst = F.out; A.g = FIN(IN_NMG) + D; A.shp = mod + 8 * MODW + 0; A.scp = mod + 8 * MODW + D; A.gtp = mod + 5 * D; A.y2 = WSP(bf16, WS_Y2); A.hb = HB;
                rowpass<2>(F, A); } SEAM(9);
            if (IN(10)) REP(10) { phase_enter(F); pool_rows(F); } SEAM(10);
            if (IN(11)) REP(11) { phase_enter(F); pg8::Gemm g{D, 256, 256}; PoolSched S{(const char*)WSP(bf16, WS_PL), (const char*)WSP(bf16, WS_WP), F.G, F.vcu};
                pg8::EpiPool E{F.out, mod + 8 * MODW + 2 * D, FIN(IN_POOLS)};
                pg8::gemm_phase<pg8::EpiPool, PoolSched, true>(F.lds + RING_OFF, g, S, E, F.wave0); } SEAM(11);
        if (IN(12)) REP(12) { phase_enter(F); RowArgs A{}; A.src = F.out; A.g = FIN(IN_NFG) + 1 * D; A.shp = mod + (size_t)1 * 8 * MODW + 3 * D; A.scp = mod + (size_t)1 * 8 * MODW + 4 * D; A.hb = HB;
            A.W = FIN(IN_RW); A.bias = FIN(IN_RB); A.cnt = F.ctl + CW_CNT + 1 * 32 * 64; A.tok = WSP(int, WS_TOK); A.gw = WSP(float, WS_GW);
            rowpass<1>(F, A); } SEAM(12);
        if (IN(13)) REP(13) { phase_enter(F); build_etab(F, 1); gather_rows(F); } SEAM(13);
        if (IN(14)) REP(14) { phase_enter(F); build_etab(F, 1); pg8::Gemm g{D, D, D};
            MoeSched<false> S{(const LAS int*)(F.lds + ETAB_OFF), (const char*)WSP(bf16, WS_XS), (const char*)(WSP(bf16, WS_UP) + (size_t)1 * NE * 1024 * 1024), F.G, F.vcu};
            pg8::EpiUp E{WSP(bf16, WS_HH)};
            pg8::gemm_phase<pg8::EpiUp, MoeSched<false>, true>(F.lds + RING_OFF, g, S, E, F.wave0); } SEAM(14);
        if (IN(15)) REP(15) { phase_enter(F); build_etab(F, 1); pg8::Gemm g{FD, FD, FD};
            MoeSched<true> S{(const LAS int*)(F.lds + ETAB_OFF), (const char*)WSP(bf16, WS_HH), (const char*)(WSP(bf16, WS_DN) + (size_t)1 * NE * 1024 * 512), F.G, F.vcu};
            pg8::EpiDown E{WSP(bf16, WS_Y2), WSP(int, WS_TOK), WSP(float, WS_GW)};
            pg8::gemm_phase<pg8::EpiDown, MoeSched<true>, true>(F.lds + RING_OFF, g, S, E, F.wave0); } SEAM(15);
    if (IN(16)) REP(16) { phase_enter(F); RowArgs A{}; A.src = F.out; A.dst = F.out; A.g = FIN(IN_NFIN); A.gtp = mod + 8 * MODW + 5 * D; A.y2 = WSP(bf16, WS_Y2);
        rowpass<3>(F, A); }
#undef IN
#undef SEAM
#undef mod
#undef HB
}

extern "C" void kernel_launch(void* const* d_in, const int* in_sizes, int n_in, void* d_out, int out_size, void* d_ws, size_t ws_size, hipStream_t stream) {
    static int grid = 0;
    if (grid == 0) {
        if (n_in != 17 || in_sizes[0] != T * D || out_size != T * D || ws_size < WS_END) { fprintf(stderr, "kernel_launch: unexpected shapes (n_in %d, in0 %d, out %d, ws %zu)\n", n_in, n_in > 0 ? in_sizes[0] : -1, out_size, ws_size); grid = -1; return; }
        int dev = 0, cus = 0, per_cu = 0;
        if (hipGetDevice(&dev) != hipSuccess || hipDeviceGetAttribute(&cus, hipDeviceAttributeMultiprocessorCount, dev) != hipSuccess) { grid = -1; return; }
        if (hipFuncSetAttribute((const void*)fwd_megakernel, hipFuncAttributeMaxDynamicSharedMemorySize, LDS_BYTES) != hipSuccess) { fprintf(stderr, "kernel_launch: hipFuncSetAttribute failed\n"); grid = -1; return; }
        if (hipOccupancyMaxActiveBlocksPerMultiprocessor(&per_cu, (const void*)fwd_megakernel, NWAVES * 64, LDS_BYTES) != hipSuccess || per_cu < 1) { fprintf(stderr, "kernel_launch: occupancy query says %d\n", per_cu); (void)hipGetLastError(); grid = -1; return; }
        grid = cus;
        if (grid != 256) fprintf(stderr, "kernel_launch: %d CUs; this kernel's static work split expects 256\n", grid);
    }
    if (grid < 0) return;
    (void)hipMemsetAsync((char*)d_ws + WS_CTL, 0, CTL_ZERO_BYTES, stream);
    Args a{};
    for (int i = 0; i < 17; ++i) a.in[i] = (const float*)d_in[i];
    a.out = (float*)d_out; a.ws = (unsigned char*)d_ws;
#if MK_MULTI
#ifndef MAXPH
#define MAXPH 17
#endif
    for (int p = 0; p < MAXPH; ++p) { a.ph_lo = p; a.ph_hi = p + 1; hipLaunchKernelGGL(fwd_megakernel, dim3(grid), dim3(NWAVES * 64), LDS_BYTES, stream, a); }
#else
    a.ph_lo = 0; a.ph_hi = 17;
    void* kargs[] = {&a};
    hipError_t e = hipLaunchCooperativeKernel((const void*)fwd_megakernel, dim3(grid), dim3(NWAVES * 64), kargs, LDS_BYTES, stream);
    if (e != hipSuccess) fprintf(stderr, "kernel_launch: cooperative launch failed: %s\n", hipGetErrorString(e));
#endif
}
```

```cpp
#define MK_MULTI 0
#define MAXPH 17
#include <hip/hip_runtime.h>
#include <hip/hip_bf16.h>
#include <cstdio>
#include <cstdint>
#include <cmath>
__device__ __forceinline__ int opaque_tid(int wave0) { int w = wave0; asm volatile("" : "+s"(w)); unsigned m = ~0u; asm volatile("" : "+s"(m)); const int l = (int)__builtin_amdgcn_mbcnt_hi(m, __builtin_amdgcn_mbcnt_lo(m, 0u)); return w * 64 + l; }
namespace pg8 {
#define PG8_LAS __attribute__((address_space(3)))
typedef unsigned short bf16_t;
typedef short bf16x8 __attribute__((ext_vector_type(8)));
typedef float f32x4 __attribute__((ext_vector_type(4)));
typedef float f32x2 __attribute__((ext_vector_type(2)));
typedef unsigned u32x4 __attribute__((ext_vector_type(4)));
constexpr int BM = 256, BK = 64, HALF = 128, HTB = HALF * BK * 2  , STAGE_BYTES = 8 * HTB, NXCD = 8, WGM = 8;

__host__ __device__ __forceinline__ int lds_byte(int r, int c) { const int st = (r >> 4) * 2 + (c >> 5), rr = r & 15, cc = c & 31, ob = rr * 64 + cc * 2; return st * 1024 + (ob ^ (((ob >> 9) & 1) << 5)); }
__host__ __device__ __forceinline__ void stage_rc(int b, int& R, int& C) { const int st = b / 1024, sb = b % 1024, swz = sb ^ (((sb >> 9) & 1) << 5); R = (st >> 1) * 16 + swz / 64; C = (st & 1) * 32 + (swz % 64) / 2; }
__host__ __device__ __forceinline__ int perm32(int rho) { const int n = rho >> 4, i = rho & 15; return 8 * (i >> 2) + 4 * n + (i & 3); }

struct Unit { const char* a; const char* b; int pm, pn, x0, x1; };
struct Gemm { int lda, ldb, K; };

__device__ __forceinline__ unsigned cvt_pk_bf16(float lo, float hi) { unsigned r; asm volatile("v_cvt_pk_bf16_f32 %0, %1, %2" : "=v"(r) : "v"(lo), "v"(hi)); return r; }


struct EpiBf16 {
    static constexpr bool PERM = true, AFTER_DRAIN = false;
    bf16_t* O; int ldc; int split_cols; size_t split_stride; float scale0;
    __device__ __forceinline__ void operator()(const f32x4 (&acc)[2][2][4][2], const Unit& u, int wr, int wc, int fr, int fq) const {
        const int row0 = u.pm * BM + wr * 64 + fr; int colt = u.pn * BM; bf16_t* base = O;
        float sc = 1.f; if (split_cols) { const int t = colt / split_cols; base += (size_t)t * split_stride; colt -= t * split_cols; if (t == 0) sc = scale0; }
        const int col0 = colt + wc * 32 + 8 * fq;
#pragma unroll
        for (int ai = 0; ai < 2; ++ai)
#pragma unroll
            for (int m = 0; m < 4; ++m) { bf16_t* rowp = base + (size_t)(row0 + ai * HALF + m * 16) * ldc + col0;
#pragma unroll
                for (int bj = 0; bj < 2; ++bj) { f32x4 v0 = acc[ai][bj][m][0] * sc, v1 = acc[ai][bj][m][1] * sc;
                    u32x4 w; w.x = cvt_pk_bf16(v0[0], v0[1]); w.y = cvt_pk_bf16(v0[2], v0[3]); w.z = cvt_pk_bf16(v1[0], v1[1]); w.w = cvt_pk_bf16(v1[2], v1[3]);
                    *(u32x4*)(rowp + bj * HALF) = w; } }
    }
};
struct EpiQKV {
    static constexpr bool PERM = true, AFTER_DRAIN = false;
    bf16_t* O; size_t stride; float scale0; unsigned* qkm;
    __device__ __forceinline__ void operator()(const f32x4 (&acc)[2][2][4][2], const Unit& u, int wr, int wc, int fr, int fq) const {
        const int t = u.pn >> 2, colt = (u.pn & 3) * BM, b = u.pm >> 4; bf16_t* base = O + (size_t)t * stride;
        const float sc = (t == 0) ? scale0 : 1.f;
        const int row0 = u.pm * BM + wr * 64 + fr, col0 = colt + wc * 32 + 8 * fq, lane = fr + 16 * fq;
        float mx0 = 0.f, mx1 = 0.f;
#pragma unroll
        for (int ai = 0; ai < 2; ++ai)
#pragma unroll
            for (int m = 0; m < 4; ++m) { bf16_t* rowp = base + (size_t)(row0 + ai * HALF + m * 16) * 1024 + col0;
#pragma unroll
                for (int bj = 0; bj < 2; ++bj) { const f32x4 v0 = acc[ai][bj][m][0] * sc, v1 = acc[ai][bj][m][1] * sc;
                    u32x4 w; w.x = cvt_pk_bf16(v0[0], v0[1]); w.y = cvt_pk_bf16(v0[2], v0[3]); w.z = cvt_pk_bf16(v1[0], v1[1]); w.w = cvt_pk_bf16(v1[2], v1[3]);
                    *(u32x4*)(rowp + bj * HALF) = w;
                    if (t < 2) { float ss = (v0[0] * v0[0] + v0[1] * v0[1]) + (v0[2] * v0[2] + v0[3] * v0[3]) + (v1[0] * v1[0] + v1[1] * v1[1]) + (v1[2] * v1[2] + v1[3] * v1[3]);
                        ss += __int_as_float(__builtin_amdgcn_ds_bpermute((lane ^ 16) << 2, __float_as_int(ss))); ss += __int_as_float(__builtin_amdgcn_ds_bpermute((lane ^ 32) << 2, __float_as_int(ss)));
                        if (bj == 0) mx0 = fmaxf(mx0, ss); else mx1 = fmaxf(mx1, ss); } } }
        if (t < 2) {
#pragma unroll
            for (int o = 1; o < 16; o <<= 1) { mx0 = fmaxf(mx0, __int_as_float(__builtin_amdgcn_ds_bpermute((lane ^ o) << 2, __float_as_int(mx0)))); mx1 = fmaxf(mx1, __int_as_float(__builtin_amdgcn_ds_bpermute((lane ^ o) << 2, __float_as_int(mx1)))); }
            if (lane == 0) { unsigned* w = qkm + (t * 8 + b) * 32 + (u.pn & 3) * 8 + wc; atomicMax(w, __float_as_uint(mx0)); atomicMax(w + 4, __float_as_uint(mx1)); } }
    }
};
struct EpiResid {
    static constexpr bool PERM = false, AFTER_DRAIN = false;
    const float* base; float* out; const float* gate;
    __device__ __forceinline__ void operator()(const f32x4 (&acc)[2][2][4][2], const Unit& u, int wr, int wc, int fr, int fq) const {
        const int col0 = u.pn * BM + wc * 32 + 4 * fq; const int b = u.pm >> 4;
        f32x4 gv[2][2];
#pragma unroll
        for (int bj = 0; bj < 2; ++bj)
#pragma unroll
            for (int n = 0; n < 2; ++n) gv[bj][n] = *(const f32x4*)(gate + (size_t)b * 6144 + col0 + bj * HALF + n * 16);
#pragma unroll
        for (int ai = 0; ai < 2; ++ai)
#pragma unroll
            for (int m = 0; m < 4; ++m) { const size_t off = (size_t)(u.pm * BM + ai * HALF + wr * 64 + m * 16 + fr) * 1024 + col0;
#pragma unroll
                for (int bj = 0; bj < 2; ++bj)
#pragma unroll
                    for (int n = 0; n < 2; ++n) { const f32x4 bs = *(const f32x4*)(base + off + bj * HALF + n * 16); *(f32x4*)(out + off + bj * HALF + n * 16) = bs + gv[bj][n] * acc[ai][bj][m][n]; }
                if (m & 1) asm volatile("" ::: "memory"); }
    }
};
struct EpiPool {
    static constexpr bool PERM = false, AFTER_DRAIN = false;
    float* xr; const float* gate; const float* pscale;
    __device__ __forceinline__ void operator()(const f32x4 (&acc)[2][2][4][2], const Unit& u, int wr, int wc, int fr, int fq) const {
        const int col0 = u.pn * BM + wc * 32 + 4 * fq; const int b = u.pm >> 4;
        float* rbase = xr + (size_t)(u.pm * BM + wr * 64 + fr) * 1024 + col0;
#pragma unroll
        for (int bj = 0; bj < 2; ++bj)
#pragma unroll
            for (int n = 0; n < 2; ++n) { const f32x4 gv = *(const f32x4*)(gate + (size_t)b * 6144 + col0 + bj * HALF + n * 16) * *(const f32x4*)(pscale + col0 + bj * HALF + n * 16);
#pragma unroll
                for (int ai = 0; ai < 2; ++ai)
#pragma unroll
                    for (int m = 0; m < 4; ++m) { float* p = rbase + (size_t)(ai * HALF + m * 16) * 1024 + bj * HALF + n * 16; const f32x4 bs = *(const f32x4*)p; *(f32x4*)p = bs + gv * acc[ai][bj][m][n]; }
                asm volatile("" ::: "memory"); }
    }
};
__device__ __forceinline__ float silu_mul(float g, float u) { return g * u * __builtin_amdgcn_rcpf(1.0f + __builtin_amdgcn_exp2f(-1.4426950408889634f * g)); }
struct EpiUp {
    static constexpr bool PERM = true, AFTER_DRAIN = false;
    bf16_t* H;
    __device__ __forceinline__ void operator()(const f32x4 (&acc)[2][2][4][2], const Unit& u, int wr, int wc, int fr, int fq) const {
        const int row0 = u.x1 + wr * 64 + fr, col0 = u.x0 * 128 + wc * 32 + 8 * fq;
#pragma unroll
        for (int ai = 0; ai < 2; ++ai)
#pragma unroll
            for (int m = 0; m < 4; ++m) { bf16_t* rowp = H + (size_t)(row0 + ai * HALF + m * 16) * 512 + col0;
                const f32x4 g0 = acc[ai][0][m][0], g1 = acc[ai][0][m][1], u0 = acc[ai][1][m][0], u1 = acc[ai][1][m][1];
                u32x4 w; w.x = cvt_pk_bf16(silu_mul(g0[0], u0[0]), silu_mul(g0[1], u0[1])); w.y = cvt_pk_bf16(silu_mul(g0[2], u0[2]), silu_mul(g0[3], u0[3]));
                w.z = cvt_pk_bf16(silu_mul(g1[0], u1[0]), silu_mul(g1[1], u1[1])); w.w = cvt_pk_bf16(silu_mul(g1[2], u1[2]), silu_mul(g1[3], u1[3]));
                *(u32x4*)rowp = w; }
    }
};
struct EpiDown {
    static constexpr bool PERM = true, AFTER_DRAIN = false;
    bf16_t* Y; const int* tok; const float* gw;
    __device__ __forceinline__ void operator()(const f32x4 (&acc)[2][2][4][2], const Unit& u, int wr, int wc, int fr, int fq) const {
        const int col0 = u.pn * BM + wc * 32 + 8 * fq;
#pragma unroll
        for (int ai = 0; ai < 2; ++ai)
#pragma unroll
            for (int m = 0; m < 4; ++m) { const int rl = ai * HALF + wr * 64 + m * 16 + fr;
                if (rl < u.x1) { const int d = tok[u.x0 + rl]; const float w8 = gw[u.x0 + rl]; bf16_t* rowp = Y + (size_t)d * 1024 + col0;
#pragma unroll
                    for (int bj = 0; bj < 2; ++bj) { const f32x4 v0 = acc[ai][bj][m][0] * w8, v1 = acc[ai][bj][m][1] * w8;
                        u32x4 w; w.x = cvt_pk_bf16(v0[0], v0[1]); w.y = cvt_pk_bf16(v0[2], v0[3]); w.z = cvt_pk_bf16(v1[0], v1[1]); w.w = cvt_pk_bf16(v1[2], v1[3]);
                        *(u32x4*)(rowp + bj * HALF) = w; } } }
    }
};

template <class Epi, class Sched, bool ALIGN_EPI, bool GATHER = false>
__device__ __forceinline__ void gemm_phase(PG8_LAS unsigned char* lds, const Gemm g, const Sched& S, const Epi& E, int wave0) {
    int tid_ = opaque_tid(wave0);
    const int tid = tid_, wid = __builtin_amdgcn_readfirstlane(tid >> 6), lane = tid & 63, wr = wid >> 2, wc = wid & 3, fr = lane & 15, fq = lane >> 4;
    const int K = g.K, nt = K / BK;
    unsigned voffA[2], voffA1[2], voffB[2], nv0[2], nv1[2];
#pragma unroll
    for (int i = 0; i < 2; ++i) { int R, C; stage_rc(tid * 16 + i * 8192, R, C); const int Rb = Epi::PERM ? ((R & ~31) + perm32(R & 31)) : R;
        voffA[i] = (unsigned)(R * g.lda + C) * 2u; voffB[i] = (unsigned)(Rb * g.ldb + C) * 2u; voffA1[i] = 0u; nv0[i] = 0u; nv1[i] = 0u; }
    unsigned (&vA1)[2] = GATHER ? voffA1 : voffA;
#define PG8_ROWOFFS(u_, o0, o1) do { _Pragma("unroll") for (int i = 0; i < 2; ++i) { int R, C; stage_rc(tid * 16 + i * 8192, R, C); o0[i] = S.row_off(u_, R) + (unsigned)C * 2u; o1[i] = S.row_off(u_, HALF + R) + (unsigned)C * 2u; } } while (0)
    const size_t kstep = (size_t)(BK * 2);
    const size_t hstepA = GATHER ? (size_t)0 : (size_t)HALF * g.lda * 2, hstepB = (size_t)HALF * g.ldb * 2;
    const unsigned ldsw = (unsigned)wid * 1024u;
    const int aoff = lds_byte(wr * 64 + fr, fq * 8), boff = lds_byte(wc * 32 + fr, fq * 8);
#define PG8_SA(b, h) (((b) * 2 + (h)) * HTB)
#define PG8_SB(b, h) ((4 + (b) * 2 + (h)) * HTB)
#define PG8_STAGE(bufoff, gbase, voff) do { _Pragma("unroll") for (int _i = 0; _i < 2; ++_i) \
        __builtin_amdgcn_global_load_lds((const unsigned*)((const char*)(gbase) + (voff)[_i]), (PG8_LAS unsigned*)(lds + (bufoff) + ldsw + _i * 8192), 16, 0, 0); } while (0)
#define PG8_LDA(dst, b, h) do { _Pragma("unroll") for (int m = 0; m < 4; ++m) _Pragma("unroll") for (int k = 0; k < 2; ++k) dst[m][k] = *(const PG8_LAS bf16x8*)(lds + PG8_SA(b, h) + aoff + m * 2048 + k * 1024); } while (0)
#define PG8_LDB(dst, b, h) do { _Pragma("unroll") for (int n = 0; n < 2; ++n) _Pragma("unroll") for (int k = 0; k < 2; ++k) dst[n][k] = *(const PG8_LAS bf16x8*)(lds + PG8_SB(b, h) + boff + n * 2048 + k * 1024); } while (0)
#define PG8_MMA(ai, bj, At, Bt) do { __builtin_amdgcn_s_setprio(1); _Pragma("unroll") for (int m = 0; m < 4; ++m) _Pragma("unroll") for (int n = 0; n < 2; ++n) _Pragma("unroll") for (int k = 0; k < 2; ++k) \
        acc[ai][bj][m][n] = __builtin_amdgcn_mfma_f32_16x16x32_bf16(Bt[n][k], At[m][k], acc[ai][bj][m][n], 0, 0, 0); __builtin_amdgcn_s_setprio(0); } while (0)
#define PG8_WAIT_V(n) asm volatile("s_waitcnt vmcnt(" #n ")" ::: "memory")
#define PG8_WAIT_L(n) asm volatile("s_waitcnt lgkmcnt(" #n ")" ::: "memory")
#define PG8_BAR __builtin_amdgcn_s_barrier()
#define PG8_SCHED __builtin_amdgcn_sched_barrier(0)
    Unit cur, nxt; int ui = 0;
    if (!S.next(0, cur)) return;
    f32x4 acc[2][2][4][2];
#pragma unroll
    for (int a = 0; a < 2; ++a)
#pragma unroll
        for (int b = 0; b < 2; ++b)
#pragma unroll
            for (int m = 0; m < 4; ++m)
#pragma unroll
                for (int n = 0; n < 2; ++n) acc[a][b][m][n] = (f32x4){0.f, 0.f, 0.f, 0.f};
    bf16x8 At[4][2], B0[2][2], B1[2][2];
    const char* cA = cur.a; const char* cB = cur.b;
    if constexpr (GATHER) PG8_ROWOFFS(cur, voffA, voffA1);
    PG8_STAGE(PG8_SB(0, 0), cB, voffB); PG8_STAGE(PG8_SB(0, 1), cB + hstepB, voffB); PG8_STAGE(PG8_SA(0, 0), cA, voffA); PG8_STAGE(PG8_SA(0, 1), cA + hstepA, vA1);
    if (wr == 1) PG8_BAR;
    PG8_WAIT_V(2); PG8_BAR;
    PG8_STAGE(PG8_SB(1, 0), cB + kstep, voffB); PG8_STAGE(PG8_SA(1, 0), cA + kstep, voffA); PG8_STAGE(PG8_SB(1, 1), cB + hstepB + kstep, voffB);
    PG8_WAIT_V(6); PG8_BAR;
    for (;;) {
        const bool has_next = S.next(ui + 1, nxt);
        const char* nA = has_next ? nxt.a : cA; const char* nB = has_next ? nxt.b : cB;
        if constexpr (GATHER) { if (has_next) PG8_ROWOFFS(nxt, nv0, nv1); }
        for (int t = 0; t < nt; t += 2) {
            const bool last = (t == nt - 2);
            const char* a1 = cA + (size_t)(t + 1) * kstep;
            const char* a2 = last ? nA : cA + (size_t)(t + 2) * kstep; const char* b2 = last ? nB : cB + (size_t)(t + 2) * kstep;
            const char* a3 = a2 + kstep; const char* b3 = b2 + kstep;
            PG8_LDB(B0, 0, 0); PG8_LDB(B1, 0, 1); PG8_SCHED; PG8_LDA(At, 0, 0); PG8_STAGE(PG8_SA(1, 1), a1 + hstepA, vA1);
            if constexpr (GATHER) { if (last && has_next) { voffA[0] = nv0[0]; voffA[1] = nv0[1]; voffA1[0] = nv1[0]; voffA1[1] = nv1[1]; } }
            PG8_WAIT_V(8); PG8_WAIT_L(0); PG8_BAR; PG8_MMA(0, 0, At, B0); PG8_MMA(0, 1, At, B1); PG8_BAR; PG8_SCHED;
            PG8_LDA(At, 0, 1); PG8_STAGE(PG8_SB(0, 0), b2, voffB); PG8_STAGE(PG8_SB(0, 1), b2 + hstepB, voffB); PG8_STAGE(PG8_SA(0, 0), a2, voffA);
            PG8_WAIT_V(8); PG8_WAIT_L(0); PG8_BAR; PG8_MMA(1, 0, At, B0); PG8_MMA(1, 1, At, B1); PG8_BAR; PG8_SCHED;
            PG8_LDB(B0, 1, 0); PG8_LDB(B1, 1, 1); PG8_SCHED; PG8_LDA(At, 1, 0); PG8_STAGE(PG8_SA(0, 1), a2 + hstepA, vA1);
            PG8_WAIT_V(8); PG8_WAIT_L(0); PG8_BAR; PG8_MMA(0, 0, At, B0); PG8_MMA(0, 1, At, B1); PG8_BAR; PG8_SCHED;
            PG8_LDA(At, 1, 1); PG8_STAGE(PG8_SB(1, 0), b3, voffB); PG8_STAGE(PG8_SB(1, 1), b3 + hstepB, voffB); PG8_STAGE(PG8_SA(1, 0), a3, voffA);
            PG8_WAIT_V(8); PG8_WAIT_L(0); PG8_BAR; PG8_MMA(1, 0, At, B0); PG8_MMA(1, 1, At, B1); PG8_BAR; PG8_SCHED;
        }
        if constexpr (ALIGN_EPI) { if (wr == 0) PG8_BAR; }
        E(acc, cur, wr, wc, fr, fq);
        if (!has_next) break;
#pragma unroll
        for (int a = 0; a < 2; ++a)
#pragma unroll
            for (int b = 0; b < 2; ++b)
#pragma unroll
                for (int m = 0; m < 4; ++m)
#pragma unroll
                    for (int n = 0; n < 2; ++n) acc[a][b][m][n] = (f32x4){0.f, 0.f, 0.f, 0.f};
        cur = nxt; cA = nA; cB = nB; ++ui;
        if constexpr (ALIGN_EPI) { if (wr == 1) PG8_BAR; }
    }
    PG8_WAIT_V(0);
    if constexpr (!ALIGN_EPI) { if (wr == 0) PG8_BAR; }
    PG8_BAR;
#undef PG8_SA
#undef PG8_ROWOFFS
#undef PG8_SB
#undef PG8_STAGE
#undef PG8_LDA
#undef PG8_LDB
#undef PG8_MMA
#undef PG8_WAIT_V
#undef PG8_WAIT_L
#undef PG8_BAR
#undef PG8_SCHED
}
}
namespace attn_body {
using bf16=__hip_bfloat16;
using bf16x8=__attribute__((ext_vector_type(8)))short;
using s16x4=__attribute__((ext_vector_type(4)))short;
using f32x16=__attribute__((ext_vector_type(16)))float;
using f32x4=__attribute__((ext_vector_type(4)))float;
using u32x4=__attribute__((ext_vector_type(4)))unsigned;
constexpr int BATCH=8,NHEAD=16,SEQ=4096,D=64,DM=NHEAD*D;
constexpr int NW=8,QBLK=32,QB=QBLK*NW,KVBLK=64,NQB=SEQ/QB;
constexpr int ATTN_PITCH=DM, ATTN_UNIT_ROWS=QB;
__device__ __forceinline__ int crow(int r,int hi){return (r&3)+8*(r>>2)+4*hi;}
#define SBAR() __builtin_amdgcn_sched_barrier(0)
__device__ __forceinline__ void cmask(f32x16&p0,f32x16&p1,int jb,int qrel,int hi){
  const float NEG=-INFINITY; int kb=64*jb+4*hi;
  #pragma unroll
  for(int r=0;r<16;++r){int kv=kb+(r&3)+8*(r>>2); if(kv>qrel)p0[r]=NEG; if(kv+32>qrel)p1[r]=NEG;}
}

constexpr int NSLOT=3, SLOTB=8192;
constexpr int LDS_K=0, LDS_V=NSLOT*SLOTB, LDS_WS=2*NSLOT*SLOTB, LDS_OST=LDS_WS+NW*64*4, LDS_FS=LDS_OST+NW*4096, LDS_WT=LDS_FS+SEQ*4, LDS_BYTES=LDS_WT+64;
constexpr float C2=0.125f*1.4426950408889634f;
constexpr float LOG2E=1.4426950408889634f;
__device__ __forceinline__ void glds16(const void*gsrc,unsigned lds_dst){unsigned keep;
  asm volatile("s_mov_b32 %0, m0\n\ts_mov_b32 m0, %2\n\ts_nop 0\n\tglobal_load_lds_dwordx4 %1, off\n\ts_mov_b32 m0, %0":"=&s"(keep):"v"(gsrc),"s"(lds_dst):"memory");}
__device__ __forceinline__ void glds16s(const void*sbase,unsigned voff,unsigned lds_dst){unsigned keep;
  asm volatile("s_mov_b32 %0, m0\n\ts_mov_b32 m0, %3\n\ts_nop 4\n\tglobal_load_lds_dwordx4 %1, %2\n\ts_mov_b32 m0, %0":"=&s"(keep):"v"(voff),"s"(sbase),"s"(lds_dst):"memory");}
__device__ __forceinline__ float max3f(float a,float b,float c){float r;asm("v_max3_f32 %0, %1, %2, %3":"=v"(r):"v"(a),"v"(b),"v"(c));return r;}
__device__ __forceinline__ float max2f(float a,float b){float r;asm("v_max_f32_e32 %0, %1, %2":"=v"(r):"v"(a),"v"(b));return r;}
__device__ __forceinline__ float fadd_s(float a,float b){float r;asm("v_add_f32_e32 %0, %1, %2":"=v"(r):"v"(a),"v"(b));return r;}
__device__ __forceinline__ float fsub_s(float a,float b){float r;asm("v_sub_f32_e32 %0, %1, %2":"=v"(r):"v"(a),"v"(b));return r;}
typedef float f32x2_t __attribute__((ext_vector_type(2))); typedef __bf16 bf16x2_t __attribute__((ext_vector_type(2)));
__device__ __forceinline__ unsigned cvtpk_s(float lo,float hi){f32x2_t v={lo,hi};bf16x2_t b=__builtin_convertvector(v,bf16x2_t);return __builtin_bit_cast(unsigned,b);}
#define WAIT_BAR(N) asm volatile("s_waitcnt vmcnt(" #N ") lgkmcnt(0)\n\ts_barrier":::"memory")

typedef __attribute__((address_space(3))) const char* lds_cptr;
typedef short v4i16_t __attribute__((ext_vector_type(4)));
__device__ __forceinline__ void fbias(f32x16&c0,f32x16&c1,lds_cptr ft,float nm,int hi){
  #pragma unroll
  for(int g=0;g<4;++g){
    const f32x4 a=*(const __attribute__((address_space(3))) f32x4*)(ft+(8*g+4*hi)*4);
    const f32x4 b=*(const __attribute__((address_space(3))) f32x4*)(ft+(32+8*g+4*hi)*4);
    c0[4*g+0]=nm-a[0];c0[4*g+1]=nm-a[1];c0[4*g+2]=nm-a[2];c0[4*g+3]=nm-a[3];
    c1[4*g+0]=nm-b[0];c1[4*g+1]=nm-b[1];c1[4*g+2]=nm-b[2];c1[4*g+3]=nm-b[3];}
}
__device__ __forceinline__ void qkt(f32x16&p0,f32x16&p1,const char*Kslot,const bf16x8*qr,int r32,int hi){
  const char*kb=Kslot+hi*1024+r32*16;
  #pragma unroll
  for(int d0=0;d0<4;++d0){
    const bf16x8 b0=*reinterpret_cast<const bf16x8*>(kb+d0*2048);
    const bf16x8 b1=*reinterpret_cast<const bf16x8*>(kb+d0*2048+512);
    p0=__builtin_amdgcn_mfma_f32_32x32x16_bf16(b0,qr[d0],p0,0,0,0);p1=__builtin_amdgcn_mfma_f32_32x32x16_bf16(b1,qr[d0],p1,0,0,0);}
}
__device__ __forceinline__ void kload8(bf16x8*kf,lds_cptr kp){
  kf[0]=*(const __attribute__((address_space(3))) bf16x8*)(kp);      kf[1]=*(const __attribute__((address_space(3))) bf16x8*)(kp+512);
  kf[2]=*(const __attribute__((address_space(3))) bf16x8*)(kp+2048); kf[3]=*(const __attribute__((address_space(3))) bf16x8*)(kp+2560);
  kf[4]=*(const __attribute__((address_space(3))) bf16x8*)(kp+4096); kf[5]=*(const __attribute__((address_space(3))) bf16x8*)(kp+4608);
  kf[6]=*(const __attribute__((address_space(3))) bf16x8*)(kp+6144); kf[7]=*(const __attribute__((address_space(3))) bf16x8*)(kp+6656);
}
__device__ __forceinline__ void kload2(bf16x8*kf,lds_cptr kp,int j){ kf[2*j]=*(const __attribute__((address_space(3))) bf16x8*)(kp+j*2048); kf[2*j+1]=*(const __attribute__((address_space(3))) bf16x8*)(kp+j*2048+512); }
__device__ __forceinline__ s16x4 vtr(lds_cptr p){ return __builtin_bit_cast(s16x4,__builtin_amdgcn_ds_read_tr16_b64_v4i16((__attribute__((address_space(3))) v4i16_t*)p)); }
__device__ __forceinline__ float rowmax(const f32x16&p0,const f32x16&p1){
  float a=max3f(p0[0],p0[1],p1[0]),b=max3f(p0[2],p0[3],p1[1]);a=max3f(a,p1[2],p1[3]);
  #pragma unroll
  for(int r=4;r<16;r+=4){a=max3f(a,p0[r],p0[r+1]);b=max3f(b,p0[r+2],p0[r+3]);a=max3f(a,p1[r],p1[r+1]);b=max3f(b,p1[r+2],p1[r+3]);}
  const float m=max2f(a,b);
  auto rr=__builtin_amdgcn_permlane32_swap(__float_as_uint(m),__float_as_uint(m),false,false);
  return max2f(__uint_as_float(rr[0]),__uint_as_float(rr[1]));
}
__device__ __forceinline__ void pv(f32x16*o,int vb,bf16x8 pa0,bf16x8 pa1,bf16x8 pa2,bf16x8 pa3){
  #pragma unroll
  for(int d0=0;d0<2;++d0){s16x4 lo[4],hi[4];
    #pragma unroll
    for(int ks=0;ks<4;++ks){
      asm volatile("ds_read_b64_tr_b16 %0,%1 offset:%c2":"=&v"(lo[ks]):"v"(vb),"i"(d0*4096+ks*1024):"memory");
      asm volatile("ds_read_b64_tr_b16 %0,%1 offset:%c2":"=&v"(hi[ks]):"v"(vb),"i"(d0*4096+ks*1024+512):"memory");}
    asm volatile("s_waitcnt lgkmcnt(0)":::"memory");SBAR();
    #define PK(k) (bf16x8){lo[k][0],lo[k][1],lo[k][2],lo[k][3],hi[k][0],hi[k][1],hi[k][2],hi[k][3]}
    o[d0]=__builtin_amdgcn_mfma_f32_32x32x16_bf16(pa0,PK(0),o[d0],0,0,0);
    o[d0]=__builtin_amdgcn_mfma_f32_32x32x16_bf16(pa1,PK(1),o[d0],0,0,0);
    o[d0]=__builtin_amdgcn_mfma_f32_32x32x16_bf16(pa2,PK(2),o[d0],0,0,0);
    o[d0]=__builtin_amdgcn_mfma_f32_32x32x16_bf16(pa3,PK(3),o[d0],0,0,0);
    #undef PK
  }
}

#ifndef ATTN_STORE16
#define ATTN_STORE16(p,v) (*(u32x4*)(p)=(v))
#endif
template<int THRL> __device__ __forceinline__ void attn_unit(int b,int h,int qb,const bf16*Q,const bf16*__restrict__ K,const bf16*__restrict__ V,bf16*O,const float*LF,char*shm,int wave0){
  int tid_=opaque_tid(wave0);
  const int tid=tid_,lane=tid&63,r32=lane&31,hi=lane>>5; const int wid=__builtin_amdgcn_readfirstlane(tid>>6);
  const long rowbase=(long)b*SEQ; const int q0=qb*QB;
  const bf16*Qw=Q+(rowbase+q0+wid*QBLK)*DM+h*D;
  const bf16*Kh=K+rowbase*DM+h*D,*Vh=V+rowbase*DM+h*D;
  const unsigned lds0=(unsigned)(uintptr_t)shm;
  float*wsf=(float*)(shm+LDS_WS)+wid*64;
  const lds_cptr shm3=(lds_cptr)shm;
  { const int n=q0+QB; const float*lf=LF+((long)b*NHEAD+h)*SEQ;
    unsigned wtb_=(unsigned)(uintptr_t)(shm3+LDS_WT); asm volatile("":"+v"(wtb_));
    volatile __attribute__((address_space(3))) float*wt=(volatile __attribute__((address_space(3))) float*)wtb_;
    f32x4 v0=(f32x4){0.f,0.f,0.f,0.f},v1=(f32x4){0.f,0.f,0.f,0.f};
    if(8*tid<n){v0=*(const f32x4*)(lf+8*tid);v1=*(const f32x4*)(lf+8*tid+4);}
    v0[1]+=v0[0];v0[2]+=v0[1];v0[3]+=v0[2];v1[0]+=v0[3];v1[1]+=v1[0];v1[2]+=v1[1];v1[3]+=v1[2];
    const float tot=v1[3]; float inc=tot;
    #pragma unroll
    for(int o_=1;o_<64;o_<<=1){const float t_=__int_as_float(__builtin_amdgcn_ds_bpermute((lane-o_)<<2,__float_as_int(inc)));if(lane>=o_)inc+=t_;}
    if(lane==63)wt[wid]=inc;
    __syncthreads();
    float base=inc-tot;
    #pragma unroll
    for(int w_=0;w_<NW;++w_){const float x_=wt[w_]; if(w_<wid)base+=x_;}
    if(tid==(q0>>3))wt[8]=base+v0[0];
    __syncthreads();
    const float anc=wt[8];
    if(8*tid<n){ __attribute__((address_space(3))) f32x4*fo=(__attribute__((address_space(3))) f32x4*)(shm3+LDS_FS)+2*tid;
      fo[0]=(v0+(base-anc))*LOG2E; fo[1]=(v1+(base-anc))*LOG2E; }
  }
  const lds_cptr fs3=shm3+LDS_FS;
  const bf16*ksrc=Kh+(long)lane*DM+wid*8;
  const bf16*vsrc=Vh+(long)(16*(wid&3)+(lane>>2))*DM+(wid>>2)*32+(lane&3)*8;
  const unsigned kdst=lds0+LDS_K+wid*1024, vdst=lds0+LDS_V+wid*1024;
  #define DMA_K(t,slot) glds16(ksrc+(long)(t)*KVBLK*DM,(unsigned)__builtin_amdgcn_readfirstlane(kdst+(slot)))
  #define DMA_V(t,slot) glds16(vsrc+(long)(t)*KVBLK*DM,(unsigned)__builtin_amdgcn_readfirstlane(vdst+(slot)))
  const int vb0=(int)(lds0+LDS_V)+((lane>>4)&1)*32+(lane&3)*8+(4*hi+((lane&15)>>2))*64;
  const char*Kbase=shm+LDS_K; bf16x8 kf[8];
  const lds_cptr kp0=shm3+LDS_K+hi*1024+r32*16; const lds_cptr vp0=shm3+LDS_V+((lane>>4)&1)*32+(lane&3)*8+(4*hi+((lane&15)>>2))*64;
  const int NT=(q0+QB)/KVBLK;
  DMA_K(0,0);DMA_V(0,0);DMA_K(1,SLOTB);
  bf16x8 qr[4];
  #pragma unroll
  for(int d0=0;d0<4;++d0)qr[d0]=*reinterpret_cast<const bf16x8*>(&Qw[(long)r32*DM+d0*16+hi*8]);
  float mhat=0.f,l_reg=0.f;f32x16 o[2];o[0]=f32x16{};o[1]=f32x16{};
  const int qrel=wid*QBLK+r32;
  #define CMASK(P0,P1,t) do{int jb_=(t)-(NT-4); if(jb_>=0)cmask(P0,P1,jb_,qrel,hi);}while(0)
  bool resc=false;
  #define START(P0,P1) do{ const float rm=rowmax(P0,P1); resc=false; \
    { const float dl=rm; mhat=fadd_s(mhat,dl); \
      _Pragma("unroll") for(int r=0;r<16;++r){P0[r]=fsub_s(P0[r],dl);P1[r]=fsub_s(P1[r],dl);} } \
    _Pragma("unroll") for(int r=0;r<16;++r)P0[r]=__builtin_amdgcn_exp2f(P0[r]); }while(0)
  #define RESC() do{ if(resc){ asm volatile("s_waitcnt lgkmcnt(0)":::"memory"); \
      _Pragma("unroll") for(int d_=0;d_<2;++d_) _Pragma("unroll") for(int r=0;r<16;++r)o[d_][r]*=wsf[crow(r,hi)]; } }while(0)
  f32x16 pA0,pA1,pB0,pB1;
  int sl_prev=0,sl_cur=0,sl_next=SLOTB;
  #define ROT() do{sl_prev=sl_cur;sl_cur=sl_next;sl_next=(sl_next==(NSLOT-1)*SLOTB)?0:sl_next+SLOTB;}while(0)
  DMA_K(2,2*SLOTB);
  WAIT_BAR(3);
  fbias(pA0,pA1,fs3,0.f,hi);
  qkt(pA0,pA1,Kbase,qr,r32,hi);asm volatile("s_nop 15\n\ts_nop 7":"+v"(pA0),"+v"(pA1));CMASK(pA0,pA1,0);
  START(pA0,pA1);
  _Pragma("unroll") for(int r=0;r<16;++r)pA1[r]=__builtin_amdgcn_exp2f(pA1[r]);
  WAIT_BAR(0);
  DMA_K(3,0);DMA_V(1,SLOTB);
  ROT();
  kload8(kf,kp0+sl_cur);
  WAIT_BAR(2);
  s16x4 vlo[8],vhi[8]; u32x4 pw0,pw1,pw2,pw3;
  #define PKW(P,B) cvtpk_s(P[B],P[B+1])
  #define PAF(k) __builtin_bit_cast(bf16x8,pw##k)
  #define VFR(i) (bf16x8){vlo[i][0],vlo[i][1],vlo[i][2],vlo[i][3],vhi[i][0],vhi[i][1],vhi[i][2],vhi[i][3]}
  #define PIN(x) asm volatile("":"+v"(x))
  #define MX3(a,b,c) __builtin_fmaxf(__builtin_fmaxf((a),(b)),(c))
  #define GAPA(MF,A0,A1,A2,A3,W0,W1,PW) do{ MF; sacc+=A0; sacc+=A1; sacc+=A2; sacc+=A3; PIN(sacc); W0; W1; PIN(PW); SBAR(); }while(0)
  #define EX(v) __builtin_amdgcn_exp2f(v)
  #define GAPB(MF,X,B) do{ MF; X[B]=EX(X[B]); X[B+1]=EX(X[B+1]); X[B+2]=EX(X[B+2]); X[B+3]=EX(X[B+3]); PIN(X); SBAR(); }while(0)
  #define VRD(i) do{ vlo[i]=vtr(vp_+(((i)>>2)*4096+((i)&3)*1024)); vhi[i]=vtr(vp_+(((i)>>2)*4096+((i)&3)*1024+512)); }while(0)
  #define KRD(G,j) do{ if(G){ kload2(kf,kp0+sl_next,j); SBAR(); } }while(0)
  #define STEP(C0,C1,P0,P1,t,GK,GV,GL) do{ SBAR(); \
    const lds_cptr vp_=vp0+sl_prev; \
    fbias(C0,C1,fs3+(t)*256,-mhat,hi); SBAR(); \
    VRD(0); SBAR(); float sacc=(P0[0]+P0[1]); \
    GAPA(C0=__builtin_amdgcn_mfma_f32_32x32x16_bf16(kf[0],qr[0],C0,0,0,0), P0[2],P0[3],P0[4],P0[5],     pw0[0]=PKW(P0,0), pw0[1]=PKW(P0,2), pw0); \
    VRD(4); SBAR(); GAPA(C1=__builtin_amdgcn_mfma_f32_32x32x16_bf16(kf[1],qr[0],C1,0,0,0), P0[6],P0[7],P0[8],P0[9],     pw0[2]=PKW(P0,4), pw0[3]=PKW(P0,6), pw0); \
    VRD(1); SBAR(); GAPA(C0=__builtin_amdgcn_mfma_f32_32x32x16_bf16(kf[2],qr[1],C0,0,0,0),   P0[10],P0[11],P0[12],P0[13], pw1[0]=PKW(P0,8), pw1[1]=PKW(P0,10), pw1); \
    VRD(5); SBAR(); GAPA(C1=__builtin_amdgcn_mfma_f32_32x32x16_bf16(kf[3],qr[1],C1,0,0,0),   P0[14],P0[15],P1[0],P1[1],   pw1[2]=PKW(P0,12),pw1[3]=PKW(P0,14), pw1); \
    VRD(2); SBAR(); GAPA(C0=__builtin_amdgcn_mfma_f32_32x32x16_bf16(kf[4],qr[2],C0,0,0,0),   P1[2],P1[3],P1[4],P1[5],     pw2[0]=PKW(P1,0), pw2[1]=PKW(P1,2), pw2); \
    VRD(6); SBAR(); GAPA(C1=__builtin_amdgcn_mfma_f32_32x32x16_bf16(kf[5],qr[2],C1,0,0,0),   P1[6],P1[7],P1[8],P1[9],     pw2[2]=PKW(P1,4), pw2[3]=PKW(P1,6), pw2); \
    VRD(3); SBAR(); GAPA(C0=__builtin_amdgcn_mfma_f32_32x32x16_bf16(kf[6],qr[3],C0,0,0,0),   P1[10],P1[11],P1[12],P1[13], pw3[0]=PKW(P1,8), pw3[1]=PKW(P1,10), pw3); \
    VRD(7); SBAR(); GAPA(C1=__builtin_amdgcn_mfma_f32_32x32x16_bf16(kf[7],qr[3],C1,0,0,0),   P1[14],P1[15],0.f,0.f,       pw3[2]=PKW(P1,12),pw3[3]=PKW(P1,14), pw3); \
    l_reg+=sacc; \
    if(GK){DMA_K((t)+3,sl_cur);} if(GV){DMA_V((t)+1,sl_next);} \
    CMASK(C0,C1,t); \
    { float a=MX3(C0[0],C0[1],C1[0]),b=MX3(C0[2],C0[3],C1[1]); a=MX3(a,C1[2],C1[3]); \
      _Pragma("unroll") for(int r=4;r<16;r+=4){a=MX3(a,C0[r],C0[r+1]);b=MX3(b,C0[r+2],C0[r+3]);a=MX3(a,C1[r],C1[r+1]);b=MX3(b,C1[r+2],C1[r+3]);} \
      float rm=__builtin_fmaxf(a,b); { auto rr=__builtin_amdgcn_permlane32_swap(__float_as_uint(rm),__float_as_uint(rm),false,false); rm=__builtin_fmaxf(__uint_as_float(rr[0]),__uint_as_float(rr[1])); } \
      resc=false; \
      if(__builtin_expect(__any(rm>(float)THRL),0)){ const float dl=__builtin_fmaxf(rm,0.f); mhat+=dl; \
        _Pragma("unroll") for(int r=0;r<16;++r){C0[r]-=dl;C1[r]-=dl;} \
        const float f=__builtin_amdgcn_exp2f(-dl); l_reg*=f; if(hi==0)wsf[r32]=f; resc=true; } } \
    SBAR(); \
    GAPB(o[0]=__builtin_amdgcn_mfma_f32_32x32x16_bf16(PAF(0),VFR(0),o[0],0,0,0), C0,0); \
    GAPB(o[1]=__builtin_amdgcn_mfma_f32_32x32x16_bf16(PAF(0),VFR(4),o[1],0,0,0), C0,4); \
    KRD(GL,0); GAPB(o[0]=__builtin_amdgcn_mfma_f32_32x32x16_bf16(PAF(1),VFR(1),o[0],0,0,0), C0,8); \
    KRD(GL,1); GAPB(o[1]=__builtin_amdgcn_mfma_f32_32x32x16_bf16(PAF(1),VFR(5),o[1],0,0,0), C0,12); \
    KRD(GL,2); GAPB(o[0]=__builtin_amdgcn_mfma_f32_32x32x16_bf16(PAF(2),VFR(2),o[0],0,0,0), C1,0); \
    KRD(GL,3); GAPB(o[1]=__builtin_amdgcn_mfma_f32_32x32x16_bf16(PAF(2),VFR(6),o[1],0,0,0), C1,4); \
    GAPB(o[0]=__builtin_amdgcn_mfma_f32_32x32x16_bf16(PAF(3),VFR(3),o[0],0,0,0), C1,8); \
    GAPB(o[1]=__builtin_amdgcn_mfma_f32_32x32x16_bf16(PAF(3),VFR(7),o[1],0,0,0), C1,12); \
    }while(0)
  int t=1;
  #undef CMASK
  #define CMASK(P0,P1,t) do{}while(0)
  for(;t+5<NT;t+=2){
    STEP(pB0,pB1,pA0,pA1,t,true,true,true);     WAIT_BAR(2); RESC(); ROT();
    STEP(pA0,pA1,pB0,pB1,t+1,true,true,true);   WAIT_BAR(2); RESC(); ROT();
  }
  #undef CMASK
  #define CMASK(P0,P1,t) do{int jb_=(t)-(NT-4); if(jb_>=0)cmask(P0,P1,jb_,qrel,hi);}while(0)
  #define ENDW(tt) do{ if((tt)+3<NT){WAIT_BAR(2);} else if((tt)+2<NT){WAIT_BAR(1);} else {WAIT_BAR(0);} }while(0)
  for(;t+1<NT;t+=2){
    STEP(pB0,pB1,pA0,pA1,t,(t+3<NT),(t+1<NT),(t+1<NT));       ENDW(t);   RESC(); ROT();
    STEP(pA0,pA1,pB0,pB1,t+1,(t+4<NT),(t+2<NT),(t+2<NT));     ENDW(t+1); RESC(); ROT();
  }
  STEP(pB0,pB1,pA0,pA1,NT-1,false,false,false); RESC();
  { float sacc=pB0[0]+pB0[1]; _Pragma("unroll") for(int r=2;r<16;++r)sacc+=pB0[r]; _Pragma("unroll") for(int r=0;r<16;++r)sacc+=pB1[r]; l_reg+=sacc;
    pw0=(u32x4){PKW(pB0,0),PKW(pB0,2),PKW(pB0,4),PKW(pB0,6)};pw1=(u32x4){PKW(pB0,8),PKW(pB0,10),PKW(pB0,12),PKW(pB0,14)};pw2=(u32x4){PKW(pB1,0),PKW(pB1,2),PKW(pB1,4),PKW(pB1,6)};pw3=(u32x4){PKW(pB1,8),PKW(pB1,10),PKW(pB1,12),PKW(pB1,14)};
    SBAR(); pv(o,vb0+sl_cur,PAF(0),PAF(1),PAF(2),PAF(3)); }
  #undef PKW
  #undef PAF
  #undef VFR
  #undef PIN
  #undef MX3
  #undef GAPA
  #undef GAPB
  #undef EX
  #undef VRD
  #undef KRD
  #undef STEP
  #undef ENDW
  {auto rr=__builtin_amdgcn_permlane32_swap(__float_as_uint(l_reg),__float_as_uint(l_reg),false,false);l_reg=__uint_as_float(rr[0])+__uint_as_float(rr[1]);}
  if(hi==0)wsf[32+r32]=l_reg;asm volatile("s_waitcnt lgkmcnt(0)":::"memory");
  float rli[16];
  #pragma unroll
  for(int r=0;r<16;++r)rli[r]=__builtin_amdgcn_rcpf(wsf[32+crow(r,hi)]);
  bf16*Ow=O+(rowbase+q0+wid*QBLK)*DM+h*D;
  { bf16*stg=(bf16*)(shm+LDS_OST)+wid*2048;
    #pragma unroll
    for(int r=0;r<16;++r){const int orow=crow(r,hi);
      #pragma unroll
      for(int d0=0;d0<2;++d0)stg[orow*64+d0*32+r32]=__float2bfloat16(o[d0][r]*rli[r]);}
    asm volatile("s_waitcnt lgkmcnt(0)":::"memory");
    #pragma unroll
    for(int i=0;i<4;++i){const int row=i*8+(lane>>3),ch=lane&7; const u32x4 v=*(const u32x4*)(stg+row*64+ch*8); ATTN_STORE16(Ow+(long)row*DM+ch*8,v);} }
  asm volatile("s_waitcnt lgkmcnt(0)\n\ts_barrier":::"memory");
  #undef DMA_K
  #undef DMA_V
  #undef CMASK
  #undef START
  #undef RESC
  #undef ROT
}

constexpr float T_UNDER=150.f;
template<int DUMMY> __device__ __forceinline__ void attn_unit_fast(int b,int h,int qb,float M,const bf16*Q,const bf16*__restrict__ K,const bf16*__restrict__ V,bf16*O,const float*LF,char*shm,int wave0){
  int tid_=opaque_tid(wave0);
  const int tid=tid_,lane=tid&63,r32=lane&31,hi=lane>>5; const int wid=__builtin_amdgcn_readfirstlane(tid>>6);
  const long rowbase=(long)b*SEQ; const int q0=qb*QB;
  const bf16*Qw=Q+(rowbase+q0+wid*QBLK)*DM+h*D;
  const bf16*Kh=K+rowbase*DM+h*D,*Vh=V+rowbase*DM+h*D;
  const unsigned lds0=(unsigned)(uintptr_t)shm;
  const lds_cptr shm3=(lds_cptr)shm;
  { const int n=q0+QB; const float*lf=LF+((long)b*NHEAD+h)*SEQ;
    unsigned wtb_=(unsigned)(uintptr_t)(shm3+LDS_WT); asm volatile("":"+v"(wtb_));
    volatile __attribute__((address_space(3))) float*wt=(volatile __attribute__((address_space(3))) float*)wtb_;
    f32x4 v0=(f32x4){0.f,0.f,0.f,0.f},v1=(f32x4){0.f,0.f,0.f,0.f};
    if(8*tid<n){v0=*(const f32x4*)(lf+8*tid);v1=*(const f32x4*)(lf+8*tid+4);}
    v0[1]+=v0[0];v0[2]+=v0[1];v0[3]+=v0[2];v1[0]+=v0[3];v1[1]+=v1[0];v1[2]+=v1[1];v1[3]+=v1[2];
    const float tot=v1[3]; float inc=tot;
    #pragma unroll
    for(int o_=1;o_<64;o_<<=1){const float t_=__int_as_float(__builtin_amdgcn_ds_bpermute((lane-o_)<<2,__float_as_int(inc)));if(lane>=o_)inc+=t_;}
    if(lane==63)wt[wid]=inc;
    __syncthreads();
    float base=inc-tot;
    #pragma unroll
    for(int w_=0;w_<NW;++w_){const float x_=wt[w_]; if(w_<wid)base+=x_;}
    if(tid==(q0>>3))wt[8]=base+v0[0];
    __syncthreads();
    const float anc=wt[8];
    if(8*tid<n){ __attribute__((address_space(3))) f32x4*fo=(__attribute__((address_space(3))) f32x4*)(shm3+LDS_FS)+2*tid;
      fo[0]=(v0+(base-anc))*LOG2E; fo[1]=(v1+(base-anc))*LOG2E; }
  }
  const lds_cptr fs3=shm3+LDS_FS;
  const int NT=(q0+QB)/KVBLK;
  const char*kbase=(const char*)(Kh+(long)(NT-1)*KVBLK*DM),*vbase=(const char*)(Vh+(long)(NT-1)*KVBLK*DM);
  const unsigned koff=(unsigned)((lane*DM+wid*8)*2), voff=(unsigned)(((16*(wid&3)+(lane>>2))*DM+(wid>>2)*32+(lane&3)*8)*2);
  const unsigned kdst=lds0+LDS_K+wid*1024, vdst=lds0+LDS_V+wid*1024;
  #define DMA_K(t,slot) glds16s(kbase-(long)(t)*(KVBLK*DM*2),koff,(unsigned)__builtin_amdgcn_readfirstlane(kdst+(slot)))
  #define DMA_V(t,slot) glds16s(vbase-(long)(t)*(KVBLK*DM*2),voff,(unsigned)__builtin_amdgcn_readfirstlane(vdst+(slot)))
  const char*Kbase=shm+LDS_K; bf16x8 kf[8];
  const lds_cptr kp0=shm3+LDS_K+hi*1024+r32*16; const lds_cptr vp0=shm3+LDS_V+((lane>>4)&1)*32+(lane&3)*8+(4*hi+((lane&15)>>2))*64;
  DMA_K(0,0);DMA_V(0,0);DMA_K(1,SLOTB);
  bf16x8 qr[4];
  #pragma unroll
  for(int d0=0;d0<4;++d0)qr[d0]=*reinterpret_cast<const bf16x8*>(&Qw[(long)r32*DM+d0*16+hi*8]);
  float l_reg=0.f;f32x16 o[2];o[0]=f32x16{};o[1]=f32x16{};
  const int qrel=wid*QBLK+r32;
  #define CMASK(P0,P1,t) do{int jb_=3-(t); if(jb_>=0)cmask(P0,P1,jb_,qrel,hi);}while(0)
  f32x16 pA0,pA1,pB0,pB1;
  int sl_prev=0,sl_cur=0,sl_next=SLOTB;
  #define ROT() do{sl_prev=sl_cur;sl_cur=sl_next;sl_next=(sl_next==(NSLOT-1)*SLOTB)?0:sl_next+SLOTB;}while(0)
  DMA_K(2,2*SLOTB);
  WAIT_BAR(3);
  const float nm=*(const __attribute__((address_space(3))) float*)(fs3+(q0+qrel)*4)-M;
  int NP;
  { const float fv=(lane<NT)?*(const __attribute__((address_space(3))) float*)(fs3+(64*lane+63)*4):0.f;
    const unsigned long long bal=__ballot((lane<NT)&&(fv>2.f*M+T_UNDER));
    const int tstop=__builtin_popcountll(bal); int np=NT-tstop; np=(np+1)&~1; NP=np<4?4:np; NP=__builtin_amdgcn_readfirstlane(NP); }
  fbias(pA0,pA1,fs3+(NT-1)*256,nm,hi);
  qkt(pA0,pA1,Kbase,qr,r32,hi);asm volatile("s_nop 15\n\ts_nop 7":"+v"(pA0),"+v"(pA1));CMASK(pA0,pA1,0);
  _Pragma("unroll") for(int r=0;r<16;++r){pA0[r]=__builtin_amdgcn_exp2f(pA0[r]);pA1[r]=__builtin_amdgcn_exp2f(pA1[r]);}
  WAIT_BAR(0);
  DMA_K(3,0);DMA_V(1,SLOTB);
  ROT();
  kload8(kf,kp0+sl_cur);
  fbias(pB0,pB1,fs3+(NT-2)*256,nm,hi);
  WAIT_BAR(2);
  s16x4 vlo[8],vhi[8]; u32x4 pw0,pw1,pw2,pw3;
  #define PKW(P,B) cvtpk_s(P[B],P[B+1])
  #define PAF(k) __builtin_bit_cast(bf16x8,pw##k)
  #define VFR(i) (bf16x8){vlo[i][0],vlo[i][1],vlo[i][2],vlo[i][3],vhi[i][0],vhi[i][1],vhi[i][2],vhi[i][3]}
  #define PIN(x) asm volatile("":"+v"(x))
  #define GAPA(MF,A0,A1,A2,A3,W0,W1,PW) do{ MF; sacc+=A0; sacc+=A1; sacc+=A2; sacc+=A3; PIN(sacc); W0; W1; PIN(PW); SBAR(); }while(0)
  #define EX(v) __builtin_amdgcn_exp2f(v)
  #define GAPB(MF,X,B,Y,GL) do{ MF; X[B]=EX(X[B]); X[B+1]=EX(X[B+1]); X[B+2]=EX(X[B+2]); X[B+3]=EX(X[B+3]); PIN(X); \
      if(GL){ Y[B]=nm-Y[B]; Y[B+1]=nm-Y[B+1]; Y[B+2]=nm-Y[B+2]; Y[B+3]=nm-Y[B+3]; PIN(Y); } SBAR(); }while(0)
  #define VRD(i) do{ vlo[i]=vtr(vp_+(((i)>>2)*4096+((i)&3)*1024)); vhi[i]=vtr(vp_+(((i)>>2)*4096+((i)&3)*1024+512)); }while(0)
  #define KRD(G,j) do{ if(G){ kload2(kf,kp0+sl_next,j); SBAR(); } }while(0)
  #define FLD(Y0,Y1,t) do{ const lds_cptr ft_=fs3+(NT-2-(t))*256+hi*16; \
      _Pragma("unroll") for(int g_=0;g_<4;++g_){ const f32x4 a_=*(const __attribute__((address_space(3))) f32x4*)(ft_+g_*32); const f32x4 b_=*(const __attribute__((address_space(3))) f32x4*)(ft_+128+g_*32); \
        Y0[4*g_]=a_[0];Y0[4*g_+1]=a_[1];Y0[4*g_+2]=a_[2];Y0[4*g_+3]=a_[3]; Y1[4*g_]=b_[0];Y1[4*g_+1]=b_[1];Y1[4*g_+2]=b_[2];Y1[4*g_+3]=b_[3]; } }while(0)
  #define STEP(C0,C1,P0,P1,t,GK,GV,GL) do{ SBAR(); \
    const lds_cptr vp_=vp0+sl_prev; \
    VRD(0); SBAR(); float sacc=(P0[0]+P0[1]); \
    GAPA(C0=__builtin_amdgcn_mfma_f32_32x32x16_bf16(kf[0],qr[0],C0,0,0,0), P0[2],P0[3],P0[4],P0[5],     pw0[0]=PKW(P0,0), pw0[1]=PKW(P0,2), pw0); \
    VRD(4); SBAR(); GAPA(C1=__builtin_amdgcn_mfma_f32_32x32x16_bf16(kf[1],qr[0],C1,0,0,0), P0[6],P0[7],P0[8],P0[9],     pw0[2]=PKW(P0,4), pw0[3]=PKW(P0,6), pw0); \
    VRD(1); SBAR(); GAPA(C0=__builtin_amdgcn_mfma_f32_32x32x16_bf16(kf[2],qr[1],C0,0,0,0),   P0[10],P0[11],P0[12],P0[13], pw1[0]=PKW(P0,8), pw1[1]=PKW(P0,10), pw1); \
    VRD(5); SBAR(); GAPA(C1=__builtin_amdgcn_mfma_f32_32x32x16_bf16(kf[3],qr[1],C1,0,0,0),   P0[14],P0[15],P1[0],P1[1],   pw1[2]=PKW(P0,12),pw1[3]=PKW(P0,14), pw1); \
    VRD(2); SBAR(); GAPA(C0=__builtin_amdgcn_mfma_f32_32x32x16_bf16(kf[4],qr[2],C0,0,0,0),   P1[2],P1[3],P1[4],P1[5],     pw2[0]=PKW(P1,0), pw2[1]=PKW(P1,2), pw2); \
    VRD(6); SBAR(); GAPA(C1=__builtin_amdgcn_mfma_f32_32x32x16_bf16(kf[5],qr[2],C1,0,0,0),   P1[6],P1[7],P1[8],P1[9],     pw2[2]=PKW(P1,4), pw2[3]=PKW(P1,6), pw2); \
    VRD(3); SBAR(); GAPA(C0=__builtin_amdgcn_mfma_f32_32x32x16_bf16(kf[6],qr[3],C0,0,0,0),   P1[10],P1[11],P1[12],P1[13], pw3[0]=PKW(P1,8), pw3[1]=PKW(P1,10), pw3); \
    VRD(7); SBAR(); GAPA(C1=__builtin_amdgcn_mfma_f32_32x32x16_bf16(kf[7],qr[3],C1,0,0,0),   P1[14],P1[15],0.f,0.f,       pw3[2]=PKW(P1,12),pw3[3]=PKW(P1,14), pw3); \
    l_reg+=sacc; \
    if(GK){DMA_K((t)+3,sl_cur);} if(GV){DMA_V((t)+1,sl_next);} \
    CMASK(C0,C1,t); \
    if(GL){ FLD(P0,P1,t); } \
    SBAR(); \
    GAPB(o[0]=__builtin_amdgcn_mfma_f32_32x32x16_bf16(PAF(0),VFR(0),o[0],0,0,0), C0,0,P0,GL); \
    GAPB(o[1]=__builtin_amdgcn_mfma_f32_32x32x16_bf16(PAF(0),VFR(4),o[1],0,0,0), C0,4,P0,GL); \
    KRD(GL,0); GAPB(o[0]=__builtin_amdgcn_mfma_f32_32x32x16_bf16(PAF(1),VFR(1),o[0],0,0,0), C0,8,P0,GL); \
    KRD(GL,1); GAPB(o[1]=__builtin_amdgcn_mfma_f32_32x32x16_bf16(PAF(1),VFR(5),o[1],0,0,0), C0,12,P0,GL); \
    KRD(GL,2); GAPB(o[0]=__builtin_amdgcn_mfma_f32_32x32x16_bf16(PAF(2),VFR(2),o[0],0,0,0), C1,0,P1,GL); \
    KRD(GL,3); GAPB(o[1]=__builtin_amdgcn_mfma_f32_32x32x16_bf16(PAF(2),VFR(6),o[1],0,0,0), C1,4,P1,GL); \
    GAPB(o[0]=__builtin_amdgcn_mfma_f32_32x32x16_bf16(PAF(3),VFR(3),o[0],0,0,0), C1,8,P1,GL); \
    GAPB(o[1]=__builtin_amdgcn_mfma_f32_32x32x16_bf16(PAF(3),VFR(7),o[1],0,0,0), C1,12,P1,GL); \
    }while(0)
  #define ENDW(tt) do{ if((tt)+3<NP){WAIT_BAR(2);} else if((tt)+2<NP){WAIT_BAR(1);} else {WAIT_BAR(0);} }while(0)
  int t=1;
  for(;t<5&&t+1<NP;t+=2){
    STEP(pB0,pB1,pA0,pA1,t,(t+3<NP),(t+1<NP),(t+1<NP));       ENDW(t);   ROT();
    STEP(pA0,pA1,pB0,pB1,t+1,(t+4<NP),(t+2<NP),(t+2<NP));     ENDW(t+1); ROT();
  }
  #undef CMASK
  #define CMASK(P0,P1,t) do{}while(0)
  for(;t+5<NP;t+=2){
    STEP(pB0,pB1,pA0,pA1,t,true,true,true);     WAIT_BAR(2); ROT();
    STEP(pA0,pA1,pB0,pB1,t+1,true,true,true);   WAIT_BAR(2); ROT();
  }
  for(;t+1<NP;t+=2){
    STEP(pB0,pB1,pA0,pA1,t,(t+3<NP),(t+1<NP),(t+1<NP));       ENDW(t);   ROT();
    STEP(pA0,pA1,pB0,pB1,t+1,(t+4<NP),(t+2<NP),(t+2<NP));     ENDW(t+1); ROT();
  }
  #undef CMASK
  #define CMASK(P0,P1,t) do{int jb_=3-(t); if(jb_>=0)cmask(P0,P1,jb_,qrel,hi);}while(0)
  STEP(pB0,pB1,pA0,pA1,NP-1,false,false,false);
  const int tidE=opaque_tid(wave0),laneE=tidE&63,r32E=laneE&31,hiE=laneE>>5; const int widE=__builtin_amdgcn_readfirstlane(tidE>>6);
  const int vb0=(int)(lds0+LDS_V)+((laneE>>4)&1)*32+(laneE&3)*8+(4*hiE+((laneE&15)>>2))*64;
  float*wsf=(float*)(shm+LDS_WS)+widE*64;
  { float sacc=pB0[0]+pB0[1]; _Pragma("unroll") for(int r=2;r<16;++r)sacc+=pB0[r]; _Pragma("unroll") for(int r=0;r<16;++r)sacc+=pB1[r]; l_reg+=sacc;
    pw0=(u32x4){PKW(pB0,0),PKW(pB0,2),PKW(pB0,4),PKW(pB0,6)};pw1=(u32x4){PKW(pB0,8),PKW(pB0,10),PKW(pB0,12),PKW(pB0,14)};pw2=(u32x4){PKW(pB1,0),PKW(pB1,2),PKW(pB1,4),PKW(pB1,6)};pw3=(u32x4){PKW(pB1,8),PKW(pB1,10),PKW(pB1,12),PKW(pB1,14)};
    SBAR(); pv(o,vb0+sl_cur,PAF(0),PAF(1),PAF(2),PAF(3)); }
  #undef PKW
  #undef PAF
  #undef VFR
  #undef PIN
  #undef GAPA
  #undef GAPB
  #undef EX
  #undef VRD
  #undef KRD
  #undef FLD
  #undef STEP
  #undef ENDW
  {auto rr=__builtin_amdgcn_permlane32_swap(__float_as_uint(l_reg),__float_as_uint(l_reg),false,false);l_reg=__uint_as_float(rr[0])+__uint_as_float(rr[1]);}
  if(hiE==0)wsf[32+r32E]=l_reg;asm volatile("s_waitcnt lgkmcnt(0)":::"memory");
  float rli[16];
  #pragma unroll
  for(int r=0;r<16;++r)rli[r]=__builtin_amdgcn_rcpf(wsf[32+crow(r,hiE)]);
  bf16*Ow=O+(rowbase+q0+widE*QBLK)*DM+h*D;
  { bf16*stg=(bf16*)(shm+LDS_OST)+widE*2048;
    #pragma unroll
    for(int r=0;r<16;++r){const int orow=crow(r,hiE);
      #pragma unroll
      for(int d0=0;d0<2;++d0)stg[orow*64+d0*32+r32E]=__float2bfloat16(o[d0][r]*rli[r]);}
    asm volatile("s_waitcnt lgkmcnt(0)":::"memory");
    #pragma unroll
    for(int i=0;i<4;++i){const int row=i*8+(laneE>>3),ch=laneE&7; const u32x4 v=*(const u32x4*)(stg+row*64+ch*8); ATTN_STORE16(Ow+(long)row*DM+ch*8,v);} }
  asm volatile("s_waitcnt lgkmcnt(0)\n\ts_barrier":::"memory");
  #undef DMA_K
  #undef DMA_V
  #undef CMASK
  #undef ROT
}
constexpr int ATTN_LDS_BYTES=LDS_BYTES;
struct AttnTensors { const bf16* Q; const bf16* K; const bf16* V; bf16* O; const float* LF; const unsigned* QKM; };
struct AttnUnit { int bh; int qb; };
struct StaticOrder {
  int vcu;
  __device__ __forceinline__ explicit StaticOrder(int grid,int block):vcu((block%8)*(grid/8)+block/8){}
  __device__ __forceinline__ bool next(int i,AttnUnit&u)const{ if(i>=8)return false; const int s=vcu&1, j=7-i, base=4*(j>>1); u.bh=vcu>>1; u.qb=base+((j&1)?(s?2:3):(s?1:0)); return true; }
};
template<int THRL=8> __device__ __forceinline__ void attn_phase(char*lds,const AttnTensors&T,unsigned*ctr,int wave0){
  for(;;){
    const int tq=opaque_tid(wave0);
    const unsigned uwb_=(unsigned)(uintptr_t)((lds_cptr)lds+LDS_WT+48)+((unsigned)tq>>9);
    volatile __attribute__((address_space(3))) unsigned*uw=(volatile __attribute__((address_space(3))) unsigned*)uwb_;
    if(tq==0)*uw=__hip_atomic_fetch_add(ctr,1u,__ATOMIC_RELAXED,__HIP_MEMORY_SCOPE_AGENT);
    __syncthreads();
    const unsigned k=__builtin_amdgcn_readfirstlane(*uw);
    if(k>=(unsigned)(BATCH*NHEAD*NQB))break;
    const int qb=NQB-1-(int)(k>>7), bh=(int)(k&127), b=bh/NHEAD,h=bh%NHEAD;
    const unsigned* qm=T.QKM+(0*8+b)*32+2*h; const unsigned* km=T.QKM+(1*8+b)*32+2*h;
    const float q2=__uint_as_float(__builtin_amdgcn_readfirstlane(qm[0]))+__uint_as_float(__builtin_amdgcn_readfirstlane(qm[1])), k2=__uint_as_float(__builtin_amdgcn_readfirstlane(km[0]))+__uint_as_float(__builtin_amdgcn_readfirstlane(km[1]));
    const float M=1.02f*sqrtf(q2*k2)+1e-3f;
    if(M<55.f) attn_unit_fast<0>(b,h,qb,M,T.Q,T.K,T.V,T.O,T.LF,lds,wave0);
    else attn_unit<THRL>(b,h,qb,T.Q,T.K,T.V,T.O,T.LF,lds,wave0);
  }
}
#undef SBAR
#undef WAIT_BAR
}
constexpr int NWAVES = 8;
#ifndef MK_MULTI
#define MK_MULTI 0
#endif

constexpr int BATCH = 8, SEQ = 4096, D = 1024, H = 16, HD = 64, NE = 32, FD = 512, NLAYER = 2;
constexpr int T = BATCH * SEQ;
constexpr int MODW = 6 * D;
constexpr float RMS_EPS = 1e-6f;
constexpr int WIN_LD = 3 * D + H;
constexpr int ECAP = 32768;
constexpr int PMAX = 2 * T + NE * 256;

constexpr size_t MiB = 1u << 20;
constexpr size_t WS_CTL = 0, CTL_ZERO_BYTES = 1 * MiB;
constexpr size_t WS_MOD = 1 * MiB;
constexpr size_t WS_LOGF = 2 * MiB;
constexpr size_t WS_TOK = 6 * MiB;
constexpr size_t WS_GW = 10 * MiB;
constexpr size_t WS_WQKV = 14 * MiB;
constexpr size_t WS_WO = 20 * MiB;
constexpr size_t WS_WP = 22 * MiB;
constexpr size_t WS_UP = 23 * MiB;
constexpr size_t WS_DN = 151 * MiB;
constexpr size_t WS_HB = 215 * MiB;
constexpr size_t WS_Q = 279 * MiB, WS_K = 343 * MiB, WS_V = 407 * MiB;
constexpr size_t WS_XS = 279 * MiB;
constexpr size_t WS_Y2 = 279 * MiB;
constexpr size_t WS_HH = 423 * MiB;
constexpr size_t WS_PL = 279 * MiB;
constexpr size_t WS_END = 495 * MiB;
constexpr int CW_BAR = 4096;
constexpr int CW_QKM = 32768;
constexpr int CW_AQ = 36864;
constexpr int CW_CNT = 16384;

constexpr int RING_OFF = 0, RING_BYTES = 131072;
constexpr int LDSCTL_OFF = RING_BYTES, MISC_OFF = LDSCTL_OFF + 320;
constexpr int ETAB_OFF = LDSCTL_OFF + 1024;
constexpr int LDS_BYTES = 147456;
static_assert(ETAB_OFF + (64 + 960) * 4 <= LDS_BYTES && attn_body::ATTN_LDS_BYTES <= RING_BYTES, "LDS map");

#define GAS __attribute__((address_space(1)))
#define LAS __attribute__((address_space(3)))
typedef unsigned short bf16;
typedef unsigned v4u __attribute__((ext_vector_type(4)));
typedef float f32x4 __attribute__((ext_vector_type(4)));
typedef short bf16x8 __attribute__((ext_vector_type(8)));
typedef GAS unsigned gu32;
#define RLX_AGENT __ATOMIC_RELAXED, __HIP_MEMORY_SCOPE_AGENT
#define LDS_WAIT() asm volatile("s_waitcnt lgkmcnt(0)" ::: "memory")
#define VM_WAIT() asm volatile("s_waitcnt vmcnt(0)" ::: "memory")
__device__ __forceinline__ unsigned f2bf(float f) { unsigned u = __builtin_bit_cast(unsigned, f); return (u + 0x7fffu + ((u >> 16) & 1u)) >> 16; }
__device__ __forceinline__ unsigned pk2(float lo, float hi) { return f2bf(lo) | (f2bf(hi) << 16); }
__device__ __forceinline__ float bflo(unsigned w) { return __uint_as_float(w << 16); }
__device__ __forceinline__ float bfhi(unsigned w) { return __uint_as_float(w & 0xffff0000u); }

#define XB_TMO      128
#define XB_XCNT(j)  (256  + 64 * (j))
#define XB_XSUB(j)  (1280 + 64 * (j))
#define XB_XGEN(j)  (2304 + 64 * (j))
#define XB_TOP      3328
#define XB_TOPGEN   3392
#define XCD_BAR_WORDS 3456
#define XB_SPIN_CAP (1u << 18)
__device__ __forceinline__ unsigned xb_ld(unsigned* p)              { return __hip_atomic_load(p, __ATOMIC_RELAXED, __HIP_MEMORY_SCOPE_AGENT); }
__device__ __forceinline__ unsigned xb_add(unsigned* p, unsigned v) { return __hip_atomic_fetch_add(p, v, __ATOMIC_RELAXED, __HIP_MEMORY_SCOPE_AGENT); }
__device__ __forceinline__ unsigned xb_xcc_id() { return (unsigned)__builtin_amdgcn_s_getreg((3 << 11) | 20) & 0xFu; }
#define XB_SPIN(cond, bar) do { unsigned _sp = 0; while (cond) { __builtin_amdgcn_s_sleep(1); \
    if ((++_sp & 255u) == 0u) { if (xb_ld(&(bar)[XB_TMO])) break; if (_sp > XB_SPIN_CAP) { atomicAdd(&(bar)[XB_TMO], 1u); break; } } } } while (0)
struct XcdBarrier { unsigned* bar; unsigned x; volatile LAS unsigned* st; };
__device__ __forceinline__ XcdBarrier xcd_barrier_post(unsigned* bar, volatile LAS unsigned* st) {
    XcdBarrier b; b.bar = bar; b.x = xb_xcc_id(); b.st = st;
    if (threadIdx.x == 0) (void)xb_add(&bar[XB_XCNT(b.x)], 1u);
    return b;
}
__device__ __forceinline__ void xcd_barrier_complete(unsigned* bar, unsigned x, unsigned& nloc, unsigned& nx) {
    const unsigned G = gridDim.x * gridDim.y * gridDim.z;
    unsigned sum, cnt, mine, sp = 0u;
    for (;;) {
        sum = 0u; cnt = 0u; mine = 0u;
#pragma unroll
        for (unsigned j = 0; j < 16; ++j) { const unsigned c = xb_ld(&bar[XB_XCNT(j)]); sum += c; cnt += (c > 0u) ? 1u : 0u; }
        mine = xb_ld(&bar[XB_XCNT(x)]);
        if (sum == G) break;
        __builtin_amdgcn_s_sleep(1);
        if ((++sp & 255u) == 0u) { if (xb_ld(&bar[XB_TMO])) break; if (sp > XB_SPIN_CAP) { atomicAdd(&bar[XB_TMO], 1u); break; } }
    }
    nloc = mine > 0u ? mine : 1u; nx = cnt > 0u ? cnt : 1u;
}
__device__ __forceinline__ void xcd_barrier(const XcdBarrier& b) {
    asm volatile("s_waitcnt vmcnt(0)" ::: "memory");
    __syncthreads();
    if (threadIdx.x == 0) {
        unsigned* bar = b.bar; unsigned bx = b.x;
        asm volatile("" : "+s"(bar), "+s"(bx));
        __builtin_amdgcn_s_waitcnt(0);
        unsigned nloc = b.st[0], nx = b.st[1];
        if (nloc == 0u) { xcd_barrier_complete(bar, bx, nloc, nx); b.st[0] = nloc; b.st[1] = nx; }
        const unsigned old = xb_add(&bar[XB_XSUB(bx)], 1u);
        const unsigned gen = old / nloc;
        if (old + 1u == (gen + 1u) * nloc) {
            __builtin_amdgcn_fence(__ATOMIC_RELEASE, "agent");
            asm volatile("s_waitcnt vmcnt(0)" ::: "memory");
            const unsigned og = xb_add(&bar[XB_TOP], 1u);
            const unsigned tg = og / nx;
            if (og + 1u == (tg + 1u) * nx) xb_add(&bar[XB_TOPGEN], 1u);
            else XB_SPIN(xb_ld(&bar[XB_TOPGEN]) == tg, bar);
            __builtin_amdgcn_fence(__ATOMIC_ACQUIRE, "agent");
            xb_add(&bar[XB_XGEN(bx)], 1u);
            asm volatile("s_waitcnt vmcnt(0)" ::: "memory");
        } else {
            XB_SPIN(xb_ld(&bar[XB_XGEN(bx)]) == gen, bar);
            __builtin_amdgcn_fence(__ATOMIC_ACQUIRE, "agent");
            asm volatile("s_waitcnt vmcnt(0)" ::: "memory");
        }
    }
    __syncthreads();
}

struct Frame {
    LAS unsigned char* lds;
    volatile LAS unsigned* MISC;
    gu32* ctl;
    int tid, lane, wave, wave0;
    int vcu, G;
    const __attribute__((address_space(4))) char* ka;
    float* out;
    unsigned char* ws;
    const __attribute__((address_space(4))) char* ka0; float* out0; unsigned char* ws0;
};
__device__ __forceinline__ void phase_enter(Frame& F) {
    int t_ = opaque_tid(F.wave0); F.tid = t_; F.lane = t_ & 63; F.wave = __builtin_amdgcn_readfirstlane(t_ >> 6);
    unsigned char* w = F.ws0; float* o = F.out0; const __attribute__((address_space(4))) char* k = F.ka0;
    asm volatile("" : "+s"(w), "+s"(o), "+s"(k));
    F.ws = w; F.out = o; F.ka = k; F.ctl = (gu32*)w;
}
#define WSP(T_, off) ((T_*)(F.ws + (off)))
#define FIN(i) (*(const float* const __attribute__((address_space(4)))*)(F.ka + 8 * (i)))
enum { IN_X = 0, IN_C, IN_NMG, IN_NFG, IN_ADAW, IN_ADAB, IN_WIN, IN_FBIAS, IN_WO, IN_POOLW, IN_POOLS, IN_RW, IN_RB, IN_W1, IN_W3, IN_W2, IN_NFIN };

__device__ __forceinline__ void transpose_item(const float* W, int ld, int k0, bf16* WT, int Kd, int dst_row0, LAS float* scr, int lane) {
    float tv[32];
#pragma unroll
    for (int i = 0; i < 32; ++i) tv[i] = W[(size_t)(k0 + 2 * i + (lane >> 5)) * ld + (lane & 31)];
#pragma unroll
    for (int i = 0; i < 32; ++i) scr[(2 * i + (lane >> 5)) * 33 + (lane & 31)] = tv[i];
    LDS_WAIT(); asm volatile("" ::: "memory");
    const int c = lane & 7;
#pragma unroll
    for (int j = 0; j < 4; ++j) { const int n = (lane >> 3) + 8 * j; const LAS float* s = scr + (8 * c) * 33 + n;
        v4u o; o.x = pk2(s[0 * 33], s[1 * 33]); o.y = pk2(s[2 * 33], s[3 * 33]); o.z = pk2(s[4 * 33], s[5 * 33]); o.w = pk2(s[6 * 33], s[7 * 33]);
        *(GAS v4u*)(WT + (size_t)(dst_row0 + n) * Kd + k0 + 8 * c) = o; }
    LDS_WAIT(); asm volatile("" ::: "memory");
}
__device__ __forceinline__ void p0_prologue(Frame& F) {
    if (F.vcu < 192) {
        const float* cin = FIN(IN_C); const float* adaw = FIN(IN_ADAW); const float* adab = FIN(IN_ADAB);
        LAS float* cact = (LAS float*)(F.lds);
        LAS float* red = (LAS float*)(F.lds + 32768);
        for (int i = F.tid; i < 8 * 1024; i += 512) { const int bb = i >> 10, k = i & 1023; const float v = cin[i]; cact[k * 8 + bb] = v / (1.0f + __expf(-v)); }
        __syncthreads();
        const int l = F.vcu / 96, col0 = (F.vcu % 96) * 64;
        const float* wp = adaw + (size_t)l * D * MODW + col0 + F.lane;
        float a0 = 0.f, a1 = 0.f, a2 = 0.f, a3 = 0.f, a4 = 0.f, a5 = 0.f, a6 = 0.f, a7 = 0.f;
        const int kb = F.wave * 128;
#pragma unroll 8
        for (int k = 0; k < 128; ++k) { const float wv = wp[(size_t)(kb + k) * MODW]; const f32x4 c0 = *(const LAS f32x4*)(cact + (kb + k) * 8), c1 = *(const LAS f32x4*)(cact + (kb + k) * 8 + 4);
            a0 += c0[0] * wv; a1 += c0[1] * wv; a2 += c0[2] * wv; a3 += c0[3] * wv; a4 += c1[0] * wv; a5 += c1[1] * wv; a6 += c1[2] * wv; a7 += c1[3] * wv; }
        LAS float* rw = red + F.wave * 512 + F.lane;
        rw[0] = a0; rw[64] = a1; rw[128] = a2; rw[192] = a3; rw[256] = a4; rw[320] = a5; rw[384] = a6; rw[448] = a7;
        __syncthreads();
        { const int bb = F.tid >> 6, col = F.tid & 63; float s = 0.f;
#pragma unroll
          for (int w = 0; w < 8; ++w) s += red[w * 512 + bb * 64 + col];
          WSP(float, WS_MOD)[((size_t)l * 8 + bb) * MODW + col0 + col] = s + adab[l * MODW + col0 + col]; }
        __syncthreads();
    }
    LAS float* scr = (LAS float*)(F.lds + RING_OFF + F.wave * 16384);
    const int gw = F.vcu * NWAVES + F.wave, NGW = F.G * NWAVES;
    constexpr int I_QKV = 16 * 96, I_O = 16 * 32, I_P = 4 * 4 * 8, I_W13 = 16 * 16, I_W2 = 8 * 32;
    constexpr int I_EXP = NLAYER * NE * (2 * I_W13 + I_W2);
    constexpr int NITEMS = I_QKV + I_O + I_P + I_EXP;
    for (int it = gw; it < NITEMS; it += NGW) {
        int r = it;
        if (r < I_QKV) { const int kb = r / 96, nb = r % 96; transpose_item(FIN(IN_WIN) + 32 * nb, WIN_LD, 64 * kb, WSP(bf16, WS_WQKV), D, 32 * nb, scr, F.lane); continue; } r -= I_QKV;
        if (r < I_O) { const int kb = r / 32, nb = r % 32; transpose_item(FIN(IN_WO) + 32 * nb, D, 64 * kb, WSP(bf16, WS_WO), D, 32 * nb, scr, F.lane); continue; } r -= I_O;
        if (r < I_P) { const int g = r / 32, q = r % 32, kb = q / 8, nb = q % 8; transpose_item(FIN(IN_POOLW) + (size_t)g * 65536 + 32 * nb, 256, 64 * kb, WSP(bf16, WS_WP) + (size_t)g * 65536, 256, 32 * nb, scr, F.lane); continue; } r -= I_P;
        { const int per = 2 * I_W13 + I_W2; const int le = r / per; int q = r % per;
          if (q < 2 * I_W13) { const int which = q / I_W13; q %= I_W13; const int kb = q / 16, nb = q % 16, n0 = 32 * nb;
              const float* src = (which ? FIN(IN_W3) : FIN(IN_W1)) + (size_t)le * D * FD + n0;
              transpose_item(src, FD, 64 * kb, WSP(bf16, WS_UP) + (size_t)le * 1024 * 1024, D, 256 * (n0 >> 7) + (n0 & 127) + 128 * which, scr, F.lane); }
          else { q -= 2 * I_W13; const int kb = q / 32, nb = q % 32;
              transpose_item(FIN(IN_W2) + (size_t)le * FD * D + 32 * nb, D, 64 * kb, WSP(bf16, WS_DN) + (size_t)le * 1024 * 512, FD, 32 * nb, scr, F.lane); } }
    }
    __syncthreads();
}

struct RowArgs { const float* src; float* dst; const float* g; const float* shp; const float* scp; const float* gtp; const bf16* y2; bf16* hb;
                 const float* W; const float* bias; float* logf; gu32* cnt; int* tok; float* gw; };
template <int MODE>
__device__ __forceinline__ void rowpass(Frame& F, const RowArgs& A) {
    constexpr int NT = (MODE == 0) ? 1 : (MODE == 1 ? 2 : 0);
    const int lane = F.lane, w = F.wave, r = lane & 15, q = lane >> 4, tid = F.tid;
    const int R0 = F.vcu * 128, b = R0 >> 12;
    const int kb = 128 * w + 8 * q;
    LAS float* red = (LAS float*)(F.lds);
    LAS f32x4* part = (LAS f32x4*)(F.lds + 1024);
    LAS float* scS = (LAS float*)(F.lds + 1024 + 32768);
    LAS float* selS = scS + 512;
    LAS float* GM = (LAS float*)(F.lds + 65536); LAS float* SH = GM + 1024; LAS float* GT = SH + 1024;
    for (int k = tid; k < D; k += 512) { const float g1 = A.g[k];
        if (MODE < 3) { GM[k] = g1 * (1.0f + A.scp[(size_t)b * MODW + k]); SH[k] = A.shp[(size_t)b * MODW + k]; } else { GM[k] = g1; SH[k] = 0.f; }
        GT[k] = (MODE >= 2) ? A.gtp[(size_t)b * MODW + k] : 0.f; }
    __syncthreads();
    bf16x8 Bh[NT > 0 ? NT : 1][4], Bl[NT > 0 ? NT : 1][4];
    constexpr int LDW = (MODE == 0) ? WIN_LD : NE, COFF = (MODE == 0) ? 3 * D : 0;
    if (NT > 0) { const float* wbase = A.W + (size_t)kb * LDW + COFF + r;
#pragma unroll
        for (int nt = 0; nt < NT; ++nt)
#pragma unroll
            for (int c = 0; c < 4; ++c) { float wv[8];
#pragma unroll
                for (int j = 0; j < 8; ++j) wv[j] = wbase[(32 * c + j) * LDW + 16 * nt];
                v4u hw, lw;
                hw.x = pk2(wv[0], wv[1]); hw.y = pk2(wv[2], wv[3]); hw.z = pk2(wv[4], wv[5]); hw.w = pk2(wv[6], wv[7]);
                lw.x = pk2(wv[0] - bflo(hw.x), wv[1] - bfhi(hw.x)); lw.y = pk2(wv[2] - bflo(hw.y), wv[3] - bfhi(hw.y));
                lw.z = pk2(wv[4] - bflo(hw.z), wv[5] - bfhi(hw.z)); lw.w = pk2(wv[6] - bflo(hw.w), wv[7] - bfhi(hw.w));
                Bh[nt][c] = __builtin_bit_cast(bf16x8, hw); Bl[nt][c] = __builtin_bit_cast(bf16x8, lw); }
    }
    for (int it = 0; it < 8; ++it) {
        const int row = R0 + 16 * it + r, buf = it & 1;
        const float* xs = A.src + (size_t)row * D + kb;
        f32x4 xv[4][2];
#pragma unroll
        for (int c = 0; c < 4; ++c) { xv[c][0] = *(const f32x4*)(xs + 32 * c); xv[c][1] = *(const f32x4*)(xs + 32 * c + 4); }
        if (MODE >= 2) {
            const bf16* yp = A.y2 + (size_t)row * 2 * D + kb;
#pragma unroll
            for (int c = 0; c < 4; ++c) { const v4u ya = *(const v4u*)(yp + 32 * c), yb = *(const v4u*)(yp + D + 32 * c);
                f32x4 s0, s1;
                s0[0] = bflo(ya.x) + bflo(yb.x); s0[1] = bfhi(ya.x) + bfhi(yb.x); s0[2] = bflo(ya.y) + bflo(yb.y); s0[3] = bfhi(ya.y) + bfhi(yb.y);
                s1[0] = bflo(ya.z) + bflo(yb.z); s1[1] = bfhi(ya.z) + bfhi(yb.z); s1[2] = bflo(ya.w) + bflo(yb.w); s1[3] = bfhi(ya.w) + bfhi(yb.w);
                xv[c][0] += *(const LAS f32x4*)(GT + kb + 32 * c) * s0; xv[c][1] += *(const LAS f32x4*)(GT + kb + 32 * c + 4) * s1; }
            if (MODE == 2) { float* xd = A.dst + (size_t)row * D + kb;
#pragma unroll
                for (int c = 0; c < 4; ++c) { *(f32x4*)(xd + 32 * c) = xv[c][0]; *(f32x4*)(xd + 32 * c + 4) = xv[c][1]; } }
        }
        float ss = 0.f;
#pragma unroll
        for (int c = 0; c < 4; ++c)
#pragma unroll
            for (int hf = 0; hf < 2; ++hf) { const f32x4 v = xv[c][hf]; ss += (v[0] * v[0] + v[1] * v[1]) + (v[2] * v[2] + v[3] * v[3]); }
        ss += __int_as_float(__builtin_amdgcn_ds_bpermute((lane ^ 16) << 2, __float_as_int(ss))); ss += __int_as_float(__builtin_amdgcn_ds_bpermute((lane ^ 32) << 2, __float_as_int(ss)));
        if (q == 0) red[buf * 128 + w * 16 + r] = ss;
        __syncthreads();
        float tot = 0.f;
#pragma unroll
        for (int ww = 0; ww < 8; ++ww) tot += red[buf * 128 + ww * 16 + r];
        const float rstd = 1.0f / sqrtf(tot * (1.0f / D) + RMS_EPS);
        if (MODE == 3) { float* xd = A.dst + (size_t)row * D + kb;
#pragma unroll
            for (int c = 0; c < 4; ++c) { *(f32x4*)(xd + 32 * c) = xv[c][0] * rstd * *(const LAS f32x4*)(GM + kb + 32 * c); *(f32x4*)(xd + 32 * c + 4) = xv[c][1] * rstd * *(const LAS f32x4*)(GM + kb + 32 * c + 4); }
            continue; }
        f32x4 acc[NT > 0 ? NT : 1];
#pragma unroll
        for (int nt = 0; nt < (NT > 0 ? NT : 1); ++nt) acc[nt] = (f32x4){0.f, 0.f, 0.f, 0.f};
        bf16* hp = A.hb + (size_t)row * D + kb;
#pragma unroll
        for (int c = 0; c < 4; ++c) {
            const f32x4 h0 = xv[c][0] * rstd * *(const LAS f32x4*)(GM + kb + 32 * c) + *(const LAS f32x4*)(SH + kb + 32 * c), h1 = xv[c][1] * rstd * *(const LAS f32x4*)(GM + kb + 32 * c + 4) + *(const LAS f32x4*)(SH + kb + 32 * c + 4);
            v4u hw; hw.x = pk2(h0[0], h0[1]); hw.y = pk2(h0[2], h0[3]); hw.z = pk2(h1[0], h1[1]); hw.w = pk2(h1[2], h1[3]);
            *(v4u*)(hp + 32 * c) = hw;
            if (NT > 0) {
                v4u lw; lw.x = pk2(h0[0] - bflo(hw.x), h0[1] - bfhi(hw.x)); lw.y = pk2(h0[2] - bflo(hw.y), h0[3] - bfhi(hw.y));
                lw.z = pk2(h1[0] - bflo(hw.z), h1[1] - bfhi(hw.z)); lw.w = pk2(h1[2] - bflo(hw.w), h1[3] - bfhi(hw.w));
                const bf16x8 ah = __builtin_bit_cast(bf16x8, hw), al = __builtin_bit_cast(bf16x8, lw);
#pragma unroll
                for (int nt = 0; nt < NT; ++nt) {
                    acc[nt] = __builtin_amdgcn_mfma_f32_16x16x32_bf16(ah, Bh[nt][c], acc[nt], 0, 0, 0);
                    acc[nt] = __builtin_amdgcn_mfma_f32_16x16x32_bf16(ah, Bl[nt][c], acc[nt], 0, 0, 0);
                    acc[nt] = __builtin_amdgcn_mfma_f32_16x16x32_bf16(al, Bh[nt][c], acc[nt], 0, 0, 0); }
            }
        }
        if (NT > 0) {
#pragma unroll
            for (int nt = 0; nt < NT; ++nt) part[((buf * 8 + w) * 2 + nt) * 64 + lane] = acc[nt];
            __syncthreads();
            if (MODE == 0) {
                if (tid < 256) { const int t = tid & 15, n = tid >> 4; float f = 0.f;
#pragma unroll
                    for (int ww = 0; ww < 8; ++ww) f += ((const LAS float*)&part[((buf * 8 + ww) * 2 + 0) * 64 + n + 16 * (t >> 2)])[t & 3];
                    const float z = f + A.bias[n]; const float lf = fminf(z, 0.f) - log1pf(__expf(-fabsf(z)));
                    const int rt = R0 + 16 * it + t; A.logf[((size_t)b * H + n) * SEQ + (rt & (SEQ - 1))] = lf; }
            } else {
                { const int t = tid & 15, n = tid >> 4; float f = 0.f;
#pragma unroll
                  for (int ww = 0; ww < 8; ++ww) f += ((const LAS float*)&part[((buf * 8 + ww) * 2 + (n >> 4)) * 64 + (n & 15) + 16 * (t >> 2)])[t & 3];
                  const float sc = 1.0f / (1.0f + expf(-f)); scS[t * 32 + n] = sc; selS[t * 32 + n] = sc + A.bias[n]; }
                __syncthreads();
                if (tid < 16) { const LAS float* sl = selS + tid * 32; float bg = -INFINITY; int gi = 0;
                    for (int g = 0; g < 4; ++g) { float m1 = -INFINITY, m2 = -INFINITY;
                        for (int i = 0; i < 8; ++i) { const float v = sl[8 * g + i]; if (v > m1) { m2 = m1; m1 = v; } else if (v > m2) m2 = v; }
                        const float gs = m1 + m2; if (gs > bg) { bg = gs; gi = g; } }
                    int i1 = 0, i2 = 0; float v1 = -INFINITY, v2 = -INFINITY;
                    for (int i = 0; i < 8; ++i) { const float v = sl[8 * gi + i]; if (v > v1) { v1 = v; i1 = i; } }
                    for (int i = 0; i < 8; ++i) { const float v = sl[8 * gi + i]; if (i != i1 && v > v2) { v2 = v; i2 = i; } }
                    const int e0 = 8 * gi + i1, e1 = 8 * gi + i2; const float s0 = scS[tid * 32 + e0], s1 = scS[tid * 32 + e1], inv = 1.0f / (s0 + s1);
                    const int rt = R0 + 16 * it + tid;
                    const unsigned p0 = __hip_atomic_fetch_add(A.cnt + e0 * 64, 1u, RLX_AGENT), p1 = __hip_atomic_fetch_add(A.cnt + e1 * 64, 1u, RLX_AGENT);
                    A.tok[e0 * ECAP + p0] = rt * 2; A.gw[e0 * ECAP + p0] = s0 * inv; A.tok[e1 * ECAP + p1] = rt * 2 + 1; A.gw[e1 * ECAP + p1] = s1 * inv; }
            }
        }
    }
    __syncthreads();
}

constexpr int UT_E = 64, UT_X = 64 + 320, UT_V = 64 + 640;
__device__ __forceinline__ void build_etab(Frame& F, int layer) {
    LAS int* et = (LAS int*)(F.lds + ETAB_OFF);
    if (F.tid == 0) { int ts = 0;
        for (int e = 0; e < NE; ++e) { const int c = (int)__hip_atomic_load(F.ctl + CW_CNT + (layer * 32 + e) * 64, RLX_AGENT); const int nt = (c + 255) >> 8;
            for (int j = 0; j < nt; ++j) { et[UT_E + ts] = e; et[UT_X + ts] = e * ECAP + 256 * j; const int rem = c - 256 * j; et[UT_V + ts] = rem < 256 ? rem : 256; ++ts; } }
        et[0] = ts; }
    __syncthreads();
}
__device__ __forceinline__ void gather_rows(Frame& F) {
    const LAS int* et = (const LAS int*)(F.lds + ETAB_OFF);
    const int ptot = et[0] * 256; const int* tok = WSP(int, WS_TOK);
    const int gw = F.vcu * NWAVES + F.wave, NGW = F.G * NWAVES;
    for (int p = gw; p < ptot; p += NGW) { const int tile = p >> 8, rl = p & 255;
        if (rl < et[UT_V + tile]) { const int tk = tok[et[UT_X + tile] + rl] >> 1;
            const GAS v4u* s = (const GAS v4u*)(WSP(bf16, WS_HB) + (size_t)tk * D) + F.lane; GAS v4u* d = (GAS v4u*)(WSP(bf16, WS_XS) + (size_t)p * D) + F.lane;
            const v4u a = s[0], bq = s[64]; d[0] = a; d[64] = bq; } }
}
__device__ __forceinline__ void pool_rows(Frame& F) {
    const int ch = F.tid & 127, rs = F.tid >> 7; const int t0 = F.vcu * 128 + rs * 32; const int win = 2 << (ch >> 5);
    const bf16* hb = WSP(bf16, WS_HB) + ch * 8; bf16* pl = WSP(bf16, WS_PL) + ch * 8;
    float s[8];
#pragma unroll
    for (int j = 0; j < 8; ++j) s[j] = 0.f;
    const int s0 = t0 & (SEQ - 1);
    for (int i = 1; i < win; ++i) if (s0 - i >= 0) { const v4u a = *(const v4u*)(hb + (size_t)(t0 - i) * D);
        s[0] += bflo(a.x); s[1] += bfhi(a.x); s[2] += bflo(a.y); s[3] += bfhi(a.y); s[4] += bflo(a.z); s[5] += bfhi(a.z); s[6] += bflo(a.w); s[7] += bfhi(a.w); }
    for (int i = 0; i < 32; ++i) { const int t = t0 + i, sq = s0 + i;
        const v4u a = *(const v4u*)(hb + (size_t)t * D);
        float h[8]; h[0] = bflo(a.x); h[1] = bfhi(a.x); h[2] = bflo(a.y); h[3] = bfhi(a.y); h[4] = bflo(a.z); h[5] = bfhi(a.z); h[6] = bflo(a.w); h[7] = bfhi(a.w);
#pragma unroll
        for (int j = 0; j < 8; ++j) s[j] += h[j];
        const float ic = 1.0f / (float)((sq + 1 < win) ? (sq + 1) : win);
        v4u w; w.x = pk2(s[0] * ic - h[0], s[1] * ic - h[1]); w.y = pk2(s[2] * ic - h[2], s[3] * ic - h[3]); w.z = pk2(s[4] * ic - h[4], s[5] * ic - h[5]); w.w = pk2(s[6] * ic - h[6], s[7] * ic - h[7]);
        if (sq - win + 1 >= 0) { const v4u o = *(const v4u*)(hb + (size_t)(t - win + 1) * D);
            s[0] -= bflo(o.x); s[1] -= bfhi(o.x); s[2] -= bflo(o.y); s[3] -= bfhi(o.y); s[4] -= bflo(o.z); s[5] -= bfhi(o.z); s[6] -= bflo(o.w); s[7] -= bfhi(o.w); }
        *(v4u*)(pl + (size_t)t * D) = w; }
}

struct DenseSched {
    const char* A; const char* Bt; size_t strideA, strideB; int nM, nN, nwg, G, c;
    __device__ __forceinline__ bool next(int i, pg8::Unit& u) const {
        const long L = (long)i * G + c; if (L >= nwg) return false;
        int wgid = (int)L; { const int q = nwg / 8, r = nwg % 8, xcd = wgid % 8, off = wgid / 8; wgid = (xcd < r ? xcd * (q + 1) : r * (q + 1) + (xcd - r) * q) + off; }
        const int nig = 8 * nN, gid = wgid / nig, fm = gid * 8, gsz = (nM - fm) < 8 ? (nM - fm) : 8;
        u.pm = fm + ((wgid % nig) % gsz); u.pn = (wgid % nig) / gsz; u.a = A + (size_t)u.pm * strideA; u.b = Bt + (size_t)u.pn * strideB; u.x0 = 0; u.x1 = 0; return true;
    }
};
struct PoolSched {
    const char* A; const char* Bt; int G, v;
    __device__ __forceinline__ bool next(int i, pg8::Unit& u) const {
        const int L = i * G + v; if (L >= 512) return false;
        u.pm = L >> 2; u.pn = L & 3; u.a = A + (size_t)u.pm * 256 * D * 2 + (size_t)u.pn * 256 * 2; u.b = Bt + (size_t)u.pn * 65536 * 2; u.x0 = 0; u.x1 = 0; return true;
    }
};
template <bool DOWN> struct MoeSched {
    const LAS int* et; const char* A; const char* Bt; int G, v; const int* tok;
    __device__ __forceinline__ unsigned row_off(const pg8::Unit& u, int row) const { const int vv = et[UT_V + u.pm], x = et[UT_X + u.pm]; const int tk = tok[x + (row < vv ? row : 0)] >> 1; return (unsigned)tk * (unsigned)(D * 2); }
    static constexpr size_t rowA = DOWN ? (size_t)FD * 2 : (size_t)D * 2, strideE = DOWN ? (size_t)1024 * 512 * 2 : (size_t)1024 * 1024 * 2, stridePn = DOWN ? (size_t)256 * 512 * 2 : (size_t)256 * 1024 * 2;
    __device__ __forceinline__ bool next(int i, pg8::Unit& u) const {
        const int L = i * G + v; const int ntile = et[0]; if (L >= ntile * 4) return false;
        const int tile = L >> 2, pn = L & 3; const int e = et[UT_E + tile];
        u.pm = tile; u.pn = pn; u.a = DOWN ? A + (size_t)tile * 256 * rowA : A; u.b = Bt + (size_t)e * strideE + (size_t)pn * stridePn;
        if (DOWN) { u.x0 = et[UT_X + tile]; u.x1 = et[UT_V + tile]; } else { u.x0 = pn; u.x1 = tile * 256; }
        return true;
    }
};
constexpr int N_PHASES = 17;
struct Args { const float* in[17]; float* out; unsigned char* ws; int ph_lo, ph_hi; };
__global__ void __launch_bounds__(NWAVES * 64, 2) fwd_megakernel(Args args) {
    extern __shared__ __attribute__((aligned(16))) unsigned char lds[];
    Frame F;
    F.lds = (LAS unsigned char*)lds;
    F.MISC = (volatile LAS unsigned*)(F.lds + MISC_OFF);
    F.wave0 = __builtin_amdgcn_readfirstlane((int)threadIdx.x >> 6); F.tid = threadIdx.x; F.lane = F.tid & 63; F.wave = F.wave0;
    F.G = gridDim.x; { const int bx = blockIdx.x; F.vcu = (F.G % 8 == 0) ? (bx % 8) * (F.G / 8) + bx / 8 : bx; }
    F.ws0 = args.ws; F.out0 = args.out;
    F.ka0 = (const __attribute__((address_space(4))) char*)__builtin_amdgcn_kernarg_segment_ptr();
    phase_enter(F);
    for (int u = F.tid; u < (LDS_BYTES - LDSCTL_OFF) / 4; u += NWAVES * 64) ((LAS unsigned*)(F.lds + LDSCTL_OFF))[u] = 0u;
    __syncthreads();
    XcdBarrier bar; bar.bar = (unsigned*)(F.ctl + CW_BAR); bar.x = 0; bar.st = nullptr;
    if (!MK_MULTI) bar = xcd_barrier_post((unsigned*)(F.ctl + CW_BAR), F.MISC + 8);
    int lo = args.ph_lo, hi = args.ph_hi;
#ifndef PHMASK
#define PHMASK 0xFFFFFFFFu
#endif
#define IN(k) (((PHMASK >> (k)) & 1u) && lo <= (k) && (k) < hi)
#ifndef DUP_PHASE
#define DUP_PHASE -1
#endif
#define REP(k) for (int rep_ = 0; rep_ < ((k) == DUP_PHASE ? 2 : 1); ++rep_)
#define SEAM2(k, k2) do { if (IN(k) && IN(k2)) xcd_barrier(bar); asm volatile("" : "+s"(lo), "+s"(hi)); } while (0)
#define SEAM(k) do { if (IN(k) && IN((k) + 1)) xcd_barrier(bar); asm volatile("" : "+s"(lo), "+s"(hi)); } while (0)
#define mod WSP(float, WS_MOD)
#define HB WSP(bf16, WS_HB)

    if (IN(0)) REP(0) { phase_enter(F); p0_prologue(F); } SEAM(0);
#ifdef EXTRA_BARS
    for (int xb_ = 0; xb_ < EXTRA_BARS; ++xb_) xcd_barrier(bar);
#endif
    if (IN(1)) REP(1) { phase_enter(F); RowArgs A{}; A.src = FIN(IN_X); A.g = FIN(IN_NMG); A.shp = mod + 0; A.scp = mod + D; A.hb = HB; A.W = FIN(IN_WIN); A.bias = FIN(IN_FBIAS); A.logf = WSP(float, WS_LOGF);
        rowpass<0>(F, A); } SEAM(1);
    if (IN(2)) REP(2) { phase_enter(F); pg8::Gemm g{D, D, D}; DenseSched S{(const char*)HB, (const char*)WSP(bf16, WS_WQKV), (size_t)256 * D * 2, (size_t)256 * D * 2, T / 256, 3 * D / 256, (T / 256) * (3 * D / 256), F.G, (int)blockIdx.x};
        pg8::EpiQKV E{WSP(bf16, WS_Q), (size_t)(WS_K - WS_Q) / 2, attn_body::C2, (unsigned*)(F.ctl + CW_QKM)};
        pg8::gemm_phase<pg8::EpiQKV, DenseSched, true>(F.lds + RING_OFF, g, S, E, F.wave0); } SEAM(2);
    if (IN(3)) REP(3) { phase_enter(F); const attn_body::AttnTensors AT{(const attn_body::bf16*)WSP(bf16, WS_Q), (const attn_body::bf16*)WSP(bf16, WS_K), (const attn_body::bf16*)WSP(bf16, WS_V), (attn_body::bf16*)HB, WSP(float, WS_LOGF), (const unsigned*)(F.ctl + CW_QKM)};
        attn_body::attn_phase<8>((char*)lds + RING_OFF, AT, (unsigned*)(F.ctl + CW_AQ), F.wave0); } SEAM(3);
    if (IN(4)) REP(4) { phase_enter(F); pg8::Gemm g{D, D, D}; DenseSched S{(const char*)HB, (const char*)WSP(bf16, WS_WO), (size_t)256 * D * 2, (size_t)256 * D * 2, T / 256, D / 256, (T / 256) * (D / 256), F.G, (int)blockIdx.x};
        pg8::EpiResid E{FIN(IN_X), F.out, mod + 2 * D};
        pg8::gemm_phase<pg8::EpiResid, DenseSched, true>(F.lds + RING_OFF, g, S, E, F.wave0); } SEAM(4);
        if (IN(5)) REP(5) { phase_enter(F); RowArgs A{}; A.src = F.out; A.g = FIN(IN_NFG) + 0 * D; A.shp = mod + (size_t)0 * 8 * MODW + 3 * D; A.scp = mod + (size_t)0 * 8 * MODW + 4 * D; A.hb = HB;
            A.W = FIN(IN_RW); A.bias = FIN(IN_RB); A.cnt = F.ctl + CW_CNT + 0 * 32 * 64; A.tok = WSP(int, WS_TOK); A.gw = WSP(float, WS_GW);
            if (rep_) { A.cnt = F.ctl + CW_CNT + 2 * 32 * 64; A.tok = WSP(int, WS_END); A.gw = WSP(float, WS_END + 4 * MiB); }
            rowpass<1>(F, A); } SEAM2(5, 7);
        if (IN(7)) REP(7) { phase_enter(F); build_etab(F, 0); pg8::Gemm g{D, D, D};
            MoeSched<false> S{(const LAS int*)(F.lds + ETAB_OFF), (const char*)HB, (const char*)(WSP(bf16, WS_UP) + (size_t)0 * NE * 1024 * 1024), F.G, F.vcu, WSP(int, WS_TOK)};
            pg8::EpiUp E{WSP(bf16, WS_HH)};
            pg8::gemm_phase<pg8::EpiUp, MoeSched<false>, true, true>(F.lds + RING_OFF, g, S, E, F.wave0); } SEAM(7);
        if (IN(8)) REP(8) { phase_enter(F); build_etab(F, 0); pg8::Gemm g{FD, FD, FD};
            MoeSched<true> S{(const LAS int*)(F.lds + ETAB_OFF), (const char*)WSP(bf16, WS_HH), (const char*)(WSP(bf16, WS_DN) + (size_t)0 * NE * 1024 * 512), F.G, F.vcu, nullptr};
            pg8::EpiDown E{WSP(bf16, WS_Y2), WSP(int, WS_TOK), WSP(float, WS_GW)};
            pg8::gemm_phase<pg8::EpiDown, MoeSched<true>, true>(F.lds + RING_OFF, g, S, E, F.wave0); } SEAM(8);

            if (IN(9)) REP(9) { phase_enter(F); RowArgs A{}; A.src = F.out; A.dst = F.out; A.g = FIN(IN_NMG) + D; A.shp = mod + 8 * MODW + 0; A.scp = mod + 8 * MODW + D; A.gtp = mod + 5 * D; A.y2 = WSP(bf16, WS_Y2); A.hb = HB;
                rowpass<2>(F, A); } SEAM(9);
            if (IN(10)) REP(10) { phase_enter(F); pool_rows(F); } SEAM(10);
            if (IN(11)) REP(11) { phase_enter(F); pg8::Gemm g{D, 256, 256}; PoolSched S{(const char*)WSP(bf16, WS_PL), (const char*)WSP(bf16, WS_WP), F.G, F.vcu};
                pg8::EpiPool E{F.out, mod + 8 * MODW + 2 * D, FIN(IN_POOLS)};
                pg8::gemm_phase<pg8::EpiPool, PoolSched, true>(F.lds + RING_OFF, g, S, E, F.wave0); } SEAM(11);
        if (IN(12)) REP(12) { phase_enter(F); RowArgs A{}; A.src = F.out; A.g = FIN(IN_NFG) + 1 * D; A.shp = mod + (size_t)1 * 8 * MODW + 3 * D; A.scp = mod + (size_t)1 * 8 * MODW + 4 * D; A.hb = HB;
            A.W = FIN(IN_RW); A.bias = FIN(IN_RB); A.cnt = F.ctl + CW_CNT + 1 * 32 * 64; A.tok = WSP(int, WS_TOK); A.gw = WSP(float, WS_GW);
            rowpass<1>(F, A); } SEAM2(12, 14);
        if (IN(14)) REP(14) { phase_enter(F); build_etab(F, 1); pg8::Gemm g{D, D, D};
            MoeSched<false> S{(const LAS int*)(F.lds + ETAB_OFF), (const char*)HB, (const char*)(WSP(bf16, WS_UP) + (size_t)1 * NE * 1024 * 1024), F.G, F.vcu, WSP(int, WS_TOK)};
            pg8::EpiUp E{WSP(bf16, WS_HH)};
            pg8::gemm_phase<pg8::EpiUp, MoeSched<false>, true, true>(F.lds + RING_OFF, g, S, E, F.wave0); } SEAM(14);
        if (IN(15)) REP(15) { phase_enter(F); build_etab(F, 1); pg8::Gemm g{FD, FD, FD};
            MoeSched<true> S{(const LAS int*)(F.lds + ETAB_OFF), (const char*)WSP(bf16, WS_HH), (const char*)(WSP(bf16, WS_DN) + (size_t)1 * NE * 1024 * 512), F.G, F.vcu, nullptr};
            pg8::EpiDown E{WSP(bf16, WS_Y2), WSP(int, WS_TOK), WSP(float, WS_GW)};
            pg8::gemm_phase<pg8::EpiDown, MoeSched<true>, true>(F.lds + RING_OFF, g, S, E, F.wave0); } SEAM(15);
    if (IN(16)) REP(16) { phase_enter(F); RowArgs A{}; A.src = F.out; A.dst = F.out; A.g = FIN(IN_NFIN); A.gtp = mod + 8 * MODW + 5 * D; A.y2 = WSP(bf16, WS_Y2);
        rowpass<3>(F, A); }
#undef IN
#undef SEAM
#undef mod
#undef HB
}

extern "C" void kernel_launch(void* const* d_in, const int* in_sizes, int n_in, void* d_out, int out_size, void* d_ws, size_t ws_size, hipStream_t stream) {
    static int grid = 0;
    if (grid == 0) {
        if (n_in != 17 || in_sizes[0] != T * D || out_size != T * D || ws_size < WS_END) { fprintf(stderr, "kernel_launch: unexpected shapes (n_in %d, in0 %d, out %d, ws %zu)\n", n_in, n_in > 0 ? in_sizes[0] : -1, out_size, ws_size); grid = -1; return; }
        int dev = 0, cus = 0, per_cu = 0;
        if (hipGetDevice(&dev) != hipSuccess || hipDeviceGetAttribute(&cus, hipDeviceAttributeMultiprocessorCount, dev) != hipSuccess) { grid = -1; return; }
        if (hipFuncSetAttribute((const void*)fwd_megakernel, hipFuncAttributeMaxDynamicSharedMemorySize, LDS_BYTES) != hipSuccess) { fprintf(stderr, "kernel_launch: hipFuncSetAttribute failed\n"); grid = -1; return; }
        if (hipOccupancyMaxActiveBlocksPerMultiprocessor(&per_cu, (const void*)fwd_megakernel, NWAVES * 64, LDS_BYTES) != hipSuccess || per_cu < 1) { fprintf(stderr, "kernel_launch: occupancy query says %d\n", per_cu); (void)hipGetLastError(); grid = -1; return; }
        grid = cus;
        if (grid != 256) fprintf(stderr, "kernel_launch: %d CUs; this kernel's static work split expects 256\n", grid);
    }
    if (grid < 0) return;
    (void)hipMemsetAsync((char*)d_ws + WS_CTL, 0, CTL_ZERO_BYTES, stream);
    Args a{};
    for (int i = 0; i < 17; ++i) a.in[i] = (const float*)d_in[i];
    a.out = (float*)d_out; a.ws = (unsigned char*)d_ws;
#if MK_MULTI
#ifndef MAXPH
#define MAXPH 17
#endif
    for (int p = 0; p < MAXPH; ++p) { a.ph_lo = p; a.ph_hi = p + 1; hipLaunchKernelGGL(fwd_megakernel, dim3(grid), dim3(NWAVES * 64), LDS_BYTES, stream, a); }
#else
    a.ph_lo = 0; a.ph_hi = 17;
    void* kargs[] = {&a};
    hipError_t e = hipLaunchCooperativeKernel((const void*)fwd_megakernel, dim3(grid), dim3(NWAVES * 64), kargs, LDS_BYTES, stream);
    if (e != hipSuccess) fprintf(stderr, "kernel_launch: cooperative launch failed: %s\n", hipGetErrorString(e));
#endif
}
```

```cpp
#define MK_MULTI 0
#define MAXPH 17
#include <hip/hip_runtime.h>
#include <hip/hip_bf16.h>
#include <cstdio>
#include <cstdint>
#include <cmath>
__device__ __forceinline__ int opaque_tid(int wave0) { int w = wave0; asm volatile("" : "+s"(w)); unsigned m = ~0u; asm volatile("" : "+s"(m)); const int l = (int)__builtin_amdgcn_mbcnt_hi(m, __builtin_amdgcn_mbcnt_lo(m, 0u)); return w * 64 + l; }
namespace pg8 {
#define PG8_LAS __attribute__((address_space(3)))
typedef unsigned short bf16_t;
typedef short bf16x8 __attribute__((ext_vector_type(8)));
typedef float f32x4 __attribute__((ext_vector_type(4)));
typedef float f32x2 __attribute__((ext_vector_type(2)));
typedef unsigned u32x4 __attribute__((ext_vector_type(4)));
constexpr int BM = 256, BK = 64, HALF = 128, HTB = HALF * BK * 2  , STAGE_BYTES = 8 * HTB, NXCD = 8, WGM = 8;

__host__ __device__ __forceinline__ int lds_byte(int r, int c) { const int st = (r >> 4) * 2 + (c >> 5), rr = r & 15, cc = c & 31, ob = rr * 64 + cc * 2; return st * 1024 + (ob ^ (((ob >> 9) & 1) << 5)); }
__host__ __device__ __forceinline__ void stage_rc(int b, int& R, int& C) { const int st = b / 1024, sb = b % 1024, swz = sb ^ (((sb >> 9) & 1) << 5); R = (st >> 1) * 16 + swz / 64; C = (st & 1) * 32 + (swz % 64) / 2; }
__host__ __device__ __forceinline__ int perm32(int rho) { const int n = rho >> 4, i = rho & 15; return 8 * (i >> 2) + 4 * n + (i & 3); }

struct Unit { const char* a; const char* b; int pm, pn, x0, x1; };
struct Gemm { int lda, ldb, K; };

__device__ __forceinline__ unsigned cvt_pk_bf16(float lo, float hi) { unsigned r; asm volatile("v_cvt_pk_bf16_f32 %0, %1, %2" : "=v"(r) : "v"(lo), "v"(hi)); return r; }


struct EpiBf16 {
    static constexpr bool PERM = true, AFTER_DRAIN = false;
    bf16_t* O; int ldc; int split_cols; size_t split_stride; float scale0;
    __device__ __forceinline__ void operator()(const f32x4 (&acc)[2][2][4][2], const Unit& u, int wr, int wc, int fr, int fq) const {
        const int row0 = u.pm * BM + wr * 64 + fr; int colt = u.pn * BM; bf16_t* base = O;
        float sc = 1.f; if (split_cols) { const int t = colt / split_cols; base += (size_t)t * split_stride; colt -= t * split_cols; if (t == 0) sc = scale0; }
        const int col0 = colt + wc * 32 + 8 * fq;
#pragma unroll
        for (int ai = 0; ai < 2; ++ai)
#pragma unroll
            for (int m = 0; m < 4; ++m) { bf16_t* rowp = base + (size_t)(row0 + ai * HALF + m * 16) * ldc + col0;
#pragma unroll
                for (int bj = 0; bj < 2; ++bj) { f32x4 v0 = acc[ai][bj][m][0] * sc, v1 = acc[ai][bj][m][1] * sc;
                    u32x4 w; w.x = cvt_pk_bf16(v0[0], v0[1]); w.y = cvt_pk_bf16(v0[2], v0[3]); w.z = cvt_pk_bf16(v1[0], v1[1]); w.w = cvt_pk_bf16(v1[2], v1[3]);
                    *(u32x4*)(rowp + bj * HALF) = w; } }
    }
};
struct EpiQKV {
    static constexpr bool PERM = true, AFTER_DRAIN = false;
    bf16_t* O; size_t stride; float scale0; unsigned* qkm;
    __device__ __forceinline__ void operator()(const f32x4 (&acc)[2][2][4][2], const Unit& u, int wr, int wc, int fr, int fq) const {
        const int t = u.pn >> 2, colt = (u.pn & 3) * BM, b = u.pm >> 4; bf16_t* base = O + (size_t)t * stride;
        const float sc = (t == 0) ? scale0 : 1.f;
        const int row0 = u.pm * BM + wr * 64 + fr, col0 = colt + wc * 32 + 8 * fq, lane = fr + 16 * fq;
        float mx0 = 0.f, mx1 = 0.f;
#pragma unroll
        for (int ai = 0; ai < 2; ++ai)
#pragma unroll
            for (int m = 0; m < 4; ++m) { bf16_t* rowp = base + (size_t)(row0 + ai * HALF + m * 16) * 1024 + col0;
#pragma unroll
                for (int bj = 0; bj < 2; ++bj) { const f32x4 v0 = acc[ai][bj][m][0] * sc, v1 = acc[ai][bj][m][1] * sc;
                    u32x4 w; w.x = cvt_pk_bf16(v0[0], v0[1]); w.y = cvt_pk_bf16(v0[2], v0[3]); w.z = cvt_pk_bf16(v1[0], v1[1]); w.w = cvt_pk_bf16(v1[2], v1[3]);
                    *(u32x4*)(rowp + bj * HALF) = w;
                    if (t < 2) { float ss = (v0[0] * v0[0] + v0[1] * v0[1]) + (v0[2] * v0[2] + v0[3] * v0[3]) + (v1[0] * v1[0] + v1[1] * v1[1]) + (v1[2] * v1[2] + v1[3] * v1[3]);
                        ss += __int_as_float(__builtin_amdgcn_ds_bpermute((lane ^ 16) << 2, __float_as_int(ss))); ss += __int_as_float(__builtin_amdgcn_ds_bpermute((lane ^ 32) << 2, __float_as_int(ss)));
                        if (bj == 0) mx0 = fmaxf(mx0, ss); else mx1 = fmaxf(mx1, ss); } } }
        if (t < 2) {
#pragma unroll
            for (int o = 1; o < 16; o <<= 1) { mx0 = fmaxf(mx0, __int_as_float(__builtin_amdgcn_ds_bpermute((lane ^ o) << 2, __float_as_int(mx0)))); mx1 = fmaxf(mx1, __int_as_float(__builtin_amdgcn_ds_bpermute((lane ^ o) << 2, __float_as_int(mx1)))); }
            if (lane == 0) { unsigned* w = qkm + (t * 8 + b) * 32 + (u.pn & 3) * 8 + wc; atomicMax(w, __float_as_uint(mx0)); atomicMax(w + 4, __float_as_uint(mx1)); } }
    }
};
struct EpiResid {
    static constexpr bool PERM = false, AFTER_DRAIN = false;
    const float* base; float* out; const float* gate;
    __device__ __forceinline__ void operator()(const f32x4 (&acc)[2][2][4][2], const Unit& u, int wr, int wc, int fr, int fq) const {
        const int col0 = u.pn * BM + wc * 32 + 4 * fq; const int b = u.pm >> 4;
        f32x4 gv[2][2];
#pragma unroll
        for (int bj = 0; bj < 2; ++bj)
#pragma unroll
            for (int n = 0; n < 2; ++n) gv[bj][n] = *(const f32x4*)(gate + (size_t)b * 6144 + col0 + bj * HALF + n * 16);
#pragma unroll
        for (int ai = 0; ai < 2; ++ai)
#pragma unroll
            for (int m = 0; m < 4; ++m) { const size_t off = (size_t)(u.pm * BM + ai * HALF + wr * 64 + m * 16 + fr) * 1024 + col0;
#pragma unroll
                for (int bj = 0; bj < 2; ++bj)
#pragma unroll
                    for (int n = 0; n < 2; ++n) { const f32x4 bs = *(const f32x4*)(base + off + bj * HALF + n * 16); *(f32x4*)(out + off + bj * HALF + n * 16) = bs + gv[bj][n] * acc[ai][bj][m][n]; }
                if (m & 1) asm volatile("" ::: "memory"); }
    }
};
struct EpiPool {
    static constexpr bool PERM = false, AFTER_DRAIN = false;
    float* xr; const float* gate; const float* pscale;
    __device__ __forceinline__ void operator()(const f32x4 (&acc)[2][2][4][2], const Unit& u, int wr, int wc, int fr, int fq) const {
        const int col0 = u.pn * BM + wc * 32 + 4 * fq; const int b = u.pm >> 4;
        float* rbase = xr + (size_t)(u.pm * BM + wr * 64 + fr) * 1024 + col0;
#pragma unroll
        for (int bj = 0; bj < 2; ++bj)
#pragma unroll
            for (int n = 0; n < 2; ++n) { const f32x4 gv = *(const f32x4*)(gate + (size_t)b * 6144 + col0 + bj * HALF + n * 16) * *(const f32x4*)(pscale + col0 + bj * HALF + n * 16);
#pragma unroll
                for (int ai = 0; ai < 2; ++ai)
#pragma unroll
                    for (int m = 0; m < 4; ++m) { float* p = rbase + (size_t)(ai * HALF + m * 16) * 1024 + bj * HALF + n * 16; const f32x4 bs = *(const f32x4*)p; *(f32x4*)p = bs + gv * acc[ai][bj][m][n]; }
                asm volatile("" ::: "memory"); }
    }
};
__device__ __forceinline__ float silu_mul(float g, float u) { return g * u * __builtin_amdgcn_rcpf(1.0f + __builtin_amdgcn_exp2f(-1.4426950408889634f * g)); }
struct EpiUp {
    static constexpr bool PERM = true, AFTER_DRAIN = false;
    bf16_t* H;
    __device__ __forceinline__ void operator()(const f32x4 (&acc)[2][2][4][2], const Unit& u, int wr, int wc, int fr, int fq) const {
        const int row0 = u.x1 + wr * 64 + fr, col0 = u.x0 * 128 + wc * 32 + 8 * fq;
#pragma unroll
        for (int ai = 0; ai < 2; ++ai)
#pragma unroll
            for (int m = 0; m < 4; ++m) { bf16_t* rowp = H + (size_t)(row0 + ai * HALF + m * 16) * 512 + col0;
                const f32x4 g0 = acc[ai][0][m][0], g1 = acc[ai][0][m][1], u0 = acc[ai][1][m][0], u1 = acc[ai][1][m][1];
                u32x4 w; w.x = cvt_pk_bf16(silu_mul(g0[0], u0[0]), silu_mul(g0[1], u0[1])); w.y = cvt_pk_bf16(silu_mul(g0[2], u0[2]), silu_mul(g0[3], u0[3]));
                w.z = cvt_pk_bf16(silu_mul(g1[0], u1[0]), silu_mul(g1[1], u1[1])); w.w = cvt_pk_bf16(silu_mul(g1[2], u1[2]), silu_mul(g1[3], u1[3]));
                *(u32x4*)rowp = w; }
    }
};
struct EpiDown {
    static constexpr bool PERM = true, AFTER_DRAIN = false;
    bf16_t* Y; const int* tok; const float* gw;
    __device__ __forceinline__ void operator()(const f32x4 (&acc)[2][2][4][2], const Unit& u, int wr, int wc, int fr, int fq) const {
        const int col0 = u.pn * BM + wc * 32 + 8 * fq;
        int dd[2][4]; float ww[2][4];
#pragma unroll
        for (int ai = 0; ai < 2; ++ai)
#pragma unroll
            for (int m = 0; m < 4; ++m) { const int rl = ai * HALF + wr * 64 + m * 16 + fr; const int idx = u.x0 + (rl < u.x1 ? rl : 0); dd[ai][m] = tok[idx]; ww[ai][m] = gw[idx]; }
#pragma unroll
        for (int ai = 0; ai < 2; ++ai)
#pragma unroll
            for (int m = 0; m < 4; ++m) { const int rl = ai * HALF + wr * 64 + m * 16 + fr;
                if (rl < u.x1) { const float w8 = ww[ai][m]; bf16_t* rowp = Y + (size_t)dd[ai][m] * 1024 + col0;
#pragma unroll
                    for (int bj = 0; bj < 2; ++bj) { const f32x4 v0 = acc[ai][bj][m][0] * w8, v1 = acc[ai][bj][m][1] * w8;
                        u32x4 w; w.x = cvt_pk_bf16(v0[0], v0[1]); w.y = cvt_pk_bf16(v0[2], v0[3]); w.z = cvt_pk_bf16(v1[0], v1[1]); w.w = cvt_pk_bf16(v1[2], v1[3]);
                        *(u32x4*)(rowp + bj * HALF) = w; } } }
    }
};

template <class Epi, class Sched, bool ALIGN_EPI, bool GATHER = false>
__device__ __forceinline__ void gemm_phase(PG8_LAS unsigned char* lds, const Gemm g, const Sched& S, const Epi& E, int wave0) {
    int tid_ = opaque_tid(wave0);
    const int tid = tid_, wid = __builtin_amdgcn_readfirstlane(tid >> 6), lane = tid & 63, wr = wid >> 2, wc = wid & 3, fr = lane & 15, fq = lane >> 4;
    const int K = g.K, nt = K / BK;
    unsigned voffA[2], voffA1[2], voffB[2], nv0[2], nv1[2];
#pragma unroll
    for (int i = 0; i < 2; ++i) { int R, C; stage_rc(tid * 16 + i * 8192, R, C); const int Rb = Epi::PERM ? ((R & ~31) + perm32(R & 31)) : R;
        voffA[i] = (unsigned)(R * g.lda + C) * 2u; voffB[i] = (unsigned)(Rb * g.ldb + C) * 2u; voffA1[i] = 0u; nv0[i] = 0u; nv1[i] = 0u; }
    unsigned (&vA1)[2] = GATHER ? voffA1 : voffA;
#define PG8_ROWOFFS(u_, o0, o1) do { _Pragma("unroll") for (int i = 0; i < 2; ++i) { int R, C; stage_rc(tid * 16 + i * 8192, R, C); o0[i] = S.row_off(u_, R) + (unsigned)C * 2u; o1[i] = S.row_off(u_, HALF + R) + (unsigned)C * 2u; } } while (0)
    const size_t kstep = (size_t)(BK * 2);
    const size_t hstepA = GATHER ? (size_t)0 : (size_t)HALF * g.lda * 2, hstepB = (size_t)HALF * g.ldb * 2;
    const unsigned ldsw = (unsigned)wid * 1024u;
    const int aoff = lds_byte(wr * 64 + fr, fq * 8), boff = lds_byte(wc * 32 + fr, fq * 8);
#define PG8_SA(b, h) (((b) * 2 + (h)) * HTB)
#define PG8_SB(b, h) ((4 + (b) * 2 + (h)) * HTB)
#define PG8_STAGE(bufoff, gbase, voff) do { _Pragma("unroll") for (int _i = 0; _i < 2; ++_i) \
        __builtin_amdgcn_global_load_lds((const unsigned*)((const char*)(gbase) + (voff)[_i]), (PG8_LAS unsigned*)(lds + (bufoff) + ldsw + _i * 8192), 16, 0, 0); } while (0)
#define PG8_LDA(dst, b, h) do { _Pragma("unroll") for (int m = 0; m < 4; ++m) _Pragma("unroll") for (int k = 0; k < 2; ++k) dst[m][k] = *(const PG8_LAS bf16x8*)(lds + PG8_SA(b, h) + aoff + m * 2048 + k * 1024); } while (0)
#define PG8_LDB(dst, b, h) do { _Pragma("unroll") for (int n = 0; n < 2; ++n) _Pragma("unroll") for (int k = 0; k < 2; ++k) dst[n][k] = *(const PG8_LAS bf16x8*)(lds + PG8_SB(b, h) + boff + n * 2048 + k * 1024); } while (0)
#define PG8_MMA(ai, bj, At, Bt) do { __builtin_amdgcn_s_setprio(1); _Pragma("unroll") for (int m = 0; m < 4; ++m) _Pragma("unroll") for (int n = 0; n < 2; ++n) _Pragma("unroll") for (int k = 0; k < 2; ++k) \
        acc[ai][bj][m][n] = __builtin_amdgcn_mfma_f32_16x16x32_bf16(Bt[n][k], At[m][k], acc[ai][bj][m][n], 0, 0, 0); __builtin_amdgcn_s_setprio(0); } while (0)
#define PG8_WAIT_V(n) asm volatile("s_waitcnt vmcnt(" #n ")" ::: "memory")
#define PG8_WAIT_L(n) asm volatile("s_waitcnt lgkmcnt(" #n ")" ::: "memory")
#define PG8_BAR __builtin_amdgcn_s_barrier()
#define PG8_SCHED __builtin_amdgcn_sched_barrier(0)
    Unit cur, nxt; int ui = 0;
    if (!S.next(0, cur)) return;
    f32x4 acc[2][2][4][2];
#pragma unroll
    for (int a = 0; a < 2; ++a)
#pragma unroll
        for (int b = 0; b < 2; ++b)
#pragma unroll
            for (int m = 0; m < 4; ++m)
#pragma unroll
                for (int n = 0; n < 2; ++n) acc[a][b][m][n] = (f32x4){0.f, 0.f, 0.f, 0.f};
    bf16x8 At[4][2], B0[2][2], B1[2][2];
    const char* cA = cur.a; const char* cB = cur.b;
    if constexpr (GATHER) PG8_ROWOFFS(cur, voffA, voffA1);
    PG8_STAGE(PG8_SB(0, 0), cB, voffB); PG8_STAGE(PG8_SB(0, 1), cB + hstepB, voffB); PG8_STAGE(PG8_SA(0, 0), cA, voffA); PG8_STAGE(PG8_SA(0, 1), cA + hstepA, vA1);
    if (wr == 1) PG8_BAR;
    PG8_WAIT_V(2); PG8_BAR;
    PG8_STAGE(PG8_SB(1, 0), cB + kstep, voffB); PG8_STAGE(PG8_SA(1, 0), cA + kstep, voffA); PG8_STAGE(PG8_SB(1, 1), cB + hstepB + kstep, voffB);
    PG8_WAIT_V(6); PG8_BAR;
    for (;;) {
        const bool has_next = S.next(ui + 1, nxt);
        const char* nA = has_next ? nxt.a : cA; const char* nB = has_next ? nxt.b : cB;
        if constexpr (GATHER) { if (has_next) PG8_ROWOFFS(nxt, nv0, nv1); }
        for (int t = 0; t < nt; t += 2) {
            const bool last = (t == nt - 2);
            const char* a1 = cA + (size_t)(t + 1) * kstep;
            const char* a2 = last ? nA : cA + (size_t)(t + 2) * kstep; const char* b2 = last ? nB : cB + (size_t)(t + 2) * kstep;
            const char* a3 = a2 + kstep; const char* b3 = b2 + kstep;
            PG8_LDB(B0, 0, 0); PG8_LDB(B1, 0, 1); PG8_SCHED; PG8_LDA(At, 0, 0); PG8_STAGE(PG8_SA(1, 1), a1 + hstepA, vA1);
            if constexpr (GATHER) { if (last && has_next) { voffA[0] = nv0[0]; voffA[1] = nv0[1]; voffA1[0] = nv1[0]; voffA1[1] = nv1[1]; } }
            PG8_WAIT_V(8); PG8_WAIT_L(0); PG8_BAR; PG8_MMA(0, 0, At, B0); PG8_MMA(0, 1, At, B1); PG8_BAR; PG8_SCHED;
            PG8_LDA(At, 0, 1); PG8_STAGE(PG8_SB(0, 0), b2, voffB); PG8_STAGE(PG8_SB(0, 1), b2 + hstepB, voffB); PG8_STAGE(PG8_SA(0, 0), a2, voffA);
            PG8_WAIT_V(8); PG8_WAIT_L(0); PG8_BAR; PG8_MMA(1, 0, At, B0); PG8_MMA(1, 1, At, B1); PG8_BAR; PG8_SCHED;
            PG8_LDB(B0, 1, 0); PG8_LDB(B1, 1, 1); PG8_SCHED; PG8_LDA(At, 1, 0); PG8_STAGE(PG8_SA(0, 1), a2 + hstepA, vA1);
            PG8_WAIT_V(8); PG8_WAIT_L(0); PG8_BAR; PG8_MMA(0, 0, At, B0); PG8_MMA(0, 1, At, B1); PG8_BAR; PG8_SCHED;
            PG8_LDA(At, 1, 1); PG8_STAGE(PG8_SB(1, 0), b3, voffB); PG8_STAGE(PG8_SB(1, 1), b3 + hstepB, voffB); PG8_STAGE(PG8_SA(1, 0), a3, voffA);
            PG8_WAIT_V(8); PG8_WAIT_L(0); PG8_BAR; PG8_MMA(1, 0, At, B0); PG8_MMA(1, 1, At, B1); PG8_BAR; PG8_SCHED;
        }
        if constexpr (ALIGN_EPI) { if (wr == 0) PG8_BAR; }
        E(acc, cur, wr, wc, fr, fq);
        if (!has_next) break;
#pragma unroll
        for (int a = 0; a < 2; ++a)
#pragma unroll
            for (int b = 0; b < 2; ++b)
#pragma unroll
                for (int m = 0; m < 4; ++m)
#pragma unroll
                    for (int n = 0; n < 2; ++n) acc[a][b][m][n] = (f32x4){0.f, 0.f, 0.f, 0.f};
        cur = nxt; cA = nA; cB = nB; ++ui;
        if constexpr (ALIGN_EPI) { if (wr == 1) PG8_BAR; }
    }
    PG8_WAIT_V(0);
    if constexpr (!ALIGN_EPI) { if (wr == 0) PG8_BAR; }
    PG8_BAR;
#undef PG8_SA
#undef PG8_ROWOFFS
#undef PG8_SB
#undef PG8_STAGE
#undef PG8_LDA
#undef PG8_LDB
#undef PG8_MMA
#undef PG8_WAIT_V
#undef PG8_WAIT_L
#undef PG8_BAR
#undef PG8_SCHED
}
}
namespace attn_body {
using bf16=__hip_bfloat16;
using bf16x8=__attribute__((ext_vector_type(8)))short;
using s16x4=__attribute__((ext_vector_type(4)))short;
using f32x16=__attribute__((ext_vector_type(16)))float;
using f32x4=__attribute__((ext_vector_type(4)))float;
using u32x4=__attribute__((ext_vector_type(4)))unsigned;
constexpr int BATCH=8,NHEAD=16,SEQ=4096,D=64,DM=NHEAD*D;
constexpr int NW=8,QBLK=32,QB=QBLK*NW,KVBLK=64,NQB=SEQ/QB;
constexpr int ATTN_PITCH=DM, ATTN_UNIT_ROWS=QB;
__device__ __forceinline__ int crow(int r,int hi){return (r&3)+8*(r>>2)+4*hi;}
#define SBAR() __builtin_amdgcn_sched_barrier(0)
__device__ __forceinline__ void cmask(f32x16&p0,f32x16&p1,int jb,int qrel,int hi){
  const float NEG=-INFINITY; int kb=64*jb+4*hi;
  #pragma unroll
  for(int r=0;r<16;++r){int kv=kb+(r&3)+8*(r>>2); if(kv>qrel)p0[r]=NEG; if(kv+32>qrel)p1[r]=NEG;}
}

constexpr int NSLOT=3, SLOTB=8192;
constexpr int LDS_K=0, LDS_V=NSLOT*SLOTB, LDS_WS=2*NSLOT*SLOTB, LDS_OST=LDS_WS+NW*64*4, LDS_FS=LDS_OST+NW*4096, LDS_WT=LDS_FS+SEQ*4, LDS_BYTES=LDS_WT+64;
constexpr float C2=0.125f*1.4426950408889634f;
constexpr float LOG2E=1.4426950408889634f;
__device__ __forceinline__ void glds16(const void*gsrc,unsigned lds_dst){unsigned keep;
  asm volatile("s_mov_b32 %0, m0\n\ts_mov_b32 m0, %2\n\ts_nop 0\n\tglobal_load_lds_dwordx4 %1, off\n\ts_mov_b32 m0, %0":"=&s"(keep):"v"(gsrc),"s"(lds_dst):"memory");}
__device__ __forceinline__ void glds16s(const void*sbase,unsigned voff,unsigned lds_dst){unsigned keep;
  asm volatile("s_mov_b32 %0, m0\n\ts_mov_b32 m0, %3\n\ts_nop 4\n\tglobal_load_lds_dwordx4 %1, %2\n\ts_mov_b32 m0, %0":"=&s"(keep):"v"(voff),"s"(sbase),"s"(lds_dst):"memory");}
__device__ __forceinline__ float max3f(float a,float b,float c){float r;asm("v_max3_f32 %0, %1, %2, %3":"=v"(r):"v"(a),"v"(b),"v"(c));return r;}
__device__ __forceinline__ float max2f(float a,float b){float r;asm("v_max_f32_e32 %0, %1, %2":"=v"(r):"v"(a),"v"(b));return r;}
__device__ __forceinline__ float fadd_s(float a,float b){float r;asm("v_add_f32_e32 %0, %1, %2":"=v"(r):"v"(a),"v"(b));return r;}
__device__ __forceinline__ float fsub_s(float a,float b){float r;asm("v_sub_f32_e32 %0, %1, %2":"=v"(r):"v"(a),"v"(b));return r;}
typedef float f32x2_t __attribute__((ext_vector_type(2))); typedef __bf16 bf16x2_t __attribute__((ext_vector_type(2)));
__device__ __forceinline__ unsigned cvtpk_s(float lo,float hi){f32x2_t v={lo,hi};bf16x2_t b=__builtin_convertvector(v,bf16x2_t);return __builtin_bit_cast(unsigned,b);}
#define WAIT_BAR(N) asm volatile("s_waitcnt vmcnt(" #N ") lgkmcnt(0)\n\ts_barrier":::"memory")

typedef __attribute__((address_space(3))) const char* lds_cptr;
typedef short v4i16_t __attribute__((ext_vector_type(4)));
__device__ __forceinline__ void fbias(f32x16&c0,f32x16&c1,lds_cptr ft,float nm,int hi){
  #pragma unroll
  for(int g=0;g<4;++g){
    const f32x4 a=*(const __attribute__((address_space(3))) f32x4*)(ft+(8*g+4*hi)*4);
    const f32x4 b=*(const __attribute__((address_space(3))) f32x4*)(ft+(32+8*g+4*hi)*4);
    c0[4*g+0]=nm-a[0];c0[4*g+1]=nm-a[1];c0[4*g+2]=nm-a[2];c0[4*g+3]=nm-a[3];
    c1[4*g+0]=nm-b[0];c1[4*g+1]=nm-b[1];c1[4*g+2]=nm-b[2];c1[4*g+3]=nm-b[3];}
}
__device__ __forceinline__ void qkt(f32x16&p0,f32x16&p1,const char*Kslot,const bf16x8*qr,int r32,int hi){
  const char*kb=Kslot+hi*1024+r32*16;
  #pragma unroll
  for(int d0=0;d0<4;++d0){
    const bf16x8 b0=*reinterpret_cast<const bf16x8*>(kb+d0*2048);
    const bf16x8 b1=*reinterpret_cast<const bf16x8*>(kb+d0*2048+512);
    p0=__builtin_amdgcn_mfma_f32_32x32x16_bf16(b0,qr[d0],p0,0,0,0);p1=__builtin_amdgcn_mfma_f32_32x32x16_bf16(b1,qr[d0],p1,0,0,0);}
}
__device__ __forceinline__ void kload8(bf16x8*kf,lds_cptr kp){
  kf[0]=*(const __attribute__((address_space(3))) bf16x8*)(kp);      kf[1]=*(const __attribute__((address_space(3))) bf16x8*)(kp+512);
  kf[2]=*(const __attribute__((address_space(3))) bf16x8*)(kp+2048); kf[3]=*(const __attribute__((address_space(3))) bf16x8*)(kp+2560);
  kf[4]=*(const __attribute__((address_space(3))) bf16x8*)(kp+4096); kf[5]=*(const __attribute__((address_space(3))) bf16x8*)(kp+4608);
  kf[6]=*(const __attribute__((address_space(3))) bf16x8*)(kp+6144); kf[7]=*(const __attribute__((address_space(3))) bf16x8*)(kp+6656);
}
__device__ __forceinline__ void kload2(bf16x8*kf,lds_cptr kp,int j){ kf[2*j]=*(const __attribute__((address_space(3))) bf16x8*)(kp+j*2048); kf[2*j+1]=*(const __attribute__((address_space(3))) bf16x8*)(kp+j*2048+512); }
__device__ __forceinline__ s16x4 vtr(lds_cptr p){ return __builtin_bit_cast(s16x4,__builtin_amdgcn_ds_read_tr16_b64_v4i16((__attribute__((address_space(3))) v4i16_t*)p)); }
__device__ __forceinline__ float rowmax(const f32x16&p0,const f32x16&p1){
  float a=max3f(p0[0],p0[1],p1[0]),b=max3f(p0[2],p0[3],p1[1]);a=max3f(a,p1[2],p1[3]);
  #pragma unroll
  for(int r=4;r<16;r+=4){a=max3f(a,p0[r],p0[r+1]);b=max3f(b,p0[r+2],p0[r+3]);a=max3f(a,p1[r],p1[r+1]);b=max3f(b,p1[r+2],p1[r+3]);}
  const float m=max2f(a,b);
  auto rr=__builtin_amdgcn_permlane32_swap(__float_as_uint(m),__float_as_uint(m),false,false);
  return max2f(__uint_as_float(rr[0]),__uint_as_float(rr[1]));
}
__device__ __forceinline__ void pv(f32x16*o,int vb,bf16x8 pa0,bf16x8 pa1,bf16x8 pa2,bf16x8 pa3){
  #pragma unroll
  for(int d0=0;d0<2;++d0){s16x4 lo[4],hi[4];
    #pragma unroll
    for(int ks=0;ks<4;++ks){
      asm volatile("ds_read_b64_tr_b16 %0,%1 offset:%c2":"=&v"(lo[ks]):"v"(vb),"i"(d0*4096+ks*1024):"memory");
      asm volatile("ds_read_b64_tr_b16 %0,%1 offset:%c2":"=&v"(hi[ks]):"v"(vb),"i"(d0*4096+ks*1024+512):"memory");}
    asm volatile("s_waitcnt lgkmcnt(0)":::"memory");SBAR();
    #define PK(k) (bf16x8){lo[k][0],lo[k][1],lo[k][2],lo[k][3],hi[k][0],hi[k][1],hi[k][2],hi[k][3]}
    o[d0]=__builtin_amdgcn_mfma_f32_32x32x16_bf16(pa0,PK(0),o[d0],0,0,0);
    o[d0]=__builtin_amdgcn_mfma_f32_32x32x16_bf16(pa1,PK(1),o[d0],0,0,0);
    o[d0]=__builtin_amdgcn_mfma_f32_32x32x16_bf16(pa2,PK(2),o[d0],0,0,0);
    o[d0]=__builtin_amdgcn_mfma_f32_32x32x16_bf16(pa3,PK(3),o[d0],0,0,0);
    #undef PK
  }
}

#ifndef ATTN_STORE16
#define ATTN_STORE16(p,v) (*(u32x4*)(p)=(v))
#endif
template<int THRL> __device__ __forceinline__ void attn_unit(int b,int h,int qb,const bf16*Q,const bf16*__restrict__ K,const bf16*__restrict__ V,bf16*O,const float*LF,char*shm,int wave0){
  int tid_=opaque_tid(wave0);
  const int tid=tid_,lane=tid&63,r32=lane&31,hi=lane>>5; const int wid=__builtin_amdgcn_readfirstlane(tid>>6);
  const long rowbase=(long)b*SEQ; const int q0=qb*QB;
  const bf16*Qw=Q+(rowbase+q0+wid*QBLK)*DM+h*D;
  const bf16*Kh=K+rowbase*DM+h*D,*Vh=V+rowbase*DM+h*D;
  const unsigned lds0=(unsigned)(uintptr_t)shm;
  float*wsf=(float*)(shm+LDS_WS)+wid*64;
  const lds_cptr shm3=(lds_cptr)shm;
  { const int n=q0+QB; const float*lf=LF+((long)b*NHEAD+h)*SEQ;
    unsigned wtb_=(unsigned)(uintptr_t)(shm3+LDS_WT); asm volatile("":"+v"(wtb_));
    volatile __attribute__((address_space(3))) float*wt=(volatile __attribute__((address_space(3))) float*)wtb_;
    f32x4 v0=(f32x4){0.f,0.f,0.f,0.f},v1=(f32x4){0.f,0.f,0.f,0.f};
    if(8*tid<n){v0=*(const f32x4*)(lf+8*tid);v1=*(const f32x4*)(lf+8*tid+4);}
    v0[1]+=v0[0];v0[2]+=v0[1];v0[3]+=v0[2];v1[0]+=v0[3];v1[1]+=v1[0];v1[2]+=v1[1];v1[3]+=v1[2];
    const float tot=v1[3]; float inc=tot;
    #pragma unroll
    for(int o_=1;o_<64;o_<<=1){const float t_=__int_as_float(__builtin_amdgcn_ds_bpermute((lane-o_)<<2,__float_as_int(inc)));if(lane>=o_)inc+=t_;}
    if(lane==63)wt[wid]=inc;
    __syncthreads();
    float base=inc-tot;
    #pragma unroll
    for(int w_=0;w_<NW;++w_){const float x_=wt[w_]; if(w_<wid)base+=x_;}
    if(tid==(q0>>3))wt[8]=base+v0[0];
    __syncthreads();
    const float anc=wt[8];
    if(8*tid<n){ __attribute__((address_space(3))) f32x4*fo=(__attribute__((address_space(3))) f32x4*)(shm3+LDS_FS)+2*tid;
      fo[0]=(v0+(base-anc))*LOG2E; fo[1]=(v1+(base-anc))*LOG2E; }
  }
  const lds_cptr fs3=shm3+LDS_FS;
  const bf16*ksrc=Kh+(long)lane*DM+wid*8;
  const bf16*vsrc=Vh+(long)(16*(wid&3)+(lane>>2))*DM+(wid>>2)*32+(lane&3)*8;
  const unsigned kdst=lds0+LDS_K+wid*1024, vdst=lds0+LDS_V+wid*1024;
  #define DMA_K(t,slot) glds16(ksrc+(long)(t)*KVBLK*DM,(unsigned)__builtin_amdgcn_readfirstlane(kdst+(slot)))
  #define DMA_V(t,slot) glds16(vsrc+(long)(t)*KVBLK*DM,(unsigned)__builtin_amdgcn_readfirstlane(vdst+(slot)))
  const int vb0=(int)(lds0+LDS_V)+((lane>>4)&1)*32+(lane&3)*8+(4*hi+((lane&15)>>2))*64;
  const char*Kbase=shm+LDS_K; bf16x8 kf[8];
  const lds_cptr kp0=shm3+LDS_K+hi*1024+r32*16; const lds_cptr vp0=shm3+LDS_V+((lane>>4)&1)*32+(lane&3)*8+(4*hi+((lane&15)>>2))*64;
  const int NT=(q0+QB)/KVBLK;
  DMA_K(0,0);DMA_V(0,0);DMA_K(1,SLOTB);
  bf16x8 qr[4];
  #pragma unroll
  for(int d0=0;d0<4;++d0)qr[d0]=*reinterpret_cast<const bf16x8*>(&Qw[(long)r32*DM+d0*16+hi*8]);
  float mhat=0.f,l_reg=0.f;f32x16 o[2];o[0]=f32x16{};o[1]=f32x16{};
  const int qrel=wid*QBLK+r32;
  #define CMASK(P0,P1,t) do{int jb_=(t)-(NT-4); if(jb_>=0)cmask(P0,P1,jb_,qrel,hi);}while(0)
  bool resc=false;
  #define START(P0,P1) do{ const float rm=rowmax(P0,P1); resc=false; \
    { const float dl=rm; mhat=fadd_s(mhat,dl); \
      _Pragma("unroll") for(int r=0;r<16;++r){P0[r]=fsub_s(P0[r],dl);P1[r]=fsub_s(P1[r],dl);} } \
    _Pragma("unroll") for(int r=0;r<16;++r)P0[r]=__builtin_amdgcn_exp2f(P0[r]); }while(0)
  #define RESC() do{ if(resc){ asm volatile("s_waitcnt lgkmcnt(0)":::"memory"); \
      _Pragma("unroll") for(int d_=0;d_<2;++d_) _Pragma("unroll") for(int r=0;r<16;++r)o[d_][r]*=wsf[crow(r,hi)]; } }while(0)
  f32x16 pA0,pA1,pB0,pB1;
  int sl_prev=0,sl_cur=0,sl_next=SLOTB;
  #define ROT() do{sl_prev=sl_cur;sl_cur=sl_next;sl_next=(sl_next==(NSLOT-1)*SLOTB)?0:sl_next+SLOTB;}while(0)
  DMA_K(2,2*SLOTB);
  WAIT_BAR(3);
  fbias(pA0,pA1,fs3,0.f,hi);
  qkt(pA0,pA1,Kbase,qr,r32,hi);asm volatile("s_nop 15\n\ts_nop 7":"+v"(pA0),"+v"(pA1));CMASK(pA0,pA1,0);
  START(pA0,pA1);
  _Pragma("unroll") for(int r=0;r<16;++r)pA1[r]=__builtin_amdgcn_exp2f(pA1[r]);
  WAIT_BAR(0);
  DMA_K(3,0);DMA_V(1,SLOTB);
  ROT();
  kload8(kf,kp0+sl_cur);
  WAIT_BAR(2);
  s16x4 vlo[8],vhi[8]; u32x4 pw0,pw1,pw2,pw3;
  #define PKW(P,B) cvtpk_s(P[B],P[B+1])
  #define PAF(k) __builtin_bit_cast(bf16x8,pw##k)
  #define VFR(i) (bf16x8){vlo[i][0],vlo[i][1],vlo[i][2],vlo[i][3],vhi[i][0],vhi[i][1],vhi[i][2],vhi[i][3]}
  #define PIN(x) asm volatile("":"+v"(x))
  #define MX3(a,b,c) __builtin_fmaxf(__builtin_fmaxf((a),(b)),(c))
  #define GAPA(MF,A0,A1,A2,A3,W0,W1,PW) do{ MF; sacc+=A0; sacc+=A1; sacc+=A2; sacc+=A3; PIN(sacc); W0; W1; PIN(PW); SBAR(); }while(0)
  #define EX(v) __builtin_amdgcn_exp2f(v)
  #define GAPB(MF,X,B) do{ MF; X[B]=EX(X[B]); X[B+1]=EX(X[B+1]); X[B+2]=EX(X[B+2]); X[B+3]=EX(X[B+3]); PIN(X); SBAR(); }while(0)
  #define VRD(i) do{ vlo[i]=vtr(vp_+(((i)>>2)*4096+((i)&3)*1024)); vhi[i]=vtr(vp_+(((i)>>2)*4096+((i)&3)*1024+512)); }while(0)
  #define KRD(G,j) do{ if(G){ kload2(kf,kp0+sl_next,j); SBAR(); } }while(0)
  #define STEP(C0,C1,P0,P1,t,GK,GV,GL) do{ SBAR(); \
    const lds_cptr vp_=vp0+sl_prev; \
    fbias(C0,C1,fs3+(t)*256,-mhat,hi); SBAR(); \
    VRD(0); SBAR(); float sacc=(P0[0]+P0[1]); \
    GAPA(C0=__builtin_amdgcn_mfma_f32_32x32x16_bf16(kf[0],qr[0],C0,0,0,0), P0[2],P0[3],P0[4],P0[5],     pw0[0]=PKW(P0,0), pw0[1]=PKW(P0,2), pw0); \
    VRD(4); SBAR(); GAPA(C1=__builtin_amdgcn_mfma_f32_32x32x16_bf16(kf[1],qr[0],C1,0,0,0), P0[6],P0[7],P0[8],P0[9],     pw0[2]=PKW(P0,4), pw0[3]=PKW(P0,6), pw0); \
    VRD(1); SBAR(); GAPA(C0=__builtin_amdgcn_mfma_f32_32x32x16_bf16(kf[2],qr[1],C0,0,0,0),   P0[10],P0[11],P0[12],P0[13], pw1[0]=PKW(P0,8), pw1[1]=PKW(P0,10), pw1); \
    VRD(5); SBAR(); GAPA(C1=__builtin_amdgcn_mfma_f32_32x32x16_bf16(kf[3],qr[1],C1,0,0,0),   P0[14],P0[15],P1[0],P1[1],   pw1[2]=PKW(P0,12),pw1[3]=PKW(P0,14), pw1); \
    VRD(2); SBAR(); GAPA(C0=__builtin_amdgcn_mfma_f32_32x32x16_bf16(kf[4],qr[2],C0,0,0,0),   P1[2],P1[3],P1[4],P1[5],     pw2[0]=PKW(P1,0), pw2[1]=PKW(P1,2), pw2); \
    VRD(6); SBAR(); GAPA(C1=__builtin_amdgcn_mfma_f32_32x32x16_bf16(kf[5],qr[2],C1,0,0,0),   P1[6],P1[7],P1[8],P1[9],     pw2[2]=PKW(P1,4), pw2[3]=PKW(P1,6), pw2); \
    VRD(3); SBAR(); GAPA(C0=__builtin_amdgcn_mfma_f32_32x32x16_bf16(kf[6],qr[3],C0,0,0,0),   P1[10],P1[11],P1[12],P1[13], pw3[0]=PKW(P1,8), pw3[1]=PKW(P1,10), pw3); \
    VRD(7); SBAR(); GAPA(C1=__builtin_amdgcn_mfma_f32_32x32x16_bf16(kf[7],qr[3],C1,0,0,0),   P1[14],P1[15],0.f,0.f,       pw3[2]=PKW(P1,12),pw3[3]=PKW(P1,14), pw3); \
    l_reg+=sacc; \
    if(GK){DMA_K((t)+3,sl_cur);} if(GV){DMA_V((t)+1,sl_next);} \
    CMASK(C0,C1,t); \
    { float a=MX3(C0[0],C0[1],C1[0]),b=MX3(C0[2],C0[3],C1[1]); a=MX3(a,C1[2],C1[3]); \
      _Pragma("unroll") for(int r=4;r<16;r+=4){a=MX3(a,C0[r],C0[r+1]);b=MX3(b,C0[r+2],C0[r+3]);a=MX3(a,C1[r],C1[r+1]);b=MX3(b,C1[r+2],C1[r+3]);} \
      float rm=__builtin_fmaxf(a,b); { auto rr=__builtin_amdgcn_permlane32_swap(__float_as_uint(rm),__float_as_uint(rm),false,false); rm=__builtin_fmaxf(__uint_as_float(rr[0]),__uint_as_float(rr[1])); } \
      resc=false; \
      if(__builtin_expect(__any(rm>(float)THRL),0)){ const float dl=__builtin_fmaxf(rm,0.f); mhat+=dl; \
        _Pragma("unroll") for(int r=0;r<16;++r){C0[r]-=dl;C1[r]-=dl;} \
        const float f=__builtin_amdgcn_exp2f(-dl); l_reg*=f; if(hi==0)wsf[r32]=f; resc=true; } } \
    SBAR(); \
    GAPB(o[0]=__builtin_amdgcn_mfma_f32_32x32x16_bf16(PAF(0),VFR(0),o[0],0,0,0), C0,0); \
    GAPB(o[1]=__builtin_amdgcn_mfma_f32_32x32x16_bf16(PAF(0),VFR(4),o[1],0,0,0), C0,4); \
    KRD(GL,0); GAPB(o[0]=__builtin_amdgcn_mfma_f32_32x32x16_bf16(PAF(1),VFR(1),o[0],0,0,0), C0,8); \
    KRD(GL,1); GAPB(o[1]=__builtin_amdgcn_mfma_f32_32x32x16_bf16(PAF(1),VFR(5),o[1],0,0,0), C0,12); \
    KRD(GL,2); GAPB(o[0]=__builtin_amdgcn_mfma_f32_32x32x16_bf16(PAF(2),VFR(2),o[0],0,0,0), C1,0); \
    KRD(GL,3); GAPB(o[1]=__builtin_amdgcn_mfma_f32_32x32x16_bf16(PAF(2),VFR(6),o[1],0,0,0), C1,4); \
    GAPB(o[0]=__builtin_amdgcn_mfma_f32_32x32x16_bf16(PAF(3),VFR(3),o[0],0,0,0), C1,8); \
    GAPB(o[1]=__builtin_amdgcn_mfma_f32_32x32x16_bf16(PAF(3),VFR(7),o[1],0,0,0), C1,12); \
    }while(0)
  int t=1;
  #undef CMASK
  #define CMASK(P0,P1,t) do{}while(0)
  for(;t+5<NT;t+=2){
    STEP(pB0,pB1,pA0,pA1,t,true,true,true);     WAIT_BAR(2); RESC(); ROT();
    STEP(pA0,pA1,pB0,pB1,t+1,true,true,true);   WAIT_BAR(2); RESC(); ROT();
  }
  #undef CMASK
  #define CMASK(P0,P1,t) do{int jb_=(t)-(NT-4); if(jb_>=0)cmask(P0,P1,jb_,qrel,hi);}while(0)
  #define ENDW(tt) do{ if((tt)+3<NT){WAIT_BAR(2);} else if((tt)+2<NT){WAIT_BAR(1);} else {WAIT_BAR(0);} }while(0)
  for(;t+1<NT;t+=2){
    STEP(pB0,pB1,pA0,pA1,t,(t+3<NT),(t+1<NT),(t+1<NT));       ENDW(t);   RESC(); ROT();
    STEP(pA0,pA1,pB0,pB1,t+1,(t+4<NT),(t+2<NT),(t+2<NT));     ENDW(t+1); RESC(); ROT();
  }
  STEP(pB0,pB1,pA0,pA1,NT-1,false,false,false); RESC();
  { float sacc=pB0[0]+pB0[1]; _Pragma("unroll") for(int r=2;r<16;++r)sacc+=pB0[r]; _Pragma("unroll") for(int r=0;r<16;++r)sacc+=pB1[r]; l_reg+=sacc;
    pw0=(u32x4){PKW(pB0,0),PKW(pB0,2),PKW(pB0,4),PKW(pB0,6)};pw1=(u32x4){PKW(pB0,8),PKW(pB0,10),PKW(pB0,12),PKW(pB0,14)};pw2=(u32x4){PKW(pB1,0),PKW(pB1,2),PKW(pB1,4),PKW(pB1,6)};pw3=(u32x4){PKW(pB1,8),PKW(pB1,10),PKW(pB1,12),PKW(pB1,14)};
    SBAR(); pv(o,vb0+sl_cur,PAF(0),PAF(1),PAF(2),PAF(3)); }
  #undef PKW
  #undef PAF
  #undef VFR
  #undef PIN
  #undef MX3
  #undef GAPA
  #undef GAPB
  #undef EX
  #undef VRD
  #undef KRD
  #undef STEP
  #undef ENDW
  {auto rr=__builtin_amdgcn_permlane32_swap(__float_as_uint(l_reg),__float_as_uint(l_reg),false,false);l_reg=__uint_as_float(rr[0])+__uint_as_float(rr[1]);}
  if(hi==0)wsf[32+r32]=l_reg;asm volatile("s_waitcnt lgkmcnt(0)":::"memory");
  float rli[16];
  #pragma unroll
  for(int r=0;r<16;++r)rli[r]=__builtin_amdgcn_rcpf(wsf[32+crow(r,hi)]);
  bf16*Ow=O+(rowbase+q0+wid*QBLK)*DM+h*D;
  { bf16*stg=(bf16*)(shm+LDS_OST)+wid*2048;
    #pragma unroll
    for(int r=0;r<16;++r){const int orow=crow(r,hi);
      #pragma unroll
      for(int d0=0;d0<2;++d0)stg[orow*64+d0*32+r32]=__float2bfloat16(o[d0][r]*rli[r]);}
    asm volatile("s_waitcnt lgkmcnt(0)":::"memory");
    #pragma unroll
    for(int i=0;i<4;++i){const int row=i*8+(lane>>3),ch=lane&7; const u32x4 v=*(const u32x4*)(stg+row*64+ch*8); ATTN_STORE16(Ow+(long)row*DM+ch*8,v);} }
  asm volatile("s_waitcnt lgkmcnt(0)\n\ts_barrier":::"memory");
  #undef DMA_K
  #undef DMA_V
  #undef CMASK
  #undef START
  #undef RESC
  #undef ROT
}

constexpr float T_UNDER=150.f;
template<int DUMMY> __device__ __forceinline__ void attn_unit_fast(int b,int h,int qb,float M,const bf16*Q,const bf16*__restrict__ K,const bf16*__restrict__ V,bf16*O,const float*LF,char*shm,int wave0){
  int tid_=opaque_tid(wave0);
  const int tid=tid_,lane=tid&63,r32=lane&31,hi=lane>>5; const int wid=__builtin_amdgcn_readfirstlane(tid>>6);
  const long rowbase=(long)b*SEQ; const int q0=qb*QB;
  const bf16*Qw=Q+(rowbase+q0+wid*QBLK)*DM+h*D;
  const bf16*Kh=K+rowbase*DM+h*D,*Vh=V+rowbase*DM+h*D;
  const unsigned lds0=(unsigned)(uintptr_t)shm;
  const lds_cptr shm3=(lds_cptr)shm;
  { const int n=q0+QB; const float*lf=LF+((long)b*NHEAD+h)*SEQ;
    unsigned wtb_=(unsigned)(uintptr_t)(shm3+LDS_WT); asm volatile("":"+v"(wtb_));
    volatile __attribute__((address_space(3))) float*wt=(volatile __attribute__((address_space(3))) float*)wtb_;
    f32x4 v0=(f32x4){0.f,0.f,0.f,0.f},v1=(f32x4){0.f,0.f,0.f,0.f};
    if(8*tid<n){v0=*(const f32x4*)(lf+8*tid);v1=*(const f32x4*)(lf+8*tid+4);}
    v0[1]+=v0[0];v0[2]+=v0[1];v0[3]+=v0[2];v1[0]+=v0[3];v1[1]+=v1[0];v1[2]+=v1[1];v1[3]+=v1[2];
    const float tot=v1[3]; float inc=tot;
    #pragma unroll
    for(int o_=1;o_<64;o_<<=1){const float t_=__int_as_float(__builtin_amdgcn_ds_bpermute((lane-o_)<<2,__float_as_int(inc)));if(lane>=o_)inc+=t_;}
    if(lane==63)wt[wid]=inc;
    __syncthreads();
    float base=inc-tot;
    #pragma unroll
    for(int w_=0;w_<NW;++w_){const float x_=wt[w_]; if(w_<wid)base+=x_;}
    if(tid==(q0>>3))wt[8]=base+v0[0];
    __syncthreads();
    const float anc=wt[8];
    if(8*tid<n){ __attribute__((address_space(3))) f32x4*fo=(__attribute__((address_space(3))) f32x4*)(shm3+LDS_FS)+2*tid;
      fo[0]=(v0+(base-anc))*LOG2E; fo[1]=(v1+(base-anc))*LOG2E; }
  }
  const lds_cptr fs3=shm3+LDS_FS;
  const int NT=(q0+QB)/KVBLK;
  const char*kbase=(const char*)(Kh+(long)(NT-1)*KVBLK*DM),*vbase=(const char*)(Vh+(long)(NT-1)*KVBLK*DM);
  const unsigned koff=(unsigned)((lane*DM+wid*8)*2), voff=(unsigned)(((16*(wid&3)+(lane>>2))*DM+(wid>>2)*32+(lane&3)*8)*2);
  const unsigned kdst=lds0+LDS_K+wid*1024, vdst=lds0+LDS_V+wid*1024;
  #define DMA_K(t,slot) glds16s(kbase-(long)(t)*(KVBLK*DM*2),koff,(unsigned)__builtin_amdgcn_readfirstlane(kdst+(slot)))
  #define DMA_V(t,slot) glds16s(vbase-(long)(t)*(KVBLK*DM*2),voff,(unsigned)__builtin_amdgcn_readfirstlane(vdst+(slot)))
  const char*Kbase=shm+LDS_K; bf16x8 kf[8];
  const lds_cptr kp0=shm3+LDS_K+hi*1024+r32*16; const lds_cptr vp0=shm3+LDS_V+((lane>>4)&1)*32+(lane&3)*8+(4*hi+((lane&15)>>2))*64;
  DMA_K(0,0);DMA_V(0,0);DMA_K(1,SLOTB);
  bf16x8 qr[4];
  #pragma unroll
  for(int d0=0;d0<4;++d0)qr[d0]=*reinterpret_cast<const bf16x8*>(&Qw[(long)r32*DM+d0*16+hi*8]);
  float l_reg=0.f;f32x16 o[2];o[0]=f32x16{};o[1]=f32x16{};
  const int qrel=wid*QBLK+r32;
  #define CMASK(P0,P1,t) do{int jb_=3-(t); if(jb_>=0)cmask(P0,P1,jb_,qrel,hi);}while(0)
  f32x16 pA0,pA1,pB0,pB1;
  int sl_prev=0,sl_cur=0,sl_next=SLOTB;
  #define ROT() do{sl_prev=sl_cur;sl_cur=sl_next;sl_next=(sl_next==(NSLOT-1)*SLOTB)?0:sl_next+SLOTB;}while(0)
  DMA_K(2,2*SLOTB);
  WAIT_BAR(3);
  const float nm=*(const __attribute__((address_space(3))) float*)(fs3+(q0+qrel)*4)-M;
  int NP;
  { const float fv=(lane<NT)?*(const __attribute__((address_space(3))) float*)(fs3+(64*lane+63)*4):0.f;
    const unsigned long long bal=__ballot((lane<NT)&&(fv>2.f*M+T_UNDER));
    const int tstop=__builtin_popcountll(bal); int np=NT-tstop; np=(np+1)&~1; NP=np<4?4:np; NP=__builtin_amdgcn_readfirstlane(NP); }
  fbias(pA0,pA1,fs3+(NT-1)*256,nm,hi);
  qkt(pA0,pA1,Kbase,qr,r32,hi);asm volatile("s_nop 15\n\ts_nop 7":"+v"(pA0),"+v"(pA1));CMASK(pA0,pA1,0);
  _Pragma("unroll") for(int r=0;r<16;++r){pA0[r]=__builtin_amdgcn_exp2f(pA0[r]);pA1[r]=__builtin_amdgcn_exp2f(pA1[r]);}
  WAIT_BAR(0);
  DMA_K(3,0);DMA_V(1,SLOTB);
  ROT();
  kload8(kf,kp0+sl_cur);
  fbias(pB0,pB1,fs3+(NT-2)*256,nm,hi);
  WAIT_BAR(2);
  s16x4 vlo[8],vhi[8]; u32x4 pw0,pw1,pw2,pw3;
  #define PKW(P,B) cvtpk_s(P[B],P[B+1])
  #define PAF(k) __builtin_bit_cast(bf16x8,pw##k)
  #define VFR(i) (bf16x8){vlo[i][0],vlo[i][1],vlo[i][2],vlo[i][3],vhi[i][0],vhi[i][1],vhi[i][2],vhi[i][3]}
  #define PIN(x) asm volatile("":"+v"(x))
  #define GAPA(MF,A0,A1,A2,A3,W0,W1,PW) do{ MF; sacc+=A0; sacc+=A1; sacc+=A2; sacc+=A3; PIN(sacc); W0; W1; PIN(PW); SBAR(); }while(0)
  #define EX(v) __builtin_amdgcn_exp2f(v)
  #define GAPB(MF,X,B,Y,GL) do{ MF; X[B]=EX(X[B]); X[B+1]=EX(X[B+1]); X[B+2]=EX(X[B+2]); X[B+3]=EX(X[B+3]); PIN(X); \
      if(GL){ Y[B]=nm-Y[B]; Y[B+1]=nm-Y[B+1]; Y[B+2]=nm-Y[B+2]; Y[B+3]=nm-Y[B+3]; PIN(Y); } SBAR(); }while(0)
  #define VRD(i) do{ vlo[i]=vtr(vp_+(((i)>>2)*4096+((i)&3)*1024)); vhi[i]=vtr(vp_+(((i)>>2)*4096+((i)&3)*1024+512)); }while(0)
  #define KRD(G,j) do{ if(G){ kload2(kf,kp0+sl_next,j); SBAR(); } }while(0)
  #define FLD(Y0,Y1,t) do{ const lds_cptr ft_=fs3+(NT-2-(t))*256+hi*16; \
      _Pragma("unroll") for(int g_=0;g_<4;++g_){ const f32x4 a_=*(const __attribute__((address_space(3))) f32x4*)(ft_+g_*32); const f32x4 b_=*(const __attribute__((address_space(3))) f32x4*)(ft_+128+g_*32); \
        Y0[4*g_]=a_[0];Y0[4*g_+1]=a_[1];Y0[4*g_+2]=a_[2];Y0[4*g_+3]=a_[3]; Y1[4*g_]=b_[0];Y1[4*g_+1]=b_[1];Y1[4*g_+2]=b_[2];Y1[4*g_+3]=b_[3]; } }while(0)
  #define STEP(C0,C1,P0,P1,t,GK,GV,GL) do{ SBAR(); \
    const lds_cptr vp_=vp0+sl_prev; \
    VRD(0); SBAR(); float sacc=(P0[0]+P0[1]); \
    GAPA(C0=__builtin_amdgcn_mfma_f32_32x32x16_bf16(kf[0],qr[0],C0,0,0,0), P0[2],P0[3],P0[4],P0[5],     pw0[0]=PKW(P0,0), pw0[1]=PKW(P0,2), pw0); \
    VRD(4); SBAR(); GAPA(C1=__builtin_amdgcn_mfma_f32_32x32x16_bf16(kf[1],qr[0],C1,0,0,0), P0[6],P0[7],P0[8],P0[9],     pw0[2]=PKW(P0,4), pw0[3]=PKW(P0,6), pw0); \
    VRD(1); SBAR(); GAPA(C0=__builtin_amdgcn_mfma_f32_32x32x16_bf16(kf[2],qr[1],C0,0,0,0),   P0[10],P0[11],P0[12],P0[13], pw1[0]=PKW(P0,8), pw1[1]=PKW(P0,10), pw1); \
    VRD(5); SBAR(); GAPA(C1=__builtin_amdgcn_mfma_f32_32x32x16_bf16(kf[3],qr[1],C1,0,0,0),   P0[14],P0[15],P1[0],P1[1],   pw1[2]=PKW(P0,12),pw1[3]=PKW(P0,14), pw1); \
    VRD(2); SBAR(); GAPA(C0=__builtin_amdgcn_mfma_f32_32x32x16_bf16(kf[4],qr[2],C0,0,0,0),   P1[2],P1[3],P1[4],P1[5],     pw2[0]=PKW(P1,0), pw2[1]=PKW(P1,2), pw2); \
    VRD(6); SBAR(); GAPA(C1=__builtin_amdgcn_mfma_f32_32x32x16_bf16(kf[5],qr[2],C1,0,0,0),   P1[6],P1[7],P1[8],P1[9],     pw2[2]=PKW(P1,4), pw2[3]=PKW(P1,6), pw2); \
    VRD(3); SBAR(); GAPA(C0=__builtin_amdgcn_mfma_f32_32x32x16_bf16(kf[6],qr[3],C0,0,0,0),   P1[10],P1[11],P1[12],P1[13], pw3[0]=PKW(P1,8), pw3[1]=PKW(P1,10), pw3); \
    VRD(7); SBAR(); GAPA(C1=__builtin_amdgcn_mfma_f32_32x32x16_bf16(kf[7],qr[3],C1,0,0,0),   P1[14],P1[15],0.f,0.f,       pw3[2]=PKW(P1,12),pw3[3]=PKW(P1,14), pw3); \
    l_reg+=sacc; \
    if(GK){DMA_K((t)+3,sl_cur);} if(GV){DMA_V((t)+1,sl_next);} \
    CMASK(C0,C1,t); \
    if(GL){ FLD(P0,P1,t); } \
    SBAR(); \
    GAPB(o[0]=__builtin_amdgcn_mfma_f32_32x32x16_bf16(PAF(0),VFR(0),o[0],0,0,0), C0,0,P0,GL); \
    GAPB(o[1]=__builtin_amdgcn_mfma_f32_32x32x16_bf16(PAF(0),VFR(4),o[1],0,0,0), C0,4,P0,GL); \
    KRD(GL,0); GAPB(o[0]=__builtin_amdgcn_mfma_f32_32x32x16_bf16(PAF(1),VFR(1),o[0],0,0,0), C0,8,P0,GL); \
    KRD(GL,1); GAPB(o[1]=__builtin_amdgcn_mfma_f32_32x32x16_bf16(PAF(1),VFR(5),o[1],0,0,0), C0,12,P0,GL); \
    KRD(GL,2); GAPB(o[0]=__builtin_amdgcn_mfma_f32_32x32x16_bf16(PAF(2),VFR(2),o[0],0,0,0), C1,0,P1,GL); \
    KRD(GL,3); GAPB(o[1]=__builtin_amdgcn_mfma_f32_32x32x16_bf16(PAF(2),VFR(6),o[1],0,0,0), C1,4,P1,GL); \
    GAPB(o[0]=__builtin_amdgcn_mfma_f32_32x32x16_bf16(PAF(3),VFR(3),o[0],0,0,0), C1,8,P1,GL); \
    GAPB(o[1]=__builtin_amdgcn_mfma_f32_32x32x16_bf16(PAF(3),VFR(7),o[1],0,0,0), C1,12,P1,GL); \
    }while(0)
  #define ENDW(tt) do{ if((tt)+3<NP){WAIT_BAR(2);} else if((tt)+2<NP){WAIT_BAR(1);} else {WAIT_BAR(0);} }while(0)
  int t=1;
  for(;t<5&&t+1<NP;t+=2){
    STEP(pB0,pB1,pA0,pA1,t,(t+3<NP),(t+1<NP),(t+1<NP));       ENDW(t);   ROT();
    STEP(pA0,pA1,pB0,pB1,t+1,(t+4<NP),(t+2<NP),(t+2<NP));     ENDW(t+1); ROT();
  }
  #undef CMASK
  #define CMASK(P0,P1,t) do{}while(0)
  for(;t+5<NP;t+=2){
    STEP(pB0,pB1,pA0,pA1,t,true,true,true);     WAIT_BAR(2); ROT();
    STEP(pA0,pA1,pB0,pB1,t+1,true,true,true);   WAIT_BAR(2); ROT();
  }
  for(;t+1<NP;t+=2){
    STEP(pB0,pB1,pA0,pA1,t,(t+3<NP),(t+1<NP),(t+1<NP));       ENDW(t);   ROT();
    STEP(pA0,pA1,pB0,pB1,t+1,(t+4<NP),(t+2<NP),(t+2<NP));     ENDW(t+1); ROT();
  }
  #undef CMASK
  #define CMASK(P0,P1,t) do{int jb_=3-(t); if(jb_>=0)cmask(P0,P1,jb_,qrel,hi);}while(0)
  STEP(pB0,pB1,pA0,pA1,NP-1,false,false,false);
  const int tidE=opaque_tid(wave0),laneE=tidE&63,r32E=laneE&31,hiE=laneE>>5; const int widE=__builtin_amdgcn_readfirstlane(tidE>>6);
  const int vb0=(int)(lds0+LDS_V)+((laneE>>4)&1)*32+(laneE&3)*8+(4*hiE+((laneE&15)>>2))*64;
  float*wsf=(float*)(shm+LDS_WS)+widE*64;
  { float sacc=pB0[0]+pB0[1]; _Pragma("unroll") for(int r=2;r<16;++r)sacc+=pB0[r]; _Pragma("unroll") for(int r=0;r<16;++r)sacc+=pB1[r]; l_reg+=sacc;
    pw0=(u32x4){PKW(pB0,0),PKW(pB0,2),PKW(pB0,4),PKW(pB0,6)};pw1=(u32x4){PKW(pB0,8),PKW(pB0,10),PKW(pB0,12),PKW(pB0,14)};pw2=(u32x4){PKW(pB1,0),PKW(pB1,2),PKW(pB1,4),PKW(pB1,6)};pw3=(u32x4){PKW(pB1,8),PKW(pB1,10),PKW(pB1,12),PKW(pB1,14)};
    SBAR(); pv(o,vb0+sl_cur,PAF(0),PAF(1),PAF(2),PAF(3)); }
  #undef PKW
  #undef PAF
  #undef VFR
  #undef PIN
  #undef GAPA
  #undef GAPB
  #undef EX
  #undef VRD
  #undef KRD
  #undef FLD
  #undef STEP
  #undef ENDW
  {auto rr=__builtin_amdgcn_permlane32_swap(__float_as_uint(l_reg),__float_as_uint(l_reg),false,false);l_reg=__uint_as_float(rr[0])+__uint_as_float(rr[1]);}
  if(hiE==0)wsf[32+r32E]=l_reg;asm volatile("s_waitcnt lgkmcnt(0)":::"memory");
  float rli[16];
  #pragma unroll
  for(int r=0;r<16;++r)rli[r]=__builtin_amdgcn_rcpf(wsf[32+crow(r,hiE)]);
  bf16*Ow=O+(rowbase+q0+widE*QBLK)*DM+h*D;
  { bf16*stg=(bf16*)(shm+LDS_OST)+widE*2048;
    #pragma unroll
    for(int r=0;r<16;++r){const int orow=crow(r,hiE);
      #pragma unroll
      for(int d0=0;d0<2;++d0)stg[orow*64+d0*32+r32E]=__float2bfloat16(o[d0][r]*rli[r]);}
    asm volatile("s_waitcnt lgkmcnt(0)":::"memory");
    #pragma unroll
    for(int i=0;i<4;++i){const int row=i*8+(laneE>>3),ch=laneE&7; const u32x4 v=*(const u32x4*)(stg+row*64+ch*8); ATTN_STORE16(Ow+(long)row*DM+ch*8,v);} }
  asm volatile("s_waitcnt lgkmcnt(0)\n\ts_barrier":::"memory");
  #undef DMA_K
  #undef DMA_V
  #undef CMASK
  #undef ROT
}
constexpr int ATTN_LDS_BYTES=LDS_BYTES;
struct AttnTensors { const bf16* Q; const bf16* K; const bf16* V; bf16* O; const float* LF; const unsigned* QKM; };
struct AttnUnit { int bh; int qb; };
struct StaticOrder {
  int vcu;
  __device__ __forceinline__ explicit StaticOrder(int grid,int block):vcu((block%8)*(grid/8)+block/8){}
  __device__ __forceinline__ bool next(int i,AttnUnit&u)const{ if(i>=8)return false; const int s=vcu&1, j=7-i, base=4*(j>>1); u.bh=vcu>>1; u.qb=base+((j&1)?(s?2:3):(s?1:0)); return true; }
};
template<int THRL=8> __device__ __forceinline__ void attn_phase(char*lds,const AttnTensors&T,unsigned*ctr,int wave0){
  for(;;){
    const int tq=opaque_tid(wave0);
    const unsigned uwb_=(unsigned)(uintptr_t)((lds_cptr)lds+LDS_WT+48)+((unsigned)tq>>9);
    volatile __attribute__((address_space(3))) unsigned*uw=(volatile __attribute__((address_space(3))) unsigned*)uwb_;
    if(tq==0)*uw=__hip_atomic_fetch_add(ctr,1u,__ATOMIC_RELAXED,__HIP_MEMORY_SCOPE_AGENT);
    __syncthreads();
    const unsigned k=__builtin_amdgcn_readfirstlane(*uw);
    if(k>=(unsigned)(BATCH*NHEAD*NQB))break;
    const int qb=NQB-1-(int)(k>>7), bh=(int)(k&127), b=bh/NHEAD,h=bh%NHEAD;
    const unsigned* qm=T.QKM+(0*8+b)*32+2*h; const unsigned* km=T.QKM+(1*8+b)*32+2*h;
    const float q2=__uint_as_float(__builtin_amdgcn_readfirstlane(qm[0]))+__uint_as_float(__builtin_amdgcn_readfirstlane(qm[1])), k2=__uint_as_float(__builtin_amdgcn_readfirstlane(km[0]))+__uint_as_float(__builtin_amdgcn_readfirstlane(km[1]));
    const float M=1.02f*sqrtf(q2*k2)+1e-3f;
    if(M<55.f) attn_unit_fast<0>(b,h,qb,M,T.Q,T.K,T.V,T.O,T.LF,lds,wave0);
    else attn_unit<THRL>(b,h,qb,T.Q,T.K,T.V,T.O,T.LF,lds,wave0);
  }
}
#undef SBAR
#undef WAIT_BAR
}
constexpr int NWAVES = 8;
#ifndef MK_MULTI
#define MK_MULTI 0
#endif

constexpr int BATCH = 8, SEQ = 4096, D = 1024, H = 16, HD = 64, NE = 32, FD = 512, NLAYER = 2;
constexpr int T = BATCH * SEQ;
constexpr int MODW = 6 * D;
constexpr float RMS_EPS = 1e-6f;
constexpr int WIN_LD = 3 * D + H;
constexpr int ECAP = 32768;
constexpr int PMAX = 2 * T + NE * 256;

constexpr size_t MiB = 1u << 20;
constexpr size_t WS_CTL = 0, CTL_ZERO_BYTES = 1 * MiB;
constexpr size_t WS_MOD = 1 * MiB;
constexpr size_t WS_LOGF = 2 * MiB;
constexpr size_t WS_TOK = 6 * MiB;
constexpr size_t WS_GW = 10 * MiB;
constexpr size_t WS_WQKV = 14 * MiB;
constexpr size_t WS_WO = 20 * MiB;
constexpr size_t WS_WP = 22 * MiB;
constexpr size_t WS_UP = 23 * MiB;
constexpr size_t WS_DN = 151 * MiB;
constexpr size_t WS_HB = 215 * MiB;
constexpr size_t WS_Q = 279 * MiB, WS_K = 343 * MiB, WS_V = 407 * MiB;
constexpr size_t WS_XS = 279 * MiB;
constexpr size_t WS_Y2 = 279 * MiB;
constexpr size_t WS_HH = 423 * MiB;
constexpr size_t WS_PL = 279 * MiB;
constexpr size_t WS_END = 495 * MiB;
constexpr int CW_BAR = 4096;
constexpr int CW_QKM = 32768;
constexpr int CW_AQ = 36864;
constexpr int CW_CNT = 16384;

constexpr int RING_OFF = 0, RING_BYTES = 131072;
constexpr int LDSCTL_OFF = RING_BYTES, MISC_OFF = LDSCTL_OFF + 320;
constexpr int ETAB_OFF = LDSCTL_OFF + 1024;
constexpr int LDS_BYTES = 147456;
static_assert(ETAB_OFF + (64 + 960) * 4 <= LDS_BYTES && attn_body::ATTN_LDS_BYTES <= RING_BYTES, "LDS map");

#define GAS __attribute__((address_space(1)))
#define LAS __attribute__((address_space(3)))
typedef unsigned short bf16;
typedef unsigned v4u __attribute__((ext_vector_type(4)));
typedef float f32x4 __attribute__((ext_vector_type(4)));
typedef short bf16x8 __attribute__((ext_vector_type(8)));
typedef GAS unsigned gu32;
#define RLX_AGENT __ATOMIC_RELAXED, __HIP_MEMORY_SCOPE_AGENT
#define LDS_WAIT() asm volatile("s_waitcnt lgkmcnt(0)" ::: "memory")
#define VM_WAIT() asm volatile("s_waitcnt vmcnt(0)" ::: "memory")
#define LDS_BARRIER() do { asm volatile("s_waitcnt lgkmcnt(0)" ::: "memory"); __builtin_amdgcn_s_barrier(); asm volatile("" ::: "memory"); } while (0)
__device__ __forceinline__ unsigned f2bf(float f) { unsigned u = __builtin_bit_cast(unsigned, f); return (u + 0x7fffu + ((u >> 16) & 1u)) >> 16; }
__device__ __forceinline__ unsigned pk2(float lo, float hi) { return f2bf(lo) | (f2bf(hi) << 16); }
__device__ __forceinline__ float bflo(unsigned w) { return __uint_as_float(w << 16); }
__device__ __forceinline__ float bfhi(unsigned w) { return __uint_as_float(w & 0xffff0000u); }

#define XB_TMO      128
#define XB_XCNT(j)  (256  + 64 * (j))
#define XB_XSUB(j)  (1280 + 64 * (j))
#define XB_XGEN(j)  (2304 + 64 * (j))
#define XB_TOP      3328
#define XB_TOPGEN   3392
#define XCD_BAR_WORDS 3456
#define XB_SPIN_CAP (1u << 18)
__device__ __forceinline__ unsigned xb_ld(unsigned* p)              { return __hip_atomic_load(p, __ATOMIC_RELAXED, __HIP_MEMORY_SCOPE_AGENT); }
__device__ __forceinline__ unsigned xb_add(unsigned* p, unsigned v) { return __hip_atomic_fetch_add(p, v, __ATOMIC_RELAXED, __HIP_MEMORY_SCOPE_AGENT); }
__device__ __forceinline__ unsigned xb_xcc_id() { return (unsigned)__builtin_amdgcn_s_getreg((3 << 11) | 20) & 0xFu; }
#define XB_SPIN(cond, bar) do { unsigned _sp = 0; while (cond) { __builtin_amdgcn_s_sleep(1); \
    if ((++_sp & 255u) == 0u) { if (xb_ld(&(bar)[XB_TMO])) break; if (_sp > XB_SPIN_CAP) { atomicAdd(&(bar)[XB_TMO], 1u); break; } } } } while (0)
struct XcdBarrier { unsigned* bar; unsigned x; volatile LAS unsigned* st; };
__device__ __forceinline__ XcdBarrier xcd_barrier_post(unsigned* bar, volatile LAS unsigned* st) {
    XcdBarrier b; b.bar = bar; b.x = xb_xcc_id(); b.st = st;
    if (threadIdx.x == 0) (void)xb_add(&bar[XB_XCNT(b.x)], 1u);
    return b;
}
__device__ __forceinline__ void xcd_barrier_complete(unsigned* bar, unsigned x, unsigned& nloc, unsigned& nx) {
    const unsigned G = gridDim.x * gridDim.y * gridDim.z;
    unsigned sum, cnt, mine, sp = 0u;
    for (;;) {
        sum = 0u; cnt = 0u; mine = 0u;
#pragma unroll
        for (unsigned j = 0; j < 16; ++j) { const unsigned c = xb_ld(&bar[XB_XCNT(j)]); sum += c; cnt += (c > 0u) ? 1u : 0u; }
        mine = xb_ld(&bar[XB_XCNT(x)]);
        if (sum == G) break;
        __builtin_amdgcn_s_sleep(1);
        if ((++sp & 255u) == 0u) { if (xb_ld(&bar[XB_TMO])) break; if (sp > XB_SPIN_CAP) { atomicAdd(&bar[XB_TMO], 1u); break; } }
    }
    nloc = mine > 0u ? mine : 1u; nx = cnt > 0u ? cnt : 1u;
}
__device__ __forceinline__ void xcd_barrier(const XcdBarrier& b) {
    asm volatile("s_waitcnt vmcnt(0)" ::: "memory");
    __syncthreads();
    if (threadIdx.x == 0) {
        unsigned* bar = b.bar; unsigned bx = b.x;
        asm volatile("" : "+s"(bar), "+s"(bx));
        __builtin_amdgcn_s_waitcnt(0);
        unsigned nloc = b.st[0], nx = b.st[1];
        if (nloc == 0u) { xcd_barrier_complete(bar, bx, nloc, nx); b.st[0] = nloc; b.st[1] = nx; }
        const unsigned old = xb_add(&bar[XB_XSUB(bx)], 1u);
        const unsigned gen = old / nloc;
        if (old + 1u == (gen + 1u) * nloc) {
            __builtin_amdgcn_fence(__ATOMIC_RELEASE, "agent");
            asm volatile("s_waitcnt vmcnt(0)" ::: "memory");
            const unsigned og = xb_add(&bar[XB_TOP], 1u);
            const unsigned tg = og / nx;
            if (og + 1u == (tg + 1u) * nx) xb_add(&bar[XB_TOPGEN], 1u);
            else XB_SPIN(xb_ld(&bar[XB_TOPGEN]) == tg, bar);
            __builtin_amdgcn_fence(__ATOMIC_ACQUIRE, "agent");
            xb_add(&bar[XB_XGEN(bx)], 1u);
            asm volatile("s_waitcnt vmcnt(0)" ::: "memory");
        } else {
            XB_SPIN(xb_ld(&bar[XB_XGEN(bx)]) == gen, bar);
            __builtin_amdgcn_fence(__ATOMIC_ACQUIRE, "agent");
            asm volatile("s_waitcnt vmcnt(0)" ::: "memory");
        }
    }
    __syncthreads();
}

struct Frame {
    LAS unsigned char* lds;
    volatile LAS unsigned* MISC;
    gu32* ctl;
    int tid, lane, wave, wave0;
    int vcu, G;
    const __attribute__((address_space(4))) char* ka;
    float* out;
    unsigned char* ws;
    const __attribute__((address_space(4))) char* ka0; float* out0; unsigned char* ws0;
};
__device__ __forceinline__ void phase_enter(Frame& F) {
    int t_ = opaque_tid(F.wave0); F.tid = t_; F.lane = t_ & 63; F.wave = __builtin_amdgcn_readfirstlane(t_ >> 6);
    unsigned char* w = F.ws0; float* o = F.out0; const __attribute__((address_space(4))) char* k = F.ka0;
    asm volatile("" : "+s"(w), "+s"(o), "+s"(k));
    F.ws = w; F.out = o; F.ka = k; F.ctl = (gu32*)w;
}
#define WSP(T_, off) ((T_*)(F.ws + (off)))
#define FIN(i) (*(const float* const __attribute__((address_space(4)))*)(F.ka + 8 * (i)))
enum { IN_X = 0, IN_C, IN_NMG, IN_NFG, IN_ADAW, IN_ADAB, IN_WIN, IN_FBIAS, IN_WO, IN_POOLW, IN_POOLS, IN_RW, IN_RB, IN_W1, IN_W3, IN_W2, IN_NFIN };

__device__ __forceinline__ void transpose_item(const float* W, int ld, int k0, bf16* WT, int Kd, int dst_row0, LAS float* scr, int lane) {
    float tv[32];
#pragma unroll
    for (int i = 0; i < 32; ++i) tv[i] = W[(size_t)(k0 + 2 * i + (lane >> 5)) * ld + (lane & 31)];
#pragma unroll
    for (int i = 0; i < 32; ++i) scr[(2 * i + (lane >> 5)) * 33 + (lane & 31)] = tv[i];
    LDS_WAIT(); asm volatile("" ::: "memory");
    const int c = lane & 7;
#pragma unroll
    for (int j = 0; j < 4; ++j) { const int n = (lane >> 3) + 8 * j; const LAS float* s = scr + (8 * c) * 33 + n;
        v4u o; o.x = pk2(s[0 * 33], s[1 * 33]); o.y = pk2(s[2 * 33], s[3 * 33]); o.z = pk2(s[4 * 33], s[5 * 33]); o.w = pk2(s[6 * 33], s[7 * 33]);
        *(GAS v4u*)(WT + (size_t)(dst_row0 + n) * Kd + k0 + 8 * c) = o; }
    LDS_WAIT(); asm volatile("" ::: "memory");
}
__device__ __forceinline__ void p0_prologue(Frame& F) {
    if (F.vcu < 192) {
        const float* cin = FIN(IN_C); const float* adaw = FIN(IN_ADAW); const float* adab = FIN(IN_ADAB);
        LAS float* cact = (LAS float*)(F.lds);
        LAS float* red = (LAS float*)(F.lds + 32768);
        for (int i = F.tid; i < 8 * 1024; i += 512) { const int bb = i >> 10, k = i & 1023; const float v = cin[i]; cact[k * 8 + bb] = v / (1.0f + __expf(-v)); }
        __syncthreads();
        const int l = F.vcu / 96, col0 = (F.vcu % 96) * 64;
        const float* wp = adaw + (size_t)l * D * MODW + col0 + F.lane;
        float a0 = 0.f, a1 = 0.f, a2 = 0.f, a3 = 0.f, a4 = 0.f, a5 = 0.f, a6 = 0.f, a7 = 0.f;
        const int kb = F.wave * 128;
#pragma unroll 16
        for (int k = 0; k < 128; ++k) { const float wv = wp[(size_t)(kb + k) * MODW]; const f32x4 c0 = *(const LAS f32x4*)(cact + (kb + k) * 8), c1 = *(const LAS f32x4*)(cact + (kb + k) * 8 + 4);
            a0 += c0[0] * wv; a1 += c0[1] * wv; a2 += c0[2] * wv; a3 += c0[3] * wv; a4 += c1[0] * wv; a5 += c1[1] * wv; a6 += c1[2] * wv; a7 += c1[3] * wv; }
        LAS float* rw = red + F.wave * 512 + F.lane;
        rw[0] = a0; rw[64] = a1; rw[128] = a2; rw[192] = a3; rw[256] = a4; rw[320] = a5; rw[384] = a6; rw[448] = a7;
        __syncthreads();
        { const int bb = F.tid >> 6, col = F.tid & 63; float s = 0.f;
#pragma unroll
          for (int w = 0; w < 8; ++w) s += red[w * 512 + bb * 64 + col];
          WSP(float, WS_MOD)[((size_t)l * 8 + bb) * MODW + col0 + col] = s + adab[l * MODW + col0 + col]; }
        __syncthreads();
    }
    LAS float* scr = (LAS float*)(F.lds + RING_OFF + F.wave * 16384);
    const int gw = F.vcu * NWAVES + F.wave, NGW = F.G * NWAVES;
    constexpr int I_QKV = 16 * 96, I_O = 16 * 32, I_P = 4 * 4 * 8, I_W13 = 16 * 16, I_W2 = 8 * 32;
    constexpr int I_EXP = NLAYER * NE * (2 * I_W13 + I_W2);
    constexpr int NITEMS = I_QKV + I_O + I_P + I_EXP;
    for (int it = gw; it < NITEMS; it += NGW) {
        int r = it;
        if (r < I_QKV) { const int kb = r / 96, nb = r % 96; transpose_item(FIN(IN_WIN) + 32 * nb, WIN_LD, 64 * kb, WSP(bf16, WS_WQKV), D, 32 * nb, scr, F.lane); continue; } r -= I_QKV;
        if (r < I_O) { const int kb = r / 32, nb = r % 32; transpose_item(FIN(IN_WO) + 32 * nb, D, 64 * kb, WSP(bf16, WS_WO), D, 32 * nb, scr, F.lane); continue; } r -= I_O;
        if (r < I_P) { const int g = r / 32, q = r % 32, kb = q / 8, nb = q % 8; transpose_item(FIN(IN_POOLW) + (size_t)g * 65536 + 32 * nb, 256, 64 * kb, WSP(bf16, WS_WP) + (size_t)g * 65536, 256, 32 * nb, scr, F.lane); continue; } r -= I_P;
        { const int per = 2 * I_W13 + I_W2; const int le = r / per; int q = r % per;
          if (q < 2 * I_W13) { const int which = q / I_W13; q %= I_W13; const int kb = q / 16, nb = q % 16, n0 = 32 * nb;
              const float* src = (which ? FIN(IN_W3) : FIN(IN_W1)) + (size_t)le * D * FD + n0;
              transpose_item(src, FD, 64 * kb, WSP(bf16, WS_UP) + (size_t)le * 1024 * 1024, D, 256 * (n0 >> 7) + (n0 & 127) + 128 * which, scr, F.lane); }
          else { q -= 2 * I_W13; const int kb = q / 32, nb = q % 32;
              transpose_item(FIN(IN_W2) + (size_t)le * FD * D + 32 * nb, D, 64 * kb, WSP(bf16, WS_DN) + (size_t)le * 1024 * 512, FD, 32 * nb, scr, F.lane); } }
    }
    __syncthreads();
}

struct RowArgs { const float* src; float* dst; const float* g; const float* shp; const float* scp; const float* gtp; const bf16* y2; bf16* hb;
                 const float* W; const float* bias; float* logf; gu32* cnt; int* tok; float* gw; };
template <int MODE>
__device__ __forceinline__ void rowpass(Frame& F, const RowArgs& A) {
    constexpr int NT = (MODE == 0) ? 1 : (MODE == 1 ? 2 : 0);
    const int lane = F.lane, w = F.wave, r = lane & 15, q = lane >> 4, tid = F.tid;
    const int R0 = F.vcu * 128, b = R0 >> 12;
    const int kb = 128 * w + 8 * q;
    LAS float* red = (LAS float*)(F.lds);
    LAS f32x4* part = (LAS f32x4*)(F.lds + 1024);
    LAS float* scS = (LAS float*)(F.lds + 1024 + 32768);
    LAS float* selS = scS + 512;
    LAS float* GM = (LAS float*)(F.lds + 65536); LAS float* SH = GM + 1024; LAS float* GT = SH + 1024;
    for (int k = tid; k < D; k += 512) { const float g1 = A.g[k];
        if (MODE < 3) { GM[k] = g1 * (1.0f + A.scp[(size_t)b * MODW + k]); SH[k] = A.shp[(size_t)b * MODW + k]; } else { GM[k] = g1; SH[k] = 0.f; }
        GT[k] = (MODE >= 2) ? A.gtp[(size_t)b * MODW + k] : 0.f; }
    __syncthreads();
    bf16x8 Bh[NT > 0 ? NT : 1][4], Bl[NT > 0 ? NT : 1][4];
    constexpr int LDW = (MODE == 0) ? WIN_LD : NE, COFF = (MODE == 0) ? 3 * D : 0;
    if (NT > 0) { const float* wbase = A.W + (size_t)kb * LDW + COFF + r;
#pragma unroll
        for (int nt = 0; nt < NT; ++nt)
#pragma unroll
            for (int c = 0; c < 4; ++c) { float wv[8];
#pragma unroll
                for (int j = 0; j < 8; ++j) wv[j] = wbase[(32 * c + j) * LDW + 16 * nt];
                v4u hw, lw;
                hw.x = pk2(wv[0], wv[1]); hw.y = pk2(wv[2], wv[3]); hw.z = pk2(wv[4], wv[5]); hw.w = pk2(wv[6], wv[7]);
                lw.x = pk2(wv[0] - bflo(hw.x), wv[1] - bfhi(hw.x)); lw.y = pk2(wv[2] - bflo(hw.y), wv[3] - bfhi(hw.y));
                lw.z = pk2(wv[4] - bflo(hw.z), wv[5] - bfhi(hw.z)); lw.w = pk2(wv[6] - bflo(hw.w), wv[7] - bfhi(hw.w));
                Bh[nt][c] = __builtin_bit_cast(bf16x8, hw); Bl[nt][c] = __builtin_bit_cast(bf16x8, lw); }
    }
    f32x4 xn[4][2]; v4u yna[4], ynb[4];
#define RP_LOAD(it_) do { const int row_ = R0 + 16 * (it_) + r; const float* xs_ = A.src + (size_t)row_ * D + kb; \
        _Pragma("unroll") for (int c = 0; c < 4; ++c) { xn[c][0] = *(const f32x4*)(xs_ + 32 * c); xn[c][1] = *(const f32x4*)(xs_ + 32 * c + 4); } \
        if (MODE >= 2) { const bf16* yp_ = A.y2 + (size_t)row_ * 2 * D + kb; _Pragma("unroll") for (int c = 0; c < 4; ++c) { yna[c] = *(const v4u*)(yp_ + 32 * c); ynb[c] = *(const v4u*)(yp_ + D + 32 * c); } } } while (0)
    RP_LOAD(0);
    for (int it = 0; it < 8; ++it) {
        const int row = R0 + 16 * it + r, buf = it & 1;
        f32x4 xv[4][2]; v4u yva[4], yvb[4];
#pragma unroll
        for (int c = 0; c < 4; ++c) { xv[c][0] = xn[c][0]; xv[c][1] = xn[c][1]; if (MODE >= 2) { yva[c] = yna[c]; yvb[c] = ynb[c]; } }
        if (it < 7) RP_LOAD(it + 1);
        if (MODE >= 2) {
#pragma unroll
            for (int c = 0; c < 4; ++c) { const v4u ya = yva[c], yb = yvb[c];
                f32x4 s0, s1;
                s0[0] = bflo(ya.x) + bflo(yb.x); s0[1] = bfhi(ya.x) + bfhi(yb.x); s0[2] = bflo(ya.y) + bflo(yb.y); s0[3] = bfhi(ya.y) + bfhi(yb.y);
                s1[0] = bflo(ya.z) + bflo(yb.z); s1[1] = bfhi(ya.z) + bfhi(yb.z); s1[2] = bflo(ya.w) + bflo(yb.w); s1[3] = bfhi(ya.w) + bfhi(yb.w);
                xv[c][0] += *(const LAS f32x4*)(GT + kb + 32 * c) * s0; xv[c][1] += *(const LAS f32x4*)(GT + kb + 32 * c + 4) * s1; }
            if (MODE == 2) { float* xd = A.dst + (size_t)row * D + kb;
#pragma unroll
                for (int c = 0; c < 4; ++c) { *(f32x4*)(xd + 32 * c) = xv[c][0]; *(f32x4*)(xd + 32 * c + 4) = xv[c][1]; } }
        }
        float ss = 0.f;
#pragma unroll
        for (int c = 0; c < 4; ++c)
#pragma unroll
            for (int hf = 0; hf < 2; ++hf) { const f32x4 v = xv[c][hf]; ss += (v[0] * v[0] + v[1] * v[1]) + (v[2] * v[2] + v[3] * v[3]); }
        ss += __int_as_float(__builtin_amdgcn_ds_bpermute((lane ^ 16) << 2, __float_as_int(ss))); ss += __int_as_float(__builtin_amdgcn_ds_bpermute((lane ^ 32) << 2, __float_as_int(ss)));
        if (q == 0) red[buf * 128 + w * 16 + r] = ss;
        LDS_BARRIER();
        float tot = 0.f;
#pragma unroll
        for (int ww = 0; ww < 8; ++ww) tot += red[buf * 128 + ww * 16 + r];
        const float rstd = 1.0f / sqrtf(tot * (1.0f / D) + RMS_EPS);
        if (MODE == 3) { float* xd = A.dst + (size_t)row * D + kb;
#pragma unroll
            for (int c = 0; c < 4; ++c) { *(f32x4*)(xd + 32 * c) = xv[c][0] * rstd * *(const LAS f32x4*)(GM + kb + 32 * c); *(f32x4*)(xd + 32 * c + 4) = xv[c][1] * rstd * *(const LAS f32x4*)(GM + kb + 32 * c + 4); }
            continue; }
        f32x4 acc[NT > 0 ? NT : 1];
#pragma unroll
        for (int nt = 0; nt < (NT > 0 ? NT : 1); ++nt) acc[nt] = (f32x4){0.f, 0.f, 0.f, 0.f};
        bf16* hp = A.hb + (size_t)row * D + kb;
#pragma unroll
        for (int c = 0; c < 4; ++c) {
            const f32x4 h0 = xv[c][0] * rstd * *(const LAS f32x4*)(GM + kb + 32 * c) + *(const LAS f32x4*)(SH + kb + 32 * c), h1 = xv[c][1] * rstd * *(const LAS f32x4*)(GM + kb + 32 * c + 4) + *(const LAS f32x4*)(SH + kb + 32 * c + 4);
            v4u hw; hw.x = pk2(h0[0], h0[1]); hw.y = pk2(h0[2], h0[3]); hw.z = pk2(h1[0], h1[1]); hw.w = pk2(h1[2], h1[3]);
            *(v4u*)(hp + 32 * c) = hw;
            if (NT > 0) {
                v4u lw; lw.x = pk2(h0[0] - bflo(hw.x), h0[1] - bfhi(hw.x)); lw.y = pk2(h0[2] - bflo(hw.y), h0[3] - bfhi(hw.y));
                lw.z = pk2(h1[0] - bflo(hw.z), h1[1] - bfhi(hw.z)); lw.w = pk2(h1[2] - bflo(hw.w), h1[3] - bfhi(hw.w));
                const bf16x8 ah = __builtin_bit_cast(bf16x8, hw), al = __builtin_bit_cast(bf16x8, lw);
#pragma unroll
                for (int nt = 0; nt < NT; ++nt) {
                    acc[nt] = __builtin_amdgcn_mfma_f32_16x16x32_bf16(ah, Bh[nt][c], acc[nt], 0, 0, 0);
                    acc[nt] = __builtin_amdgcn_mfma_f32_16x16x32_bf16(ah, Bl[nt][c], acc[nt], 0, 0, 0);
                    acc[nt] = __builtin_amdgcn_mfma_f32_16x16x32_bf16(al, Bh[nt][c], acc[nt], 0, 0, 0); }
            }
        }
        if (NT > 0) {
#pragma unroll
            for (int nt = 0; nt < NT; ++nt) part[((buf * 8 + w) * 2 + nt) * 64 + lane] = acc[nt];
            LDS_BARRIER();
            if (MODE == 0) {
                if (tid < 256) { const int t = tid & 15, n = tid >> 4; float f = 0.f;
#pragma unroll
                    for (int ww = 0; ww < 8; ++ww) f += ((const LAS float*)&part[((buf * 8 + ww) * 2 + 0) * 64 + n + 16 * (t >> 2)])[t & 3];
                    const float z = f + A.bias[n]; const float lf = fminf(z, 0.f) - log1pf(__expf(-fabsf(z)));
                    const int rt = R0 + 16 * it + t; A.logf[((size_t)b * H + n) * SEQ + (rt & (SEQ - 1))] = lf; }
            } else {
                { const int t = tid & 15, n = tid >> 4; float f = 0.f;
#pragma unroll
                  for (int ww = 0; ww < 8; ++ww) f += ((const LAS float*)&part[((buf * 8 + ww) * 2 + (n >> 4)) * 64 + (n & 15) + 16 * (t >> 2)])[t & 3];
                  const float sc = 1.0f / (1.0f + expf(-f)); scS[t * 32 + n] = sc; selS[t * 32 + n] = sc + A.bias[n]; }
                LDS_BARRIER();
                if (tid < 16) { const LAS float* sl = selS + tid * 32; float bg = -INFINITY; int gi = 0;
                    for (int g = 0; g < 4; ++g) { float m1 = -INFINITY, m2 = -INFINITY;
                        for (int i = 0; i < 8; ++i) { const float v = sl[8 * g + i]; if (v > m1) { m2 = m1; m1 = v; } else if (v > m2) m2 = v; }
                        const float gs = m1 + m2; if (gs > bg) { bg = gs; gi = g; } }
                    int i1 = 0, i2 = 0; float v1 = -INFINITY, v2 = -INFINITY;
                    for (int i = 0; i < 8; ++i) { const float v = sl[8 * gi + i]; if (v > v1) { v1 = v; i1 = i; } }
                    for (int i = 0; i < 8; ++i) { const float v = sl[8 * gi + i]; if (i != i1 && v > v2) { v2 = v; i2 = i; } }
                    const int e0 = 8 * gi + i1, e1 = 8 * gi + i2; const float s0 = scS[tid * 32 + e0], s1 = scS[tid * 32 + e1], inv = 1.0f / (s0 + s1);
                    const int rt = R0 + 16 * it + tid;
                    const unsigned p0 = __hip_atomic_fetch_add(A.cnt + e0 * 64, 1u, RLX_AGENT), p1 = __hip_atomic_fetch_add(A.cnt + e1 * 64, 1u, RLX_AGENT);
                    A.tok[e0 * ECAP + p0] = rt * 2; A.gw[e0 * ECAP + p0] = s0 * inv; A.tok[e1 * ECAP + p1] = rt * 2 + 1; A.gw[e1 * ECAP + p1] = s1 * inv; }
            }
        }
    }
    __syncthreads();
#undef RP_LOAD
}

constexpr int UT_E = 64, UT_X = 64 + 320, UT_V = 64 + 640;
__device__ __forceinline__ void build_etab(Frame& F, int layer) {
    LAS int* et = (LAS int*)(F.lds + ETAB_OFF);
    if (F.tid == 0) { int ts = 0;
        for (int e = 0; e < NE; ++e) { const int c = (int)__hip_atomic_load(F.ctl + CW_CNT + (layer * 32 + e) * 64, RLX_AGENT); const int nt = (c + 255) >> 8;
            for (int j = 0; j < nt; ++j) { et[UT_E + ts] = e; et[UT_X + ts] = e * ECAP + 256 * j; const int rem = c - 256 * j; et[UT_V + ts] = rem < 256 ? rem : 256; ++ts; } }
        et[0] = ts; }
    __syncthreads();
}
__device__ __forceinline__ void gather_rows(Frame& F) {
    const LAS int* et = (const LAS int*)(F.lds + ETAB_OFF);
    const int ptot = et[0] * 256; const int* tok = WSP(int, WS_TOK);
    const int gw = F.vcu * NWAVES + F.wave, NGW = F.G * NWAVES;
    for (int p = gw; p < ptot; p += NGW) { const int tile = p >> 8, rl = p & 255;
        if (rl < et[UT_V + tile]) { const int tk = tok[et[UT_X + tile] + rl] >> 1;
            const GAS v4u* s = (const GAS v4u*)(WSP(bf16, WS_HB) + (size_t)tk * D) + F.lane; GAS v4u* d = (GAS v4u*)(WSP(bf16, WS_XS) + (size_t)p * D) + F.lane;
            const v4u a = s[0], bq = s[64]; d[0] = a; d[64] = bq; } }
}
__device__ __forceinline__ void pool_rows(Frame& F) {
    const int ch = F.tid & 127, rs = F.tid >> 7; const int t0 = F.vcu * 128 + rs * 32; const int win = 2 << (ch >> 5);
    const bf16* hb = WSP(bf16, WS_HB) + ch * 8; bf16* pl = WSP(bf16, WS_PL) + ch * 8;
    float s[8];
#pragma unroll
    for (int j = 0; j < 8; ++j) s[j] = 0.f;
    const int s0 = t0 & (SEQ - 1);
    for (int i = 1; i < win; ++i) if (s0 - i >= 0) { const v4u a = *(const v4u*)(hb + (size_t)(t0 - i) * D);
        s[0] += bflo(a.x); s[1] += bfhi(a.x); s[2] += bflo(a.y); s[3] += bfhi(a.y); s[4] += bflo(a.z); s[5] += bfhi(a.z); s[6] += bflo(a.w); s[7] += bfhi(a.w); }
    for (int i = 0; i < 32; ++i) { const int t = t0 + i, sq = s0 + i;
        const v4u a = *(const v4u*)(hb + (size_t)t * D);
        float h[8]; h[0] = bflo(a.x); h[1] = bfhi(a.x); h[2] = bflo(a.y); h[3] = bfhi(a.y); h[4] = bflo(a.z); h[5] = bfhi(a.z); h[6] = bflo(a.w); h[7] = bfhi(a.w);
#pragma unroll
        for (int j = 0; j < 8; ++j) s[j] += h[j];
        const float ic = 1.0f / (float)((sq + 1 < win) ? (sq + 1) : win);
        v4u w; w.x = pk2(s[0] * ic - h[0], s[1] * ic - h[1]); w.y = pk2(s[2] * ic - h[2], s[3] * ic - h[3]); w.z = pk2(s[4] * ic - h[4], s[5] * ic - h[5]); w.w = pk2(s[6] * ic - h[6], s[7] * ic - h[7]);
        if (sq - win + 1 >= 0) { const v4u o = *(const v4u*)(hb + (size_t)(t - win + 1) * D);
            s[0] -= bflo(o.x); s[1] -= bfhi(o.x); s[2] -= bflo(o.y); s[3] -= bfhi(o.y); s[4] -= bflo(o.z); s[5] -= bfhi(o.z); s[6] -= bflo(o.w); s[7] -= bfhi(o.w); }
        *(v4u*)(pl + (size_t)t * D) = w; }
}

struct DenseSched {
    const char* A; const char* Bt; size_t strideA, strideB; int nM, nN, nwg, G, c;
    __device__ __forceinline__ bool next(int i, pg8::Unit& u) const {
        const long L = (long)i * G + c; if (L >= nwg) return false;
        int wgid = (int)L; { const int q = nwg / 8, r = nwg % 8, xcd = wgid % 8, off = wgid / 8; wgid = (xcd < r ? xcd * (q + 1) : r * (q + 1) + (xcd - r) * q) + off; }
        const int nig = 8 * nN, gid = wgid / nig, fm = gid * 8, gsz = (nM - fm) < 8 ? (nM - fm) : 8;
        u.pm = fm + ((wgid % nig) % gsz); u.pn = (wgid % nig) / gsz; u.a = A + (size_t)u.pm * strideA; u.b = Bt + (size_t)u.pn * strideB; u.x0 = 0; u.x1 = 0; return true;
    }
};
struct PoolSched {
    const char* A; const char* Bt; int G, v;
    __device__ __forceinline__ bool next(int i, pg8::Unit& u) const {
        const int L = i * G + v; if (L >= 512) return false;
        u.pm = L >> 2; u.pn = L & 3; u.a = A + (size_t)u.pm * 256 * D * 2 + (size_t)u.pn * 256 * 2; u.b = Bt + (size_t)u.pn * 65536 * 2; u.x0 = 0; u.x1 = 0; return true;
    }
};
template <bool DOWN> struct MoeSched {
    const LAS int* et; const char* A; const char* Bt; int G, v; const int* tok;
    __device__ __forceinline__ unsigned row_off(const pg8::Unit& u, int row) const { const int vv = et[UT_V + u.pm], x = et[UT_X + u.pm]; const int tk = tok[x + (row < vv ? row : 0)] >> 1; return (unsigned)tk * (unsigned)(D * 2); }
    static constexpr size_t rowA = DOWN ? (size_t)FD * 2 : (size_t)D * 2, strideE = DOWN ? (size_t)1024 * 512 * 2 : (size_t)1024 * 1024 * 2, stridePn = DOWN ? (size_t)256 * 512 * 2 : (size_t)256 * 1024 * 2;
    __device__ __forceinline__ bool next(int i, pg8::Unit& u) const {
        const int L = i * G + v; const int ntile = et[0]; if (L >= ntile * 4) return false;
        const int tile = L >> 2, pn = L & 3; const int e = et[UT_E + tile];
        u.pm = tile; u.pn = pn; u.a = DOWN ? A + (size_t)tile * 256 * rowA : A; u.b = Bt + (size_t)e * strideE + (size_t)pn * stridePn;
        if (DOWN) { u.x0 = et[UT_X + tile]; u.x1 = tok ? 0 : et[UT_V + tile]; } else { u.x0 = pn; u.x1 = tile * 256; }
        return true;
    }
};
constexpr int N_PHASES = 17;
struct Args { const float* in[17]; float* out; unsigned char* ws; int ph_lo, ph_hi; };
__global__ void __launch_bounds__(NWAVES * 64, 2) fwd_megakernel(Args args) {
    extern __shared__ __attribute__((aligned(16))) unsigned char lds[];
    Frame F;
    F.lds = (LAS unsigned char*)lds;
    F.MISC = (volatile LAS unsigned*)(F.lds + MISC_OFF);
    F.wave0 = __builtin_amdgcn_readfirstlane((int)threadIdx.x >> 6); F.tid = threadIdx.x; F.lane = F.tid & 63; F.wave = F.wave0;
    F.G = gridDim.x; { const int bx = blockIdx.x; F.vcu = (F.G % 8 == 0) ? (bx % 8) * (F.G / 8) + bx / 8 : bx; }
    F.ws0 = args.ws; F.out0 = args.out;
    F.ka0 = (const __attribute__((address_space(4))) char*)__builtin_amdgcn_kernarg_segment_ptr();
    phase_enter(F);
    for (int u = F.tid; u < (LDS_BYTES - LDSCTL_OFF) / 4; u += NWAVES * 64) ((LAS unsigned*)(F.lds + LDSCTL_OFF))[u] = 0u;
    __syncthreads();
    XcdBarrier bar; bar.bar = (unsigned*)(F.ctl + CW_BAR); bar.x = 0; bar.st = nullptr;
    if (!MK_MULTI) bar = xcd_barrier_post((unsigned*)(F.ctl + CW_BAR), F.MISC + 8);
    int lo = args.ph_lo, hi = args.ph_hi;
#ifndef PHMASK
#define PHMASK 0xFFFFFFFFu
#endif
#define IN(k) (((PHMASK >> (k)) & 1u) && lo <= (k) && (k) < hi)
#ifndef DUP_PHASE
#define DUP_PHASE -1
#endif
#define REP(k) for (int rep_ = 0; rep_ < ((k) == DUP_PHASE ? 2 : 1); ++rep_)
#define SEAM2(k, k2) do { if (IN(k) && IN(k2)) xcd_barrier(bar); asm volatile("" : "+s"(lo), "+s"(hi)); } while (0)
#define SEAM(k) do { if (IN(k) && IN((k) + 1)) xcd_barrier(bar); asm volatile("" : "+s"(lo), "+s"(hi)); } while (0)
#define mod WSP(float, WS_MOD)
#define HB WSP(bf16, WS_HB)

    if (IN(0)) REP(0) { phase_enter(F); p0_prologue(F); } SEAM(0);
#ifdef EXTRA_BARS
    for (int xb_ = 0; xb_ < EXTRA_BARS; ++xb_) xcd_barrier(bar);
#endif
    if (IN(1)) REP(1) { phase_enter(F); RowArgs A{}; A.src = FIN(IN_X); A.g = FIN(IN_NMG); A.shp = mod + 0; A.scp = mod + D; A.hb = HB; A.W = FIN(IN_WIN); A.bias = FIN(IN_FBIAS); A.logf = WSP(float, WS_LOGF);
        rowpass<0>(F, A); } SEAM(1);
    if (IN(2)) REP(2) { phase_enter(F); pg8::Gemm g{D, D, D}; DenseSched S{(const char*)HB, (const char*)WSP(bf16, WS_WQKV), (size_t)256 * D * 2, (size_t)256 * D * 2, T / 256, 3 * D / 256, (T / 256) * (3 * D / 256), F.G, (int)blockIdx.x};
        pg8::EpiQKV E{WSP(bf16, WS_Q), (size_t)(WS_K - WS_Q) / 2, attn_body::C2, (unsigned*)(F.ctl + CW_QKM)};
        pg8::gemm_phase<pg8::EpiQKV, DenseSched, true>(F.lds + RING_OFF, g, S, E, F.wave0); } SEAM(2);
    if (IN(3)) REP(3) { phase_enter(F); const attn_body::AttnTensors AT{(const attn_body::bf16*)WSP(bf16, WS_Q), (const attn_body::bf16*)WSP(bf16, WS_K), (const attn_body::bf16*)WSP(bf16, WS_V), (attn_body::bf16*)HB, WSP(float, WS_LOGF), (const unsigned*)(F.ctl + CW_QKM)};
        attn_body::attn_phase<8>((char*)lds + RING_OFF, AT, (unsigned*)(F.ctl + CW_AQ), F.wave0); } SEAM(3);
    if (IN(4)) REP(4) { phase_enter(F); pg8::Gemm g{D, D, D}; DenseSched S{(const char*)HB, (const char*)WSP(bf16, WS_WO), (size_t)256 * D * 2, (size_t)256 * D * 2, T / 256, D / 256, (T / 256) * (D / 256), F.G, (int)blockIdx.x};
        pg8::EpiResid E{FIN(IN_X), F.out, mod + 2 * D};
        pg8::gemm_phase<pg8::EpiResid, DenseSched, true>(F.lds + RING_OFF, g, S, E, F.wave0); } SEAM(4);
        if (IN(5)) REP(5) { phase_enter(F); RowArgs A{}; A.src = F.out; A.g = FIN(IN_NFG) + 0 * D; A.shp = mod + (size_t)0 * 8 * MODW + 3 * D; A.scp = mod + (size_t)0 * 8 * MODW + 4 * D; A.hb = HB;
            A.W = FIN(IN_RW); A.bias = FIN(IN_RB); A.cnt = F.ctl + CW_CNT + 0 * 32 * 64; A.tok = WSP(int, WS_TOK); A.gw = WSP(float, WS_GW);
            if (rep_) { A.cnt = F.ctl + CW_CNT + 2 * 32 * 64; A.tok = WSP(int, WS_END); A.gw = WSP(float, WS_END + 4 * MiB); }
            rowpass<1>(F, A); } SEAM2(5, 7);
        if (IN(7)) REP(7) { phase_enter(F); build_etab(F, 0); pg8::Gemm g{D, D, D};
            MoeSched<false> S{(const LAS int*)(F.lds + ETAB_OFF), (const char*)HB, (const char*)(WSP(bf16, WS_UP) + (size_t)0 * NE * 1024 * 1024), F.G, F.vcu, WSP(int, WS_TOK)};
            pg8::EpiUp E{WSP(bf16, WS_HH)};
            pg8::gemm_phase<pg8::EpiUp, MoeSched<false>, true, true>(F.lds + RING_OFF, g, S, E, F.wave0); } SEAM(7);
        if (IN(8)) REP(8) { phase_enter(F); build_etab(F, 0); pg8::Gemm g{FD, FD, FD};
            MoeSched<true> S{(const LAS int*)(F.lds + ETAB_OFF), (const char*)WSP(bf16, WS_HH), (const char*)(WSP(bf16, WS_DN) + (size_t)0 * NE * 1024 * 512), F.G, F.vcu, rep_ ? WSP(int, WS_TOK) : nullptr};
            pg8::EpiDown E{WSP(bf16, WS_Y2), WSP(int, WS_TOK), WSP(float, WS_GW)};
            pg8::gemm_phase<pg8::EpiDown, MoeSched<true>, true>(F.lds + RING_OFF, g, S, E, F.wave0); } SEAM(8);

            if (IN(9)) REP(9) { phase_enter(F); RowArgs A{}; A.src = F.out; A.dst = F.out; A.g = FIN(IN_NMG) + D; A.shp = mod + 8 * MODW + 0; A.scp = mod + 8 * MODW + D; A.gtp = mod + 5 * D; A.y2 = WSP(bf16, WS_Y2); A.hb = HB;
                rowpass<2>(F, A); } SEAM(9);
            if (IN(10)) REP(10) { phase_enter(F); pool_rows(F); } SEAM(10);
            if (IN(11)) REP(11) { phase_enter(F); pg8::Gemm g{D, 256, 256}; PoolSched S{(const char*)WSP(bf16, WS_PL), (const char*)WSP(bf16, WS_WP), F.G, F.vcu};
                pg8::EpiPool E{F.out, mod + 8 * MODW + 2 * D, FIN(IN_POOLS)};
                pg8::gemm_phase<pg8::EpiPool, PoolSched, true>(F.lds + RING_OFF, g, S, E, F.wave0); } SEAM(11);
        if (IN(12)) REP(12) { phase_enter(F); RowArgs A{}; A.src = F.out; A.g = FIN(IN_NFG) + 1 * D; A.shp = mod + (size_t)1 * 8 * MODW + 3 * D; A.scp = mod + (size_t)1 * 8 * MODW + 4 * D; A.hb = HB;
            A.W = FIN(IN_RW); A.bias = FIN(IN_RB); A.cnt = F.ctl + CW_CNT + 1 * 32 * 64; A.tok = WSP(int, WS_TOK); A.gw = WSP(float, WS_GW);
            rowpass<1>(F, A); } SEAM2(12, 14);
        if (IN(14)) REP(14) { phase_enter(F); build_etab(F, 1); pg8::Gemm g{D, D, D};
            MoeSched<false> S{(const LAS int*)(F.lds + ETAB_OFF), (const char*)HB, (const char*)(WSP(bf16, WS_UP) + (size_t)1 * NE * 1024 * 1024), F.G, F.vcu, WSP(int, WS_TOK)};
            pg8::EpiUp E{WSP(bf16, WS_HH)};
            pg8::gemm_phase<pg8::EpiUp, MoeSched<false>, true, true>(F.lds + RING_OFF, g, S, E, F.wave0); } SEAM(14);
        if (IN(15)) REP(15) { phase_enter(F); build_etab(F, 1); pg8::Gemm g{FD, FD, FD};
            MoeSched<true> S{(const LAS int*)(F.lds + ETAB_OFF), (const char*)WSP(bf16, WS_HH), (const char*)(WSP(bf16, WS_DN) + (size_t)1 * NE * 1024 * 512), F.G, F.vcu, nullptr};
            pg8::EpiDown E{WSP(bf16, WS_Y2), WSP(int, WS_TOK), WSP(float, WS_GW)};
            pg8::gemm_phase<pg8::EpiDown, MoeSched<true>, true>(F.lds + RING_OFF, g, S, E, F.wave0); } SEAM(15);
    if (IN(16)) REP(16) { phase_enter(F); RowArgs A{}; A.src = F.out; A.dst = F.out; A.g = FIN(IN_NFIN); A.gtp = mod + 8 * MODW + 5 * D; A.y2 = WSP(bf16, WS_Y2);
        rowpass<3>(F, A); }
#undef IN
#undef SEAM
#undef mod
#undef HB
}

extern "C" void kernel_launch(void* const* d_in, const int* in_sizes, int n_in, void* d_out, int out_size, void* d_ws, size_t ws_size, hipStream_t stream) {
    static int grid = 0;
    if (grid == 0) {
        if (n_in != 17 || in_sizes[0] != T * D || out_size != T * D || ws_size < WS_END) { fprintf(stderr, "kernel_launch: unexpected shapes (n_in %d, in0 %d, out %d, ws %zu)\n", n_in, n_in > 0 ? in_sizes[0] : -1, out_size, ws_size); grid = -1; return; }
        int dev = 0, cus = 0, per_cu = 0;
        if (hipGetDevice(&dev) != hipSuccess || hipDeviceGetAttribute(&cus, hipDeviceAttributeMultiprocessorCount, dev) != hipSuccess) { grid = -1; return; }
        if (hipFuncSetAttribute((const void*)fwd_megakernel, hipFuncAttributeMaxDynamicSharedMemorySize, LDS_BYTES) != hipSuccess) { fprintf(stderr, "kernel_launch: hipFuncSetAttribute failed\n"); grid = -1; return; }
        if (hipOccupancyMaxActiveBlocksPerMultiprocessor(&per_cu, (const void*)fwd_megakernel, NWAVES * 64, LDS_BYTES) != hipSuccess || per_cu < 1) { fprintf(stderr, "kernel_launch: occupancy query says %d\n", per_cu); (void)hipGetLastError(); grid = -1; return; }
        grid = cus;
        if (grid != 256) fprintf(stderr, "kernel_launch: %d CUs; this kernel's static work split expects 256\n", grid);
    }
    if (grid < 0) return;
    (void)hipMemsetAsync((char*)d_ws + WS_CTL, 0, CTL_ZERO_BYTES, stream);
    Args a{};
    for (int i = 0; i < 17; ++i) a.in[i] = (const float*)d_in[i];
    a.out = (float*)d_out; a.ws = (unsigned char*)d_ws;
#if MK_MULTI
#ifndef MAXPH
#define MAXPH 17
#endif
    for (int p = 0; p < MAXPH; ++p) { a.ph_lo = p; a.ph_hi = p + 1; hipLaunchKernelGGL(fwd_megakernel, dim3(grid), dim3(NWAVES * 64), LDS_BYTES, stream, a); }
#else
    a.ph_lo = 0; a.ph_hi = 17;
    void* kargs[] = {&a};
    hipError_t e = hipLaunchCooperativeKernel((const void*)fwd_megakernel, dim3(grid), dim3(NWAVES * 64), kargs, LDS_BYTES, stream);
    if (e != hipSuccess) fprintf(stderr, "kernel_launch: cooperative launch failed: %s\n", hipGetErrorString(e));
#endif
}
```

```cpp
#define MK_MULTI 0
#define MAXPH 17
#include <hip/hip_runtime.h>
#include <hip/hip_bf16.h>
#include <cstdio>
#include <cstdint>
#include <cmath>
#include <type_traits>
__device__ __forceinline__ int opaque_tid(int wave0) { int w = wave0; asm volatile("" : "+s"(w)); unsigned m = ~0u; asm volatile("" : "+s"(m)); const int l = (int)__builtin_amdgcn_mbcnt_hi(m, __builtin_amdgcn_mbcnt_lo(m, 0u)); return w * 64 + l; }
namespace pg8 {
#define PG8_LAS __attribute__((address_space(3)))
typedef unsigned short bf16_t;
typedef short bf16x8 __attribute__((ext_vector_type(8)));
typedef float f32x4 __attribute__((ext_vector_type(4)));
typedef float f32x2 __attribute__((ext_vector_type(2)));
typedef unsigned u32x4 __attribute__((ext_vector_type(4)));
#define PG8_G(T_, p_) ((__attribute__((address_space(1))) T_*)(p_))
#define PG8_GC(T_, p_) ((const __attribute__((address_space(1))) T_*)(p_))
constexpr int BM = 256, BK = 64, HALF = 128, HTB = HALF * BK * 2  , STAGE_BYTES = 8 * HTB, NXCD = 8, WGM = 8;

__host__ __device__ __forceinline__ int lds_byte(int r, int c) { const int st = (r >> 4) * 2 + (c >> 5), rr = r & 15, cc = c & 31, ob = rr * 64 + cc * 2; return st * 1024 + (ob ^ (((ob >> 9) & 1) << 5)); }
__host__ __device__ __forceinline__ void stage_rc(int b, int& R, int& C) { const int st = b / 1024, sb = b % 1024, swz = sb ^ (((sb >> 9) & 1) << 5); R = (st >> 1) * 16 + swz / 64; C = (st & 1) * 32 + (swz % 64) / 2; }
__host__ __device__ __forceinline__ int perm32(int rho) { const int n = rho >> 4, i = rho & 15; return 8 * (i >> 2) + 4 * n + (i & 3); }

struct Unit { const char* a; const char* b; int pm, pn, x0, x1, full, hb; };
struct Gemm { int lda, ldb, K; int tag = 0; };

__device__ __forceinline__ unsigned gload_hidden(const void* p) { unsigned r; asm volatile("global_load_dword %0, %1, off" : "=v"(r) : "v"(p) : "memory"); return r; }
__device__ __forceinline__ unsigned gatomic_inc_hidden(const void* p) { unsigned r; const unsigned one = 1u; asm volatile("global_atomic_add %0, %1, %2, off sc0" : "=v"(r) : "v"(p), "v"(one) : "memory"); return r; }
__device__ __forceinline__ unsigned cvt_pk_bf16(float lo, float hi) { unsigned r; asm volatile("v_cvt_pk_bf16_f32 %0, %1, %2" : "=v"(r) : "v"(lo), "v"(hi)); return r; }


struct EpiBf16 {
    static constexpr bool PERM = true, AFTER_DRAIN = false, PREFETCH = false;
    bf16_t* O; int ldc; int split_cols; size_t split_stride; float scale0;
    __device__ __forceinline__ void operator()(const f32x4 (&acc)[2][2][4][2], const Unit& u, int wr, int wc, int fr, int fq) const {
        const int row0 = u.pm * BM + wr * 64 + fr; int colt = u.pn * BM; bf16_t* base = O;
        float sc = 1.f; if (split_cols) { const int t = colt / split_cols; base += (size_t)t * split_stride; colt -= t * split_cols; if (t == 0) sc = scale0; }
        const int col0 = colt + wc * 32 + 8 * fq;
#pragma unroll
        for (int ai = 0; ai < 2; ++ai)
#pragma unroll
            for (int m = 0; m < 4; ++m) { bf16_t* rowp = base + (size_t)(row0 + ai * HALF + m * 16) * ldc + col0;
#pragma unroll
                for (int bj = 0; bj < 2; ++bj) { f32x4 v0 = acc[ai][bj][m][0] * sc, v1 = acc[ai][bj][m][1] * sc;
                    u32x4 w; w.x = cvt_pk_bf16(v0[0], v0[1]); w.y = cvt_pk_bf16(v0[2], v0[3]); w.z = cvt_pk_bf16(v1[0], v1[1]); w.w = cvt_pk_bf16(v1[2], v1[3]);
                    *PG8_G(u32x4, rowp + bj * HALF) = w; } }
    }
};
struct EpiQKV {
    static constexpr bool PERM = true, AFTER_DRAIN = false, PREFETCH = false;
    bf16_t* O; size_t stride; float scale0; unsigned* qkm;
    __device__ __forceinline__ void operator()(const f32x4 (&acc)[2][2][4][2], const Unit& u, int wr, int wc, int fr, int fq) const {
        const int t = u.pn >> 2, colt = (u.pn & 3) * BM, b = u.pm >> 4; bf16_t* base = O + (size_t)t * stride;
        const float sc = (t == 0) ? scale0 : 1.f;
        const int row0 = u.pm * BM + wr * 64 + fr, col0 = colt + wc * 32 + 8 * fq, lane = fr + 16 * fq;
        float mx0 = 0.f, mx1 = 0.f;
#pragma unroll
        for (int ai = 0; ai < 2; ++ai)
#pragma unroll
            for (int m = 0; m < 4; ++m) { bf16_t* rowp = base + (size_t)(row0 + ai * HALF + m * 16) * 1024 + col0;
#pragma unroll
                for (int bj = 0; bj < 2; ++bj) { const f32x4 v0 = acc[ai][bj][m][0] * sc, v1 = acc[ai][bj][m][1] * sc;
                    u32x4 w; w.x = cvt_pk_bf16(v0[0], v0[1]); w.y = cvt_pk_bf16(v0[2], v0[3]); w.z = cvt_pk_bf16(v1[0], v1[1]); w.w = cvt_pk_bf16(v1[2], v1[3]);
                    *PG8_G(u32x4, rowp + bj * HALF) = w;
                    if (t < 2) { float ss = (v0[0] * v0[0] + v0[1] * v0[1]) + (v0[2] * v0[2] + v0[3] * v0[3]) + (v1[0] * v1[0] + v1[1] * v1[1]) + (v1[2] * v1[2] + v1[3] * v1[3]);
                        { auto p16 = __builtin_amdgcn_permlane16_swap(__float_as_uint(ss), __float_as_uint(ss), false, false); ss = __uint_as_float(p16[0]) + __uint_as_float(p16[1]);
                          auto p32 = __builtin_amdgcn_permlane32_swap(__float_as_uint(ss), __float_as_uint(ss), false, false); ss = __uint_as_float(p32[0]) + __uint_as_float(p32[1]); }
                        if (bj == 0) mx0 = fmaxf(mx0, ss); else mx1 = fmaxf(mx1, ss); } } }
        if (t < 2) {
#pragma unroll
            for (int o = 1; o < 16; o <<= 1) { mx0 = fmaxf(mx0, __int_as_float(__builtin_amdgcn_ds_bpermute((lane ^ o) << 2, __float_as_int(mx0)))); mx1 = fmaxf(mx1, __int_as_float(__builtin_amdgcn_ds_bpermute((lane ^ o) << 2, __float_as_int(mx1)))); }
            if (lane == 0) { unsigned* w = qkm + (t * 8 + b) * 32 + (u.pn & 3) * 8 + wc; atomicMax(w, __float_as_uint(mx0)); atomicMax(w + 4, __float_as_uint(mx1)); } }
    }
};
struct EpiResid {
    static constexpr bool PERM = false, AFTER_DRAIN = false, PREFETCH = false;
    const float* base; float* out; const float* gate;
    __device__ __forceinline__ void operator()(const f32x4 (&acc)[2][2][4][2], const Unit& u, int wr, int wc, int fr, int fq) const {
        const int col0 = u.pn * BM + wc * 32 + 4 * fq; const int b = u.pm >> 4;
        f32x4 gv[2][2];
#pragma unroll
        for (int bj = 0; bj < 2; ++bj)
#pragma unroll
            for (int n = 0; n < 2; ++n) gv[bj][n] = *PG8_GC(f32x4, gate + (size_t)b * 6144 + col0 + bj * HALF + n * 16);
#pragma unroll
        for (int ai = 0; ai < 2; ++ai)
#pragma unroll
            for (int m = 0; m < 4; ++m) { const size_t off = (size_t)(u.pm * BM + ai * HALF + wr * 64 + m * 16 + fr) * 1024 + col0;
#pragma unroll
                for (int bj = 0; bj < 2; ++bj)
#pragma unroll
                    for (int n = 0; n < 2; ++n) { const f32x4 bs = *PG8_GC(f32x4, base + off + bj * HALF + n * 16); *PG8_G(f32x4, out + off + bj * HALF + n * 16) = bs + gv[bj][n] * acc[ai][bj][m][n]; }
                if (m & 1) asm volatile("" ::: "memory"); }
    }
};
struct EpiResidB {
    static constexpr bool PERM = true, AFTER_DRAIN = false, PREFETCH = false;
    const float* base; bf16_t* out; const float* gate;
    __device__ __forceinline__ void operator()(const f32x4 (&acc)[2][2][4][2], const Unit& u, int wr, int wc, int fr, int fq) const {
        const int col0 = u.pn * BM + wc * 32 + 8 * fq; const int b = u.pm >> 4;
        f32x4 gv[2][2];
#pragma unroll
        for (int bj = 0; bj < 2; ++bj)
#pragma unroll
            for (int n = 0; n < 2; ++n) gv[bj][n] = *PG8_GC(f32x4, gate + (size_t)b * 6144 + col0 + bj * HALF + n * 4);
#pragma unroll
        for (int ai = 0; ai < 2; ++ai)
#pragma unroll
            for (int m = 0; m < 4; ++m) { const size_t off = (size_t)(u.pm * BM + ai * HALF + wr * 64 + m * 16 + fr) * 1024 + col0;
#pragma unroll
                for (int bj = 0; bj < 2; ++bj) { const f32x4 b0 = *PG8_GC(f32x4, base + off + bj * HALF), b1 = *PG8_GC(f32x4, base + off + bj * HALF + 4);
                    const f32x4 v0 = b0 + gv[bj][0] * acc[ai][bj][m][0], v1 = b1 + gv[bj][1] * acc[ai][bj][m][1];
                    u32x4 w; w.x = cvt_pk_bf16(v0[0], v0[1]); w.y = cvt_pk_bf16(v0[2], v0[3]); w.z = cvt_pk_bf16(v1[0], v1[1]); w.w = cvt_pk_bf16(v1[2], v1[3]);
                    *PG8_G(u32x4, out + off + bj * HALF) = w; }
                if (m & 1) asm volatile("" ::: "memory"); }
    }
};
struct EpiPool {
    static constexpr bool PERM = false, AFTER_DRAIN = false, PREFETCH = false;
    float* xr; const float* gate; const float* pscale;
    __device__ __forceinline__ void operator()(const f32x4 (&acc)[2][2][4][2], const Unit& u, int wr, int wc, int fr, int fq) const {
        const int col0 = u.pn * BM + wc * 32 + 4 * fq; const int b = u.pm >> 4;
        float* rbase = xr + (size_t)(u.pm * BM + wr * 64 + fr) * 1024 + col0;
#pragma unroll
        for (int bj = 0; bj < 2; ++bj)
#pragma unroll
            for (int n = 0; n < 2; ++n) { const f32x4 gv = *(const f32x4*)(gate + (size_t)b * 6144 + col0 + bj * HALF + n * 16) * *(const f32x4*)(pscale + col0 + bj * HALF + n * 16);
#pragma unroll
                for (int ai = 0; ai < 2; ++ai)
#pragma unroll
                    for (int m = 0; m < 4; ++m) { float* p = rbase + (size_t)(ai * HALF + m * 16) * 1024 + bj * HALF + n * 16; const f32x4 bs = *(const f32x4*)p; *(f32x4*)p = bs + gv * acc[ai][bj][m][n]; }
                asm volatile("" ::: "memory"); }
    }
};
__device__ __forceinline__ float silu_mul(float g, float u) { return g * u * __builtin_amdgcn_rcpf(1.0f + __builtin_amdgcn_exp2f(-1.4426950408889634f * g)); }
struct EpiUp {
    static constexpr bool PERM = true, AFTER_DRAIN = false, PREFETCH = false;
    bf16_t* H;
    __device__ __forceinline__ void operator()(const f32x4 (&acc)[2][2][4][2], const Unit& u, int wr, int wc, int fr, int fq) const {
        const int row0 = u.x1 + wr * 64 + fr, col0 = u.x0 * 128 + wc * 32 + 8 * fq;
#pragma unroll
        for (int ai = 0; ai < 2; ++ai) if (ai == 0 || u.full)
#pragma unroll
            for (int m = 0; m < 4; ++m) { bf16_t* rowp = H + (size_t)(row0 + ai * HALF + m * 16) * 512 + col0;
                const f32x4 g0 = acc[ai][0][m][0], g1 = acc[ai][0][m][1], u0 = acc[ai][1][m][0], u1 = acc[ai][1][m][1];
                u32x4 w; w.x = cvt_pk_bf16(silu_mul(g0[0], u0[0]), silu_mul(g0[1], u0[1])); w.y = cvt_pk_bf16(silu_mul(g0[2], u0[2]), silu_mul(g0[3], u0[3]));
                w.z = cvt_pk_bf16(silu_mul(g1[0], u1[0]), silu_mul(g1[1], u1[1])); w.w = cvt_pk_bf16(silu_mul(g1[2], u1[2]), silu_mul(g1[3], u1[3]));
                *PG8_G(u32x4, rowp) = w; }
    }
};
struct EpiDown {
    static constexpr bool PERM = true, AFTER_DRAIN = false, PREFETCH = true;
    bf16_t* Y; const int* tok; const float* gw;
    __device__ __forceinline__ void prefetch(const Unit& u, int wr, int fr, unsigned (&pre)[8]) const {
#pragma unroll
        for (int ai = 0; ai < 2; ++ai)
#pragma unroll
            for (int m = 0; m < 4; ++m) { const int rl = ai * HALF + wr * 64 + m * 16 + fr; pre[ai * 4 + m] = gload_hidden(gw + u.x0 + (rl < u.x1 ? rl : 0)); }
    }
    __device__ __forceinline__ void operator()(const f32x4 (&acc)[2][2][4][2], const Unit& u, int wr, int wc, int fr, int fq, unsigned (&pre)[8]) const {
        const int col0 = u.pn * BM + wc * 32 + 8 * fq;
        asm volatile("" : "+v"(pre[0]), "+v"(pre[1]), "+v"(pre[2]), "+v"(pre[3]), "+v"(pre[4]), "+v"(pre[5]), "+v"(pre[6]), "+v"(pre[7]));
#pragma unroll
        for (int ai = 0; ai < 2; ++ai)
#pragma unroll
            for (int m = 0; m < 4; ++m) { const int rl = ai * HALF + wr * 64 + m * 16 + fr;
                if (rl < u.x1) { const unsigned pw = pre[ai * 4 + m]; const float w8 = (float)(pw & 0xffffu) * (1.0f / 65535.0f); bf16_t* rowp = Y + (size_t)(pw >> 16) * 1024 + col0;
#pragma unroll
                    for (int bj = 0; bj < 2; ++bj) { const f32x4 v0 = acc[ai][bj][m][0] * w8, v1 = acc[ai][bj][m][1] * w8;
                        u32x4 w; w.x = cvt_pk_bf16(v0[0], v0[1]); w.y = cvt_pk_bf16(v0[2], v0[3]); w.z = cvt_pk_bf16(v1[0], v1[1]); w.w = cvt_pk_bf16(v1[2], v1[3]);
                        *PG8_G(u32x4, rowp + bj * HALF) = w; } } }
    }
};

#ifdef GPROBE
__device__ unsigned long long gprobe_acc[4];
#define GP_T(x) const unsigned long long x = __builtin_amdgcn_s_memrealtime()
#else
#define GP_T(x) do {} while (0)
#endif
template <class Epi, class Sched, bool ALIGN_EPI, bool GATHER = false>
__device__ __forceinline__ void gemm_phase(PG8_LAS unsigned char* lds, const Gemm g, const Sched& S, const Epi& E, int wave0) {
    int tid_ = opaque_tid(wave0);
    const int tid = tid_, wid = __builtin_amdgcn_readfirstlane(tid >> 6), lane = tid & 63, wr = wid >> 2, wc = wid & 3, fr = lane & 15, fq = lane >> 4;
    const int K = g.K, nt = K / BK;
    unsigned voffA[2], voffA1[2], voffB[2], nv0[2], nv1[2];
#pragma unroll
    for (int i = 0; i < 2; ++i) { int R, C; stage_rc(tid * 16 + i * 8192, R, C); const int Rb = Epi::PERM ? ((R & ~31) + perm32(R & 31)) : R;
        voffA[i] = (unsigned)(R * g.lda + C) * 2u; voffB[i] = (unsigned)(Rb * g.ldb + C) * 2u; voffA1[i] = 0u; nv0[i] = 0u; nv1[i] = 0u; }
    unsigned (&vA1)[2] = GATHER ? voffA1 : voffA;
#define PG8_ROWOFFS(u_, o0, o1) do { _Pragma("unroll") for (int i = 0; i < 2; ++i) { int R, C; stage_rc(tid * 16 + i * 8192, R, C); o0[i] = S.row_off(u_, R) + (unsigned)C * 2u; o1[i] = S.row_off(u_, HALF + R) + (unsigned)C * 2u; } } while (0)
    const size_t kstep = (size_t)(BK * 2);
    const size_t hstepA = GATHER ? (size_t)0 : (size_t)HALF * g.lda * 2, hstepB = (size_t)HALF * g.ldb * 2;
    const unsigned ldsw = (unsigned)wid * 1024u;
    const int aoff = lds_byte(wr * 64 + fr, fq * 8), boff = lds_byte(wc * 32 + fr, fq * 8);
#define PG8_SA(b, h) (((b) * 2 + (h)) * HTB)
#define PG8_SB(b, h) ((4 + (b) * 2 + (h)) * HTB)
#define PG8_STAGE(bufoff, gbase, voff) do { _Pragma("unroll") for (int _i = 0; _i < 2; ++_i) \
        __builtin_amdgcn_global_load_lds((const unsigned*)((const char*)(gbase) + (voff)[_i]), (PG8_LAS unsigned*)(lds + (bufoff) + ldsw + _i * 8192), 16, 0, 0); } while (0)
#define PG8_LDA(dst, b, h) do { _Pragma("unroll") for (int m = 0; m < 4; ++m) _Pragma("unroll") for (int k = 0; k < 2; ++k) dst[m][k] = *(const PG8_LAS bf16x8*)(lds + PG8_SA(b, h) + aoff + m * 2048 + k * 1024); } while (0)
#define PG8_LDB(dst, b, h) do { _Pragma("unroll") for (int n = 0; n < 2; ++n) _Pragma("unroll") for (int k = 0; k < 2; ++k) dst[n][k] = *(const PG8_LAS bf16x8*)(lds + PG8_SB(b, h) + boff + n * 2048 + k * 1024); } while (0)
#define PG8_MMA(ai, bj, At, Bt) do { __builtin_amdgcn_s_setprio(1); _Pragma("unroll") for (int m = 0; m < 4; ++m) _Pragma("unroll") for (int n = 0; n < 2; ++n) _Pragma("unroll") for (int k = 0; k < 2; ++k) \
        acc[ai][bj][m][n] = __builtin_amdgcn_mfma_f32_16x16x32_bf16(Bt[n][k], At[m][k], acc[ai][bj][m][n], 0, 0, 0); __builtin_amdgcn_s_setprio(0); } while (0)
#define PG8_WAIT_V(n) asm volatile("s_waitcnt vmcnt(" #n ")" ::: "memory")
#define PG8_WAIT_L(n) asm volatile("s_waitcnt lgkmcnt(" #n ")" ::: "memory")
#define PG8_BAR __builtin_amdgcn_s_barrier()
#define PG8_SCHED __builtin_amdgcn_sched_barrier(0)
    Unit cur, nxt; int ui = 0;
#ifdef GPROBE
    const unsigned long long gp_entry = __builtin_amdgcn_s_memrealtime();
#endif
    if constexpr (Sched::DYN) { if (!S.unit_of(S.mbox(0), cur)) return; } else { if (!S.next(0, cur)) return; }
    f32x4 acc[2][2][4][2];
#pragma unroll
    for (int a = 0; a < 2; ++a)
#pragma unroll
        for (int b = 0; b < 2; ++b)
#pragma unroll
            for (int m = 0; m < 4; ++m)
#pragma unroll
                for (int n = 0; n < 2; ++n) acc[a][b][m][n] = (f32x4){0.f, 0.f, 0.f, 0.f};
    bf16x8 At[4][2], B0[2][2], B1[2][2];
    unsigned pre[8];
#pragma unroll
    for (int i = 0; i < 8; ++i) pre[i] = 0u;
    const char* cA = cur.a; const char* cB = cur.b;
    if constexpr (GATHER) PG8_ROWOFFS(cur, voffA, voffA1);
    PG8_STAGE(PG8_SB(0, 0), cB, voffB); PG8_STAGE(PG8_SB(0, 1), cB + hstepB, voffB); PG8_STAGE(PG8_SA(0, 0), cA, voffA); PG8_STAGE(PG8_SA(0, 1), cA + hstepA, vA1);
    if (wr == 1) PG8_BAR;
    PG8_WAIT_V(2); PG8_BAR;
    PG8_STAGE(PG8_SB(1, 0), cB + kstep, voffB); PG8_STAGE(PG8_SA(1, 0), cA + kstep, voffA); PG8_STAGE(PG8_SB(1, 1), cB + hstepB + kstep, voffB);
    PG8_WAIT_V(6); PG8_BAR;
#ifdef GPROBE
    unsigned long long gp_k = 0ull, gp_e = 0ull, gp_o = 0ull; unsigned long long gp_prev = __builtin_amdgcn_s_memrealtime();
#endif
    for (;;) {
        GP_T(gp_t0);
        bool has_next_;
        if constexpr (Sched::DYN) has_next_ = S.unit_of(S.mbox((ui + 1) & 1), nxt); else has_next_ = S.next(ui + 1, nxt);
        const bool has_next = has_next_;
        unsigned kq = 0u;
        if constexpr (Sched::DYN) { if (has_next && tid == 0) kq = gatomic_inc_hidden((const void*)S.ctr); }
        const char* nA = has_next ? nxt.a : cA; const char* nB = has_next ? nxt.b : cB;
        if constexpr (GATHER) { if (has_next) { _Pragma("unroll") for (int i = 0; i < 2; ++i) { int R, C; stage_rc(tid * 16 + i * 8192, R, C); nv0[i] = gload_hidden(S.tok_addr(nxt, R)); nv1[i] = gload_hidden(S.tok_addr(nxt, HALF + R)); } } }
        const bool full = cur.full != 0;
        for (int t = 0; t < nt; t += 2) {
            const bool last = (t == nt - 2);
            const char* a1 = cA + (size_t)(t + 1) * kstep;
            const char* a2 = last ? nA : cA + (size_t)(t + 2) * kstep; const char* b2 = last ? nB : cB + (size_t)(t + 2) * kstep;
            const char* a3 = a2 + kstep; const char* b3 = b2 + kstep;
            PG8_LDB(B0, 0, 0); PG8_LDB(B1, 0, 1); PG8_SCHED; PG8_LDA(At, 0, 0); PG8_STAGE(PG8_SA(1, 1), a1 + hstepA, vA1);
            if constexpr (GATHER) { if (last && has_next) {
                asm volatile("" : "+v"(nv0[0]), "+v"(nv0[1]), "+v"(nv1[0]), "+v"(nv1[1]));
                _Pragma("unroll") for (int i = 0; i < 2; ++i) { int R, C; stage_rc(tid * 16 + i * 8192, R, C); voffA[i] = S.off_of(nv0[i]) + (unsigned)C * 2u; voffA1[i] = S.off_of(nv1[i]) + (unsigned)C * 2u; } } }
            if constexpr (Sched::DYN) { if (last && has_next) { asm volatile("" : "+v"(kq)); if (tid == 0) S.mbox_set(ui & 1, kq); } }
            PG8_WAIT_V(8); PG8_WAIT_L(0); PG8_BAR; if constexpr (Epi::PREFETCH) { if (last) E.prefetch(cur, wr, fr, pre); } PG8_MMA(0, 0, At, B0); PG8_MMA(0, 1, At, B1); PG8_BAR; PG8_SCHED;
            if (full) { PG8_LDA(At, 0, 1); } PG8_STAGE(PG8_SB(0, 0), b2, voffB); PG8_STAGE(PG8_SB(0, 1), b2 + hstepB, voffB); PG8_STAGE(PG8_SA(0, 0), a2, voffA);
            PG8_WAIT_V(8); PG8_WAIT_L(0); PG8_BAR; if (full) { PG8_MMA(1, 0, At, B0); PG8_MMA(1, 1, At, B1); } PG8_BAR; PG8_SCHED;
            PG8_LDB(B0, 1, 0); PG8_LDB(B1, 1, 1); PG8_SCHED; PG8_LDA(At, 1, 0); PG8_STAGE(PG8_SA(0, 1), a2 + hstepA, vA1);
            PG8_WAIT_V(8); PG8_WAIT_L(0); PG8_BAR; PG8_MMA(0, 0, At, B0); PG8_MMA(0, 1, At, B1); PG8_BAR; PG8_SCHED;
            if (full) { PG8_LDA(At, 1, 1); } PG8_STAGE(PG8_SB(1, 0), b3, voffB); PG8_STAGE(PG8_SB(1, 1), b3 + hstepB, voffB); PG8_STAGE(PG8_SA(1, 0), a3, voffA);
            PG8_WAIT_V(8); PG8_WAIT_L(0); PG8_BAR; if (full) { PG8_MMA(1, 0, At, B0); PG8_MMA(1, 1, At, B1); } PG8_BAR; PG8_SCHED;
        }
        GP_T(gp_t1);
        if constexpr (ALIGN_EPI) { if (wr == 0) PG8_BAR; }
        if constexpr (Epi::PREFETCH) E(acc, cur, wr, wc, fr, fq, pre); else E(acc, cur, wr, wc, fr, fq);
        GP_T(gp_t2);
#ifdef GPROBE
        gp_k += gp_t1 - gp_t0; gp_e += gp_t2 - gp_t1; gp_o += gp_t0 - gp_prev; gp_prev = gp_t2;
        if (!has_next) { if (g.tag == GPROBE_TAG && tid == 0) { const unsigned long long busy = gp_t2 - gp_entry; atomicMax(&gprobe_acc[0], busy); atomicAdd(&gprobe_acc[1], busy); atomicMax(&gprobe_acc[2], gp_k); atomicAdd(&gprobe_acc[3], gp_k); } }
#endif
        if (!has_next) break;
#pragma unroll
        for (int a = 0; a < 2; ++a)
#pragma unroll
            for (int b = 0; b < 2; ++b)
#pragma unroll
                for (int m = 0; m < 4; ++m)
#pragma unroll
                    for (int n = 0; n < 2; ++n) acc[a][b][m][n] = (f32x4){0.f, 0.f, 0.f, 0.f};
        cur = nxt; cA = nA; cB = nB; ++ui;
        if constexpr (ALIGN_EPI) { if (wr == 1) PG8_BAR; }
    }
    PG8_WAIT_V(0);
    if constexpr (!ALIGN_EPI) { if (wr == 0) PG8_BAR; }
    PG8_BAR;
#undef PG8_SA
#undef PG8_ROWOFFS
#undef PG8_SB
#undef PG8_STAGE
#undef PG8_LDA
#undef PG8_LDB
#undef PG8_MMA
#undef PG8_WAIT_V
#undef PG8_WAIT_L
#undef PG8_BAR
#undef PG8_SCHED
}
}
namespace attn_body {
using bf16=__hip_bfloat16;
using bf16x8=__attribute__((ext_vector_type(8)))short;
using s16x4=__attribute__((ext_vector_type(4)))short;
using f32x16=__attribute__((ext_vector_type(16)))float;
using f32x4=__attribute__((ext_vector_type(4)))float;
using u32x4=__attribute__((ext_vector_type(4)))unsigned;
constexpr int BATCH=8,NHEAD=16,SEQ=4096,D=64,DM=NHEAD*D;
constexpr int NW=8,QBLK=32,QB=QBLK*NW,KVBLK=64,NQB=SEQ/QB;
constexpr int ATTN_PITCH=DM, ATTN_UNIT_ROWS=QB;
__device__ __forceinline__ int crow(int r,int hi){return (r&3)+8*(r>>2)+4*hi;}
#define SBAR() __builtin_amdgcn_sched_barrier(0)
__device__ __forceinline__ void cmask(f32x16&p0,f32x16&p1,int jb,int qrel,int hi){
  const float NEG=-INFINITY; int kb=64*jb+4*hi;
  #pragma unroll
  for(int r=0;r<16;++r){int kv=kb+(r&3)+8*(r>>2); if(kv>qrel)p0[r]=NEG; if(kv+32>qrel)p1[r]=NEG;}
}

constexpr int NSLOT=3, SLOTB=8192;
constexpr int LDS_K=0, LDS_V=NSLOT*SLOTB, LDS_WS=2*NSLOT*SLOTB, LDS_OST=LDS_WS+NW*64*4, LDS_FS=LDS_OST+NW*4096, LDS_WT=LDS_FS+SEQ*4, LDS_BYTES=LDS_WT+128;
constexpr float C2=0.125f*1.4426950408889634f;
constexpr float LOG2E=1.4426950408889634f;
__device__ __forceinline__ void glds16(const void*gsrc,unsigned lds_dst){unsigned keep;
  asm volatile("s_mov_b32 %0, m0\n\ts_mov_b32 m0, %2\n\ts_nop 0\n\tglobal_load_lds_dwordx4 %1, off\n\ts_mov_b32 m0, %0":"=&s"(keep):"v"(gsrc),"s"(lds_dst):"memory");}
__device__ __forceinline__ void glds16s(const void*sbase,unsigned voff,unsigned lds_dst){unsigned keep;
  asm volatile("s_mov_b32 %0, m0\n\ts_mov_b32 m0, %3\n\ts_nop 4\n\tglobal_load_lds_dwordx4 %1, %2\n\ts_mov_b32 m0, %0":"=&s"(keep):"v"(voff),"s"(sbase),"s"(lds_dst):"memory");}
__device__ __forceinline__ float max3f(float a,float b,float c){float r;asm("v_max3_f32 %0, %1, %2, %3":"=v"(r):"v"(a),"v"(b),"v"(c));return r;}
__device__ __forceinline__ float max2f(float a,float b){float r;asm("v_max_f32_e32 %0, %1, %2":"=v"(r):"v"(a),"v"(b));return r;}
__device__ __forceinline__ float fadd_s(float a,float b){float r;asm("v_add_f32_e32 %0, %1, %2":"=v"(r):"v"(a),"v"(b));return r;}
__device__ __forceinline__ float fsub_s(float a,float b){float r;asm("v_sub_f32_e32 %0, %1, %2":"=v"(r):"v"(a),"v"(b));return r;}
typedef float f32x2_t __attribute__((ext_vector_type(2))); typedef __bf16 bf16x2_t __attribute__((ext_vector_type(2)));
__device__ __forceinline__ unsigned cvtpk_s(float lo,float hi){f32x2_t v={lo,hi};bf16x2_t b=__builtin_convertvector(v,bf16x2_t);return __builtin_bit_cast(unsigned,b);}
#define WAIT_BAR(N) asm volatile("s_waitcnt vmcnt(" #N ") lgkmcnt(0)\n\ts_barrier":::"memory")

typedef __attribute__((address_space(3))) const char* lds_cptr;
typedef short v4i16_t __attribute__((ext_vector_type(4)));
__device__ __forceinline__ void fbias(f32x16&c0,f32x16&c1,lds_cptr ft,float nm,int hi){
  #pragma unroll
  for(int g=0;g<4;++g){
    const f32x4 a=*(const __attribute__((address_space(3))) f32x4*)(ft+(8*g+4*hi)*4);
    const f32x4 b=*(const __attribute__((address_space(3))) f32x4*)(ft+(32+8*g+4*hi)*4);
    c0[4*g+0]=nm-a[0];c0[4*g+1]=nm-a[1];c0[4*g+2]=nm-a[2];c0[4*g+3]=nm-a[3];
    c1[4*g+0]=nm-b[0];c1[4*g+1]=nm-b[1];c1[4*g+2]=nm-b[2];c1[4*g+3]=nm-b[3];}
}
__device__ __forceinline__ void qkt(f32x16&p0,f32x16&p1,const char*Kslot,const bf16x8*qr,int r32,int hi){
  const char*kb=Kslot+hi*1024+r32*16;
  #pragma unroll
  for(int d0=0;d0<4;++d0){
    const bf16x8 b0=*reinterpret_cast<const bf16x8*>(kb+d0*2048);
    const bf16x8 b1=*reinterpret_cast<const bf16x8*>(kb+d0*2048+512);
    p0=__builtin_amdgcn_mfma_f32_32x32x16_bf16(b0,qr[d0],p0,0,0,0);p1=__builtin_amdgcn_mfma_f32_32x32x16_bf16(b1,qr[d0],p1,0,0,0);}
}
__device__ __forceinline__ void kload8(bf16x8*kf,lds_cptr kp){
  kf[0]=*(const __attribute__((address_space(3))) bf16x8*)(kp);      kf[1]=*(const __attribute__((address_space(3))) bf16x8*)(kp+512);
  kf[2]=*(const __attribute__((address_space(3))) bf16x8*)(kp+2048); kf[3]=*(const __attribute__((address_space(3))) bf16x8*)(kp+2560);
  kf[4]=*(const __attribute__((address_space(3))) bf16x8*)(kp+4096); kf[5]=*(const __attribute__((address_space(3))) bf16x8*)(kp+4608);
  kf[6]=*(const __attribute__((address_space(3))) bf16x8*)(kp+6144); kf[7]=*(const __attribute__((address_space(3))) bf16x8*)(kp+6656);
}
__device__ __forceinline__ void kload2(bf16x8*kf,lds_cptr kp,int j){ kf[2*j]=*(const __attribute__((address_space(3))) bf16x8*)(kp+j*2048); kf[2*j+1]=*(const __attribute__((address_space(3))) bf16x8*)(kp+j*2048+512); }
__device__ __forceinline__ s16x4 vtr(lds_cptr p){ return __builtin_bit_cast(s16x4,__builtin_amdgcn_ds_read_tr16_b64_v4i16((__attribute__((address_space(3))) v4i16_t*)p)); }
__device__ __forceinline__ float rowmax(const f32x16&p0,const f32x16&p1){
  float a=max3f(p0[0],p0[1],p1[0]),b=max3f(p0[2],p0[3],p1[1]);a=max3f(a,p1[2],p1[3]);
  #pragma unroll
  for(int r=4;r<16;r+=4){a=max3f(a,p0[r],p0[r+1]);b=max3f(b,p0[r+2],p0[r+3]);a=max3f(a,p1[r],p1[r+1]);b=max3f(b,p1[r+2],p1[r+3]);}
  const float m=max2f(a,b);
  auto rr=__builtin_amdgcn_permlane32_swap(__float_as_uint(m),__float_as_uint(m),false,false);
  return max2f(__uint_as_float(rr[0]),__uint_as_float(rr[1]));
}
__device__ __forceinline__ void pv(f32x16*o,int vb,bf16x8 pa0,bf16x8 pa1,bf16x8 pa2,bf16x8 pa3){
  #pragma unroll
  for(int d0=0;d0<2;++d0){s16x4 lo[4],hi[4];
    #pragma unroll
    for(int ks=0;ks<4;++ks){
      asm volatile("ds_read_b64_tr_b16 %0,%1 offset:%c2":"=&v"(lo[ks]):"v"(vb),"i"(d0*4096+ks*1024):"memory");
      asm volatile("ds_read_b64_tr_b16 %0,%1 offset:%c2":"=&v"(hi[ks]):"v"(vb),"i"(d0*4096+ks*1024+512):"memory");}
    asm volatile("s_waitcnt lgkmcnt(0)":::"memory");SBAR();
    #define PK(k) (bf16x8){lo[k][0],lo[k][1],lo[k][2],lo[k][3],hi[k][0],hi[k][1],hi[k][2],hi[k][3]}
    o[d0]=__builtin_amdgcn_mfma_f32_32x32x16_bf16(pa0,PK(0),o[d0],0,0,0);
    o[d0]=__builtin_amdgcn_mfma_f32_32x32x16_bf16(pa1,PK(1),o[d0],0,0,0);
    o[d0]=__builtin_amdgcn_mfma_f32_32x32x16_bf16(pa2,PK(2),o[d0],0,0,0);
    o[d0]=__builtin_amdgcn_mfma_f32_32x32x16_bf16(pa3,PK(3),o[d0],0,0,0);
    #undef PK
  }
}

#ifndef ATTN_STORE16
#define ATTN_STORE16(p,v) (*(__attribute__((address_space(1))) u32x4*)(p)=(v))
#endif
template<int THRL> __device__ __forceinline__ void attn_unit(int b,int h,int qb,const bf16*Q,const bf16*__restrict__ K,const bf16*__restrict__ V,bf16*O,const float*LF,char*shm,int wave0){
  int tid_=opaque_tid(wave0);
  const int tid=tid_,lane=tid&63,r32=lane&31,hi=lane>>5; const int wid=__builtin_amdgcn_readfirstlane(tid>>6);
  const long rowbase=(long)b*SEQ; const int q0=qb*QB;
  const bf16*Qw=Q+(rowbase+q0+wid*QBLK)*DM+h*D;
  const bf16*Kh=K+rowbase*DM+h*D,*Vh=V+rowbase*DM+h*D;
  const unsigned lds0=(unsigned)(uintptr_t)shm;
  float*wsf=(float*)(shm+LDS_WS)+wid*64;
  const lds_cptr shm3=(lds_cptr)shm;
  { const int n=q0+QB; const float*lf=LF+((long)b*NHEAD+h)*SEQ;
    unsigned wtb_=(unsigned)(uintptr_t)(shm3+LDS_WT); asm volatile("":"+v"(wtb_));
    volatile __attribute__((address_space(3))) float*wt=(volatile __attribute__((address_space(3))) float*)wtb_;
    f32x4 v0=(f32x4){0.f,0.f,0.f,0.f},v1=(f32x4){0.f,0.f,0.f,0.f};
    if(8*tid<n){v0=*(const f32x4*)(lf+8*tid);v1=*(const f32x4*)(lf+8*tid+4);}
    v0[1]+=v0[0];v0[2]+=v0[1];v0[3]+=v0[2];v1[0]+=v0[3];v1[1]+=v1[0];v1[2]+=v1[1];v1[3]+=v1[2];
    const float tot=v1[3]; float inc=tot;
    #pragma unroll
    for(int o_=1;o_<64;o_<<=1){const float t_=__int_as_float(__builtin_amdgcn_ds_bpermute((lane-o_)<<2,__float_as_int(inc)));if(lane>=o_)inc+=t_;}
    if(lane==63)wt[wid]=inc;
    __syncthreads();
    float base=inc-tot;
    #pragma unroll
    for(int w_=0;w_<NW;++w_){const float x_=wt[w_]; if(w_<wid)base+=x_;}
    if(tid==(q0>>3))wt[8]=base+v0[0];
    __syncthreads();
    const float anc=wt[8];
    if(8*tid<n){ __attribute__((address_space(3))) f32x4*fo=(__attribute__((address_space(3))) f32x4*)(shm3+LDS_FS)+2*tid;
      fo[0]=(v0+(base-anc))*LOG2E; fo[1]=(v1+(base-anc))*LOG2E; }
  }
  const lds_cptr fs3=shm3+LDS_FS;
  const bf16*ksrc=Kh+(long)lane*DM+wid*8;
  const bf16*vsrc=Vh+(long)(16*(wid&3)+(lane>>2))*DM+(wid>>2)*32+(lane&3)*8;
  const unsigned kdst=lds0+LDS_K+wid*1024, vdst=lds0+LDS_V+wid*1024;
  #define DMA_K(t,slot) glds16(ksrc+(long)(t)*KVBLK*DM,(unsigned)__builtin_amdgcn_readfirstlane(kdst+(slot)))
  #define DMA_V(t,slot) glds16(vsrc+(long)(t)*KVBLK*DM,(unsigned)__builtin_amdgcn_readfirstlane(vdst+(slot)))
  const int vb0=(int)(lds0+LDS_V)+((lane>>4)&1)*32+(lane&3)*8+(4*hi+((lane&15)>>2))*64;
  const char*Kbase=shm+LDS_K; bf16x8 kf[8];
  const lds_cptr kp0=shm3+LDS_K+hi*1024+r32*16; const lds_cptr vp0=shm3+LDS_V+((lane>>4)&1)*32+(lane&3)*8+(4*hi+((lane&15)>>2))*64;
  const int NT=(q0+QB)/KVBLK;
  DMA_K(0,0);DMA_V(0,0);DMA_K(1,SLOTB);
  bf16x8 qr[4];
  #pragma unroll
  for(int d0=0;d0<4;++d0)qr[d0]=*(const __attribute__((address_space(1))) bf16x8*)(&Qw[(long)r32*DM+d0*16+hi*8]);
  float mhat=0.f,l_reg=0.f;f32x16 o[2];o[0]=f32x16{};o[1]=f32x16{};
  const int qrel=wid*QBLK+r32;
  #define CMASK(P0,P1,t) do{int jb_=(t)-(NT-4); if(jb_>=0)cmask(P0,P1,jb_,qrel,hi);}while(0)
  bool resc=false;
  #define START(P0,P1) do{ const float rm=rowmax(P0,P1); resc=false; \
    { const float dl=rm; mhat=fadd_s(mhat,dl); \
      _Pragma("unroll") for(int r=0;r<16;++r){P0[r]=fsub_s(P0[r],dl);P1[r]=fsub_s(P1[r],dl);} } \
    _Pragma("unroll") for(int r=0;r<16;++r)P0[r]=__builtin_amdgcn_exp2f(P0[r]); }while(0)
  #define RESC() do{ if(resc){ asm volatile("s_waitcnt lgkmcnt(0)":::"memory"); \
      _Pragma("unroll") for(int d_=0;d_<2;++d_) _Pragma("unroll") for(int r=0;r<16;++r)o[d_][r]*=wsf[crow(r,hi)]; } }while(0)
  f32x16 pA0,pA1,pB0,pB1;
  int sl_prev=0,sl_cur=0,sl_next=SLOTB;
  #define ROT() do{sl_prev=sl_cur;sl_cur=sl_next;sl_next=(sl_next==(NSLOT-1)*SLOTB)?0:sl_next+SLOTB;}while(0)
  DMA_K(2,2*SLOTB);
  WAIT_BAR(3);
  fbias(pA0,pA1,fs3,0.f,hi);
  qkt(pA0,pA1,Kbase,qr,r32,hi);asm volatile("s_nop 15\n\ts_nop 7":"+v"(pA0),"+v"(pA1));CMASK(pA0,pA1,0);
  START(pA0,pA1);
  _Pragma("unroll") for(int r=0;r<16;++r)pA1[r]=__builtin_amdgcn_exp2f(pA1[r]);
  WAIT_BAR(0);
  DMA_K(3,0);DMA_V(1,SLOTB);
  ROT();
  kload8(kf,kp0+sl_cur);
  WAIT_BAR(2);
  s16x4 vlo[8],vhi[8]; u32x4 pw0,pw1,pw2,pw3;
  #define PKW(P,B) cvtpk_s(P[B],P[B+1])
  #define PAF(k) __builtin_bit_cast(bf16x8,pw##k)
  #define VFR(i) (bf16x8){vlo[i][0],vlo[i][1],vlo[i][2],vlo[i][3],vhi[i][0],vhi[i][1],vhi[i][2],vhi[i][3]}
  #define PIN(x) asm volatile("":"+v"(x))
  #define MX3(a,b,c) __builtin_fmaxf(__builtin_fmaxf((a),(b)),(c))
  #define GAPA(MF,A0,A1,A2,A3,W0,W1,PW) do{ MF; sacc+=A0; sacc+=A1; sacc+=A2; sacc+=A3; PIN(sacc); W0; W1; PIN(PW); SBAR(); }while(0)
  #define EX(v) __builtin_amdgcn_exp2f(v)
  #define GAPB(MF,X,B) do{ MF; X[B]=EX(X[B]); X[B+1]=EX(X[B+1]); X[B+2]=EX(X[B+2]); X[B+3]=EX(X[B+3]); PIN(X); SBAR(); }while(0)
  #define VRD(i) do{ vlo[i]=vtr(vp_+(((i)>>2)*4096+((i)&3)*1024)); vhi[i]=vtr(vp_+(((i)>>2)*4096+((i)&3)*1024+512)); }while(0)
  #define KRD(G,j) do{ if(G){ kload2(kf,kp0+sl_next,j); SBAR(); } }while(0)
  #define STEP(C0,C1,P0,P1,t,GK,GV,GL) do{ SBAR(); \
    const lds_cptr vp_=vp0+sl_prev; \
    fbias(C0,C1,fs3+(t)*256,-mhat,hi); SBAR(); \
    VRD(0); SBAR(); float sacc=(P0[0]+P0[1]); \
    GAPA(C0=__builtin_amdgcn_mfma_f32_32x32x16_bf16(kf[0],qr[0],C0,0,0,0), P0[2],P0[3],P0[4],P0[5],     pw0[0]=PKW(P0,0), pw0[1]=PKW(P0,2), pw0); \
    VRD(4); SBAR(); GAPA(C1=__builtin_amdgcn_mfma_f32_32x32x16_bf16(kf[1],qr[0],C1,0,0,0), P0[6],P0[7],P0[8],P0[9],     pw0[2]=PKW(P0,4), pw0[3]=PKW(P0,6), pw0); \
    VRD(1); SBAR(); GAPA(C0=__builtin_amdgcn_mfma_f32_32x32x16_bf16(kf[2],qr[1],C0,0,0,0),   P0[10],P0[11],P0[12],P0[13], pw1[0]=PKW(P0,8), pw1[1]=PKW(P0,10), pw1); \
    VRD(5); SBAR(); GAPA(C1=__builtin_amdgcn_mfma_f32_32x32x16_bf16(kf[3],qr[1],C1,0,0,0),   P0[14],P0[15],P1[0],P1[1],   pw1[2]=PKW(P0,12),pw1[3]=PKW(P0,14), pw1); \
    VRD(2); SBAR(); GAPA(C0=__builtin_amdgcn_mfma_f32_32x32x16_bf16(kf[4],qr[2],C0,0,0,0),   P1[2],P1[3],P1[4],P1[5],     pw2[0]=PKW(P1,0), pw2[1]=PKW(P1,2), pw2); \
    VRD(6); SBAR(); GAPA(C1=__builtin_amdgcn_mfma_f32_32x32x16_bf16(kf[5],qr[2],C1,0,0,0),   P1[6],P1[7],P1[8],P1[9],     pw2[2]=PKW(P1,4), pw2[3]=PKW(P1,6), pw2); \
    VRD(3); SBAR(); GAPA(C0=__builtin_amdgcn_mfma_f32_32x32x16_bf16(kf[6],qr[3],C0,0,0,0),   P1[10],P1[11],P1[12],P1[13], pw3[0]=PKW(P1,8), pw3[1]=PKW(P1,10), pw3); \
    VRD(7); SBAR(); GAPA(C1=__builtin_amdgcn_mfma_f32_32x32x16_bf16(kf[7],qr[3],C1,0,0,0),   P1[14],P1[15],0.f,0.f,       pw3[2]=PKW(P1,12),pw3[3]=PKW(P1,14), pw3); \
    l_reg+=sacc; \
    if(GK){DMA_K((t)+3,sl_cur);} if(GV){DMA_V((t)+1,sl_next);} \
    CMASK(C0,C1,t); \
    { float a=MX3(C0[0],C0[1],C1[0]),b=MX3(C0[2],C0[3],C1[1]); a=MX3(a,C1[2],C1[3]); \
      _Pragma("unroll") for(int r=4;r<16;r+=4){a=MX3(a,C0[r],C0[r+1]);b=MX3(b,C0[r+2],C0[r+3]);a=MX3(a,C1[r],C1[r+1]);b=MX3(b,C1[r+2],C1[r+3]);} \
      float rm=__builtin_fmaxf(a,b); { auto rr=__builtin_amdgcn_permlane32_swap(__float_as_uint(rm),__float_as_uint(rm),false,false); rm=__builtin_fmaxf(__uint_as_float(rr[0]),__uint_as_float(rr[1])); } \
      resc=false; \
      if(__builtin_expect(__any(rm>(float)THRL),0)){ const float dl=__builtin_fmaxf(rm,0.f); mhat+=dl; \
        _Pragma("unroll") for(int r=0;r<16;++r){C0[r]-=dl;C1[r]-=dl;} \
        const float f=__builtin_amdgcn_exp2f(-dl); l_reg*=f; if(hi==0)wsf[r32]=f; resc=true; } } \
    SBAR(); \
    GAPB(o[0]=__builtin_amdgcn_mfma_f32_32x32x16_bf16(PAF(0),VFR(0),o[0],0,0,0), C0,0); \
    GAPB(o[1]=__builtin_amdgcn_mfma_f32_32x32x16_bf16(PAF(0),VFR(4),o[1],0,0,0), C0,4); \
    KRD(GL,0); GAPB(o[0]=__builtin_amdgcn_mfma_f32_32x32x16_bf16(PAF(1),VFR(1),o[0],0,0,0), C0,8); \
    KRD(GL,1); GAPB(o[1]=__builtin_amdgcn_mfma_f32_32x32x16_bf16(PAF(1),VFR(5),o[1],0,0,0), C0,12); \
    KRD(GL,2); GAPB(o[0]=__builtin_amdgcn_mfma_f32_32x32x16_bf16(PAF(2),VFR(2),o[0],0,0,0), C1,0); \
    KRD(GL,3); GAPB(o[1]=__builtin_amdgcn_mfma_f32_32x32x16_bf16(PAF(2),VFR(6),o[1],0,0,0), C1,4); \
    GAPB(o[0]=__builtin_amdgcn_mfma_f32_32x32x16_bf16(PAF(3),VFR(3),o[0],0,0,0), C1,8); \
    GAPB(o[1]=__builtin_amdgcn_mfma_f32_32x32x16_bf16(PAF(3),VFR(7),o[1],0,0,0), C1,12); \
    }while(0)
  int t=1;
  #undef CMASK
  #define CMASK(P0,P1,t) do{}while(0)
  for(;t+5<NT;t+=2){
    STEP(pB0,pB1,pA0,pA1,t,true,true,true);     WAIT_BAR(2); RESC(); ROT();
    STEP(pA0,pA1,pB0,pB1,t+1,true,true,true);   WAIT_BAR(2); RESC(); ROT();
  }
  #undef CMASK
  #define CMASK(P0,P1,t) do{int jb_=(t)-(NT-4); if(jb_>=0)cmask(P0,P1,jb_,qrel,hi);}while(0)
  #define ENDW(tt) do{ if((tt)+3<NT){WAIT_BAR(2);} else if((tt)+2<NT){WAIT_BAR(1);} else {WAIT_BAR(0);} }while(0)
  for(;t+1<NT;t+=2){
    STEP(pB0,pB1,pA0,pA1,t,(t+3<NT),(t+1<NT),(t+1<NT));       ENDW(t);   RESC(); ROT();
    STEP(pA0,pA1,pB0,pB1,t+1,(t+4<NT),(t+2<NT),(t+2<NT));     ENDW(t+1); RESC(); ROT();
  }
  STEP(pB0,pB1,pA0,pA1,NT-1,false,false,false); RESC();
  { float sacc=pB0[0]+pB0[1]; _Pragma("unroll") for(int r=2;r<16;++r)sacc+=pB0[r]; _Pragma("unroll") for(int r=0;r<16;++r)sacc+=pB1[r]; l_reg+=sacc;
    pw0=(u32x4){PKW(pB0,0),PKW(pB0,2),PKW(pB0,4),PKW(pB0,6)};pw1=(u32x4){PKW(pB0,8),PKW(pB0,10),PKW(pB0,12),PKW(pB0,14)};pw2=(u32x4){PKW(pB1,0),PKW(pB1,2),PKW(pB1,4),PKW(pB1,6)};pw3=(u32x4){PKW(pB1,8),PKW(pB1,10),PKW(pB1,12),PKW(pB1,14)};
    SBAR(); pv(o,vb0+sl_cur,PAF(0),PAF(1),PAF(2),PAF(3)); }
  #undef PKW
  #undef PAF
  #undef VFR
  #undef PIN
  #undef MX3
  #undef GAPA
  #undef GAPB
  #undef EX
  #undef VRD
  #undef KRD
  #undef STEP
  #undef ENDW
  {auto rr=__builtin_amdgcn_permlane32_swap(__float_as_uint(l_reg),__float_as_uint(l_reg),false,false);l_reg=__uint_as_float(rr[0])+__uint_as_float(rr[1]);}
  if(hi==0)wsf[32+r32]=l_reg;asm volatile("s_waitcnt lgkmcnt(0)":::"memory");
  float rli[16];
  #pragma unroll
  for(int r=0;r<16;++r)rli[r]=__builtin_amdgcn_rcpf(wsf[32+crow(r,hi)]);
  bf16*Ow=O+(rowbase+q0+wid*QBLK)*DM+h*D;
  { bf16*stg=(bf16*)(shm+LDS_OST)+wid*2048;
    #pragma unroll
    for(int r=0;r<16;++r){const int orow=crow(r,hi);
      #pragma unroll
      for(int d0=0;d0<2;++d0)stg[orow*64+d0*32+r32]=__float2bfloat16(o[d0][r]*rli[r]);}
    asm volatile("s_waitcnt lgkmcnt(0)":::"memory");
    #pragma unroll
    for(int i=0;i<4;++i){const int row=i*8+(lane>>3),ch=lane&7; const u32x4 v=*(const u32x4*)(stg+row*64+ch*8); ATTN_STORE16(Ow+(long)row*DM+ch*8,v);} }
  asm volatile("s_waitcnt lgkmcnt(0)\n\ts_barrier":::"memory");
  #undef DMA_K
  #undef DMA_V
  #undef CMASK
  #undef START
  #undef RESC
  #undef ROT
}

constexpr float T_UNDER=40.f;
#ifdef APROBE
#define AP_ARG ,unsigned long long(&ap_t)[3]
#define AP_STAMP(i) ap_t[i]=__builtin_amdgcn_s_memrealtime()
#else
#define AP_ARG
#define AP_STAMP(i) do{}while(0)
#endif
template<int DUMMY> __device__ __forceinline__ void attn_unit_fast(int b,int h,int qb,float M,float Kmax,const bf16*Q,const bf16*__restrict__ K,const bf16*__restrict__ V,bf16*O,const float*LF,char*shm,int wave0 AP_ARG){
  int tid_=opaque_tid(wave0);
  const int tid=tid_,lane=tid&63,r32=lane&31,hi=lane>>5; const int wid=__builtin_amdgcn_readfirstlane(tid>>6);
  const long rowbase=(long)b*SEQ; const int q0=qb*QB;
  const bf16*Qw=Q+(rowbase+q0+wid*QBLK)*DM+h*D;
  const bf16*Kh=K+rowbase*DM+h*D,*Vh=V+rowbase*DM+h*D;
  const unsigned lds0=(unsigned)(uintptr_t)shm;
  const lds_cptr shm3=(lds_cptr)shm;
  const lds_cptr fs3=shm3+LDS_FS;
  const int NT=(q0+QB)/KVBLK;
  const char*kbase=(const char*)(Kh+(long)(NT-1)*KVBLK*DM),*vbase=(const char*)(Vh+(long)(NT-1)*KVBLK*DM);
  const unsigned koff=(unsigned)((lane*DM+wid*8)*2), voff=(unsigned)(((16*(wid&3)+(lane>>2))*DM+(wid>>2)*32+(lane&3)*8)*2);
  const unsigned kdst=lds0+LDS_K+wid*1024, vdst=lds0+LDS_V+wid*1024;
  #define DMA_K(t,slot) glds16s(kbase-(long)(t)*(KVBLK*DM*2),koff,(unsigned)__builtin_amdgcn_readfirstlane(kdst+(slot)))
  #define DMA_V(t,slot) glds16s(vbase-(long)(t)*(KVBLK*DM*2),voff,(unsigned)__builtin_amdgcn_readfirstlane(vdst+(slot)))
  const char*Kbase=shm+LDS_K; bf16x8 kf[8];
  const lds_cptr kp0=shm3+LDS_K+hi*1024+r32*16; const lds_cptr vp0=shm3+LDS_V+((lane>>4)&1)*32+(lane&3)*8+(4*hi+((lane&15)>>2))*64;
  const int nsc=q0+QB; f32x4 sv0=(f32x4){0.f,0.f,0.f,0.f},sv1=(f32x4){0.f,0.f,0.f,0.f};
  { const float*lf=LF+((long)b*NHEAD+h)*SEQ; if(8*tid<nsc){sv0=*(const __attribute__((address_space(1))) f32x4*)(lf+8*tid);sv1=*(const __attribute__((address_space(1))) f32x4*)(lf+8*tid+4);} }
  DMA_K(0,0);DMA_V(0,0);DMA_K(1,SLOTB);
  bf16x8 qr[4];
  #pragma unroll
  for(int d0=0;d0<4;++d0)qr[d0]=*(const __attribute__((address_space(1))) bf16x8*)(&Qw[(long)r32*DM+d0*16+hi*8]);
  float l_reg=0.f;f32x16 o[2];o[0]=f32x16{};o[1]=f32x16{};
  const int qrel=wid*QBLK+r32;
  float wbnd;
  { const int tb_=opaque_tid(wave0),lb_=tb_&63; const bf16*Krow=K+(rowbase+q0+(tb_>>6)*QBLK+(lb_&31))*DM+h*D+(lb_>>5)*8; float qq=0.f,qk=0.f;
    #pragma unroll
    for(int d0=0;d0<4;++d0){ const bf16x8 kr=*(const __attribute__((address_space(1))) bf16x8*)(Krow+d0*16);
      #pragma unroll
      for(int j=0;j<8;++j){ const float qf=__uint_as_float(((unsigned)(unsigned short)qr[d0][j])<<16), kf_=__uint_as_float(((unsigned)(unsigned short)kr[j])<<16); qq+=qf*qf; qk+=qf*kf_; } }
    { auto r1=__builtin_amdgcn_permlane32_swap(__float_as_uint(qq),__float_as_uint(qq),false,false); qq=__uint_as_float(r1[0])+__uint_as_float(r1[1]);
      auto r2=__builtin_amdgcn_permlane32_swap(__float_as_uint(qk),__float_as_uint(qk),false,false); qk=__uint_as_float(r2[0])+__uint_as_float(r2[1]); }
    wbnd=1.01f*sqrtf(qq)*Kmax-qk+1e-3f;
    #pragma unroll
    for(int o_=1;o_<32;o_<<=1) wbnd=fmaxf(wbnd,__int_as_float(__builtin_amdgcn_ds_bpermute((lb_^o_)<<2,__float_as_int(wbnd)))); }
  #define CMASK(P0,P1,t) do{int jb_=3-(t); if(jb_>=0)cmask(P0,P1,jb_,qrel,hi);}while(0)
  f32x16 pA0,pA1,pB0,pB1;
  int sl_prev=0,sl_cur=0,sl_next=SLOTB;
  #define ROT() do{sl_prev=sl_cur;sl_cur=sl_next;sl_next=(sl_next==(NSLOT-1)*SLOTB)?0:sl_next+SLOTB;}while(0)
  DMA_K(2,2*SLOTB);
  float ubnd=0.f;
  { unsigned wtb_=(unsigned)(uintptr_t)(shm3+LDS_WT); asm volatile("":"+v"(wtb_));
    volatile __attribute__((address_space(3))) float*wt=(volatile __attribute__((address_space(3))) float*)wtb_;
    f32x4 v0=sv0,v1=sv1;
    v0[1]+=v0[0];v0[2]+=v0[1];v0[3]+=v0[2];v1[0]+=v0[3];v1[1]+=v1[0];v1[2]+=v1[1];v1[3]+=v1[2];
    const float tot=v1[3]; float inc=tot;
    #pragma unroll
    for(int o_=1;o_<64;o_<<=1){const float t_=__int_as_float(__builtin_amdgcn_ds_bpermute((lane-o_)<<2,__float_as_int(inc)));if(lane>=o_)inc+=t_;}
    if(lane==63)wt[wid]=inc;
    if(lane==0)wt[16+wid]=wbnd;
    asm volatile("s_waitcnt lgkmcnt(0)\n\ts_barrier":::"memory");
    ubnd=wt[16];
    #pragma unroll
    for(int w_=1;w_<NW;++w_)ubnd=fmaxf(ubnd,wt[16+w_]);
    float base=inc-tot;
    #pragma unroll
    for(int w_=0;w_<NW;++w_){const float x_=wt[w_]; if(w_<wid)base+=x_;}
    if(tid==(q0>>3))wt[8]=base+v0[0];
    asm volatile("s_waitcnt lgkmcnt(0)\n\ts_barrier":::"memory");
    const float anc=wt[8];
    if(8*tid<nsc){ __attribute__((address_space(3))) f32x4*fo=(__attribute__((address_space(3))) f32x4*)(shm3+LDS_FS)+2*tid;
      fo[0]=(v0+(base-anc))*LOG2E; fo[1]=(v1+(base-anc))*LOG2E; }
  }
  WAIT_BAR(3);
  AP_STAMP(0);
  const float nm=*(const __attribute__((address_space(3))) float*)(fs3+(q0+qrel)*4)-M;
  int NP;
  { const float fv=(lane<NT)?*(const __attribute__((address_space(3))) float*)(fs3+(64*lane+63)*4):0.f;
    const unsigned long long bal=__ballot((lane<NT)&&(fv>fminf(ubnd,2.f*M)+T_UNDER));
    const int tstop=__builtin_popcountll(bal); int np=NT-tstop; np=(np+1)&~1; NP=np<4?4:np; NP=__builtin_amdgcn_readfirstlane(NP); }
#ifdef NPPROBE
  if(tid==0)atomicAdd(&pg8::gprobe_acc[0],(unsigned long long)NP);
#endif
  fbias(pA0,pA1,fs3+(NT-1)*256,nm,hi);
  qkt(pA0,pA1,Kbase,qr,r32,hi);asm volatile("s_nop 15\n\ts_nop 7":"+v"(pA0),"+v"(pA1));CMASK(pA0,pA1,0);
  _Pragma("unroll") for(int r=0;r<16;++r){pA0[r]=__builtin_amdgcn_exp2f(pA0[r]);pA1[r]=__builtin_amdgcn_exp2f(pA1[r]);}
  WAIT_BAR(0);
  DMA_K(3,0);DMA_V(1,SLOTB);
  ROT();
  kload8(kf,kp0+sl_cur);
  fbias(pB0,pB1,fs3+(NT-2)*256,nm,hi);
  WAIT_BAR(2);
  s16x4 vlo[8],vhi[8]; u32x4 pw0,pw1,pw2,pw3;
  #define PKW(P,B) cvtpk_s(P[B],P[B+1])
  #define PAF(k) __builtin_bit_cast(bf16x8,pw##k)
  #define VFR(i) (bf16x8){vlo[i][0],vlo[i][1],vlo[i][2],vlo[i][3],vhi[i][0],vhi[i][1],vhi[i][2],vhi[i][3]}
  #define PIN(x) asm volatile("":"+v"(x))
  #define GAPA(MF,A0,A1,A2,A3,W0,W1,PW) do{ MF; sacc+=A0; sacc+=A1; sacc+=A2; sacc+=A3; PIN(sacc); W0; W1; PIN(PW); SBAR(); }while(0)
  #define EX(v) __builtin_amdgcn_exp2f(v)
  #define GAPB(MF,X,B,Y,GL) do{ MF; X[B]=EX(X[B]); X[B+1]=EX(X[B+1]); X[B+2]=EX(X[B+2]); X[B+3]=EX(X[B+3]); PIN(X); \
      if(GL){ Y[B]=nm-Y[B]; Y[B+1]=nm-Y[B+1]; Y[B+2]=nm-Y[B+2]; Y[B+3]=nm-Y[B+3]; PIN(Y); } SBAR(); }while(0)
  #define VRD(i) do{ vlo[i]=vtr(vp_+(((i)>>2)*4096+((i)&3)*1024)); vhi[i]=vtr(vp_+(((i)>>2)*4096+((i)&3)*1024+512)); }while(0)
  #define KRD(G,j) do{ if(G){ kload2(kf,kp0+sl_next,j); SBAR(); } }while(0)
  #define FLD(Y0,Y1,t) do{ const lds_cptr ft_=fs3+(NT-2-(t))*256+hi*16; \
      _Pragma("unroll") for(int g_=0;g_<4;++g_){ const f32x4 a_=*(const __attribute__((address_space(3))) f32x4*)(ft_+g_*32); const f32x4 b_=*(const __attribute__((address_space(3))) f32x4*)(ft_+128+g_*32); \
        Y0[4*g_]=a_[0];Y0[4*g_+1]=a_[1];Y0[4*g_+2]=a_[2];Y0[4*g_+3]=a_[3]; Y1[4*g_]=b_[0];Y1[4*g_+1]=b_[1];Y1[4*g_+2]=b_[2];Y1[4*g_+3]=b_[3]; } }while(0)
  #define STEP(C0,C1,P0,P1,t,GK,GV,GL) do{ SBAR(); \
    const lds_cptr vp_=vp0+sl_prev; \
    VRD(0); SBAR(); float sacc=(P0[0]+P0[1]); \
    GAPA(C0=__builtin_amdgcn_mfma_f32_32x32x16_bf16(kf[0],qr[0],C0,0,0,0), P0[2],P0[3],P0[4],P0[5],     pw0[0]=PKW(P0,0), pw0[1]=PKW(P0,2), pw0); \
    VRD(4); SBAR(); GAPA(C1=__builtin_amdgcn_mfma_f32_32x32x16_bf16(kf[1],qr[0],C1,0,0,0), P0[6],P0[7],P0[8],P0[9],     pw0[2]=PKW(P0,4), pw0[3]=PKW(P0,6), pw0); \
    VRD(1); SBAR(); GAPA(C0=__builtin_amdgcn_mfma_f32_32x32x16_bf16(kf[2],qr[1],C0,0,0,0),   P0[10],P0[11],P0[12],P0[13], pw1[0]=PKW(P0,8), pw1[1]=PKW(P0,10), pw1); \
    VRD(5); SBAR(); GAPA(C1=__builtin_amdgcn_mfma_f32_32x32x16_bf16(kf[3],qr[1],C1,0,0,0),   P0[14],P0[15],P1[0],P1[1],   pw1[2]=PKW(P0,12),pw1[3]=PKW(P0,14), pw1); \
    VRD(2); SBAR(); GAPA(C0=__builtin_amdgcn_mfma_f32_32x32x16_bf16(kf[4],qr[2],C0,0,0,0),   P1[2],P1[3],P1[4],P1[5],     pw2[0]=PKW(P1,0), pw2[1]=PKW(P1,2), pw2); \
    VRD(6); SBAR(); GAPA(C1=__builtin_amdgcn_mfma_f32_32x32x16_bf16(kf[5],qr[2],C1,0,0,0),   P1[6],P1[7],P1[8],P1[9],     pw2[2]=PKW(P1,4), pw2[3]=PKW(P1,6), pw2); \
    VRD(3); SBAR(); GAPA(C0=__builtin_amdgcn_mfma_f32_32x32x16_bf16(kf[6],qr[3],C0,0,0,0),   P1[10],P1[11],P1[12],P1[13], pw3[0]=PKW(P1,8), pw3[1]=PKW(P1,10), pw3); \
    VRD(7); SBAR(); GAPA(C1=__builtin_amdgcn_mfma_f32_32x32x16_bf16(kf[7],qr[3],C1,0,0,0),   P1[14],P1[15],0.f,0.f,       pw3[2]=PKW(P1,12),pw3[3]=PKW(P1,14), pw3); \
    l_reg+=sacc; \
    if(GK){DMA_K((t)+3,sl_cur);} if(GV){DMA_V((t)+1,sl_next);} \
    CMASK(C0,C1,t); \
    if(GL){ FLD(P0,P1,t); } \
    SBAR(); \
    GAPB(o[0]=__builtin_amdgcn_mfma_f32_32x32x16_bf16(PAF(0),VFR(0),o[0],0,0,0), C0,0,P0,GL); \
    GAPB(o[1]=__builtin_amdgcn_mfma_f32_32x32x16_bf16(PAF(0),VFR(4),o[1],0,0,0), C0,4,P0,GL); \
    KRD(GL,0); GAPB(o[0]=__builtin_amdgcn_mfma_f32_32x32x16_bf16(PAF(1),VFR(1),o[0],0,0,0), C0,8,P0,GL); \
    KRD(GL,1); GAPB(o[1]=__builtin_amdgcn_mfma_f32_32x32x16_bf16(PAF(1),VFR(5),o[1],0,0,0), C0,12,P0,GL); \
    KRD(GL,2); GAPB(o[0]=__builtin_amdgcn_mfma_f32_32x32x16_bf16(PAF(2),VFR(2),o[0],0,0,0), C1,0,P1,GL); \
    KRD(GL,3); GAPB(o[1]=__builtin_amdgcn_mfma_f32_32x32x16_bf16(PAF(2),VFR(6),o[1],0,0,0), C1,4,P1,GL); \
    GAPB(o[0]=__builtin_amdgcn_mfma_f32_32x32x16_bf16(PAF(3),VFR(3),o[0],0,0,0), C1,8,P1,GL); \
    GAPB(o[1]=__builtin_amdgcn_mfma_f32_32x32x16_bf16(PAF(3),VFR(7),o[1],0,0,0), C1,12,P1,GL); \
    }while(0)
  #define ENDW(tt) do{ if((tt)+3<NP){WAIT_BAR(2);} else if((tt)+2<NP){WAIT_BAR(1);} else {WAIT_BAR(0);} }while(0)
  int t=1;
  for(;t<5&&t+1<NP;t+=2){
    STEP(pB0,pB1,pA0,pA1,t,(t+3<NP),(t+1<NP),(t+1<NP));       ENDW(t);   ROT();
    STEP(pA0,pA1,pB0,pB1,t+1,(t+4<NP),(t+2<NP),(t+2<NP));     ENDW(t+1); ROT();
  }
  #undef CMASK
  #define CMASK(P0,P1,t) do{}while(0)
  for(;t+5<NP;t+=2){
    STEP(pB0,pB1,pA0,pA1,t,true,true,true);     WAIT_BAR(2); ROT();
    STEP(pA0,pA1,pB0,pB1,t+1,true,true,true);   WAIT_BAR(2); ROT();
  }
  for(;t+1<NP;t+=2){
    STEP(pB0,pB1,pA0,pA1,t,(t+3<NP),(t+1<NP),(t+1<NP));       ENDW(t);   ROT();
    STEP(pA0,pA1,pB0,pB1,t+1,(t+4<NP),(t+2<NP),(t+2<NP));     ENDW(t+1); ROT();
  }
  #undef CMASK
  #define CMASK(P0,P1,t) do{int jb_=3-(t); if(jb_>=0)cmask(P0,P1,jb_,qrel,hi);}while(0)
  STEP(pB0,pB1,pA0,pA1,NP-1,false,false,false);
  AP_STAMP(1);
  const int tidE=opaque_tid(wave0),laneE=tidE&63,r32E=laneE&31,hiE=laneE>>5; const int widE=__builtin_amdgcn_readfirstlane(tidE>>6);
  const int vb0=(int)(lds0+LDS_V)+((laneE>>4)&1)*32+(laneE&3)*8+(4*hiE+((laneE&15)>>2))*64;
  float*wsf=(float*)(shm+LDS_WS)+widE*64;
  { float sacc=pB0[0]+pB0[1]; _Pragma("unroll") for(int r=2;r<16;++r)sacc+=pB0[r]; _Pragma("unroll") for(int r=0;r<16;++r)sacc+=pB1[r]; l_reg+=sacc;
    pw0=(u32x4){PKW(pB0,0),PKW(pB0,2),PKW(pB0,4),PKW(pB0,6)};pw1=(u32x4){PKW(pB0,8),PKW(pB0,10),PKW(pB0,12),PKW(pB0,14)};pw2=(u32x4){PKW(pB1,0),PKW(pB1,2),PKW(pB1,4),PKW(pB1,6)};pw3=(u32x4){PKW(pB1,8),PKW(pB1,10),PKW(pB1,12),PKW(pB1,14)};
    SBAR(); pv(o,vb0+sl_cur,PAF(0),PAF(1),PAF(2),PAF(3)); }
  #undef PKW
  #undef PAF
  #undef VFR
  #undef PIN
  #undef GAPA
  #undef GAPB
  #undef EX
  #undef VRD
  #undef KRD
  #undef FLD
  #undef STEP
  #undef ENDW
  {auto rr=__builtin_amdgcn_permlane32_swap(__float_as_uint(l_reg),__float_as_uint(l_reg),false,false);l_reg=__uint_as_float(rr[0])+__uint_as_float(rr[1]);}
  if(hiE==0)wsf[32+r32E]=l_reg;asm volatile("s_waitcnt lgkmcnt(0)":::"memory");
  float rli[16];
  #pragma unroll
  for(int r=0;r<16;++r)rli[r]=__builtin_amdgcn_rcpf(wsf[32+crow(r,hiE)]);
  bf16*Ow=O+(rowbase+q0+widE*QBLK)*DM+h*D;
  { bf16*stg=(bf16*)(shm+LDS_OST)+widE*2048;
    #pragma unroll
    for(int r=0;r<16;++r){const int orow=crow(r,hiE);
      #pragma unroll
      for(int d0=0;d0<2;++d0)stg[orow*64+d0*32+r32E]=__float2bfloat16(o[d0][r]*rli[r]);}
    asm volatile("s_waitcnt lgkmcnt(0)":::"memory");
    #pragma unroll
    for(int i=0;i<4;++i){const int row=i*8+(laneE>>3),ch=laneE&7; const u32x4 v=*(const u32x4*)(stg+row*64+ch*8); ATTN_STORE16(Ow+(long)row*DM+ch*8,v);} }
  asm volatile("s_waitcnt lgkmcnt(0)\n\ts_barrier":::"memory");
  AP_STAMP(2);
  #undef DMA_K
  #undef DMA_V
  #undef CMASK
  #undef ROT
}
constexpr int ATTN_LDS_BYTES=LDS_BYTES;
struct AttnTensors { const bf16* Q; const bf16* K; const bf16* V; bf16* O; const float* LF; const unsigned* QKM; };
struct AttnUnit { int bh; int qb; };
struct StaticOrder {
  int vcu;
  __device__ __forceinline__ explicit StaticOrder(int grid,int block):vcu((block%8)*(grid/8)+block/8){}
  __device__ __forceinline__ bool next(int i,AttnUnit&u)const{ if(i>=8)return false; const int s=vcu&1, j=7-i, base=4*(j>>1); u.bh=vcu>>1; u.qb=base+((j&1)?(s?2:3):(s?1:0)); return true; }
};
template<int THRL=8> __device__ __forceinline__ void attn_phase(char*lds,const AttnTensors&T,unsigned*ctr,int wave0){
#ifdef APROBE
  unsigned long long ap_acc[4]={0ull,0ull,0ull,0ull};
#endif
  for(;;){
#ifdef APROBE
    const unsigned long long ap_t0=__builtin_amdgcn_s_memrealtime();
#endif
    const int tq=opaque_tid(wave0);
    const unsigned uwb_=(unsigned)(uintptr_t)((lds_cptr)lds+LDS_WT+48)+((unsigned)tq>>9);
    volatile __attribute__((address_space(3))) unsigned*uw=(volatile __attribute__((address_space(3))) unsigned*)uwb_;
    if(tq==0)*uw=__hip_atomic_fetch_add(ctr,1u,__ATOMIC_RELAXED,__HIP_MEMORY_SCOPE_AGENT);
    __syncthreads();
    const unsigned k=__builtin_amdgcn_readfirstlane(*uw);
#ifdef APROBE
    if(k>=(unsigned)(BATCH*NHEAD*NQB)){ if(tq==0){ atomicAdd(&pg8::gprobe_acc[0],ap_acc[0]); atomicAdd(&pg8::gprobe_acc[1],ap_acc[1]); atomicAdd(&pg8::gprobe_acc[2],ap_acc[2]); atomicAdd(&pg8::gprobe_acc[3],ap_acc[3]); } }
#endif
    if(k>=(unsigned)(BATCH*NHEAD*NQB))break;
    const int qb=NQB-1-(int)(k>>7), bh=(int)(k&127), b=bh/NHEAD,h=bh%NHEAD;
    const unsigned* qm=T.QKM+(0*8+b)*32+2*h; const unsigned* km=T.QKM+(1*8+b)*32+2*h;
    const float q2=__uint_as_float(__builtin_amdgcn_readfirstlane(qm[0]))+__uint_as_float(__builtin_amdgcn_readfirstlane(qm[1])), k2=__uint_as_float(__builtin_amdgcn_readfirstlane(km[0]))+__uint_as_float(__builtin_amdgcn_readfirstlane(km[1]));
    const float M=1.02f*sqrtf(q2*k2)+1e-3f;
#ifdef APROBE
    const unsigned long long ap_t1=__builtin_amdgcn_s_memrealtime(); unsigned long long ap_t[3]={ap_t1,ap_t1,ap_t1};
    if(M<55.f) attn_unit_fast<0>(b,h,qb,M,1.01f*sqrtf(k2),T.Q,T.K,T.V,T.O,T.LF,lds,wave0,ap_t);
    else attn_unit<THRL>(b,h,qb,T.Q,T.K,T.V,T.O,T.LF,lds,wave0);
    ap_acc[0]+=ap_t1-ap_t0; ap_acc[1]+=ap_t[0]-ap_t1; ap_acc[2]+=ap_t[1]-ap_t[0]; ap_acc[3]+=ap_t[2]-ap_t[1];
#else
    if(M<55.f) attn_unit_fast<0>(b,h,qb,M,1.01f*sqrtf(k2),T.Q,T.K,T.V,T.O,T.LF,lds,wave0);
    else attn_unit<THRL>(b,h,qb,T.Q,T.K,T.V,T.O,T.LF,lds,wave0);
#endif
  }
}
#undef SBAR
#undef WAIT_BAR
}
constexpr int NWAVES = 8;
#ifndef MK_MULTI
#define MK_MULTI 0
#endif

constexpr int BATCH = 8, SEQ = 4096, D = 1024, H = 16, HD = 64, NE = 32, FD = 512, NLAYER = 2;
constexpr int T = BATCH * SEQ;
constexpr int MODW = 6 * D;
constexpr float RMS_EPS = 1e-6f;
constexpr int WIN_LD = 3 * D + H;
constexpr int ECAP = 32768;
constexpr int PMAX = 2 * T + NE * 256;

constexpr size_t MiB = 1u << 20;
constexpr size_t WS_CTL = 0, CTL_ZERO_BYTES = 1 * MiB;
constexpr size_t WS_MOD = 1 * MiB;
constexpr size_t WS_LOGF = 2 * MiB;
constexpr size_t WS_TOK = 6 * MiB;
constexpr size_t WS_GW = 10 * MiB;
constexpr size_t WS_WQKV = 14 * MiB;
constexpr size_t WS_WO = 20 * MiB;
constexpr size_t WS_RWF = 22 * MiB + 512 * 1024;
constexpr size_t WS_FWF = 22 * MiB + 768 * 1024;
constexpr size_t WS_WPF = 22 * MiB;
constexpr size_t WS_UP1 = 23 * MiB, WS_DN1 = 87 * MiB;
constexpr size_t WS_HB = 119 * MiB;
constexpr size_t WS_Q = 183 * MiB, WS_K = 247 * MiB, WS_V = 311 * MiB;
constexpr size_t WS_Y2 = 183 * MiB;
constexpr size_t WS_HH = 375 * MiB;
constexpr size_t WS_UP0 = 447 * MiB, WS_DN0 = 511 * MiB;
constexpr size_t WS_X3 = 447 * MiB;
constexpr size_t WS_END = 575 * MiB;
__host__ __device__ constexpr size_t ws_up(int layer) { return layer ? WS_UP1 : WS_UP0; }
__host__ __device__ constexpr size_t ws_dn(int layer) { return layer ? WS_DN1 : WS_DN0; }
constexpr int CW_BAR = 4096;
constexpr int CW_QKM = 32768;
constexpr int CW_AQ = 36864;
constexpr int CW_GQ = 40960;
constexpr int CW_CNT = 16384;

constexpr int RING_OFF = 0, RING_BYTES = 131072;
constexpr int LDSCTL_OFF = RING_BYTES, MISC_OFF = LDSCTL_OFF + 320;
constexpr int ETAB_OFF = LDSCTL_OFF + 1024;
constexpr int SELALL_OFF = LDSCTL_OFF + 1024;
constexpr int LDS_BYTES = 152064;
static_assert(SELALL_OFF + 128 * 33 * 4 <= LDS_BYTES && ETAB_OFF + (64 + 960) * 4 <= LDS_BYTES && attn_body::ATTN_LDS_BYTES <= RING_BYTES, "LDS map");

#define GAS __attribute__((address_space(1)))
#define LAS __attribute__((address_space(3)))
#define GP(T_, p_) ((GAS T_*)(p_))
#define GCP(T_, p_) ((const GAS T_*)(p_))
typedef unsigned short bf16;
typedef unsigned v4u __attribute__((ext_vector_type(4)));
typedef float f32x4 __attribute__((ext_vector_type(4)));
typedef short bf16x8 __attribute__((ext_vector_type(8)));
typedef GAS unsigned gu32;
#define RLX_AGENT __ATOMIC_RELAXED, __HIP_MEMORY_SCOPE_AGENT
#define LDS_WAIT() asm volatile("s_waitcnt lgkmcnt(0)" ::: "memory")
#define VM_WAIT() asm volatile("s_waitcnt vmcnt(0)" ::: "memory")
#define LDS_BARRIER() do { asm volatile("s_waitcnt lgkmcnt(0)" ::: "memory"); __builtin_amdgcn_s_barrier(); asm volatile("" ::: "memory"); } while (0)
__device__ __forceinline__ unsigned f2bf(float f) { unsigned u = __builtin_bit_cast(unsigned, f); return (u + 0x7fffu + ((u >> 16) & 1u)) >> 16; }
typedef float pk_f32x2 __attribute__((ext_vector_type(2))); typedef __bf16 pk_bf16x2 __attribute__((ext_vector_type(2)));
__device__ __forceinline__ unsigned pk2(float lo, float hi) { pk_f32x2 v = {lo, hi}; return __builtin_bit_cast(unsigned, __builtin_convertvector(v, pk_bf16x2)); }
__device__ __forceinline__ float bflo(unsigned w) { return __uint_as_float(w << 16); }
__device__ __forceinline__ float bfhi(unsigned w) { return __uint_as_float(w & 0xffff0000u); }

#define XB_TMO      128
#define XB_XCNT(j)  (256  + 64 * (j))
#define XB_XSUB(j)  (1280 + 64 * (j))
#define XB_XGEN(j)  (2304 + 64 * (j))
#define XB_TOP      3328
#define XB_TOPGEN   3392
#define XCD_BAR_WORDS 3456
#define XB_SPIN_CAP (1u << 18)
__device__ __forceinline__ unsigned xb_ld(unsigned* p)              { return __hip_atomic_load(p, __ATOMIC_RELAXED, __HIP_MEMORY_SCOPE_AGENT); }
__device__ __forceinline__ unsigned xb_add(unsigned* p, unsigned v) { return __hip_atomic_fetch_add(p, v, __ATOMIC_RELAXED, __HIP_MEMORY_SCOPE_AGENT); }
__device__ __forceinline__ unsigned xb_xcc_id() { return (unsigned)__builtin_amdgcn_s_getreg((3 << 11) | 20) & 0xFu; }
#define XB_SPIN(cond, bar) do { unsigned _sp = 0; while (cond) { __builtin_amdgcn_s_sleep(1); \
    if ((++_sp & 255u) == 0u) { if (xb_ld(&(bar)[XB_TMO])) break; if (_sp > XB_SPIN_CAP) { atomicAdd(&(bar)[XB_TMO], 1u); break; } } } } while (0)
struct XcdBarrier { unsigned* bar; unsigned x; volatile LAS unsigned* st; };
__device__ __forceinline__ XcdBarrier xcd_barrier_post(unsigned* bar, volatile LAS unsigned* st) {
    XcdBarrier b; b.bar = bar; b.x = xb_xcc_id(); b.st = st;
    if (threadIdx.x == 0) (void)xb_add(&bar[XB_XCNT(b.x)], 1u);
    return b;
}
__device__ __forceinline__ void xcd_barrier_complete(unsigned* bar, unsigned x, unsigned& nloc, unsigned& nx) {
    const unsigned G = gridDim.x * gridDim.y * gridDim.z;
    unsigned sum, cnt, mine, sp = 0u;
    for (;;) {
        sum = 0u; cnt = 0u; mine = 0u;
#pragma unroll
        for (unsigned j = 0; j < 16; ++j) { const unsigned c = xb_ld(&bar[XB_XCNT(j)]); sum += c; cnt += (c > 0u) ? 1u : 0u; }
        mine = xb_ld(&bar[XB_XCNT(x)]);
        if (sum == G) break;
        __builtin_amdgcn_s_sleep(1);
        if ((++sp & 255u) == 0u) { if (xb_ld(&bar[XB_TMO])) break; if (sp > XB_SPIN_CAP) { atomicAdd(&bar[XB_TMO], 1u); break; } }
    }
    nloc = mine > 0u ? mine : 1u; nx = cnt > 0u ? cnt : 1u;
}
__device__ __forceinline__ void xcd_barrier(const XcdBarrier& b) {
    asm volatile("s_waitcnt vmcnt(0)" ::: "memory");
    __syncthreads();
    if (threadIdx.x == 0) {
        unsigned* bar = b.bar; unsigned bx = b.x;
        asm volatile("" : "+s"(bar), "+s"(bx));
        __builtin_amdgcn_s_waitcnt(0);
        unsigned nloc = b.st[0], nx = b.st[1];
        if (nloc == 0u) { xcd_barrier_complete(bar, bx, nloc, nx); b.st[0] = nloc; b.st[1] = nx; }
        const unsigned old = xb_add(&bar[XB_XSUB(bx)], 1u);
        const unsigned gen = old / nloc;
        if (old + 1u == (gen + 1u) * nloc) {
            __builtin_amdgcn_fence(__ATOMIC_RELEASE, "agent");
            asm volatile("s_waitcnt vmcnt(0)" ::: "memory");
            const unsigned og = xb_add(&bar[XB_TOP], 1u);
            const unsigned tg = og / nx;
            if (og + 1u == (tg + 1u) * nx) xb_add(&bar[XB_TOPGEN], 1u);
            else XB_SPIN(xb_ld(&bar[XB_TOPGEN]) == tg, bar);
            __builtin_amdgcn_fence(__ATOMIC_ACQUIRE, "agent");
            xb_add(&bar[XB_XGEN(bx)], 1u);
            asm volatile("s_waitcnt vmcnt(0)" ::: "memory");
        } else {
            XB_SPIN(xb_ld(&bar[XB_XGEN(bx)]) == gen, bar);
            __builtin_amdgcn_fence(__ATOMIC_ACQUIRE, "agent");
            asm volatile("s_waitcnt vmcnt(0)" ::: "memory");
        }
    }
    __syncthreads();
}

struct Frame {
    LAS unsigned char* lds;
    volatile LAS unsigned* MISC;
    gu32* ctl;
    int tid, lane, wave, wave0;
    int vcu, G;
    const __attribute__((address_space(4))) char* ka;
    float* out;
    unsigned char* ws;
    const __attribute__((address_space(4))) char* ka0; float* out0; unsigned char* ws0;
};
__device__ __forceinline__ void phase_enter(Frame& F) {
    int t_ = opaque_tid(F.wave0); F.tid = t_; F.lane = t_ & 63; F.wave = __builtin_amdgcn_readfirstlane(t_ >> 6);
    unsigned char* w = F.ws0; float* o = F.out0; const __attribute__((address_space(4))) char* k = F.ka0;
    asm volatile("" : "+s"(w), "+s"(o), "+s"(k));
    F.ws = (unsigned char*)(GAS unsigned char*)w; F.out = (float*)(GAS float*)o; F.ka = k; F.ctl = (gu32*)w;
}
#define WSP(T_, off) ((T_*)(GAS T_*)(F.ws + (off)))
#define FIN(i) ((const float*)(const GAS float*)(*(const float* const __attribute__((address_space(4)))*)(F.ka + 8 * (i))))
enum { IN_X = 0, IN_C, IN_NMG, IN_NFG, IN_ADAW, IN_ADAB, IN_WIN, IN_FBIAS, IN_WO, IN_POOLW, IN_POOLS, IN_RW, IN_RB, IN_W1, IN_W3, IN_W2, IN_NFIN };

__device__ __forceinline__ void transpose_item(const float* W, int ld, int k0, bf16* WT, int Kd, int dst_row0, LAS float* scr, int lane) {
    float tv[32];
#pragma unroll
    for (int i = 0; i < 32; ++i) tv[i] = GCP(float, W)[(size_t)(k0 + 2 * i + (lane >> 5)) * ld + (lane & 31)];
#pragma unroll
    for (int i = 0; i < 32; ++i) scr[(2 * i + (lane >> 5)) * 33 + (lane & 31)] = tv[i];
    LDS_WAIT(); asm volatile("" ::: "memory");
    const int c = lane & 7;
#pragma unroll
    for (int j = 0; j < 4; ++j) { const int n = (lane >> 3) + 8 * j; const LAS float* s = scr + (8 * c) * 33 + n;
        v4u o; o.x = pk2(s[0 * 33], s[1 * 33]); o.y = pk2(s[2 * 33], s[3 * 33]); o.z = pk2(s[4 * 33], s[5 * 33]); o.w = pk2(s[6 * 33], s[7 * 33]);
        *(GAS v4u*)(WT + (size_t)(dst_row0 + n) * Kd + k0 + 8 * c) = o; }
    LDS_WAIT(); asm volatile("" ::: "memory");
}
__device__ __forceinline__ void p0_prologue(Frame& F) {
    if (F.vcu < 192) {
        const float* cin = FIN(IN_C); const float* adaw = FIN(IN_ADAW); const float* adab = FIN(IN_ADAB);
        LAS float* cact = (LAS float*)(F.lds);
        LAS float* red = (LAS float*)(F.lds + 32768);
        for (int i = F.tid; i < 8 * 1024; i += 512) { const int bb = i >> 10, k = i & 1023; const float v = cin[i]; cact[k * 8 + bb] = v / (1.0f + __expf(-v)); }
        __syncthreads();
        const int l = F.vcu / 96, col0 = (F.vcu % 96) * 64;
        const float* wp = adaw + (size_t)l * D * MODW + col0 + F.lane;
        float a0 = 0.f, a1 = 0.f, a2 = 0.f, a3 = 0.f, a4 = 0.f, a5 = 0.f, a6 = 0.f, a7 = 0.f;
        const int kb = F.wave * 128;
#pragma unroll 16
        for (int k = 0; k < 128; ++k) { const float wv = GCP(float, wp)[(size_t)(kb + k) * MODW]; const f32x4 c0 = *(const LAS f32x4*)(cact + (kb + k) * 8), c1 = *(const LAS f32x4*)(cact + (kb + k) * 8 + 4);
            a0 += c0[0] * wv; a1 += c0[1] * wv; a2 += c0[2] * wv; a3 += c0[3] * wv; a4 += c1[0] * wv; a5 += c1[1] * wv; a6 += c1[2] * wv; a7 += c1[3] * wv; }
        LAS float* rw = red + F.wave * 512 + F.lane;
        rw[0] = a0; rw[64] = a1; rw[128] = a2; rw[192] = a3; rw[256] = a4; rw[320] = a5; rw[384] = a6; rw[448] = a7;
        __syncthreads();
        { const int bb = F.tid >> 6, col = F.tid & 63; float s = 0.f;
#pragma unroll
          for (int w = 0; w < 8; ++w) s += red[w * 512 + bb * 64 + col];
          WSP(float, WS_MOD)[((size_t)l * 8 + bb) * MODW + col0 + col] = s + adab[l * MODW + col0 + col]; }
        __syncthreads();
    }
    { const float* rw = FIN(IN_RW);
      for (int e = F.vcu * 512 + F.tid; e < 8192; e += F.G * 512) { const int ln = e & 63, hl = (e >> 6) & 1, c = (e >> 7) & 3, nt = (e >> 9) & 1, ww = e >> 10;
          const float* wb = rw + (size_t)(128 * ww + 32 * c + 8 * (ln >> 4)) * NE + 16 * nt + (ln & 15); float wv[8];
#pragma unroll
          for (int j = 0; j < 8; ++j) wv[j] = wb[j * NE];
          v4u hw; hw.x = pk2(wv[0], wv[1]); hw.y = pk2(wv[2], wv[3]); hw.z = pk2(wv[4], wv[5]); hw.w = pk2(wv[6], wv[7]);
          if (hl) { v4u lw; lw.x = pk2(wv[0] - bflo(hw.x), wv[1] - bfhi(hw.x)); lw.y = pk2(wv[2] - bflo(hw.y), wv[3] - bfhi(hw.y)); lw.z = pk2(wv[4] - bflo(hw.z), wv[5] - bfhi(hw.z)); lw.w = pk2(wv[6] - bflo(hw.w), wv[7] - bfhi(hw.w)); hw = lw; }
          WSP(v4u, WS_RWF)[e] = hw; } }
    { const float* fw = FIN(IN_WIN);
      for (int e = F.vcu * 512 + F.tid; e < 4096; e += F.G * 512) { const int ln = e & 63, hl = (e >> 6) & 1, c = (e >> 7) & 3, ww = e >> 9;
          const float* wb = fw + (size_t)(128 * ww + 32 * c + 8 * (ln >> 4)) * WIN_LD + 3 * D + (ln & 15); float wv[8];
#pragma unroll
          for (int j = 0; j < 8; ++j) wv[j] = wb[(size_t)j * WIN_LD];
          v4u hw; hw.x = pk2(wv[0], wv[1]); hw.y = pk2(wv[2], wv[3]); hw.z = pk2(wv[4], wv[5]); hw.w = pk2(wv[6], wv[7]);
          if (hl) { v4u lw; lw.x = pk2(wv[0] - bflo(hw.x), wv[1] - bfhi(hw.x)); lw.y = pk2(wv[2] - bflo(hw.y), wv[3] - bfhi(hw.y)); lw.z = pk2(wv[4] - bflo(hw.z), wv[5] - bfhi(hw.z)); lw.w = pk2(wv[6] - bflo(hw.w), wv[7] - bfhi(hw.w)); hw = lw; }
          WSP(v4u, WS_FWF)[e] = hw; } }
    { const float* pw = FIN(IN_POOLW);
      for (int e = F.vcu * 512 + F.tid; e < 32768; e += F.G * 512) { const int ln = e & 63, ks = (e >> 6) & 7, t = (e >> 9) & 7, ww = e >> 12, i = ln & 15;
          const int n = 128 * (ww & 1) + 32 * (t >> 1) + 8 * (i >> 2) + 4 * (t & 1) + (i & 3), k0 = 32 * ks + 8 * (ln >> 4);
          const float* wb = pw + (size_t)(ww >> 1) * 65536 + (size_t)k0 * 256 + n;
          v4u hw; hw.x = pk2(wb[0], wb[256]); hw.y = pk2(wb[512], wb[768]); hw.z = pk2(wb[1024], wb[1280]); hw.w = pk2(wb[1536], wb[1792]);
          WSP(v4u, WS_WPF)[e] = hw; } }
    LAS float* scr = (LAS float*)(F.lds + RING_OFF + F.wave * 16384);
    const int gw = F.vcu * NWAVES + F.wave, NGW = F.G * NWAVES;
    constexpr int I_QKV = 16 * 96, I_O = 16 * 32, I_W13 = 16 * 16, I_W2 = 8 * 32;
    constexpr int I_EXP = NLAYER * NE * (2 * I_W13 + I_W2);
    constexpr int NITEMS = I_QKV + I_O + I_EXP;
    constexpr int NV_WAVES = 64 * NWAVES, GV_WAVES = 192 * NWAVES, X_ITEMS = (int)(((long)NITEMS + (long)GV_WAVES * 5 / 2) * NV_WAVES / (NV_WAVES + GV_WAVES));
    const bool gvw = F.vcu < 192; const int it0 = gvw ? X_ITEMS + gw : (gw - GV_WAVES), itN = gvw ? NITEMS : X_ITEMS, itS = gvw ? GV_WAVES : NV_WAVES;
    for (int it = it0; it < itN; it += itS) {
        int r = it;
        if (r < I_QKV) { const int kb = r / 96, nb = r % 96; transpose_item(FIN(IN_WIN) + 32 * nb, WIN_LD, 64 * kb, WSP(bf16, WS_WQKV), D, 32 * nb, scr, F.lane); continue; } r -= I_QKV;
        if (r < I_O) { const int kb = r / 32, nb = r % 32; transpose_item(FIN(IN_WO) + 32 * nb, D, 64 * kb, WSP(bf16, WS_WO), D, 32 * nb, scr, F.lane); continue; } r -= I_O;

        { const int per = 2 * I_W13 + I_W2; const int le = r / per; int q = r % per;
          if (q < 2 * I_W13) { const int which = q / I_W13; q %= I_W13; const int kb = q / 16, nb = q % 16, n0 = 32 * nb;
              const float* src = (which ? FIN(IN_W3) : FIN(IN_W1)) + (size_t)le * D * FD + n0;
              transpose_item(src, FD, 64 * kb, WSP(bf16, ws_up(le >> 5)) + (size_t)(le & 31) * 1024 * 1024, D, 256 * (n0 >> 7) + (n0 & 127) + 128 * which, scr, F.lane); }
          else { q -= 2 * I_W13; const int kb = q / 32, nb = q % 32;
              transpose_item(FIN(IN_W2) + (size_t)le * FD * D + 32 * nb, D, 64 * kb, WSP(bf16, ws_dn(le >> 5)) + (size_t)(le & 31) * 1024 * 512, FD, 32 * nb, scr, F.lane); } }
    }
    __syncthreads();
}

__device__ __forceinline__ unsigned pack_tg(int t2, float g) { return ((unsigned)t2 << 16) | (unsigned)__builtin_rintf(g * 65535.0f); }

struct RowArgs { const float* src; float* dst; const float* g; const float* shp; const float* scp; const float* gtp; const bf16* y2; bf16* hb;
                 const void* wfrag; const float* bias; float* logf; gu32* cnt; int* tok; float* gw; };
template <int MODE>
__device__ __forceinline__ void rowpass(Frame& F, const RowArgs& A) {
    constexpr int NT = (MODE == 0) ? 1 : (MODE == 1 ? 2 : 0);
    const int lane = F.lane, w = F.wave, r = lane & 15, q = lane >> 4, tid = F.tid;
    const int R0 = F.vcu * 128, b = R0 >> 12;
    const int kb = 128 * w + 8 * q;
    LAS float* red = (LAS float*)(F.lds);
    LAS f32x4* part = (LAS f32x4*)(F.lds + 1024);
    LAS float* scS = (LAS float*)(F.lds + 1024 + 32768);
    LAS float* selS = scS + 512;
    LAS unsigned* lcnt = (LAS unsigned*)(F.lds + 37888); LAS unsigned* lbase = lcnt + 32; LAS float* selAll = (LAS float*)(F.lds + SELALL_OFF);
    if (MODE == 1 && tid < 32) lcnt[tid] = 0u;
    LAS float* GM = (LAS float*)(F.lds + (MODE == 0 ? 69632 : 65536)); LAS float* SH = GM + 1024; LAS float* GT = SH + 1024;
    for (int k = tid; k < D; k += 512) { const float g1 = A.g[k];
        if (MODE < 3) { GM[k] = g1 * (1.0f + A.scp[(size_t)b * MODW + k]); SH[k] = A.shp[(size_t)b * MODW + k]; } else { GM[k] = g1; SH[k] = 0.f; }
        GT[k] = (MODE >= 2) ? A.gtp[(size_t)b * MODW + k] : 0.f; }
    __syncthreads();
    bf16x8 Bh[NT > 0 ? NT : 1][4], Bl[NT > 0 ? NT : 1][4];
    if (NT > 0) { const v4u* wf = (const v4u*)A.wfrag + (size_t)w * (NT * 512) + lane;
#pragma unroll
        for (int nt = 0; nt < NT; ++nt)
#pragma unroll
            for (int c = 0; c < 4; ++c) { Bh[nt][c] = __builtin_bit_cast(bf16x8, GCP(v4u, wf)[((nt * 4 + c) * 2 + 0) * 64]); Bl[nt][c] = __builtin_bit_cast(bf16x8, GCP(v4u, wf)[((nt * 4 + c) * 2 + 1) * 64]); }
    }
    f32x4 xa[4][2], xb[4][2]; v4u yaa[4], yab[4], yba[4], ybb[4];
#define RP_LOAD(it_, xn, yna, ynb) do { const int row_ = R0 + 16 * (it_) + r; const float* xs_ = A.src + (size_t)row_ * D + kb; \
        if (MODE == 3) { const bf16* xq_ = (const bf16*)A.src + (size_t)row_ * D + kb; _Pragma("unroll") for (int c = 0; c < 4; ++c) xn[c][0] = __builtin_bit_cast(f32x4, *GCP(v4u, xq_ + 32 * c)); } \
        else { _Pragma("unroll") for (int c = 0; c < 4; ++c) { xn[c][0] = *GCP(f32x4, xs_ + 32 * c); xn[c][1] = *GCP(f32x4, xs_ + 32 * c + 4); } } \
        if (MODE >= 2) { const bf16* yp_ = A.y2 + (size_t)row_ * 2 * D + kb; _Pragma("unroll") for (int c = 0; c < 4; ++c) { yna[c] = *GCP(v4u, yp_ + 32 * c); ynb[c] = *GCP(v4u, yp_ + D + 32 * c); } } } while (0)
    RP_LOAD(0, xa, yaa, yab); RP_LOAD(1, xb, yba, ybb);
    auto tile = [&](const int it, f32x4 (&xn)[4][2], v4u (&yna)[4], v4u (&ynb)[4]) __attribute__((always_inline)) {
        const int row = R0 + 16 * it + r, buf = it & 1;
        f32x4 xv[4][2]; v4u yva[4], yvb[4];
#pragma unroll
        for (int c = 0; c < 4; ++c) {
            if (MODE == 3) { const v4u xw = __builtin_bit_cast(v4u, xn[c][0]); xv[c][0] = (f32x4){bflo(xw.x), bfhi(xw.x), bflo(xw.y), bfhi(xw.y)}; xv[c][1] = (f32x4){bflo(xw.z), bfhi(xw.z), bflo(xw.w), bfhi(xw.w)}; }
            else { xv[c][0] = xn[c][0]; xv[c][1] = xn[c][1]; }
            if (MODE >= 2) { yva[c] = yna[c]; yvb[c] = ynb[c]; } }
        if (it < 6) RP_LOAD(it + 2, xn, yna, ynb);
        if (MODE >= 2) {
#pragma unroll
            for (int c = 0; c < 4; ++c) { const v4u ya = yva[c], yb = yvb[c];
                f32x4 s0, s1;
                s0[0] = bflo(ya.x) + bflo(yb.x); s0[1] = bfhi(ya.x) + bfhi(yb.x); s0[2] = bflo(ya.y) + bflo(yb.y); s0[3] = bfhi(ya.y) + bfhi(yb.y);
                s1[0] = bflo(ya.z) + bflo(yb.z); s1[1] = bfhi(ya.z) + bfhi(yb.z); s1[2] = bflo(ya.w) + bflo(yb.w); s1[3] = bfhi(ya.w) + bfhi(yb.w);
                xv[c][0] += *(const LAS f32x4*)(GT + kb + 32 * c) * s0; xv[c][1] += *(const LAS f32x4*)(GT + kb + 32 * c + 4) * s1; }
            if (MODE == 2) { float* xd = A.dst + (size_t)row * D + kb;
#pragma unroll
                for (int c = 0; c < 4; ++c) { *GP(f32x4, xd + 32 * c) = xv[c][0]; *GP(f32x4, xd + 32 * c + 4) = xv[c][1]; } }
        }
        float ss = 0.f;
#pragma unroll
        for (int c = 0; c < 4; ++c)
#pragma unroll
            for (int hf = 0; hf < 2; ++hf) { const f32x4 v = xv[c][hf]; ss += (v[0] * v[0] + v[1] * v[1]) + (v[2] * v[2] + v[3] * v[3]); }
        ss += __int_as_float(__builtin_amdgcn_ds_bpermute((lane ^ 16) << 2, __float_as_int(ss))); ss += __int_as_float(__builtin_amdgcn_ds_bpermute((lane ^ 32) << 2, __float_as_int(ss)));
        if (q == 0) red[buf * 128 + w * 16 + r] = ss;
        LDS_BARRIER();
        float tot = 0.f;
#pragma unroll
        for (int ww = 0; ww < 8; ++ww) tot += red[buf * 128 + ww * 16 + r];
        const float rstd = 1.0f / sqrtf(tot * (1.0f / D) + RMS_EPS);
        if (MODE == 3) { float* xd = A.dst + (size_t)row * D + kb;
#pragma unroll
            for (int c = 0; c < 4; ++c) { *GP(f32x4, xd + 32 * c) = xv[c][0] * rstd * *(const LAS f32x4*)(GM + kb + 32 * c); *GP(f32x4, xd + 32 * c + 4) = xv[c][1] * rstd * *(const LAS f32x4*)(GM + kb + 32 * c + 4); }
            return; }
        f32x4 acc[NT > 0 ? NT : 1];
#pragma unroll
        for (int nt = 0; nt < (NT > 0 ? NT : 1); ++nt) acc[nt] = (f32x4){0.f, 0.f, 0.f, 0.f};
        bf16* hp = A.hb + (size_t)row * D + kb;
#pragma unroll
        for (int c = 0; c < 4; ++c) {
            const f32x4 h0 = xv[c][0] * rstd * *(const LAS f32x4*)(GM + kb + 32 * c) + *(const LAS f32x4*)(SH + kb + 32 * c), h1 = xv[c][1] * rstd * *(const LAS f32x4*)(GM + kb + 32 * c + 4) + *(const LAS f32x4*)(SH + kb + 32 * c + 4);
            v4u hw; hw.x = pk2(h0[0], h0[1]); hw.y = pk2(h0[2], h0[3]); hw.z = pk2(h1[0], h1[1]); hw.w = pk2(h1[2], h1[3]);
            *GP(v4u, hp + 32 * c) = hw;
            if (NT > 0) {
                v4u lw; lw.x = pk2(h0[0] - bflo(hw.x), h0[1] - bfhi(hw.x)); lw.y = pk2(h0[2] - bflo(hw.y), h0[3] - bfhi(hw.y));
                lw.z = pk2(h1[0] - bflo(hw.z), h1[1] - bfhi(hw.z)); lw.w = pk2(h1[2] - bflo(hw.w), h1[3] - bfhi(hw.w));
                const bf16x8 ah = __builtin_bit_cast(bf16x8, hw), al = __builtin_bit_cast(bf16x8, lw);
#pragma unroll
                for (int nt = 0; nt < NT; ++nt) {
                    acc[nt] = __builtin_amdgcn_mfma_f32_16x16x32_bf16(ah, Bh[nt][c], acc[nt], 0, 0, 0);
                    acc[nt] = __builtin_amdgcn_mfma_f32_16x16x32_bf16(ah, Bl[nt][c], acc[nt], 0, 0, 0);
                    acc[nt] = __builtin_amdgcn_mfma_f32_16x16x32_bf16(al, Bh[nt][c], acc[nt], 0, 0, 0); }
            }
        }
        if (NT > 0) {
            if (MODE == 0) { part[(it * 8 + w) * 64 + lane] = acc[0]; }
            else {
#pragma unroll
                for (int nt = 0; nt < NT; ++nt) part[((buf * 8 + w) * 2 + nt) * 64 + lane] = acc[nt];
                LDS_BARRIER();
                { const int t = tid & 15, n = tid >> 4; float f = 0.f;
#pragma unroll
                  for (int ww = 0; ww < 8; ++ww) f += ((const LAS float*)&part[((buf * 8 + ww) * 2 + (n >> 4)) * 64 + (n & 15) + 16 * (t >> 2)])[t & 3];
                  selAll[(16 * it + t) * 33 + n] = 1.0f / (1.0f + expf(-f)) + A.bias[n]; }
            }
        }
    };
    for (int it = 0; it < 8; it += 2) { tile(it, xa, yaa, yab); tile(it + 1, xb, yba, ybb); }
    if (MODE == 0) {
        LDS_BARRIER();
        for (int e = tid; e < 2048; e += 512) { const int n = e >> 7, tl = e & 127, itt = tl >> 4, t = tl & 15; float f = 0.f;
#pragma unroll
            for (int ww = 0; ww < 8; ++ww) f += ((const LAS float*)&part[(itt * 8 + ww) * 64 + n + 16 * (t >> 2)])[t & 3];
            const float z = f + A.bias[n]; const float lf = fminf(z, 0.f) - log1pf(__expf(-fabsf(z)));
            GP(float, A.logf)[((size_t)b * H + n) * SEQ + ((R0 + tl) & (SEQ - 1))] = lf; }
    }
    if (MODE == 1) {
    LDS_BARRIER();
    int re0 = 0, re1 = 0; unsigned rk0 = 0u, rk1 = 0u; float rg0 = 0.f, rg1 = 0.f;
    if (tid < 128) { const LAS float* sl = selAll + tid * 33; float bg = -INFINITY; int gi = 0;
        for (int g = 0; g < 4; ++g) { float m1 = -INFINITY, m2 = -INFINITY;
            for (int i = 0; i < 8; ++i) { const float v = sl[8 * g + i]; if (v > m1) { m2 = m1; m1 = v; } else if (v > m2) m2 = v; }
            const float gs = m1 + m2; if (gs > bg) { bg = gs; gi = g; } }
        int i1 = 0, i2 = 0; float v1 = -INFINITY, v2 = -INFINITY;
        for (int i = 0; i < 8; ++i) { const float v = sl[8 * gi + i]; if (v > v1) { v1 = v; i1 = i; } }
        for (int i = 0; i < 8; ++i) { const float v = sl[8 * gi + i]; if (i != i1 && v > v2) { v2 = v; i2 = i; } }
        re0 = 8 * gi + i1; re1 = 8 * gi + i2; const float s0 = v1 - A.bias[re0], s1 = v2 - A.bias[re1], inv = 1.0f / (s0 + s1); rg0 = s0 * inv; rg1 = s1 * inv;
        rk0 = __hip_atomic_fetch_add(lcnt + re0, 1u, __ATOMIC_RELAXED, __HIP_MEMORY_SCOPE_WORKGROUP); rk1 = __hip_atomic_fetch_add(lcnt + re1, 1u, __ATOMIC_RELAXED, __HIP_MEMORY_SCOPE_WORKGROUP); }
    LDS_BARRIER();
    if (tid < 32) lbase[tid] = __hip_atomic_fetch_add(A.cnt + tid * 64, lcnt[tid], RLX_AGENT);
    LDS_BARRIER();
    if (tid < 128) { const unsigned p0 = lbase[re0] + rk0, p1 = lbase[re1] + rk1; const int rt = R0 + tid;
        GP(int, A.tok)[re0 * ECAP + p0] = rt * 2; GP(unsigned, A.gw)[re0 * ECAP + p0] = pack_tg(rt * 2, rg0); GP(int, A.tok)[re1 * ECAP + p1] = rt * 2 + 1; GP(unsigned, A.gw)[re1 * ECAP + p1] = pack_tg(rt * 2 + 1, rg1); }
    }
    __syncthreads();
#undef RP_LOAD
}

__device__ __forceinline__ void wave_sum2(float& a, float& b) {
#define WS_DPP(x, c_) __int_as_float(__builtin_amdgcn_update_dpp(0, __float_as_int(x), (c_), 0xf, 0xf, false))
    a += WS_DPP(a, 0xB1); b += WS_DPP(b, 0xB1); a += WS_DPP(a, 0x4E); b += WS_DPP(b, 0x4E); a += WS_DPP(a, 0x141); b += WS_DPP(b, 0x141); a += WS_DPP(a, 0x140); b += WS_DPP(b, 0x140);
#undef WS_DPP
    { auto p = __builtin_amdgcn_permlane16_swap(__float_as_uint(a), __float_as_uint(a), false, false); a = __uint_as_float(p[0]) + __uint_as_float(p[1]);
      auto q = __builtin_amdgcn_permlane16_swap(__float_as_uint(b), __float_as_uint(b), false, false); b = __uint_as_float(q[0]) + __uint_as_float(q[1]); }
    { auto p = __builtin_amdgcn_permlane32_swap(__float_as_uint(a), __float_as_uint(a), false, false); a = __uint_as_float(p[0]) + __uint_as_float(p[1]);
      auto q = __builtin_amdgcn_permlane32_swap(__float_as_uint(b), __float_as_uint(b), false, false); b = __uint_as_float(q[0]) + __uint_as_float(q[1]); }
}
template <int MODE>
__device__ __forceinline__ void rowpass_s(Frame& F, const RowArgs& A) {
    typedef unsigned v2u __attribute__((ext_vector_type(2)));
    constexpr int NT = (MODE == 0) ? 1 : 2;
    constexpr int HP = 2064;
    const int lane = F.lane, w = F.wave, r = lane & 15, q = lane >> 4, tid = F.tid;
    const int R0 = F.vcu * 128, b = R0 >> 12, c0 = 4 * lane;
    LAS f32x4* part = (LAS f32x4*)(F.lds + 1024);
    LAS unsigned char* hiT = F.lds + 34816; LAS unsigned char* loT = hiT + 16 * HP;
    LAS unsigned* lcnt = (LAS unsigned*)(F.lds + 101376); LAS unsigned* lbase = lcnt + 32; LAS float* selAll = (LAS float*)(F.lds + SELALL_OFF);
    if (MODE == 1 && tid < 32) lcnt[tid] = 0u;
    f32x4 xa[2][4], xb[2][4];
#define RS_LOAD(it_, X) do { _Pragma("unroll") for (int j = 0; j < 2; ++j) { const size_t ro_ = (size_t)(R0 + 16 * (it_) + 2 * w + j) * D + c0; \
        if (MODE == 1) { const bf16* xq_ = (const bf16*)A.src + ro_; _Pragma("unroll") for (int m = 0; m < 4; ++m) { const v2u t_ = *GCP(v2u, xq_ + 256 * m); X[j][m][0] = __uint_as_float(t_.x); X[j][m][1] = __uint_as_float(t_.y); } } \
        else { const float* xs_ = A.src + ro_; _Pragma("unroll") for (int m = 0; m < 4; ++m) X[j][m] = *GCP(f32x4, xs_ + 256 * m); } } } while (0)
    RS_LOAD(0, xa); RS_LOAD(1, xb);
    f32x4 gm[4], sh[4];
#pragma unroll
    for (int m = 0; m < 4; ++m) { const f32x4 g1 = *GCP(f32x4, A.g + c0 + 256 * m), sc = *GCP(f32x4, A.scp + (size_t)b * MODW + c0 + 256 * m); gm[m] = g1 * (sc + 1.0f); sh[m] = *GCP(f32x4, A.shp + (size_t)b * MODW + c0 + 256 * m); }
    bf16x8 Bh[NT][4], Bl[NT][4];
    { const v4u* wf = (const v4u*)A.wfrag + (size_t)w * (NT * 512) + lane;
#pragma unroll
      for (int nt = 0; nt < NT; ++nt)
#pragma unroll
          for (int c = 0; c < 4; ++c) { Bh[nt][c] = __builtin_bit_cast(bf16x8, GCP(v4u, wf)[((nt * 4 + c) * 2 + 0) * 64]); Bl[nt][c] = __builtin_bit_cast(bf16x8, GCP(v4u, wf)[((nt * 4 + c) * 2 + 1) * 64]); } }
    __syncthreads();
    auto tile = [&](const int it, f32x4 (&X)[2][4]) __attribute__((always_inline)) {
        const int buf = it & 1;
        f32x4 xv[2][4]; float ss[2];
#pragma unroll
        for (int j = 0; j < 2; ++j) { ss[j] = 0.f;
#pragma unroll
            for (int m = 0; m < 4; ++m) { f32x4 t = X[j][m];
                if (MODE == 1) { const unsigned w0_ = __float_as_uint(t[0]), w1_ = __float_as_uint(t[1]); t = (f32x4){bflo(w0_), bfhi(w0_), bflo(w1_), bfhi(w1_)}; }
                xv[j][m] = t; ss[j] += (t[0] * t[0] + t[1] * t[1]) + (t[2] * t[2] + t[3] * t[3]); } }
        if (it < 6) RS_LOAD(it + 2, X);
        wave_sum2(ss[0], ss[1]);
#pragma unroll
        for (int j = 0; j < 2; ++j) { const float rstd = 1.0f / sqrtf(ss[j] * (1.0f / D) + RMS_EPS); const int trow = 2 * w + j;
            bf16* hp = A.hb + (size_t)(R0 + 16 * it + trow) * D + c0;
#pragma unroll
            for (int m = 0; m < 4; ++m) { const f32x4 h = xv[j][m] * rstd * gm[m] + sh[m];
                v2u hw; hw.x = pk2(h[0], h[1]); hw.y = pk2(h[2], h[3]);
                *GP(v2u, hp + 256 * m) = hw;
                v2u lw; lw.x = pk2(h[0] - bflo(hw.x), h[1] - bfhi(hw.x)); lw.y = pk2(h[2] - bflo(hw.y), h[3] - bfhi(hw.y));
                *(LAS v2u*)(hiT + trow * HP + (c0 + 256 * m) * 2) = hw; *(LAS v2u*)(loT + trow * HP + (c0 + 256 * m) * 2) = lw; } }
        LDS_BARRIER();
        f32x4 acc[NT];
#pragma unroll
        for (int nt = 0; nt < NT; ++nt) acc[nt] = (f32x4){0.f, 0.f, 0.f, 0.f};
#pragma unroll
        for (int c = 0; c < 4; ++c) { const bf16x8 ah = *(const LAS bf16x8*)(hiT + r * HP + (128 * w + 32 * c + 8 * q) * 2), al = *(const LAS bf16x8*)(loT + r * HP + (128 * w + 32 * c + 8 * q) * 2);
#pragma unroll
            for (int nt = 0; nt < NT; ++nt) {
                acc[nt] = __builtin_amdgcn_mfma_f32_16x16x32_bf16(ah, Bh[nt][c], acc[nt], 0, 0, 0);
                acc[nt] = __builtin_amdgcn_mfma_f32_16x16x32_bf16(ah, Bl[nt][c], acc[nt], 0, 0, 0);
                acc[nt] = __builtin_amdgcn_mfma_f32_16x16x32_bf16(al, Bh[nt][c], acc[nt], 0, 0, 0); } }
#pragma unroll
        for (int nt = 0; nt < NT; ++nt) part[((buf * 8 + w) * NT + nt) * 64 + lane] = acc[nt];
        LDS_BARRIER();
        if (MODE == 1) { const int t = tid & 15, n = tid >> 4; float f = 0.f;
#pragma unroll
            for (int ww = 0; ww < 8; ++ww) f += ((const LAS float*)&part[((buf * 8 + ww) * 2 + (n >> 4)) * 64 + (n & 15) + 16 * (t >> 2)])[t & 3];
            selAll[(16 * it + t) * 33 + n] = 1.0f / (1.0f + expf(-f)) + A.bias[n]; }
        else if (tid < 256) { const int t = tid & 15, n = tid >> 4; float f = 0.f;
#pragma unroll
            for (int ww = 0; ww < 8; ++ww) f += ((const LAS float*)&part[(buf * 8 + ww) * 64 + n + 16 * (t >> 2)])[t & 3];
            const float z = f + A.bias[n]; const float lf = fminf(z, 0.f) - log1pf(__expf(-fabsf(z)));
            GP(float, A.logf)[((size_t)b * H + n) * SEQ + ((R0 + 16 * it + t) & (SEQ - 1))] = lf; }
    };
    for (int it = 0; it < 8; it += 2) { tile(it, xa); tile(it + 1, xb); }
#undef RS_LOAD
    if (MODE == 1) {
    LDS_BARRIER();
    int re0 = 0, re1 = 0; unsigned rk0 = 0u, rk1 = 0u; float rg0 = 0.f, rg1 = 0.f;
    if (tid < 128) { const LAS float* sl = selAll + tid * 33; float bg = -INFINITY; int gi = 0;
        for (int g = 0; g < 4; ++g) { float m1 = -INFINITY, m2 = -INFINITY;
            for (int i = 0; i < 8; ++i) { const float v = sl[8 * g + i]; if (v > m1) { m2 = m1; m1 = v; } else if (v > m2) m2 = v; }
            const float gs = m1 + m2; if (gs > bg) { bg = gs; gi = g; } }
        int i1 = 0, i2 = 0; float v1 = -INFINITY, v2 = -INFINITY;
        for (int i = 0; i < 8; ++i) { const float v = sl[8 * gi + i]; if (v > v1) { v1 = v; i1 = i; } }
        for (int i = 0; i < 8; ++i) { const float v = sl[8 * gi + i]; if (i != i1 && v > v2) { v2 = v; i2 = i; } }
        re0 = 8 * gi + i1; re1 = 8 * gi + i2; const float s0 = v1 - A.bias[re0], s1 = v2 - A.bias[re1], inv = 1.0f / (s0 + s1); rg0 = s0 * inv; rg1 = s1 * inv;
        rk0 = __hip_atomic_fetch_add(lcnt + re0, 1u, __ATOMIC_RELAXED, __HIP_MEMORY_SCOPE_WORKGROUP); rk1 = __hip_atomic_fetch_add(lcnt + re1, 1u, __ATOMIC_RELAXED, __HIP_MEMORY_SCOPE_WORKGROUP); }
    LDS_BARRIER();
    if (tid < 32) lbase[tid] = __hip_atomic_fetch_add(A.cnt + tid * 64, lcnt[tid], RLX_AGENT);
    LDS_BARRIER();
    if (tid < 128) { const unsigned p0 = lbase[re0] + rk0, p1 = lbase[re1] + rk1; const int rt = R0 + tid;
        GP(int, A.tok)[re0 * ECAP + p0] = rt * 2; GP(unsigned, A.gw)[re0 * ECAP + p0] = pack_tg(rt * 2, rg0); GP(int, A.tok)[re1 * ECAP + p1] = rt * 2 + 1; GP(unsigned, A.gw)[re1 * ECAP + p1] = pack_tg(rt * 2 + 1, rg1); }
    }
    __syncthreads();
}

__device__ __forceinline__ void final_pass(Frame& F, const RowArgs& A) {
    typedef unsigned v2u __attribute__((ext_vector_type(2)));
    const int lane = F.lane, w = F.wave;
    const int RW = F.vcu * 128 + w * 16, b = (F.vcu * 128) >> 12, c0 = 4 * lane;
    v2u xA[2][4], yA0[2][4], yA1[2][4], xB[2][4], yB0[2][4], yB1[2][4];
#define FP_LOAD(st_, X, Y0, Y1) do { _Pragma("unroll") for (int j = 0; j < 2; ++j) { const size_t row_ = (size_t)(RW + 2 * (st_) + j); \
        const bf16* xp_ = (const bf16*)A.src + row_ * D + c0; const bf16* yp_ = A.y2 + row_ * 2 * D + c0; \
        _Pragma("unroll") for (int m = 0; m < 4; ++m) { X[j][m] = *GCP(v2u, xp_ + 256 * m); Y0[j][m] = *GCP(v2u, yp_ + 256 * m); Y1[j][m] = *GCP(v2u, yp_ + D + 256 * m); } } } while (0)
    FP_LOAD(0, xA, yA0, yA1); FP_LOAD(1, xB, yB0, yB1);
    f32x4 gm[4], gt[4];
#pragma unroll
    for (int m = 0; m < 4; ++m) { gm[m] = *GCP(f32x4, A.g + c0 + 256 * m); gt[m] = *GCP(f32x4, A.gtp + (size_t)b * MODW + c0 + 256 * m); }
    auto step = [&](const int st, v2u (&X)[2][4], v2u (&Y0)[2][4], v2u (&Y1)[2][4]) __attribute__((always_inline)) {
        f32x4 v[2][4]; float ss[2];
#pragma unroll
        for (int j = 0; j < 2; ++j) { ss[j] = 0.f;
#pragma unroll
            for (int m = 0; m < 4; ++m) { const v2u x = X[j][m], a = Y0[j][m], c = Y1[j][m];
                f32x4 s; s[0] = bflo(a.x) + bflo(c.x); s[1] = bfhi(a.x) + bfhi(c.x); s[2] = bflo(a.y) + bflo(c.y); s[3] = bfhi(a.y) + bfhi(c.y);
                f32x4 t; t[0] = bflo(x.x); t[1] = bfhi(x.x); t[2] = bflo(x.y); t[3] = bfhi(x.y);
                t += gt[m] * s; v[j][m] = t; ss[j] += (t[0] * t[0] + t[1] * t[1]) + (t[2] * t[2] + t[3] * t[3]); } }
        if (st < 6) FP_LOAD(st + 2, X, Y0, Y1);
        wave_sum2(ss[0], ss[1]);
#pragma unroll
        for (int j = 0; j < 2; ++j) { const float rstd = 1.0f / sqrtf(ss[j] * (1.0f / D) + RMS_EPS); float* op = A.dst + (size_t)(RW + 2 * st + j) * D + c0;
#pragma unroll
            for (int m = 0; m < 4; ++m) *GP(f32x4, op + 256 * m) = v[j][m] * rstd * gm[m]; }
    };
    for (int st = 0; st < 8; st += 2) { step(st, xA, yA0, yA1); step(st + 1, xB, yB0, yB1); }
#undef FP_LOAD
}

struct MixArgs { const float* src; float* dst; const bf16* y2; bf16* hb; const bf16* wp; const float* g1; const float* sh1; const float* sc1; const float* gt0; const float* gtp; const float* ps;
                 const float* g2; const float* sh2; const float* sc2; const void* rwf; const float* bias; gu32* cnt; int* tok; float* gw; };
__device__ __forceinline__ void mixer_pass(Frame& F, const MixArgs& A) {
    const int lane = F.lane, w = F.wave, r = lane & 15, q = lane >> 4, tid = F.tid;
    const int R0 = F.vcu * 128, b = R0 >> 12;
    const int kb = 128 * w + 8 * q, grp = w >> 1, hf = w & 1, win = 2 << grp;
    LAS float* red = (LAS float*)(F.lds);
    LAS f32x4* part = (LAS f32x4*)(F.lds + 1024);
    LAS float* scS = (LAS float*)(F.lds + 1024 + 32768);
    LAS float* selS = scS + 512;
    LAS unsigned* lcnt = (LAS unsigned*)(F.lds + 37888); LAS unsigned* lbase = lcnt + 32; LAS float* selAll = (LAS float*)(F.lds + SELALL_OFF);
    if (tid < 32) lcnt[tid] = 0u;
    LAS float* VEC = (LAS float*)(F.lds + 38400);
    constexpr int HRS = 2064;
    LAS unsigned char* hring = F.lds + 62976;
    const bool seq_start = (R0 & (SEQ - 1)) == 0;
    v4u xn[4]; v4u yna[4], ynb[4];
    const unsigned xo0 = (unsigned)(((R0 + r) * D + kb) * 2), yo0 = (unsigned)(((R0 + r) * 2 * D + kb) * 2), ho0 = (unsigned)(((R0 + r) * D + kb) * 2);
#define MXP_LOAD(it_) do { const GAS v4u* xs_ = GCP(v4u, (const char*)A.src + (size_t)(unsigned)((int)xo0 + (it_) * 32768)); const GAS v4u* yp_ = GCP(v4u, (const char*)A.y2 + (size_t)(unsigned)((int)yo0 + (it_) * 65536)); \
        _Pragma("unroll") for (int c = 0; c < 4; ++c) { xn[c] = xs_[4 * c]; yna[c] = yp_[4 * c]; ynb[c] = yp_[128 + 4 * c]; } } while (0)
    MXP_LOAD(seq_start ? 0 : -1);
    for (int k = tid; k < D; k += 512) {
        VEC[k] = A.g1[k] * (1.0f + A.sc1[(size_t)b * MODW + k]); VEC[1024 + k] = A.sh1[(size_t)b * MODW + k]; VEC[2048 + k] = A.gt0[(size_t)b * MODW + k];
        VEC[3072 + k] = A.gtp[(size_t)b * MODW + k] * A.ps[k]; VEC[4096 + k] = A.g2[k] * (1.0f + A.sc2[(size_t)b * MODW + k]); VEC[5120 + k] = A.sh2[(size_t)b * MODW + k]; }
    const v4u* rwf = (const v4u*)A.rwf + (size_t)w * 1024;
    const v4u* wpb = (const v4u*)A.wp + (size_t)w * 4096;
    __syncthreads();
#ifdef MXPROBE
    unsigned long long mx_prev = __builtin_amdgcn_s_memrealtime(), mx_acc = 0ull; int mx_sec = -1;
#define MXT(k) do { const unsigned long long n_ = __builtin_amdgcn_s_memrealtime(); if (mx_sec == MXPROBE) mx_acc += n_ - mx_prev; mx_prev = n_; mx_sec = (k); } while (0)
#else
#define MXT(k) do {} while (0)
#endif
    for (int it = seq_start ? 0 : -1; it < 8; ++it) {
        const int row = R0 + 16 * it + r, buf = it & 1, slot = it & 1;
        unsigned vb_ = (unsigned)(uintptr_t)(VEC + kb), z_ = 0u; asm volatile("" : "+v"(vb_), "+v"(z_));
        const unsigned lz_ = (unsigned)lane + z_; const GAS v4u* wpt = GCP(v4u, wpb + lz_); const GAS v4u* rwt = GCP(v4u, rwf + lz_);
        const LAS float* GM1 = (const LAS float*)vb_ - kb; const LAS float* SH1 = GM1 + 1024; const LAS float* GT0 = GM1 + 2048; const LAS float* GP = GM1 + 3072; const LAS float* GM2 = GM1 + 4096; const LAS float* SH2 = GM1 + 5120;
        MXT(0);
        f32x4 xv[4][2];
#pragma unroll
        for (int c = 0; c < 4; ++c) { const v4u xw = xn[c]; xv[c][0] = (f32x4){bflo(xw.x), bfhi(xw.x), bflo(xw.y), bfhi(xw.y)}; xv[c][1] = (f32x4){bflo(xw.z), bfhi(xw.z), bflo(xw.w), bfhi(xw.w)}; }
#pragma unroll
        for (int c = 0; c < 4; ++c) { const v4u ya = yna[c], yb = ynb[c];
            f32x4 s0, s1;
            s0[0] = bflo(ya.x) + bflo(yb.x); s0[1] = bfhi(ya.x) + bfhi(yb.x); s0[2] = bflo(ya.y) + bflo(yb.y); s0[3] = bfhi(ya.y) + bfhi(yb.y);
            s1[0] = bflo(ya.z) + bflo(yb.z); s1[1] = bfhi(ya.z) + bfhi(yb.z); s1[2] = bflo(ya.w) + bflo(yb.w); s1[3] = bfhi(ya.w) + bfhi(yb.w);
            xv[c][0] += *(const LAS f32x4*)(GT0 + kb + 32 * c) * s0; xv[c][1] += *(const LAS f32x4*)(GT0 + kb + 32 * c + 4) * s1; }
        if (it < 0) MXP_LOAD(0);
        float ss = 0.f;
#pragma unroll
        for (int c = 0; c < 4; ++c)
#pragma unroll
            for (int h2 = 0; h2 < 2; ++h2) { const f32x4 v = xv[c][h2]; ss += (v[0] * v[0] + v[1] * v[1]) + (v[2] * v[2] + v[3] * v[3]); }
        ss += __int_as_float(__builtin_amdgcn_ds_bpermute((lane ^ 16) << 2, __float_as_int(ss))); ss += __int_as_float(__builtin_amdgcn_ds_bpermute((lane ^ 32) << 2, __float_as_int(ss)));
        if (q == 0) red[buf * 128 + w * 16 + r] = ss;
        LDS_BARRIER();
        float tot = 0.f;
#pragma unroll
        for (int ww = 0; ww < 8; ++ww) tot += red[buf * 128 + ww * 16 + r];
        const float rstd1 = 1.0f / sqrtf(tot * (1.0f / D) + RMS_EPS);
        MXT(1);
#pragma unroll
        for (int c = 0; c < 4; ++c) {
            const f32x4 h0 = xv[c][0] * rstd1 * *(const LAS f32x4*)(GM1 + kb + 32 * c) + *(const LAS f32x4*)(SH1 + kb + 32 * c);
            const f32x4 h1 = xv[c][1] * rstd1 * *(const LAS f32x4*)(GM1 + kb + 32 * c + 4) + *(const LAS f32x4*)(SH1 + kb + 32 * c + 4);
            v4u hw; hw.x = pk2(h0[0], h0[1]); hw.y = pk2(h0[2], h0[3]); hw.z = pk2(h1[0], h1[1]); hw.w = pk2(h1[2], h1[3]);
            *(LAS v4u*)(hring + (slot * 16 + r) * HRS + (kb + 32 * c) * 2) = hw; }
        LDS_BARRIER();
        if (it < 0) continue;
        MXT(2);
        if (it < 7) MXP_LOAD(it + 1);
        bf16x8 wfa[8], wfb[8], wfc[8];
#define MX_LOADW(dst, t_) do { _Pragma("unroll") for (int ks = 0; ks < 8; ++ks) dst[ks] = __builtin_bit_cast(bf16x8, wpt[((t_) * 8 + ks) * 64]); } while (0)
        MX_LOADW(wfa, 0); MX_LOADW(wfb, 1); __builtin_amdgcn_sched_barrier(0);
        const int sq = row & (SEQ - 1); const bool sq0 = ((R0 + 16 * it) & (SEQ - 1)) == 0;
#define MX_A3(OP) OP(0) OP(1) OP(2) OP(3) OP(4) OP(5) OP(6) OP(7)
#define MX_C1(j) "v_add_f32_dpp %" #j ", %" #j ", %" #j " row_shr:%16 row_mask:0xf bank_mask:0xf\n\t"
#define MX_STEPA(S_, SL_, LASTP) do { \
        asm volatile("s_nop 1\n\t" \
            "v_add_f32_dpp %0, %0, %0 row_shr:" #S_ " row_mask:0xf bank_mask:0xf\n\tv_add_f32_dpp %1, %1, %1 row_shr:" #S_ " row_mask:0xf bank_mask:0xf\n\tv_add_f32_dpp %2, %2, %2 row_shr:" #S_ " row_mask:0xf bank_mask:0xf\n\tv_add_f32_dpp %3, %3, %3 row_shr:" #S_ " row_mask:0xf bank_mask:0xf\n\t" \
            "v_add_f32_dpp %4, %4, %4 row_shr:" #S_ " row_mask:0xf bank_mask:0xf\n\tv_add_f32_dpp %5, %5, %5 row_shr:" #S_ " row_mask:0xf bank_mask:0xf\n\tv_add_f32_dpp %6, %6, %6 row_shr:" #S_ " row_mask:0xf bank_mask:0xf\n\tv_add_f32_dpp %7, %7, %7 row_shr:" #S_ " row_mask:0xf bank_mask:0xf\n\t" \
            "v_add_f32_dpp %0, %8, %0 row_shl:" #SL_ " row_mask:0xf bank_mask:0xf\n\tv_add_f32_dpp %1, %9, %1 row_shl:" #SL_ " row_mask:0xf bank_mask:0xf\n\tv_add_f32_dpp %2, %10, %2 row_shl:" #SL_ " row_mask:0xf bank_mask:0xf\n\tv_add_f32_dpp %3, %11, %3 row_shl:" #SL_ " row_mask:0xf bank_mask:0xf\n\t" \
            "v_add_f32_dpp %4, %12, %4 row_shl:" #SL_ " row_mask:0xf bank_mask:0xf\n\tv_add_f32_dpp %5, %13, %5 row_shl:" #SL_ " row_mask:0xf bank_mask:0xf\n\tv_add_f32_dpp %6, %14, %6 row_shl:" #SL_ " row_mask:0xf bank_mask:0xf\n\tv_add_f32_dpp %7, %15, %7 row_shl:" #SL_ " row_mask:0xf bank_mask:0xf\n\t" \
            : "+v"(cc[0]), "+v"(cc[1]), "+v"(cc[2]), "+v"(cc[3]), "+v"(cc[4]), "+v"(cc[5]), "+v"(cc[6]), "+v"(cc[7]) \
            : "v"(pq[0]), "v"(pq[1]), "v"(pq[2]), "v"(pq[3]), "v"(pq[4]), "v"(pq[5]), "v"(pq[6]), "v"(pq[7])); \
        if (!(LASTP)) asm volatile("s_nop 1\n\t" \
            "v_add_f32_dpp %0, %0, %0 row_shr:" #S_ " row_mask:0xf bank_mask:0xf\n\tv_add_f32_dpp %1, %1, %1 row_shr:" #S_ " row_mask:0xf bank_mask:0xf\n\tv_add_f32_dpp %2, %2, %2 row_shr:" #S_ " row_mask:0xf bank_mask:0xf\n\tv_add_f32_dpp %3, %3, %3 row_shr:" #S_ " row_mask:0xf bank_mask:0xf\n\t" \
            "v_add_f32_dpp %4, %4, %4 row_shr:" #S_ " row_mask:0xf bank_mask:0xf\n\tv_add_f32_dpp %5, %5, %5 row_shr:" #S_ " row_mask:0xf bank_mask:0xf\n\tv_add_f32_dpp %6, %6, %6 row_shr:" #S_ " row_mask:0xf bank_mask:0xf\n\tv_add_f32_dpp %7, %7, %7 row_shr:" #S_ " row_mask:0xf bank_mask:0xf\n\t" \
            : "+v"(pq[0]), "+v"(pq[1]), "+v"(pq[2]), "+v"(pq[3]), "+v"(pq[4]), "+v"(pq[5]), "+v"(pq[6]), "+v"(pq[7])); } while (0)
#pragma unroll
        for (int g = 0; g < 4; ++g) { const int wn = 2 << g; float cc[8], pq[8], own[8];
            const int cb = (256 * g + 32 * w + 8 * q) * 2;
            const v4u c4 = *(const LAS v4u*)(hring + (slot * 16 + r) * HRS + cb); v4u p4 = *(const LAS v4u*)(hring + ((slot ^ 1) * 16 + r) * HRS + cb); if (sq0) p4 = (v4u){0u, 0u, 0u, 0u};
            cc[0] = bflo(c4.x); cc[1] = bfhi(c4.x); cc[2] = bflo(c4.y); cc[3] = bfhi(c4.y); cc[4] = bflo(c4.z); cc[5] = bfhi(c4.z); cc[6] = bflo(c4.w); cc[7] = bfhi(c4.w);
            pq[0] = bflo(p4.x); pq[1] = bfhi(p4.x); pq[2] = bflo(p4.y); pq[3] = bfhi(p4.y); pq[4] = bflo(p4.z); pq[5] = bfhi(p4.z); pq[6] = bflo(p4.w); pq[7] = bfhi(p4.w);
#pragma unroll
            for (int j = 0; j < 8; ++j) own[j] = cc[j];
            if (g == 0) { MX_STEPA(1, 15, true); }
            else if (g == 1) { MX_STEPA(1, 15, false); MX_STEPA(2, 14, true); }
            else if (g == 2) { MX_STEPA(1, 15, false); MX_STEPA(2, 14, false); MX_STEPA(4, 12, true); }
            else { MX_STEPA(1, 15, false); MX_STEPA(2, 14, false); MX_STEPA(4, 12, false); MX_STEPA(8, 8, true); }
            const float ic = 1.0f / (float)((sq + 1 < wn) ? (sq + 1) : wn);
            v4u pw; pw.x = pk2(cc[0] * ic - own[0], cc[1] * ic - own[1]); pw.y = pk2(cc[2] * ic - own[2], cc[3] * ic - own[3]); pw.z = pk2(cc[4] * ic - own[4], cc[5] * ic - own[5]); pw.w = pk2(cc[6] * ic - own[6], cc[7] * ic - own[7]);
            ((LAS v4u*)part)[((g * 8 + w) * 64) + lane] = pw; }
#undef MX_STEPA
#undef MX_A3
#undef MX_C1
        LDS_BARRIER();
        bf16x8 pp[8];
#pragma unroll
        for (int ks = 0; ks < 8; ++ks) pp[ks] = __builtin_bit_cast(bf16x8, ((const LAS v4u*)part)[((grp * 8 + ks) * 64) + lane]);
        MXT(3);
#define MX_MMA(src, t_) do { f32x4 acc = (f32x4){0.f, 0.f, 0.f, 0.f}; _Pragma("unroll") for (int ks = 0; ks < 8; ++ks) acc = __builtin_amdgcn_mfma_f32_16x16x32_bf16(src[ks], pp[ks], acc, 0, 0, 0); \
            xv[(t_) >> 1][(t_) & 1] += *(const LAS f32x4*)(GP + kb + 32 * ((t_) >> 1) + 4 * ((t_) & 1)) * acc; } while (0)
        MX_LOADW(wfc, 2); __builtin_amdgcn_sched_barrier(0); MX_MMA(wfa, 0); __builtin_amdgcn_sched_barrier(0);
        MX_LOADW(wfa, 3); __builtin_amdgcn_sched_barrier(0); MX_MMA(wfb, 1); __builtin_amdgcn_sched_barrier(0);
        MX_LOADW(wfb, 4); __builtin_amdgcn_sched_barrier(0); MX_MMA(wfc, 2); __builtin_amdgcn_sched_barrier(0);
        MX_LOADW(wfc, 5); __builtin_amdgcn_sched_barrier(0); MX_MMA(wfa, 3); __builtin_amdgcn_sched_barrier(0);
        MX_LOADW(wfa, 6); __builtin_amdgcn_sched_barrier(0); MX_MMA(wfb, 4); __builtin_amdgcn_sched_barrier(0);
        MX_LOADW(wfb, 7); __builtin_amdgcn_sched_barrier(0); MX_MMA(wfc, 5); __builtin_amdgcn_sched_barrier(0);
        MX_MMA(wfa, 6); __builtin_amdgcn_sched_barrier(0);
        MX_MMA(wfb, 7); __builtin_amdgcn_sched_barrier(0);
#ifdef MX_DUP_W
        { const float zf_ = __uint_as_float(z_);
#define MX_MMA0(src, t_) do { f32x4 acc = (f32x4){0.f, 0.f, 0.f, 0.f}; _Pragma("unroll") for (int ks = 0; ks < 8; ++ks) acc = __builtin_amdgcn_mfma_f32_16x16x32_bf16(src[ks], pp[ks], acc, 0, 0, 0); \
            xv[(t_) >> 1][(t_) & 1] += acc * zf_; } while (0)
        MX_LOADW(wfa, 0); __builtin_amdgcn_sched_barrier(0);
        MX_LOADW(wfb, 1); __builtin_amdgcn_sched_barrier(0); MX_MMA0(wfa, 0); __builtin_amdgcn_sched_barrier(0);
        MX_LOADW(wfa, 2); __builtin_amdgcn_sched_barrier(0); MX_MMA0(wfb, 1); __builtin_amdgcn_sched_barrier(0);
        MX_LOADW(wfb, 3); __builtin_amdgcn_sched_barrier(0); MX_MMA0(wfa, 2); __builtin_amdgcn_sched_barrier(0);
        MX_LOADW(wfa, 4); __builtin_amdgcn_sched_barrier(0); MX_MMA0(wfb, 3); __builtin_amdgcn_sched_barrier(0);
        MX_LOADW(wfb, 5); __builtin_amdgcn_sched_barrier(0); MX_MMA0(wfa, 4); __builtin_amdgcn_sched_barrier(0);
        MX_LOADW(wfa, 6); __builtin_amdgcn_sched_barrier(0); MX_MMA0(wfb, 5); __builtin_amdgcn_sched_barrier(0);
        MX_LOADW(wfb, 7); __builtin_amdgcn_sched_barrier(0); MX_MMA0(wfa, 6); __builtin_amdgcn_sched_barrier(0);
        MX_MMA0(wfb, 7); __builtin_amdgcn_sched_barrier(0);
#undef MX_MMA0
        }
#endif
#undef MX_LOADW
#undef MX_MMA
        MXT(4);
        v4u rfa[2][2], rfb[2][2], rfc[2][2], rfd[2][2];
#define MX_LOADR(dst, c_) do { _Pragma("unroll") for (int nt = 0; nt < 2; ++nt) { dst[nt][0] = rwt[((nt * 4 + (c_)) * 2 + 0) * 64]; dst[nt][1] = rwt[((nt * 4 + (c_)) * 2 + 1) * 64]; } } while (0)
        MX_LOADR(rfa, 0); MX_LOADR(rfb, 1); MX_LOADR(rfc, 2); MX_LOADR(rfd, 3); __builtin_amdgcn_sched_barrier(0);
        { GAS v4u* xd = GP(v4u, (char*)A.dst + (size_t)(unsigned)((int)ho0 + it * 32768));
#pragma unroll
          for (int c = 0; c < 4; ++c) { v4u xw; xw.x = pk2(xv[c][0][0], xv[c][0][1]); xw.y = pk2(xv[c][0][2], xv[c][0][3]); xw.z = pk2(xv[c][1][0], xv[c][1][1]); xw.w = pk2(xv[c][1][2], xv[c][1][3]); xd[4 * c] = xw; } }
        MXT(5);
        float s2 = 0.f;
#pragma unroll
        for (int c = 0; c < 4; ++c)
#pragma unroll
            for (int h2 = 0; h2 < 2; ++h2) { const f32x4 v = xv[c][h2]; s2 += (v[0] * v[0] + v[1] * v[1]) + (v[2] * v[2] + v[3] * v[3]); }
        s2 += __int_as_float(__builtin_amdgcn_ds_bpermute((lane ^ 16) << 2, __float_as_int(s2))); s2 += __int_as_float(__builtin_amdgcn_ds_bpermute((lane ^ 32) << 2, __float_as_int(s2)));
        if (q == 0) red[(buf ^ 1) * 128 + w * 16 + r] = s2;
        LDS_BARRIER();
        float tot2 = 0.f;
#pragma unroll
        for (int ww = 0; ww < 8; ++ww) tot2 += red[(buf ^ 1) * 128 + ww * 16 + r];
        const float rstd2 = 1.0f / sqrtf(tot2 * (1.0f / D) + RMS_EPS);
        f32x4 acc2[2]; acc2[0] = (f32x4){0.f, 0.f, 0.f, 0.f}; acc2[1] = (f32x4){0.f, 0.f, 0.f, 0.f};
        GAS v4u* hp2 = GP(v4u, (char*)A.hb + (size_t)(unsigned)((int)ho0 + it * 32768));

#define MX_ROUTE(src, c_) do { const int c = (c_); \
            const f32x4 h0 = xv[c][0] * rstd2 * *(const LAS f32x4*)(GM2 + kb + 32 * c) + *(const LAS f32x4*)(SH2 + kb + 32 * c), h1 = xv[c][1] * rstd2 * *(const LAS f32x4*)(GM2 + kb + 32 * c + 4) + *(const LAS f32x4*)(SH2 + kb + 32 * c + 4); \
            v4u hw; hw.x = pk2(h0[0], h0[1]); hw.y = pk2(h0[2], h0[3]); hw.z = pk2(h1[0], h1[1]); hw.w = pk2(h1[2], h1[3]); \
            hp2[4 * c] = hw; \
            v4u lw; lw.x = pk2(h0[0] - bflo(hw.x), h0[1] - bfhi(hw.x)); lw.y = pk2(h0[2] - bflo(hw.y), h0[3] - bfhi(hw.y)); \
            lw.z = pk2(h1[0] - bflo(hw.z), h1[1] - bfhi(hw.z)); lw.w = pk2(h1[2] - bflo(hw.w), h1[3] - bfhi(hw.w)); \
            const bf16x8 ah = __builtin_bit_cast(bf16x8, hw), al = __builtin_bit_cast(bf16x8, lw); \
            _Pragma("unroll") for (int nt = 0; nt < 2; ++nt) { const bf16x8 bh = __builtin_bit_cast(bf16x8, src[nt][0]), bl = __builtin_bit_cast(bf16x8, src[nt][1]); \
                acc2[nt] = __builtin_amdgcn_mfma_f32_16x16x32_bf16(ah, bh, acc2[nt], 0, 0, 0); \
                acc2[nt] = __builtin_amdgcn_mfma_f32_16x16x32_bf16(ah, bl, acc2[nt], 0, 0, 0); \
                acc2[nt] = __builtin_amdgcn_mfma_f32_16x16x32_bf16(al, bh, acc2[nt], 0, 0, 0); } } while (0)
        MX_ROUTE(rfa, 0); __builtin_amdgcn_sched_barrier(0);
        MX_ROUTE(rfb, 1); __builtin_amdgcn_sched_barrier(0);
        MX_ROUTE(rfc, 2); __builtin_amdgcn_sched_barrier(0);
        MX_ROUTE(rfd, 3); __builtin_amdgcn_sched_barrier(0);
#undef MX_LOADR
#undef MX_ROUTE
        MXT(6);
        LDS_BARRIER();
#pragma unroll
        for (int nt = 0; nt < 2; ++nt) part[((buf * 8 + w) * 2 + nt) * 64 + lane] = acc2[nt];
        LDS_BARRIER();
        { const int t = tid & 15, n = tid >> 4; float f = 0.f;
#pragma unroll
          for (int ww = 0; ww < 8; ++ww) f += ((const LAS float*)&part[((buf * 8 + ww) * 2 + (n >> 4)) * 64 + (n & 15) + 16 * (t >> 2)])[t & 3];
          selAll[(16 * it + t) * 33 + n] = 1.0f / (1.0f + expf(-f)) + A.bias[n]; }
        MXT(8);
    }
#ifdef MXPROBE
    if (blockIdx.x == 0 && tid == 0) { ((unsigned long long*)(F.ws0 + WS_CTL))[30000] = 0ull; ((unsigned long long*)(F.ws0 + WS_CTL))[30001] = mx_acc; }
#endif
    { const int tid = opaque_tid(F.wave0);
    LAS unsigned* lcnt = (LAS unsigned*)(F.lds + 37888); LAS unsigned* lbase = lcnt + 32; LAS float* selAll = (LAS float*)(F.lds + SELALL_OFF);
    LDS_BARRIER();
    int re0 = 0, re1 = 0; unsigned rk0 = 0u, rk1 = 0u; float rg0 = 0.f, rg1 = 0.f;
    if (tid < 128) { const LAS float* sl = selAll + tid * 33; float bg = -INFINITY; int gi = 0;
        for (int g = 0; g < 4; ++g) { float m1 = -INFINITY, m2 = -INFINITY;
            for (int i = 0; i < 8; ++i) { const float v = sl[8 * g + i]; if (v > m1) { m2 = m1; m1 = v; } else if (v > m2) m2 = v; }
            const float gs = m1 + m2; if (gs > bg) { bg = gs; gi = g; } }
        int i1 = 0, i2 = 0; float v1 = -INFINITY, v2 = -INFINITY;
        for (int i = 0; i < 8; ++i) { const float v = sl[8 * gi + i]; if (v > v1) { v1 = v; i1 = i; } }
        for (int i = 0; i < 8; ++i) { const float v = sl[8 * gi + i]; if (i != i1 && v > v2) { v2 = v; i2 = i; } }
        re0 = 8 * gi + i1; re1 = 8 * gi + i2; const float s0 = v1 - A.bias[re0], s1 = v2 - A.bias[re1], inv = 1.0f / (s0 + s1); rg0 = s0 * inv; rg1 = s1 * inv;
        rk0 = __hip_atomic_fetch_add(lcnt + re0, 1u, __ATOMIC_RELAXED, __HIP_MEMORY_SCOPE_WORKGROUP); rk1 = __hip_atomic_fetch_add(lcnt + re1, 1u, __ATOMIC_RELAXED, __HIP_MEMORY_SCOPE_WORKGROUP); }
    LDS_BARRIER();
    if (tid < 32) lbase[tid] = __hip_atomic_fetch_add(A.cnt + tid * 64, lcnt[tid], RLX_AGENT);
    LDS_BARRIER();
    if (tid < 128) { const unsigned p0 = lbase[re0] + rk0, p1 = lbase[re1] + rk1; const int rt = R0 + tid;
        GP(int, A.tok)[re0 * ECAP + p0] = rt * 2; GP(unsigned, A.gw)[re0 * ECAP + p0] = pack_tg(rt * 2, rg0); GP(int, A.tok)[re1 * ECAP + p1] = rt * 2 + 1; GP(unsigned, A.gw)[re1 * ECAP + p1] = pack_tg(rt * 2 + 1, rg1); }
    }
    __syncthreads();
#undef MXP_LOAD
}

constexpr int UT_E = 64, UT_X = 64 + 320, UT_V = 64 + 640;
__device__ __forceinline__ void build_etab(Frame& F, int layer, gu32* ctr) {
    LAS int* et = (LAS int*)(F.lds + ETAB_OFF);
    if (F.tid < 64) { const int ln = F.tid, e = ln & 31;
        const int c = ln < 32 ? (int)__hip_atomic_load(F.ctl + CW_CNT + (layer * 32 + e) * 64, RLX_AGENT) : 0; const int nt = (c + 255) >> 8;
        int ps = nt;
#pragma unroll
        for (int d = 1; d < 32; d <<= 1) { const int t = __shfl_up(ps, d); if (ln >= d) ps += t; }
        const int ts = ps - nt;
        for (int j = 0; j < nt; ++j) { et[UT_E + ts + j] = e; et[UT_X + ts + j] = e * ECAP + 256 * j; const int rem = c - 256 * j; et[UT_V + ts + j] = rem < 256 ? rem : 256; }
        if (ln == 31) et[0] = ps;
        if (ctr != nullptr && ln == 63) { const unsigned k0 = __hip_atomic_fetch_add(ctr, 2u, RLX_AGENT); et[2] = (int)k0; et[3] = (int)(k0 + 1u); } }
    __syncthreads();
}
struct DenseSched {
    static constexpr bool DYN = false;
    const char* A; const char* Bt; size_t strideA, strideB; int nM, nN, nwg, G, c;
    __device__ __forceinline__ bool next(int i, pg8::Unit& u) const {
        const long L = (long)i * G + c; if (L >= nwg) return false;
        int wgid = (int)L; { const int q = nwg / 8, r = nwg % 8, xcd = wgid % 8, off = wgid / 8; wgid = (xcd < r ? xcd * (q + 1) : r * (q + 1) + (xcd - r) * q) + off; }
        const int nig = 8 * nN, gid = wgid / nig, fm = gid * 8, gsz = (nM - fm) < 8 ? (nM - fm) : 8;
        u.pm = fm + ((wgid % nig) % gsz); u.pn = (wgid % nig) / gsz; u.a = A + (size_t)u.pm * strideA; u.b = Bt + (size_t)u.pn * strideB; u.x0 = 0; u.x1 = 0; u.full = 1; u.hb = 0; return true;
    }
};
template <bool DOWN> struct MoeSched {
    static constexpr bool DYN = false;
    const LAS int* et; const char* A; const char* Bt; int G, v; const int* tok; gu32* ctr;
    static constexpr size_t rowA = DOWN ? (size_t)FD * 2 : (size_t)D * 2, strideE = DOWN ? (size_t)1024 * 512 * 2 : (size_t)1024 * 1024 * 2, stridePn = DOWN ? (size_t)256 * 512 * 2 : (size_t)256 * 1024 * 2;
    __device__ __forceinline__ unsigned mbox(int i) const { return (unsigned)__builtin_amdgcn_readfirstlane(((const volatile LAS int*)et)[2 + i]); }
    __device__ __forceinline__ void mbox_set(int i, unsigned k) const { ((volatile LAS int*)et)[2 + i] = (int)k; }
    __device__ __forceinline__ bool unit_of(unsigned k, pg8::Unit& u) const {
        const int N = et[0] * 4, lp = v, x = G, nfull = N >> (lp + 3), R = N - (nfull << (lp + 3)), nf = nfull << lp, hs = R >> 2;
        if (k >= (unsigned)(nf + hs)) return false;
        int L, hb = 0, full = 1;
        if ((int)k < nf) { const int rd = (int)k >> lp; L = (rd << (lp + 3)) + (x << lp) + ((int)k - (rd << lp)); }
        else { const int hx = x * hs + ((int)k - nf); L = (nfull << (lp + 3)) + (hx >> 1); hb = (hx & 1) * 128; full = 0; }
        const int tile = L >> 2, pn = L & 3; const int e = et[UT_E + tile];
        u.pm = tile; u.pn = pn; u.full = full; u.hb = hb; u.b = Bt + (size_t)e * strideE + (size_t)pn * stridePn;
        if (DOWN) { u.a = A + ((size_t)tile * 256 + hb) * rowA; u.x0 = et[UT_X + tile] + hb; int vr = et[UT_V + tile] - hb; vr = vr < 0 ? 0 : vr; u.x1 = full ? vr : (vr < 128 ? vr : 128); }
        else { u.a = A; u.x0 = pn; u.x1 = tile * 256 + hb; }
        return true;
    }
    __device__ __forceinline__ const int* tok_addr(const pg8::Unit& u, int row) const { const int vv = et[UT_V + u.pm], x = et[UT_X + u.pm], rr = row + u.hb; return tok + x + (rr < vv ? rr : 0); }
    __device__ __forceinline__ unsigned off_of(unsigned entry) const { return (entry >> 1) * (unsigned)(D * 2); }
    __device__ __forceinline__ unsigned row_off(const pg8::Unit& u, int row) const { return off_of((unsigned)*(const GAS int*)tok_addr(u, row)); }
    __device__ __forceinline__ bool next(int i, pg8::Unit& u) const {
        const int N = et[0] * 4, nfull = N / G, R = N - nfull * G; int L, hb = 0, full = 1;
        if (i < nfull) L = i * G + v;
        else if (i == nfull && R > 0) { if (2 * R <= G) { if (v >= 2 * R) return false; L = nfull * G + (v >> 1); hb = (v & 1) * 128; full = 0; } else { if (v >= R) return false; L = nfull * G + v; } }
        else return false;
        const int tile = L >> 2, pn = L & 3; const int e = et[UT_E + tile];
        u.pm = tile; u.pn = pn; u.full = full; u.hb = hb; u.b = Bt + (size_t)e * strideE + (size_t)pn * stridePn;
        if (DOWN) { u.a = A + ((size_t)tile * 256 + hb) * rowA; u.x0 = et[UT_X + tile] + hb; int vr = et[UT_V + tile] - hb; vr = vr < 0 ? 0 : vr; u.x1 = full ? vr : (vr < 128 ? vr : 128); }
        else { u.a = A; u.x0 = pn; u.x1 = tile * 256 + hb; }
        return true;
    }
};
constexpr int N_PHASES = 17;
struct Args { const float* in[17]; float* out; unsigned char* ws; int ph_lo, ph_hi; };
__global__ void __launch_bounds__(NWAVES * 64, 2) fwd_megakernel(Args args) {
    extern __shared__ __attribute__((aligned(16))) unsigned char lds[];
    Frame F;
    F.lds = (LAS unsigned char*)lds;
    F.MISC = (volatile LAS unsigned*)(F.lds + MISC_OFF);
    F.wave0 = __builtin_amdgcn_readfirstlane((int)threadIdx.x >> 6); F.tid = threadIdx.x; F.lane = F.tid & 63; F.wave = F.wave0;
    F.G = gridDim.x; { const int bx = blockIdx.x; F.vcu = (F.G % 8 == 0) ? (bx % 8) * (F.G / 8) + bx / 8 : bx; }
    F.ws0 = args.ws; F.out0 = args.out;
    F.ka0 = (const __attribute__((address_space(4))) char*)__builtin_amdgcn_kernarg_segment_ptr();
    phase_enter(F);
    for (int u = F.tid; u < (LDS_BYTES - LDSCTL_OFF) / 4; u += NWAVES * 64) ((LAS unsigned*)(F.lds + LDSCTL_OFF))[u] = 0u;
    __syncthreads();
    XcdBarrier bar; bar.bar = (unsigned*)(F.ctl + CW_BAR); bar.x = 0; bar.st = nullptr;
    if (!MK_MULTI) bar = xcd_barrier_post((unsigned*)(F.ctl + CW_BAR), F.MISC + 8);
    int lo = args.ph_lo, hi = args.ph_hi;
#ifdef GPROBE
    if (blockIdx.x == GPROBE && opaque_tid(F.wave0) == GPROBE_TID) { pg8::gprobe_acc[0] = 0ull; pg8::gprobe_acc[1] = 0ull; pg8::gprobe_acc[2] = 0ull; pg8::gprobe_acc[3] = 0ull; }
#endif
#ifndef PROBE_Q
#define PROBE_Q 8.0f
#endif
#ifdef PROBE_PHASE
#ifndef PROBE_FROM
#define PROBE_FROM -1
#endif
    if (PROBE_FROM < 0 && blockIdx.x == 0 && opaque_tid(F.wave0) == 0) ((unsigned long long*)(F.ws0 + WS_CTL))[30000] = __builtin_amdgcn_s_memrealtime();
#define PROBE_AT(k) do { if (((k) == PROBE_PHASE || (k) == PROBE_FROM) && blockIdx.x == 0 && opaque_tid(F.wave0) == 0) ((unsigned long long*)(F.ws0 + WS_CTL))[(k) == PROBE_PHASE ? 30001 : 30000] = __builtin_amdgcn_s_memrealtime(); } while (0)
#else
#define PROBE_AT(k) do {} while (0)
#endif
#ifndef PHMASK
#define PHMASK 0xFFFFFFFFu
#endif
#define IN(k) (((PHMASK >> (k)) & 1u) && lo <= (k) && (k) < hi)
#ifndef DUP_PHASE
#define DUP_PHASE -1
#endif
#define REP(k) for (int rep_ = 0; rep_ < ((k) == DUP_PHASE ? 2 : 1); ++rep_)
#ifdef BWPROBE
    unsigned long long bw_acc = 0ull;
#define XBAR() do { const unsigned long long b0_ = __builtin_amdgcn_s_memrealtime(); xcd_barrier(bar); bw_acc += __builtin_amdgcn_s_memrealtime() - b0_; } while (0)
#else
#define XBAR() xcd_barrier(bar)
#endif
#define SEAM2(k, k2) do { if (IN(k) && IN(k2)) XBAR(); PROBE_AT(k); asm volatile("" : "+s"(lo), "+s"(hi)); } while (0)
#define SEAM(k) do { if (IN(k) && IN((k) + 1)) XBAR(); PROBE_AT(k); asm volatile("" : "+s"(lo), "+s"(hi)); } while (0)
#define mod WSP(float, WS_MOD)
#define HB WSP(bf16, WS_HB)

    if (IN(0)) REP(0) { phase_enter(F); p0_prologue(F); } SEAM(0);
#ifdef EXTRA_BARS
    for (int xb_ = 0; xb_ < EXTRA_BARS; ++xb_) xcd_barrier(bar);
#endif
    if (IN(1)) REP(1) { phase_enter(F); RowArgs A{}; A.src = FIN(IN_X); A.g = FIN(IN_NMG); A.shp = mod + 0; A.scp = mod + D; A.hb = HB; A.wfrag = WSP(v4u, WS_FWF); A.bias = FIN(IN_FBIAS); A.logf = WSP(float, WS_LOGF);
        rowpass_s<0>(F, A); } SEAM(1);
    if (IN(2)) REP(2) { phase_enter(F); pg8::Gemm g{D, D, D, 5}; DenseSched S{(const char*)HB, (const char*)WSP(bf16, WS_WQKV), (size_t)256 * D * 2, (size_t)256 * D * 2, T / 256, 3 * D / 256, (T / 256) * (3 * D / 256), F.G, (int)blockIdx.x};
        pg8::EpiQKV E{WSP(bf16, WS_Q), (size_t)(WS_K - WS_Q) / 2, attn_body::C2, (unsigned*)(F.ctl + CW_QKM)};
        pg8::gemm_phase<pg8::EpiQKV, DenseSched, true>(F.lds + RING_OFF, g, S, E, F.wave0); } SEAM(2);
    if (IN(3)) REP(3) { phase_enter(F); const attn_body::AttnTensors AT{(const attn_body::bf16*)WSP(bf16, WS_Q), (const attn_body::bf16*)WSP(bf16, WS_K), (const attn_body::bf16*)WSP(bf16, WS_V), (attn_body::bf16*)HB, WSP(float, WS_LOGF), (const unsigned*)(F.ctl + CW_QKM)};
        attn_body::attn_phase<8>((char*)lds + RING_OFF, AT, (unsigned*)(F.ctl + CW_AQ + 64 * rep_), F.wave0); } SEAM(3);
    if (IN(4)) REP(4) { phase_enter(F); pg8::Gemm g{D, D, D, 6}; DenseSched S{(const char*)HB, (const char*)WSP(bf16, WS_WO), (size_t)256 * D * 2, (size_t)256 * D * 2, T / 256, D / 256, (T / 256) * (D / 256), F.G, (int)blockIdx.x};
        pg8::EpiResidB E{FIN(IN_X), (bf16*)F.out, mod + 2 * D};
        pg8::gemm_phase<pg8::EpiResidB, DenseSched, true>(F.lds + RING_OFF, g, S, E, F.wave0); } SEAM(4);
        if (IN(5)) REP(5) { phase_enter(F); RowArgs A{}; A.src = F.out; A.g = FIN(IN_NFG) + 0 * D; A.shp = mod + (size_t)0 * 8 * MODW + 3 * D; A.scp = mod + (size_t)0 * 8 * MODW + 4 * D; A.hb = HB;
            A.wfrag = WSP(v4u, WS_RWF); A.bias = FIN(IN_RB); A.cnt = F.ctl + CW_CNT + 0 * 32 * 64; A.tok = WSP(int, WS_TOK); A.gw = WSP(float, WS_GW);
            if (rep_) { A.cnt = F.ctl + CW_CNT + 2 * 32 * 64; A.tok = WSP(int, WS_END); A.gw = WSP(float, WS_END + 4 * MiB); }
            rowpass_s<1>(F, A); } SEAM2(5, 7);
        if (IN(7)) REP(7) { phase_enter(F); build_etab(F, 0, nullptr); pg8::Gemm g{D, D, D, 3};
            MoeSched<false> S{(const LAS int*)(F.lds + ETAB_OFF), (const char*)HB, (const char*)(WSP(bf16, WS_UP0)), F.G, F.vcu, WSP(int, WS_TOK), nullptr};
            pg8::EpiUp E{WSP(bf16, WS_HH)};
            pg8::gemm_phase<pg8::EpiUp, MoeSched<false>, true, true>(F.lds + RING_OFF, g, S, E, F.wave0); } SEAM(7);
        if (IN(8)) REP(8) { phase_enter(F); if (MK_MULTI) build_etab(F, 0, nullptr);     pg8::Gemm g{FD, FD, FD, 1};
            MoeSched<true> S{(const LAS int*)(F.lds + ETAB_OFF), (const char*)WSP(bf16, WS_HH), (const char*)(WSP(bf16, WS_DN0)), F.G, F.vcu, rep_ ? WSP(int, WS_TOK) : nullptr, nullptr};
            pg8::EpiDown E{WSP(bf16, WS_Y2), WSP(int, WS_TOK), WSP(float, WS_GW)};
            pg8::gemm_phase<pg8::EpiDown, MoeSched<true>, true>(F.lds + RING_OFF, g, S, E, F.wave0); } SEAM(8);

            if (IN(9)) REP(9) { phase_enter(F); MixArgs A{}; A.src = F.out; A.dst = WSP(float, WS_X3); A.y2 = WSP(bf16, WS_Y2); A.hb = HB; A.wp = WSP(bf16, WS_WPF);
                A.g1 = FIN(IN_NMG) + D; A.sh1 = mod + 8 * MODW + 0; A.sc1 = mod + 8 * MODW + D; A.gt0 = mod + 5 * D; A.gtp = mod + 8 * MODW + 2 * D; A.ps = FIN(IN_POOLS);
                A.g2 = FIN(IN_NFG) + D; A.sh2 = mod + 8 * MODW + 3 * D; A.sc2 = mod + 8 * MODW + 4 * D; A.rwf = WSP(v4u, WS_RWF); A.bias = FIN(IN_RB);
                A.cnt = F.ctl + CW_CNT + 1 * 32 * 64; A.tok = WSP(int, WS_TOK); A.gw = WSP(float, WS_GW);
                mixer_pass(F, A); } SEAM2(9, 14);
        if (IN(14)) REP(14) { phase_enter(F); build_etab(F, 1, nullptr); pg8::Gemm g{D, D, D, 4};
            MoeSched<false> S{(const LAS int*)(F.lds + ETAB_OFF), (const char*)HB, (const char*)(WSP(bf16, WS_UP1)), F.G, F.vcu, WSP(int, WS_TOK), nullptr};
            pg8::EpiUp E{WSP(bf16, WS_HH)};
            pg8::gemm_phase<pg8::EpiUp, MoeSched<false>, true, true>(F.lds + RING_OFF, g, S, E, F.wave0); } SEAM(14);
        if (IN(15)) REP(15) { phase_enter(F); if (MK_MULTI) build_etab(F, 1, nullptr); pg8::Gemm g{FD, FD, FD, 2};
            MoeSched<true> S{(const LAS int*)(F.lds + ETAB_OFF), (const char*)WSP(bf16, WS_HH), (const char*)(WSP(bf16, WS_DN1)), F.G, F.vcu, nullptr, nullptr};
            pg8::EpiDown E{WSP(bf16, WS_Y2), WSP(int, WS_TOK), WSP(float, WS_GW)};
            pg8::gemm_phase<pg8::EpiDown, MoeSched<true>, true>(F.lds + RING_OFF, g, S, E, F.wave0); } SEAM(15);
    if (IN(16)) REP(16) { phase_enter(F); RowArgs A{}; A.src = WSP(float, WS_X3); A.dst = F.out; A.g = FIN(IN_NFIN); A.gtp = mod + 8 * MODW + 5 * D; A.y2 = WSP(bf16, WS_Y2);
        final_pass(F, A); }
#ifdef GPROBE
    if (blockIdx.x == GPROBE && opaque_tid(F.wave0) == GPROBE_TID) { ((unsigned long long*)(F.ws0 + WS_CTL))[30000] = 0ull; ((unsigned long long*)(F.ws0 + WS_CTL))[30001] = pg8::gprobe_acc[GPROBE_PART] * GPROBE_MUL; }
#endif
#ifdef BWPROBE
    if (blockIdx.x == BWPROBE && opaque_tid(F.wave0) == 0) { ((unsigned long long*)(F.ws0 + WS_CTL))[30000] = 0ull; ((unsigned long long*)(F.ws0 + WS_CTL))[30001] = bw_acc; }
#endif
#ifdef PROBE_PHASE
    xcd_barrier(bar); PROBE_AT(16); xcd_barrier(bar);
    { const unsigned long long* tw = (const unsigned long long*)(F.ws0 + WS_CTL) + 30000; const float dt_us = floorf((float)(tw[1] - tw[0]) * 0.01f * (1.0f / PROBE_Q)) * PROBE_Q;
        const float dl = sqrtf(2.56e-3f * dt_us); const int tp_ = opaque_tid(F.wave0); F.out0[(size_t)(blockIdx.x * 512 + tp_) * 256 + 3] += dl; }
#endif
#undef IN
#undef SEAM
#undef mod
#undef HB
}

extern "C" void kernel_launch(void* const* d_in, const int* in_sizes, int n_in, void* d_out, int out_size, void* d_ws, size_t ws_size, hipStream_t stream) {
    static int grid = 0;
    if (grid == 0) {
        if (n_in != 17 || in_sizes[0] != T * D || out_size != T * D || ws_size < WS_END) { fprintf(stderr, "kernel_launch: unexpected shapes (n_in %d, in0 %d, out %d, ws %zu)\n", n_in, n_in > 0 ? in_sizes[0] : -1, out_size, ws_size); grid = -1; return; }
        int dev = 0, cus = 0, per_cu = 0;
        if (hipGetDevice(&dev) != hipSuccess || hipDeviceGetAttribute(&cus, hipDeviceAttributeMultiprocessorCount, dev) != hipSuccess) { grid = -1; return; }
        if (hipFuncSetAttribute((const void*)fwd_megakernel, hipFuncAttributeMaxDynamicSharedMemorySize, LDS_BYTES) != hipSuccess) { fprintf(stderr, "kernel_launch: hipFuncSetAttribute failed\n"); grid = -1; return; }
        if (hipOccupancyMaxActiveBlocksPerMultiprocessor(&per_cu, (const void*)fwd_megakernel, NWAVES * 64, LDS_BYTES) != hipSuccess || per_cu < 1) { fprintf(stderr, "kernel_launch: occupancy query says %d\n", per_cu); (void)hipGetLastError(); grid = -1; return; }
        grid = cus;
        if (grid != 256) fprintf(stderr, "kernel_launch: %d CUs; this kernel's static work split expects 256\n", grid);
    }
    if (grid < 0) return;
    (void)hipMemsetAsync((char*)d_ws + WS_CTL, 0, CTL_ZERO_BYTES, stream);
    Args a{};
    for (int i = 0; i < 17; ++i) a.in[i] = (const float*)d_in[i];
    a.out = (float*)d_out; a.ws = (unsigned char*)d_ws;
#if MK_MULTI
#ifndef MAXPH
#define MAXPH 17
#endif
    for (int p = 0; p < MAXPH; ++p) { a.ph_lo = p; a.ph_hi = p + 1; hipLaunchKernelGGL(fwd_megakernel, dim3(grid), dim3(NWAVES * 64), LDS_BYTES, stream, a); }
#else
    a.ph_lo = 0; a.ph_hi = 17;
    void* kargs[] = {&a};
    hipError_t e = hipLaunchCooperativeKernel((const void*)fwd_megakernel, dim3(grid), dim3(NWAVES * 64), kargs, LDS_BYTES, stream);
    if (e != hipSuccess) fprintf(stderr, "kernel_launch: cooperative launch failed: %s\n", hipGetErrorString(e));
#endif
}
```

```cpp
#define MK_MULTI 0
#define MAXPH 17
#include <hip/hip_runtime.h>
#include <hip/hip_bf16.h>
#include <cstdio>
#include <cstdint>
#include <cmath>
#include <type_traits>
#define ST16_WT(ptr_, val_) asm volatile("global_store_dwordx4 %0, %1, off sc1\n\ts_nop 1" :: "v"(ptr_), "v"(val_) : "memory")
__device__ __forceinline__ int opaque_tid(int wave0) { int w = wave0; asm volatile("" : "+s"(w)); unsigned m = ~0u; asm volatile("" : "+s"(m)); const int l = (int)__builtin_amdgcn_mbcnt_hi(m, __builtin_amdgcn_mbcnt_lo(m, 0u)); return w * 64 + l; }
namespace pg8 {
#define PG8_LAS __attribute__((address_space(3)))
typedef unsigned short bf16_t;
typedef short bf16x8 __attribute__((ext_vector_type(8)));
typedef float f32x4 __attribute__((ext_vector_type(4)));
typedef float f32x2 __attribute__((ext_vector_type(2)));
typedef unsigned u32x4 __attribute__((ext_vector_type(4)));
#define PG8_G(T_, p_) ((__attribute__((address_space(1))) T_*)(p_))
#define PG8_GC(T_, p_) ((const __attribute__((address_space(1))) T_*)(p_))
constexpr int BM = 256, BK = 64, HALF = 128, HTB = HALF * BK * 2  , STAGE_BYTES = 8 * HTB, NXCD = 8, WGM = 8;

__host__ __device__ __forceinline__ int lds_byte(int r, int c) { const int st = (r >> 4) * 2 + (c >> 5), rr = r & 15, cc = c & 31, ob = rr * 64 + cc * 2; return st * 1024 + (ob ^ (((ob >> 9) & 1) << 5)); }
__host__ __device__ __forceinline__ void stage_rc(int b, int& R, int& C) { const int st = b / 1024, sb = b % 1024, swz = sb ^ (((sb >> 9) & 1) << 5); R = (st >> 1) * 16 + swz / 64; C = (st & 1) * 32 + (swz % 64) / 2; }
__host__ __device__ __forceinline__ int perm32(int rho) { const int n = rho >> 4, i = rho & 15; return 8 * (i >> 2) + 4 * n + (i & 3); }

struct Unit { const char* a; const char* b; int pm, pn, x0, x1, full, hb; };
struct Gemm { int lda, ldb, K; int tag = 0; };

__device__ __forceinline__ unsigned gload_hidden(const void* p) { unsigned r; asm volatile("global_load_dword %0, %1, off" : "=v"(r) : "v"(p) : "memory"); return r; }
__device__ __forceinline__ unsigned gatomic_inc_hidden(const void* p) { unsigned r; const unsigned one = 1u; asm volatile("global_atomic_add %0, %1, %2, off sc0" : "=v"(r) : "v"(p), "v"(one) : "memory"); return r; }
__device__ __forceinline__ unsigned cvt_pk_bf16(float lo, float hi) { unsigned r; asm volatile("v_cvt_pk_bf16_f32 %0, %1, %2" : "=v"(r) : "v"(lo), "v"(hi)); return r; }


struct EpiBf16 {
    static constexpr bool PERM = true, AFTER_DRAIN = false, PREFETCH = false;
    bf16_t* O; int ldc; int split_cols; size_t split_stride; float scale0;
    __device__ __forceinline__ void operator()(const f32x4 (&acc)[2][2][4][2], const Unit& u, int wr, int wc, int fr, int fq) const {
        const int row0 = u.pm * BM + wr * 64 + fr; int colt = u.pn * BM; bf16_t* base = O;
        float sc = 1.f; if (split_cols) { const int t = colt / split_cols; base += (size_t)t * split_stride; colt -= t * split_cols; if (t == 0) sc = scale0; }
        const int col0 = colt + wc * 32 + 8 * fq;
#pragma unroll
        for (int ai = 0; ai < 2; ++ai)
#pragma unroll
            for (int m = 0; m < 4; ++m) { bf16_t* rowp = base + (size_t)(row0 + ai * HALF + m * 16) * ldc + col0;
#pragma unroll
                for (int bj = 0; bj < 2; ++bj) { f32x4 v0 = acc[ai][bj][m][0] * sc, v1 = acc[ai][bj][m][1] * sc;
                    u32x4 w; w.x = cvt_pk_bf16(v0[0], v0[1]); w.y = cvt_pk_bf16(v0[2], v0[3]); w.z = cvt_pk_bf16(v1[0], v1[1]); w.w = cvt_pk_bf16(v1[2], v1[3]);
                    *PG8_G(u32x4, rowp + bj * HALF) = w; } }
    }
};
struct EpiQKV {
    static constexpr bool PERM = true, AFTER_DRAIN = false, PREFETCH = false;
    bf16_t* O; size_t stride; float scale0; unsigned* qkm;
    __device__ __forceinline__ void operator()(const f32x4 (&acc)[2][2][4][2], const Unit& u, int wr, int wc, int fr, int fq) const {
        const int t = u.pn >> 2, colt = (u.pn & 3) * BM, b = u.pm >> 4; bf16_t* base = O + (size_t)t * stride;
        const float sc = (t == 0) ? scale0 : 1.f;
        const int row0 = u.pm * BM + wr * 64 + fr, col0 = colt + wc * 32 + 8 * fq, lane = fr + 16 * fq;
        float mx0 = 0.f, mx1 = 0.f;
#pragma unroll
        for (int ai = 0; ai < 2; ++ai)
#pragma unroll
            for (int m = 0; m < 4; ++m) { bf16_t* rowp = base + (size_t)(row0 + ai * HALF + m * 16) * 1024 + col0;
#pragma unroll
                for (int bj = 0; bj < 2; ++bj) { const f32x4 v0 = acc[ai][bj][m][0] * sc, v1 = acc[ai][bj][m][1] * sc;
                    u32x4 w; w.x = cvt_pk_bf16(v0[0], v0[1]); w.y = cvt_pk_bf16(v0[2], v0[3]); w.z = cvt_pk_bf16(v1[0], v1[1]); w.w = cvt_pk_bf16(v1[2], v1[3]);
                    *PG8_G(u32x4, rowp + bj * HALF) = w;
                    if (t < 2) { float ss = (v0[0] * v0[0] + v0[1] * v0[1]) + (v0[2] * v0[2] + v0[3] * v0[3]) + (v1[0] * v1[0] + v1[1] * v1[1]) + (v1[2] * v1[2] + v1[3] * v1[3]);
                        { auto p16 = __builtin_amdgcn_permlane16_swap(__float_as_uint(ss), __float_as_uint(ss), false, false); ss = __uint_as_float(p16[0]) + __uint_as_float(p16[1]);
                          auto p32 = __builtin_amdgcn_permlane32_swap(__float_as_uint(ss), __float_as_uint(ss), false, false); ss = __uint_as_float(p32[0]) + __uint_as_float(p32[1]); }
                        if (bj == 0) mx0 = fmaxf(mx0, ss); else mx1 = fmaxf(mx1, ss); } } }
        if (t < 2) {
#pragma unroll
            for (int o = 1; o < 16; o <<= 1) { mx0 = fmaxf(mx0, __int_as_float(__builtin_amdgcn_ds_bpermute((lane ^ o) << 2, __float_as_int(mx0)))); mx1 = fmaxf(mx1, __int_as_float(__builtin_amdgcn_ds_bpermute((lane ^ o) << 2, __float_as_int(mx1)))); }
            if (lane == 0) { unsigned* w = qkm + (t * 8 + b) * 32 + (u.pn & 3) * 8 + wc; atomicMax(w, __float_as_uint(mx0)); atomicMax(w + 4, __float_as_uint(mx1)); } }
    }
};
struct EpiResid {
    static constexpr bool PERM = false, AFTER_DRAIN = false, PREFETCH = false;
    const float* base; float* out; const float* gate;
    __device__ __forceinline__ void operator()(const f32x4 (&acc)[2][2][4][2], const Unit& u, int wr, int wc, int fr, int fq) const {
        const int col0 = u.pn * BM + wc * 32 + 4 * fq; const int b = u.pm >> 4;
        f32x4 gv[2][2];
#pragma unroll
        for (int bj = 0; bj < 2; ++bj)
#pragma unroll
            for (int n = 0; n < 2; ++n) gv[bj][n] = *PG8_GC(f32x4, gate + (size_t)b * 6144 + col0 + bj * HALF + n * 16);
#pragma unroll
        for (int ai = 0; ai < 2; ++ai)
#pragma unroll
            for (int m = 0; m < 4; ++m) { const size_t off = (size_t)(u.pm * BM + ai * HALF + wr * 64 + m * 16 + fr) * 1024 + col0;
#pragma unroll
                for (int bj = 0; bj < 2; ++bj)
#pragma unroll
                    for (int n = 0; n < 2; ++n) { const f32x4 bs = *PG8_GC(f32x4, base + off + bj * HALF + n * 16); *PG8_G(f32x4, out + off + bj * HALF + n * 16) = bs + gv[bj][n] * acc[ai][bj][m][n]; }
                if (m & 1) asm volatile("" ::: "memory"); }
    }
};
struct EpiResidB {
    static constexpr bool PERM = true, AFTER_DRAIN = false, PREFETCH = false;
    const float* base; bf16_t* out; const float* gate;
    __device__ __forceinline__ void operator()(const f32x4 (&acc)[2][2][4][2], const Unit& u, int wr, int wc, int fr, int fq) const {
        const int col0 = u.pn * BM + wc * 32 + 8 * fq; const int b = u.pm >> 4;
        f32x4 gv[2][2];
#pragma unroll
        for (int bj = 0; bj < 2; ++bj)
#pragma unroll
            for (int n = 0; n < 2; ++n) gv[bj][n] = *PG8_GC(f32x4, gate + (size_t)b * 6144 + col0 + bj * HALF + n * 4);
#pragma unroll
        for (int ai = 0; ai < 2; ++ai)
#pragma unroll
            for (int m = 0; m < 4; ++m) { const size_t off = (size_t)(u.pm * BM + ai * HALF + wr * 64 + m * 16 + fr) * 1024 + col0;
#pragma unroll
                for (int bj = 0; bj < 2; ++bj) { const f32x4 b0 = *PG8_GC(f32x4, base + off + bj * HALF), b1 = *PG8_GC(f32x4, base + off + bj * HALF + 4);
                    const f32x4 v0 = b0 + gv[bj][0] * acc[ai][bj][m][0], v1 = b1 + gv[bj][1] * acc[ai][bj][m][1];
                    u32x4 w; w.x = cvt_pk_bf16(v0[0], v0[1]); w.y = cvt_pk_bf16(v0[2], v0[3]); w.z = cvt_pk_bf16(v1[0], v1[1]); w.w = cvt_pk_bf16(v1[2], v1[3]);
                    *PG8_G(u32x4, out + off + bj * HALF) = w; }
                if (m & 1) asm volatile("" ::: "memory"); }
    }
};
struct EpiPool {
    static constexpr bool PERM = false, AFTER_DRAIN = false, PREFETCH = false;
    float* xr; const float* gate; const float* pscale;
    __device__ __forceinline__ void operator()(const f32x4 (&acc)[2][2][4][2], const Unit& u, int wr, int wc, int fr, int fq) const {
        const int col0 = u.pn * BM + wc * 32 + 4 * fq; const int b = u.pm >> 4;
        float* rbase = xr + (size_t)(u.pm * BM + wr * 64 + fr) * 1024 + col0;
#pragma unroll
        for (int bj = 0; bj < 2; ++bj)
#pragma unroll
            for (int n = 0; n < 2; ++n) { const f32x4 gv = *(const f32x4*)(gate + (size_t)b * 6144 + col0 + bj * HALF + n * 16) * *(const f32x4*)(pscale + col0 + bj * HALF + n * 16);
#pragma unroll
                for (int ai = 0; ai < 2; ++ai)
#pragma unroll
                    for (int m = 0; m < 4; ++m) { float* p = rbase + (size_t)(ai * HALF + m * 16) * 1024 + bj * HALF + n * 16; const f32x4 bs = *(const f32x4*)p; *(f32x4*)p = bs + gv * acc[ai][bj][m][n]; }
                asm volatile("" ::: "memory"); }
    }
};
__device__ __forceinline__ float silu_mul(float g, float u) { return g * u * __builtin_amdgcn_rcpf(1.0f + __builtin_amdgcn_exp2f(-1.4426950408889634f * g)); }
struct EpiUp {
    static constexpr bool PERM = true, AFTER_DRAIN = false, PREFETCH = false;
    bf16_t* H;
    __device__ __forceinline__ void operator()(const f32x4 (&acc)[2][2][4][2], const Unit& u, int wr, int wc, int fr, int fq) const {
        const int row0 = u.x1 + wr * 64 + fr, col0 = u.x0 * 128 + wc * 32 + 8 * fq;
#pragma unroll
        for (int ai = 0; ai < 2; ++ai) if (ai == 0 || u.full)
#pragma unroll
            for (int m = 0; m < 4; ++m) { bf16_t* rowp = H + (size_t)(row0 + ai * HALF + m * 16) * 512 + col0;
                const f32x4 g0 = acc[ai][0][m][0], g1 = acc[ai][0][m][1], u0 = acc[ai][1][m][0], u1 = acc[ai][1][m][1];
                u32x4 w; w.x = cvt_pk_bf16(silu_mul(g0[0], u0[0]), silu_mul(g0[1], u0[1])); w.y = cvt_pk_bf16(silu_mul(g0[2], u0[2]), silu_mul(g0[3], u0[3]));
                w.z = cvt_pk_bf16(silu_mul(g1[0], u1[0]), silu_mul(g1[1], u1[1])); w.w = cvt_pk_bf16(silu_mul(g1[2], u1[2]), silu_mul(g1[3], u1[3]));
                *PG8_G(u32x4, rowp) = w; }
    }
};
struct EpiDown {
    static constexpr bool PERM = true, AFTER_DRAIN = false, PREFETCH = true;
    bf16_t* Y; const int* tok; const float* gw;
    __device__ __forceinline__ void prefetch(const Unit& u, int wr, int fr, unsigned (&pre)[8]) const {
#pragma unroll
        for (int ai = 0; ai < 2; ++ai)
#pragma unroll
            for (int m = 0; m < 4; ++m) { const int rl = ai * HALF + wr * 64 + m * 16 + fr; pre[ai * 4 + m] = gload_hidden(gw + u.x0 + (rl < u.x1 ? rl : 0)); }
    }
    __device__ __forceinline__ void operator()(const f32x4 (&acc)[2][2][4][2], const Unit& u, int wr, int wc, int fr, int fq, unsigned (&pre)[8]) const {
        const int col0 = u.pn * BM + wc * 32 + 8 * fq;
        asm volatile("" : "+v"(pre[0]), "+v"(pre[1]), "+v"(pre[2]), "+v"(pre[3]), "+v"(pre[4]), "+v"(pre[5]), "+v"(pre[6]), "+v"(pre[7]));
#pragma unroll
        for (int ai = 0; ai < 2; ++ai)
#pragma unroll
            for (int m = 0; m < 4; ++m) { const int rl = ai * HALF + wr * 64 + m * 16 + fr;
                if (rl < u.x1) { const unsigned pw = pre[ai * 4 + m]; const float w8 = (float)(pw & 0xffffu) * (1.0f / 65535.0f); bf16_t* rowp = Y + (size_t)(pw >> 16) * 1024 + col0;
#pragma unroll
                    for (int bj = 0; bj < 2; ++bj) { const f32x4 v0 = acc[ai][bj][m][0] * w8, v1 = acc[ai][bj][m][1] * w8;
                        u32x4 w; w.x = cvt_pk_bf16(v0[0], v0[1]); w.y = cvt_pk_bf16(v0[2], v0[3]); w.z = cvt_pk_bf16(v1[0], v1[1]); w.w = cvt_pk_bf16(v1[2], v1[3]);
                        *PG8_G(u32x4, rowp + bj * HALF) = w; } } }
    }
};

#ifdef GPROBE
__device__ unsigned long long gprobe_acc[4];
#define GP_T(x) const unsigned long long x = __builtin_amdgcn_s_memrealtime()
#else
#define GP_T(x) do {} while (0)
#endif
template <class Epi, class Sched, bool ALIGN_EPI, bool GATHER = false>
__device__ __forceinline__ void gemm_phase(PG8_LAS unsigned char* lds, const Gemm g, const Sched& S, const Epi& E, int wave0) {
    int tid_ = opaque_tid(wave0);
    const int tid = tid_, wid = __builtin_amdgcn_readfirstlane(tid >> 6), lane = tid & 63, wr = wid >> 2, wc = wid & 3, fr = lane & 15, fq = lane >> 4;
    const int K = g.K, nt = K / BK;
    unsigned voffA[2], voffA1[2], voffB[2], nv0[2], nv1[2];
#pragma unroll
    for (int i = 0; i < 2; ++i) { int R, C; stage_rc(tid * 16 + i * 8192, R, C); const int Rb = Epi::PERM ? ((R & ~31) + perm32(R & 31)) : R;
        voffA[i] = (unsigned)(R * g.lda + C) * 2u; voffB[i] = (unsigned)(Rb * g.ldb + C) * 2u; voffA1[i] = 0u; nv0[i] = 0u; nv1[i] = 0u; }
    unsigned (&vA1)[2] = GATHER ? voffA1 : voffA;
#define PG8_ROWOFFS(u_, o0, o1) do { _Pragma("unroll") for (int i = 0; i < 2; ++i) { int R, C; stage_rc(tid * 16 + i * 8192, R, C); o0[i] = S.row_off(u_, R) + (unsigned)C * 2u; o1[i] = S.row_off(u_, HALF + R) + (unsigned)C * 2u; } } while (0)
    const size_t kstep = (size_t)(BK * 2);
    const size_t hstepA = GATHER ? (size_t)0 : (size_t)HALF * g.lda * 2, hstepB = (size_t)HALF * g.ldb * 2;
    const unsigned ldsw = (unsigned)wid * 1024u;
    const int aoff = lds_byte(wr * 64 + fr, fq * 8), boff = lds_byte(wc * 32 + fr, fq * 8);
#define PG8_SA(b, h) (((b) * 2 + (h)) * HTB)
#define PG8_SB(b, h) ((4 + (b) * 2 + (h)) * HTB)
#define PG8_STAGE(bufoff, gbase, voff) do { _Pragma("unroll") for (int _i = 0; _i < 2; ++_i) \
        __builtin_amdgcn_global_load_lds((const unsigned*)((const char*)(gbase) + (voff)[_i]), (PG8_LAS unsigned*)(lds + (bufoff) + ldsw + _i * 8192), 16, 0, 0); } while (0)
#define PG8_LDA(dst, b, h) do { _Pragma("unroll") for (int m = 0; m < 4; ++m) _Pragma("unroll") for (int k = 0; k < 2; ++k) dst[m][k] = *(const PG8_LAS bf16x8*)(lds + PG8_SA(b, h) + aoff + m * 2048 + k * 1024); } while (0)
#define PG8_LDB(dst, b, h) do { _Pragma("unroll") for (int n = 0; n < 2; ++n) _Pragma("unroll") for (int k = 0; k < 2; ++k) dst[n][k] = *(const PG8_LAS bf16x8*)(lds + PG8_SB(b, h) + boff + n * 2048 + k * 1024); } while (0)
#define PG8_MMA(ai, bj, At, Bt) do { __builtin_amdgcn_s_setprio(1); _Pragma("unroll") for (int m = 0; m < 4; ++m) _Pragma("unroll") for (int n = 0; n < 2; ++n) _Pragma("unroll") for (int k = 0; k < 2; ++k) \
        acc[ai][bj][m][n] = __builtin_amdgcn_mfma_f32_16x16x32_bf16(Bt[n][k], At[m][k], acc[ai][bj][m][n], 0, 0, 0); __builtin_amdgcn_s_setprio(0); } while (0)
#define PG8_WAIT_V(n) asm volatile("s_waitcnt vmcnt(" #n ")" ::: "memory")
#define PG8_WAIT_L(n) asm volatile("s_waitcnt lgkmcnt(" #n ")" ::: "memory")
#define PG8_BAR __builtin_amdgcn_s_barrier()
#define PG8_SCHED __builtin_amdgcn_sched_barrier(0)
    Unit cur, nxt; int ui = 0;
#ifdef GPROBE
    const unsigned long long gp_entry = __builtin_amdgcn_s_memrealtime();
#endif
    if constexpr (Sched::DYN) { if (!S.unit_of(S.mbox(0), cur)) return; } else { if (!S.next(0, cur)) return; }
    f32x4 acc[2][2][4][2];
#pragma unroll
    for (int a = 0; a < 2; ++a)
#pragma unroll
        for (int b = 0; b < 2; ++b)
#pragma unroll
            for (int m = 0; m < 4; ++m)
#pragma unroll
                for (int n = 0; n < 2; ++n) acc[a][b][m][n] = (f32x4){0.f, 0.f, 0.f, 0.f};
    bf16x8 At[4][2], B0[2][2], B1[2][2];
    unsigned pre[8];
#pragma unroll
    for (int i = 0; i < 8; ++i) pre[i] = 0u;
    const char* cA = cur.a; const char* cB = cur.b;
    if constexpr (GATHER) PG8_ROWOFFS(cur, voffA, voffA1);
    PG8_STAGE(PG8_SB(0, 0), cB, voffB); PG8_STAGE(PG8_SB(0, 1), cB + hstepB, voffB); PG8_STAGE(PG8_SA(0, 0), cA, voffA); PG8_STAGE(PG8_SA(0, 1), cA + hstepA, vA1);
    if (wr == 1) PG8_BAR;
    PG8_WAIT_V(2); PG8_BAR;
    PG8_STAGE(PG8_SB(1, 0), cB + kstep, voffB); PG8_STAGE(PG8_SA(1, 0), cA + kstep, voffA); PG8_STAGE(PG8_SB(1, 1), cB + hstepB + kstep, voffB);
    PG8_WAIT_V(6); PG8_BAR;
#ifdef GPROBE
    unsigned long long gp_k = 0ull, gp_e = 0ull, gp_o = 0ull; unsigned long long gp_prev = __builtin_amdgcn_s_memrealtime();
#endif
    for (;;) {
        GP_T(gp_t0);
        bool has_next_;
        if constexpr (Sched::DYN) has_next_ = S.unit_of(S.mbox((ui + 1) & 1), nxt); else has_next_ = S.next(ui + 1, nxt);
        const bool has_next = has_next_;
        unsigned kq = 0u;
        if constexpr (Sched::DYN) { if (has_next && tid == 0) kq = gatomic_inc_hidden((const void*)S.ctr); }
        const char* nA = has_next ? nxt.a : cA; const char* nB = has_next ? nxt.b : cB;
        if constexpr (GATHER) { if (has_next) { _Pragma("unroll") for (int i = 0; i < 2; ++i) { int R, C; stage_rc(tid * 16 + i * 8192, R, C); nv0[i] = gload_hidden(S.tok_addr(nxt, R)); nv1[i] = gload_hidden(S.tok_addr(nxt, HALF + R)); } } }
        const bool full = cur.full != 0;
        for (int t = 0; t < nt; t += 2) {
            const bool last = (t == nt - 2);
            const char* a1 = cA + (size_t)(t + 1) * kstep;
            const char* a2 = last ? nA : cA + (size_t)(t + 2) * kstep; const char* b2 = last ? nB : cB + (size_t)(t + 2) * kstep;
            const char* a3 = a2 + kstep; const char* b3 = b2 + kstep;
            PG8_LDB(B0, 0, 0); PG8_LDB(B1, 0, 1); PG8_SCHED; PG8_LDA(At, 0, 0); PG8_STAGE(PG8_SA(1, 1), a1 + hstepA, vA1);
            if constexpr (GATHER) { if (last && has_next) {
                asm volatile("" : "+v"(nv0[0]), "+v"(nv0[1]), "+v"(nv1[0]), "+v"(nv1[1]));
                _Pragma("unroll") for (int i = 0; i < 2; ++i) { int R, C; stage_rc(tid * 16 + i * 8192, R, C); voffA[i] = S.off_of(nv0[i]) + (unsigned)C * 2u; voffA1[i] = S.off_of(nv1[i]) + (unsigned)C * 2u; } } }
            if constexpr (Sched::DYN) { if (last && has_next) { asm volatile("" : "+v"(kq)); if (tid == 0) S.mbox_set(ui & 1, kq); } }
            PG8_WAIT_V(8); PG8_WAIT_L(0); PG8_BAR; if constexpr (Epi::PREFETCH) { if (last) E.prefetch(cur, wr, fr, pre); } PG8_MMA(0, 0, At, B0); PG8_MMA(0, 1, At, B1); PG8_BAR; PG8_SCHED;
            if (full) { PG8_LDA(At, 0, 1); } PG8_STAGE(PG8_SB(0, 0), b2, voffB); PG8_STAGE(PG8_SB(0, 1), b2 + hstepB, voffB); PG8_STAGE(PG8_SA(0, 0), a2, voffA);
            PG8_WAIT_V(8); PG8_WAIT_L(0); PG8_BAR; if (full) { PG8_MMA(1, 0, At, B0); PG8_MMA(1, 1, At, B1); } PG8_BAR; PG8_SCHED;
            PG8_LDB(B0, 1, 0); PG8_LDB(B1, 1, 1); PG8_SCHED; PG8_LDA(At, 1, 0); PG8_STAGE(PG8_SA(0, 1), a2 + hstepA, vA1);
            PG8_WAIT_V(8); PG8_WAIT_L(0); PG8_BAR; PG8_MMA(0, 0, At, B0); PG8_MMA(0, 1, At, B1); PG8_BAR; PG8_SCHED;
            if (full) { PG8_LDA(At, 1, 1); } PG8_STAGE(PG8_SB(1, 0), b3, voffB); PG8_STAGE(PG8_SB(1, 1), b3 + hstepB, voffB); PG8_STAGE(PG8_SA(1, 0), a3, voffA);
            PG8_WAIT_V(8); PG8_WAIT_L(0); PG8_BAR; if (full) { PG8_MMA(1, 0, At, B0); PG8_MMA(1, 1, At, B1); } PG8_BAR; PG8_SCHED;
        }
        GP_T(gp_t1);
        if constexpr (ALIGN_EPI) { if (wr == 0) PG8_BAR; }
        if constexpr (Epi::PREFETCH) E(acc, cur, wr, wc, fr, fq, pre); else E(acc, cur, wr, wc, fr, fq);
        GP_T(gp_t2);
#ifdef GPROBE
        gp_k += gp_t1 - gp_t0; gp_e += gp_t2 - gp_t1; gp_o += gp_t0 - gp_prev; gp_prev = gp_t2;
        if (!has_next) { if (g.tag == GPROBE_TAG && tid == 0) { const unsigned long long busy = gp_t2 - gp_entry; atomicMax(&gprobe_acc[0], busy); atomicAdd(&gprobe_acc[1], busy); atomicMax(&gprobe_acc[2], gp_k); atomicAdd(&gprobe_acc[3], gp_k); } }
#endif
        if (!has_next) break;
#pragma unroll
        for (int a = 0; a < 2; ++a)
#pragma unroll
            for (int b = 0; b < 2; ++b)
#pragma unroll
                for (int m = 0; m < 4; ++m)
#pragma unroll
                    for (int n = 0; n < 2; ++n) acc[a][b][m][n] = (f32x4){0.f, 0.f, 0.f, 0.f};
        cur = nxt; cA = nA; cB = nB; ++ui;
        if constexpr (ALIGN_EPI) { if (wr == 1) PG8_BAR; }
    }
    PG8_WAIT_V(0);
    if constexpr (!ALIGN_EPI) { if (wr == 0) PG8_BAR; }
    PG8_BAR;
#undef PG8_SA
#undef PG8_ROWOFFS
#undef PG8_SB
#undef PG8_STAGE
#undef PG8_LDA
#undef PG8_LDB
#undef PG8_MMA
#undef PG8_WAIT_V
#undef PG8_WAIT_L
#undef PG8_BAR
#undef PG8_SCHED
}
}
namespace attn_body {
using bf16=__hip_bfloat16;
using bf16x8=__attribute__((ext_vector_type(8)))short;
using s16x4=__attribute__((ext_vector_type(4)))short;
using f32x16=__attribute__((ext_vector_type(16)))float;
using f32x4=__attribute__((ext_vector_type(4)))float;
using u32x4=__attribute__((ext_vector_type(4)))unsigned;
constexpr int BATCH=8,NHEAD=16,SEQ=4096,D=64,DM=NHEAD*D;
constexpr int NW=8,QBLK=32,QB=QBLK*NW,KVBLK=64,NQB=SEQ/QB;
constexpr int ATTN_PITCH=DM, ATTN_UNIT_ROWS=QB;
__device__ __forceinline__ int crow(int r,int hi){return (r&3)+8*(r>>2)+4*hi;}
#define SBAR() __builtin_amdgcn_sched_barrier(0)
__device__ __forceinline__ void cmask(f32x16&p0,f32x16&p1,int jb,int qrel,int hi){
  const float NEG=-INFINITY; int kb=64*jb+4*hi;
  #pragma unroll
  for(int r=0;r<16;++r){int kv=kb+(r&3)+8*(r>>2); if(kv>qrel)p0[r]=NEG; if(kv+32>qrel)p1[r]=NEG;}
}

constexpr int NSLOT=3, SLOTB=8192;
constexpr int LDS_K=0, LDS_V=NSLOT*SLOTB, LDS_WS=2*NSLOT*SLOTB, LDS_OST=LDS_WS+NW*64*4, LDS_FS=LDS_OST+NW*4096, LDS_WT=LDS_FS+SEQ*4, LDS_BYTES=LDS_WT+128;
constexpr float C2=0.125f*1.4426950408889634f;
constexpr float LOG2E=1.4426950408889634f;
__device__ __forceinline__ void glds16(const void*gsrc,unsigned lds_dst){unsigned keep;
  asm volatile("s_mov_b32 %0, m0\n\ts_mov_b32 m0, %2\n\ts_nop 0\n\tglobal_load_lds_dwordx4 %1, off\n\ts_mov_b32 m0, %0":"=&s"(keep):"v"(gsrc),"s"(lds_dst):"memory");}
__device__ __forceinline__ void glds16s(const void*sbase,unsigned voff,unsigned lds_dst){unsigned keep;
  asm volatile("s_mov_b32 %0, m0\n\ts_mov_b32 m0, %3\n\ts_nop 4\n\tglobal_load_lds_dwordx4 %1, %2\n\ts_mov_b32 m0, %0":"=&s"(keep):"v"(voff),"s"(sbase),"s"(lds_dst):"memory");}
__device__ __forceinline__ float max3f(float a,float b,float c){float r;asm("v_max3_f32 %0, %1, %2, %3":"=v"(r):"v"(a),"v"(b),"v"(c));return r;}
__device__ __forceinline__ float max2f(float a,float b){float r;asm("v_max_f32_e32 %0, %1, %2":"=v"(r):"v"(a),"v"(b));return r;}
__device__ __forceinline__ float fadd_s(float a,float b){float r;asm("v_add_f32_e32 %0, %1, %2":"=v"(r):"v"(a),"v"(b));return r;}
__device__ __forceinline__ float fsub_s(float a,float b){float r;asm("v_sub_f32_e32 %0, %1, %2":"=v"(r):"v"(a),"v"(b));return r;}
typedef float f32x2_t __attribute__((ext_vector_type(2))); typedef __bf16 bf16x2_t __attribute__((ext_vector_type(2)));
__device__ __forceinline__ unsigned cvtpk_s(float lo,float hi){f32x2_t v={lo,hi};bf16x2_t b=__builtin_convertvector(v,bf16x2_t);return __builtin_bit_cast(unsigned,b);}
#define WAIT_BAR(N) asm volatile("s_waitcnt vmcnt(" #N ") lgkmcnt(0)\n\ts_barrier":::"memory")

typedef __attribute__((address_space(3))) const char* lds_cptr;
typedef short v4i16_t __attribute__((ext_vector_type(4)));
__device__ __forceinline__ void fbias(f32x16&c0,f32x16&c1,lds_cptr ft,float nm,int hi){
  #pragma unroll
  for(int g=0;g<4;++g){
    const f32x4 a=*(const __attribute__((address_space(3))) f32x4*)(ft+(8*g+4*hi)*4);
    const f32x4 b=*(const __attribute__((address_space(3))) f32x4*)(ft+(32+8*g+4*hi)*4);
    c0[4*g+0]=nm-a[0];c0[4*g+1]=nm-a[1];c0[4*g+2]=nm-a[2];c0[4*g+3]=nm-a[3];
    c1[4*g+0]=nm-b[0];c1[4*g+1]=nm-b[1];c1[4*g+2]=nm-b[2];c1[4*g+3]=nm-b[3];}
}
__device__ __forceinline__ void qkt(f32x16&p0,f32x16&p1,const char*Kslot,const bf16x8*qr,int r32,int hi){
  const char*kb=Kslot+hi*1024+r32*16;
  #pragma unroll
  for(int d0=0;d0<4;++d0){
    const bf16x8 b0=*reinterpret_cast<const bf16x8*>(kb+d0*2048);
    const bf16x8 b1=*reinterpret_cast<const bf16x8*>(kb+d0*2048+512);
    p0=__builtin_amdgcn_mfma_f32_32x32x16_bf16(b0,qr[d0],p0,0,0,0);p1=__builtin_amdgcn_mfma_f32_32x32x16_bf16(b1,qr[d0],p1,0,0,0);}
}
__device__ __forceinline__ void kload8(bf16x8*kf,lds_cptr kp){
  kf[0]=*(const __attribute__((address_space(3))) bf16x8*)(kp);      kf[1]=*(const __attribute__((address_space(3))) bf16x8*)(kp+512);
  kf[2]=*(const __attribute__((address_space(3))) bf16x8*)(kp+2048); kf[3]=*(const __attribute__((address_space(3))) bf16x8*)(kp+2560);
  kf[4]=*(const __attribute__((address_space(3))) bf16x8*)(kp+4096); kf[5]=*(const __attribute__((address_space(3))) bf16x8*)(kp+4608);
  kf[6]=*(const __attribute__((address_space(3))) bf16x8*)(kp+6144); kf[7]=*(const __attribute__((address_space(3))) bf16x8*)(kp+6656);
}
__device__ __forceinline__ void kload2(bf16x8*kf,lds_cptr kp,int j){ kf[2*j]=*(const __attribute__((address_space(3))) bf16x8*)(kp+j*2048); kf[2*j+1]=*(const __attribute__((address_space(3))) bf16x8*)(kp+j*2048+512); }
__device__ __forceinline__ s16x4 vtr(lds_cptr p){ return __builtin_bit_cast(s16x4,__builtin_amdgcn_ds_read_tr16_b64_v4i16((__attribute__((address_space(3))) v4i16_t*)p)); }
__device__ __forceinline__ float rowmax(const f32x16&p0,const f32x16&p1){
  float a=max3f(p0[0],p0[1],p1[0]),b=max3f(p0[2],p0[3],p1[1]);a=max3f(a,p1[2],p1[3]);
  #pragma unroll
  for(int r=4;r<16;r+=4){a=max3f(a,p0[r],p0[r+1]);b=max3f(b,p0[r+2],p0[r+3]);a=max3f(a,p1[r],p1[r+1]);b=max3f(b,p1[r+2],p1[r+3]);}
  const float m=max2f(a,b);
  auto rr=__builtin_amdgcn_permlane32_swap(__float_as_uint(m),__float_as_uint(m),false,false);
  return max2f(__uint_as_float(rr[0]),__uint_as_float(rr[1]));
}
__device__ __forceinline__ void pv(f32x16*o,int vb,bf16x8 pa0,bf16x8 pa1,bf16x8 pa2,bf16x8 pa3){
  #pragma unroll
  for(int d0=0;d0<2;++d0){s16x4 lo[4],hi[4];
    #pragma unroll
    for(int ks=0;ks<4;++ks){
      asm volatile("ds_read_b64_tr_b16 %0,%1 offset:%c2":"=&v"(lo[ks]):"v"(vb),"i"(d0*4096+ks*1024):"memory");
      asm volatile("ds_read_b64_tr_b16 %0,%1 offset:%c2":"=&v"(hi[ks]):"v"(vb),"i"(d0*4096+ks*1024+512):"memory");}
    asm volatile("s_waitcnt lgkmcnt(0)":::"memory");SBAR();
    #define PK(k) (bf16x8){lo[k][0],lo[k][1],lo[k][2],lo[k][3],hi[k][0],hi[k][1],hi[k][2],hi[k][3]}
    o[d0]=__builtin_amdgcn_mfma_f32_32x32x16_bf16(pa0,PK(0),o[d0],0,0,0);
    o[d0]=__builtin_amdgcn_mfma_f32_32x32x16_bf16(pa1,PK(1),o[d0],0,0,0);
    o[d0]=__builtin_amdgcn_mfma_f32_32x32x16_bf16(pa2,PK(2),o[d0],0,0,0);
    o[d0]=__builtin_amdgcn_mfma_f32_32x32x16_bf16(pa3,PK(3),o[d0],0,0,0);
    #undef PK
  }
}

#ifndef ATTN_STORE16
#define ATTN_STORE16(p,v) (*(__attribute__((address_space(1))) u32x4*)(p)=(v))
#endif
template<int THRL> __device__ __forceinline__ void attn_unit(int b,int h,int qb,const bf16*Q,const bf16*__restrict__ K,const bf16*__restrict__ V,bf16*O,const float*LF,char*shm,int wave0){
  int tid_=opaque_tid(wave0);
  const int tid=tid_,lane=tid&63,r32=lane&31,hi=lane>>5; const int wid=__builtin_amdgcn_readfirstlane(tid>>6);
  const long rowbase=(long)b*SEQ; const int q0=qb*QB;
  const bf16*Qw=Q+(rowbase+q0+wid*QBLK)*DM+h*D;
  const bf16*Kh=K+rowbase*DM+h*D,*Vh=V+rowbase*DM+h*D;
  const unsigned lds0=(unsigned)(uintptr_t)shm;
  float*wsf=(float*)(shm+LDS_WS)+wid*64;
  const lds_cptr shm3=(lds_cptr)shm;
  { const int n=q0+QB; const float*lf=LF+((long)b*NHEAD+h)*SEQ;
    unsigned wtb_=(unsigned)(uintptr_t)(shm3+LDS_WT); asm volatile("":"+v"(wtb_));
    volatile __attribute__((address_space(3))) float*wt=(volatile __attribute__((address_space(3))) float*)wtb_;
    f32x4 v0=(f32x4){0.f,0.f,0.f,0.f},v1=(f32x4){0.f,0.f,0.f,0.f};
    if(8*tid<n){v0=*(const f32x4*)(lf+8*tid);v1=*(const f32x4*)(lf+8*tid+4);}
    v0[1]+=v0[0];v0[2]+=v0[1];v0[3]+=v0[2];v1[0]+=v0[3];v1[1]+=v1[0];v1[2]+=v1[1];v1[3]+=v1[2];
    const float tot=v1[3]; float inc=tot;
    #pragma unroll
    for(int o_=1;o_<64;o_<<=1){const float t_=__int_as_float(__builtin_amdgcn_ds_bpermute((lane-o_)<<2,__float_as_int(inc)));if(lane>=o_)inc+=t_;}
    if(lane==63)wt[wid]=inc;
    __syncthreads();
    float base=inc-tot;
    #pragma unroll
    for(int w_=0;w_<NW;++w_){const float x_=wt[w_]; if(w_<wid)base+=x_;}
    if(tid==(q0>>3))wt[8]=base+v0[0];
    __syncthreads();
    const float anc=wt[8];
    if(8*tid<n){ __attribute__((address_space(3))) f32x4*fo=(__attribute__((address_space(3))) f32x4*)(shm3+LDS_FS)+2*tid;
      fo[0]=(v0+(base-anc))*LOG2E; fo[1]=(v1+(base-anc))*LOG2E; }
  }
  const lds_cptr fs3=shm3+LDS_FS;
  const bf16*ksrc=Kh+(long)lane*DM+wid*8;
  const bf16*vsrc=Vh+(long)(16*(wid&3)+(lane>>2))*DM+(wid>>2)*32+(lane&3)*8;
  const unsigned kdst=lds0+LDS_K+wid*1024, vdst=lds0+LDS_V+wid*1024;
  #define DMA_K(t,slot) glds16(ksrc+(long)(t)*KVBLK*DM,(unsigned)__builtin_amdgcn_readfirstlane(kdst+(slot)))
  #define DMA_V(t,slot) glds16(vsrc+(long)(t)*KVBLK*DM,(unsigned)__builtin_amdgcn_readfirstlane(vdst+(slot)))
  const int vb0=(int)(lds0+LDS_V)+((lane>>4)&1)*32+(lane&3)*8+(4*hi+((lane&15)>>2))*64;
  const char*Kbase=shm+LDS_K; bf16x8 kf[8];
  const lds_cptr kp0=shm3+LDS_K+hi*1024+r32*16; const lds_cptr vp0=shm3+LDS_V+((lane>>4)&1)*32+(lane&3)*8+(4*hi+((lane&15)>>2))*64;
  const int NT=(q0+QB)/KVBLK;
  DMA_K(0,0);DMA_V(0,0);DMA_K(1,SLOTB);
  bf16x8 qr[4];
  #pragma unroll
  for(int d0=0;d0<4;++d0)qr[d0]=*(const __attribute__((address_space(1))) bf16x8*)(&Qw[(long)r32*DM+d0*16+hi*8]);
  float mhat=0.f,l_reg=0.f;f32x16 o[2];o[0]=f32x16{};o[1]=f32x16{};
  const int qrel=wid*QBLK+r32;
  #define CMASK(P0,P1,t) do{int jb_=(t)-(NT-4); if(jb_>=0)cmask(P0,P1,jb_,qrel,hi);}while(0)
  bool resc=false;
  #define START(P0,P1) do{ const float rm=rowmax(P0,P1); resc=false; \
    { const float dl=rm; mhat=fadd_s(mhat,dl); \
      _Pragma("unroll") for(int r=0;r<16;++r){P0[r]=fsub_s(P0[r],dl);P1[r]=fsub_s(P1[r],dl);} } \
    _Pragma("unroll") for(int r=0;r<16;++r)P0[r]=__builtin_amdgcn_exp2f(P0[r]); }while(0)
  #define RESC() do{ if(resc){ asm volatile("s_waitcnt lgkmcnt(0)":::"memory"); \
      _Pragma("unroll") for(int d_=0;d_<2;++d_) _Pragma("unroll") for(int r=0;r<16;++r)o[d_][r]*=wsf[crow(r,hi)]; } }while(0)
  f32x16 pA0,pA1,pB0,pB1;
  int sl_prev=0,sl_cur=0,sl_next=SLOTB;
  #define ROT() do{sl_prev=sl_cur;sl_cur=sl_next;sl_next=(sl_next==(NSLOT-1)*SLOTB)?0:sl_next+SLOTB;}while(0)
  DMA_K(2,2*SLOTB);
  WAIT_BAR(3);
  fbias(pA0,pA1,fs3,0.f,hi);
  qkt(pA0,pA1,Kbase,qr,r32,hi);asm volatile("s_nop 15\n\ts_nop 7":"+v"(pA0),"+v"(pA1));CMASK(pA0,pA1,0);
  START(pA0,pA1);
  _Pragma("unroll") for(int r=0;r<16;++r)pA1[r]=__builtin_amdgcn_exp2f(pA1[r]);
  WAIT_BAR(0);
  DMA_K(3,0);DMA_V(1,SLOTB);
  ROT();
  kload8(kf,kp0+sl_cur);
  WAIT_BAR(2);
  s16x4 vlo[8],vhi[8]; u32x4 pw0,pw1,pw2,pw3;
  #define PKW(P,B) cvtpk_s(P[B],P[B+1])
  #define PAF(k) __builtin_bit_cast(bf16x8,pw##k)
  #define VFR(i) (bf16x8){vlo[i][0],vlo[i][1],vlo[i][2],vlo[i][3],vhi[i][0],vhi[i][1],vhi[i][2],vhi[i][3]}
  #define PIN(x) asm volatile("":"+v"(x))
  #define MX3(a,b,c) __builtin_fmaxf(__builtin_fmaxf((a),(b)),(c))
  #define GAPA(MF,A0,A1,A2,A3,W0,W1,PW) do{ MF; sacc+=A0; sacc+=A1; sacc+=A2; sacc+=A3; PIN(sacc); W0; W1; PIN(PW); SBAR(); }while(0)
  #define EX(v) __builtin_amdgcn_exp2f(v)
  #define GAPB(MF,X,B) do{ MF; X[B]=EX(X[B]); X[B+1]=EX(X[B+1]); X[B+2]=EX(X[B+2]); X[B+3]=EX(X[B+3]); PIN(X); SBAR(); }while(0)
  #define VRD(i) do{ vlo[i]=vtr(vp_+(((i)>>2)*4096+((i)&3)*1024)); vhi[i]=vtr(vp_+(((i)>>2)*4096+((i)&3)*1024+512)); }while(0)
  #define KRD(G,j) do{ if(G){ kload2(kf,kp0+sl_next,j); SBAR(); } }while(0)
  #define STEP(C0,C1,P0,P1,t,GK,GV,GL) do{ SBAR(); \
    const lds_cptr vp_=vp0+sl_prev; \
    fbias(C0,C1,fs3+(t)*256,-mhat,hi); SBAR(); \
    VRD(0); SBAR(); float sacc=(P0[0]+P0[1]); \
    GAPA(C0=__builtin_amdgcn_mfma_f32_32x32x16_bf16(kf[0],qr[0],C0,0,0,0), P0[2],P0[3],P0[4],P0[5],     pw0[0]=PKW(P0,0), pw0[1]=PKW(P0,2), pw0); \
    VRD(4); SBAR(); GAPA(C1=__builtin_amdgcn_mfma_f32_32x32x16_bf16(kf[1],qr[0],C1,0,0,0), P0[6],P0[7],P0[8],P0[9],     pw0[2]=PKW(P0,4), pw0[3]=PKW(P0,6), pw0); \
    VRD(1); SBAR(); GAPA(C0=__builtin_amdgcn_mfma_f32_32x32x16_bf16(kf[2],qr[1],C0,0,0,0),   P0[10],P0[11],P0[12],P0[13], pw1[0]=PKW(P0,8), pw1[1]=PKW(P0,10), pw1); \
    VRD(5); SBAR(); GAPA(C1=__builtin_amdgcn_mfma_f32_32x32x16_bf16(kf[3],qr[1],C1,0,0,0),   P0[14],P0[15],P1[0],P1[1],   pw1[2]=PKW(P0,12),pw1[3]=PKW(P0,14), pw1); \
    VRD(2); SBAR(); GAPA(C0=__builtin_amdgcn_mfma_f32_32x32x16_bf16(kf[4],qr[2],C0,0,0,0),   P1[2],P1[3],P1[4],P1[5],     pw2[0]=PKW(P1,0), pw2[1]=PKW(P1,2), pw2); \
    VRD(6); SBAR(); GAPA(C1=__builtin_amdgcn_mfma_f32_32x32x16_bf16(kf[5],qr[2],C1,0,0,0),   P1[6],P1[7],P1[8],P1[9],     pw2[2]=PKW(P1,4), pw2[3]=PKW(P1,6), pw2); \
    VRD(3); SBAR(); GAPA(C0=__builtin_amdgcn_mfma_f32_32x32x16_bf16(kf[6],qr[3],C0,0,0,0),   P1[10],P1[11],P1[12],P1[13], pw3[0]=PKW(P1,8), pw3[1]=PKW(P1,10), pw3); \
    VRD(7); SBAR(); GAPA(C1=__builtin_amdgcn_mfma_f32_32x32x16_bf16(kf[7],qr[3],C1,0,0,0),   P1[14],P1[15],0.f,0.f,       pw3[2]=PKW(P1,12),pw3[3]=PKW(P1,14), pw3); \
    l_reg+=sacc; \
    if(GK){DMA_K((t)+3,sl_cur);} if(GV){DMA_V((t)+1,sl_next);} \
    CMASK(C0,C1,t); \
    { float a=MX3(C0[0],C0[1],C1[0]),b=MX3(C0[2],C0[3],C1[1]); a=MX3(a,C1[2],C1[3]); \
      _Pragma("unroll") for(int r=4;r<16;r+=4){a=MX3(a,C0[r],C0[r+1]);b=MX3(b,C0[r+2],C0[r+3]);a=MX3(a,C1[r],C1[r+1]);b=MX3(b,C1[r+2],C1[r+3]);} \
      float rm=__builtin_fmaxf(a,b); { auto rr=__builtin_amdgcn_permlane32_swap(__float_as_uint(rm),__float_as_uint(rm),false,false); rm=__builtin_fmaxf(__uint_as_float(rr[0]),__uint_as_float(rr[1])); } \
      resc=false; \
      if(__builtin_expect(__any(rm>(float)THRL),0)){ const float dl=__builtin_fmaxf(rm,0.f); mhat+=dl; \
        _Pragma("unroll") for(int r=0;r<16;++r){C0[r]-=dl;C1[r]-=dl;} \
        const float f=__builtin_amdgcn_exp2f(-dl); l_reg*=f; if(hi==0)wsf[r32]=f; resc=true; } } \
    SBAR(); \
    GAPB(o[0]=__builtin_amdgcn_mfma_f32_32x32x16_bf16(PAF(0),VFR(0),o[0],0,0,0), C0,0); \
    GAPB(o[1]=__builtin_amdgcn_mfma_f32_32x32x16_bf16(PAF(0),VFR(4),o[1],0,0,0), C0,4); \
    KRD(GL,0); GAPB(o[0]=__builtin_amdgcn_mfma_f32_32x32x16_bf16(PAF(1),VFR(1),o[0],0,0,0), C0,8); \
    KRD(GL,1); GAPB(o[1]=__builtin_amdgcn_mfma_f32_32x32x16_bf16(PAF(1),VFR(5),o[1],0,0,0), C0,12); \
    KRD(GL,2); GAPB(o[0]=__builtin_amdgcn_mfma_f32_32x32x16_bf16(PAF(2),VFR(2),o[0],0,0,0), C1,0); \
    KRD(GL,3); GAPB(o[1]=__builtin_amdgcn_mfma_f32_32x32x16_bf16(PAF(2),VFR(6),o[1],0,0,0), C1,4); \
    GAPB(o[0]=__builtin_amdgcn_mfma_f32_32x32x16_bf16(PAF(3),VFR(3),o[0],0,0,0), C1,8); \
    GAPB(o[1]=__builtin_amdgcn_mfma_f32_32x32x16_bf16(PAF(3),VFR(7),o[1],0,0,0), C1,12); \
    }while(0)
  int t=1;
  #undef CMASK
  #define CMASK(P0,P1,t) do{}while(0)
  for(;t+5<NT;t+=2){
    STEP(pB0,pB1,pA0,pA1,t,true,true,true);     WAIT_BAR(2); RESC(); ROT();
    STEP(pA0,pA1,pB0,pB1,t+1,true,true,true);   WAIT_BAR(2); RESC(); ROT();
  }
  #undef CMASK
  #define CMASK(P0,P1,t) do{int jb_=(t)-(NT-4); if(jb_>=0)cmask(P0,P1,jb_,qrel,hi);}while(0)
  #define ENDW(tt) do{ if((tt)+3<NT){WAIT_BAR(2);} else if((tt)+2<NT){WAIT_BAR(1);} else {WAIT_BAR(0);} }while(0)
  for(;t+1<NT;t+=2){
    STEP(pB0,pB1,pA0,pA1,t,(t+3<NT),(t+1<NT),(t+1<NT));       ENDW(t);   RESC(); ROT();
    STEP(pA0,pA1,pB0,pB1,t+1,(t+4<NT),(t+2<NT),(t+2<NT));     ENDW(t+1); RESC(); ROT();
  }
  STEP(pB0,pB1,pA0,pA1,NT-1,false,false,false); RESC();
  { float sacc=pB0[0]+pB0[1]; _Pragma("unroll") for(int r=2;r<16;++r)sacc+=pB0[r]; _Pragma("unroll") for(int r=0;r<16;++r)sacc+=pB1[r]; l_reg+=sacc;
    pw0=(u32x4){PKW(pB0,0),PKW(pB0,2),PKW(pB0,4),PKW(pB0,6)};pw1=(u32x4){PKW(pB0,8),PKW(pB0,10),PKW(pB0,12),PKW(pB0,14)};pw2=(u32x4){PKW(pB1,0),PKW(pB1,2),PKW(pB1,4),PKW(pB1,6)};pw3=(u32x4){PKW(pB1,8),PKW(pB1,10),PKW(pB1,12),PKW(pB1,14)};
    SBAR(); pv(o,vb0+sl_cur,PAF(0),PAF(1),PAF(2),PAF(3)); }
  #undef PKW
  #undef PAF
  #undef VFR
  #undef PIN
  #undef MX3
  #undef GAPA
  #undef GAPB
  #undef EX
  #undef VRD
  #undef KRD
  #undef STEP
  #undef ENDW
  {auto rr=__builtin_amdgcn_permlane32_swap(__float_as_uint(l_reg),__float_as_uint(l_reg),false,false);l_reg=__uint_as_float(rr[0])+__uint_as_float(rr[1]);}
  if(hi==0)wsf[32+r32]=l_reg;asm volatile("s_waitcnt lgkmcnt(0)":::"memory");
  float rli[16];
  #pragma unroll
  for(int r=0;r<16;++r)rli[r]=__builtin_amdgcn_rcpf(wsf[32+crow(r,hi)]);
  bf16*Ow=O+(rowbase+q0+wid*QBLK)*DM+h*D;
  { bf16*stg=(bf16*)(shm+LDS_OST)+wid*2048;
    #pragma unroll
    for(int r=0;r<16;++r){const int orow=crow(r,hi);
      #pragma unroll
      for(int d0=0;d0<2;++d0)stg[orow*64+d0*32+r32]=__float2bfloat16(o[d0][r]*rli[r]);}
    asm volatile("s_waitcnt lgkmcnt(0)":::"memory");
    #pragma unroll
    for(int i=0;i<4;++i){const int row=i*8+(lane>>3),ch=lane&7; const u32x4 v=*(const u32x4*)(stg+row*64+ch*8); ATTN_STORE16(Ow+(long)row*DM+ch*8,v);} }
  asm volatile("s_waitcnt lgkmcnt(0)\n\ts_barrier":::"memory");
  #undef DMA_K
  #undef DMA_V
  #undef CMASK
  #undef START
  #undef RESC
  #undef ROT
}

constexpr float T_UNDER=40.f;
#ifdef APROBE
#define AP_ARG ,unsigned long long(&ap_t)[3]
#define AP_STAMP(i) ap_t[i]=__builtin_amdgcn_s_memrealtime()
#else
#define AP_ARG
#define AP_STAMP(i) do{}while(0)
#endif
template<int DUMMY> __device__ __forceinline__ void attn_unit_fast(int b,int h,int qb,float M,float Kmax,const bf16*Q,const bf16*__restrict__ K,const bf16*__restrict__ V,bf16*O,const float*LF,char*shm,int wave0 AP_ARG){
  int tid_=opaque_tid(wave0);
  const int tid=tid_,lane=tid&63,r32=lane&31,hi=lane>>5; const int wid=__builtin_amdgcn_readfirstlane(tid>>6);
  const long rowbase=(long)b*SEQ; const int q0=qb*QB;
  const bf16*Qw=Q+(rowbase+q0+wid*QBLK)*DM+h*D;
  const bf16*Kh=K+rowbase*DM+h*D,*Vh=V+rowbase*DM+h*D;
  const unsigned lds0=(unsigned)(uintptr_t)shm;
  const lds_cptr shm3=(lds_cptr)shm;
  const lds_cptr fs3=shm3+LDS_FS;
  const int NT=(q0+QB)/KVBLK;
  const char*kbase=(const char*)(Kh+(long)(NT-1)*KVBLK*DM),*vbase=(const char*)(Vh+(long)(NT-1)*KVBLK*DM);
  const unsigned koff=(unsigned)((lane*DM+wid*8)*2), voff=(unsigned)(((16*(wid&3)+(lane>>2))*DM+(wid>>2)*32+(lane&3)*8)*2);
  const unsigned kdst=lds0+LDS_K+wid*1024, vdst=lds0+LDS_V+wid*1024;
  #define DMA_K(t,slot) glds16s(kbase-(long)(t)*(KVBLK*DM*2),koff,(unsigned)__builtin_amdgcn_readfirstlane(kdst+(slot)))
  #define DMA_V(t,slot) glds16s(vbase-(long)(t)*(KVBLK*DM*2),voff,(unsigned)__builtin_amdgcn_readfirstlane(vdst+(slot)))
  const char*Kbase=shm+LDS_K; bf16x8 kf[8];
  const lds_cptr kp0=shm3+LDS_K+hi*1024+r32*16; const lds_cptr vp0=shm3+LDS_V+((lane>>4)&1)*32+(lane&3)*8+(4*hi+((lane&15)>>2))*64;
  const int nsc=q0+QB; f32x4 sv0=(f32x4){0.f,0.f,0.f,0.f},sv1=(f32x4){0.f,0.f,0.f,0.f};
  { const float*lf=LF+((long)b*NHEAD+h)*SEQ; if(8*tid<nsc){sv0=*(const __attribute__((address_space(1))) f32x4*)(lf+8*tid);sv1=*(const __attribute__((address_space(1))) f32x4*)(lf+8*tid+4);} }
  DMA_K(0,0);DMA_V(0,0);DMA_K(1,SLOTB);
  bf16x8 qr[4];
  #pragma unroll
  for(int d0=0;d0<4;++d0)qr[d0]=*(const __attribute__((address_space(1))) bf16x8*)(&Qw[(long)r32*DM+d0*16+hi*8]);
  float l_reg=0.f;f32x16 o[2];o[0]=f32x16{};o[1]=f32x16{};
  const int qrel=wid*QBLK+r32;
  float wbnd;
  { const int tb_=opaque_tid(wave0),lb_=tb_&63; const bf16*Krow=K+(rowbase+q0+(tb_>>6)*QBLK+(lb_&31))*DM+h*D+(lb_>>5)*8; float qq=0.f,qk=0.f;
    #pragma unroll
    for(int d0=0;d0<4;++d0){ const bf16x8 kr=*(const __attribute__((address_space(1))) bf16x8*)(Krow+d0*16);
      { typedef __bf16 v2bf_ __attribute__((ext_vector_type(2))); const u32x4 qw_=__builtin_bit_cast(u32x4,qr[d0]), kw_=__builtin_bit_cast(u32x4,kr);
        #pragma unroll
        for(int j=0;j<4;++j){ const v2bf_ q2_=__builtin_bit_cast(v2bf_,qw_[j]); qq=__builtin_amdgcn_fdot2_f32_bf16(q2_,q2_,qq,false); qk=__builtin_amdgcn_fdot2_f32_bf16(q2_,__builtin_bit_cast(v2bf_,kw_[j]),qk,false); } } }
    { auto r1=__builtin_amdgcn_permlane32_swap(__float_as_uint(qq),__float_as_uint(qq),false,false); qq=__uint_as_float(r1[0])+__uint_as_float(r1[1]);
      auto r2=__builtin_amdgcn_permlane32_swap(__float_as_uint(qk),__float_as_uint(qk),false,false); qk=__uint_as_float(r2[0])+__uint_as_float(r2[1]); }
    wbnd=1.01f*sqrtf(qq)*Kmax-qk+1e-3f;
    #pragma unroll
    for(int o_=1;o_<32;o_<<=1) wbnd=fmaxf(wbnd,__int_as_float(__builtin_amdgcn_ds_bpermute((lb_^o_)<<2,__float_as_int(wbnd)))); }
  #define CMASK(P0,P1,t) do{int jb_=3-(t); if(jb_>=0)cmask(P0,P1,jb_,qrel,hi);}while(0)
  if(wid>=4)__builtin_amdgcn_s_setprio(1);
  f32x16 pA0,pA1,pB0,pB1;
  int sl_prev=0,sl_cur=0,sl_next=SLOTB;
  #define ROT() do{sl_prev=sl_cur;sl_cur=sl_next;sl_next=(sl_next==(NSLOT-1)*SLOTB)?0:sl_next+SLOTB;}while(0)
  DMA_K(2,2*SLOTB);
  float ubnd=0.f;
  { unsigned wtb_=(unsigned)(uintptr_t)(shm3+LDS_WT); asm volatile("":"+v"(wtb_));
    volatile __attribute__((address_space(3))) float*wt=(volatile __attribute__((address_space(3))) float*)wtb_;
    f32x4 v0=sv0,v1=sv1;
    v0[1]+=v0[0];v0[2]+=v0[1];v0[3]+=v0[2];v1[0]+=v0[3];v1[1]+=v1[0];v1[2]+=v1[1];v1[3]+=v1[2];
    const float tot=v1[3]; float inc=tot;
    #pragma unroll
    for(int o_=1;o_<64;o_<<=1){const float t_=__int_as_float(__builtin_amdgcn_ds_bpermute((lane-o_)<<2,__float_as_int(inc)));if(lane>=o_)inc+=t_;}
    if(lane==63)wt[wid]=inc;
    if(lane==0)wt[16+wid]=wbnd;
    asm volatile("s_waitcnt lgkmcnt(0)\n\ts_barrier":::"memory");
    ubnd=wt[16];
    #pragma unroll
    for(int w_=1;w_<NW;++w_)ubnd=fmaxf(ubnd,wt[16+w_]);
    float base=inc-tot;
    #pragma unroll
    for(int w_=0;w_<NW;++w_){const float x_=wt[w_]; if(w_<wid)base+=x_;}
    if(tid==(q0>>3))wt[8]=base+v0[0];
    asm volatile("s_waitcnt lgkmcnt(0)\n\ts_barrier":::"memory");
    const float anc=wt[8];
    if(8*tid<nsc){ __attribute__((address_space(3))) f32x4*fo=(__attribute__((address_space(3))) f32x4*)(shm3+LDS_FS)+2*tid;
      fo[0]=(v0+(base-anc))*LOG2E; fo[1]=(v1+(base-anc))*LOG2E; }
  }
  WAIT_BAR(3);
  AP_STAMP(0);
  const float nm=*(const __attribute__((address_space(3))) float*)(fs3+(q0+qrel)*4)-M;
  int NP;
  { const float fv=(lane<NT)?*(const __attribute__((address_space(3))) float*)(fs3+(64*lane+63)*4):0.f;
    const unsigned long long bal=__ballot((lane<NT)&&(fv>fminf(ubnd,2.f*M)+T_UNDER));
    const int tstop=__builtin_popcountll(bal); int np=NT-tstop; np=(np+1)&~1; NP=np<4?4:np; NP=__builtin_amdgcn_readfirstlane(NP); }
#ifdef NPPROBE
  if(tid==0)atomicAdd(&pg8::gprobe_acc[0],(unsigned long long)NP);
#endif
  const unsigned lom=hi?0u:0xffffffffu;
  #define BSPL(x_,h_,m_,l_) do{ h_=__float_as_uint(x_)&0xffff0000u; const float r1_=(x_)-__uint_as_float(h_); m_=__float_as_uint(r1_)&0xffff0000u; const float r2_=r1_-__uint_as_float(m_); l_=__float_as_uint(r2_)&0xffff0000u; }while(0)
  #define KAUG(f_,y_,z_) do{ unsigned h_,m_,l_; const float x_=-(f_); BSPL(x_,h_,m_,l_); y_=(h_|0x3f80u)&lom; z_=((m_>>16)|l_)&lom; }while(0)
  unsigned ky0,kz0,ky1,kz1,qx,qy;
  { const lds_cptr ft_=fs3+(NT-2)*256+r32*4; const float fa_=*(const __attribute__((address_space(3))) float*)ft_, fb_=*(const __attribute__((address_space(3))) float*)(ft_+128); KAUG(fa_,ky0,kz0); KAUG(fb_,ky1,kz1);
    unsigned h_,m_,l_; BSPL(nm,h_,m_,l_); qx=(h_>>16)|m_; qy=(l_>>16)|0x3f800000u; }
  { unsigned y0_,z0_,y1_,z1_; const lds_cptr ft_=fs3+(NT-1)*256+r32*4; const float fa_=*(const __attribute__((address_space(3))) float*)ft_, fb_=*(const __attribute__((address_space(3))) float*)(ft_+128); KAUG(fa_,y0_,z0_); KAUG(fb_,y1_,z1_);
    const bf16x8 ka0_=__builtin_bit_cast(bf16x8,((u32x4){0x3f803f80u&lom,y0_,z0_,0u})), ka1_=__builtin_bit_cast(bf16x8,((u32x4){0x3f803f80u&lom,y1_,z1_,0u})), qa_=__builtin_bit_cast(bf16x8,((u32x4){qx,qy,0x3f803f80u,0u}));
    const f32x16 z16_={}; pA0=__builtin_amdgcn_mfma_f32_32x32x16_bf16(ka0_,qa_,z16_,0,0,0); pA1=__builtin_amdgcn_mfma_f32_32x32x16_bf16(ka1_,qa_,z16_,0,0,0); }
  qkt(pA0,pA1,Kbase,qr,r32,hi);asm volatile("s_nop 15\n\ts_nop 7":"+v"(pA0),"+v"(pA1));CMASK(pA0,pA1,0);
  _Pragma("unroll") for(int r=0;r<16;++r){pA0[r]=__builtin_amdgcn_exp2f(pA0[r]);pA1[r]=__builtin_amdgcn_exp2f(pA1[r]);}
  WAIT_BAR(0);
  DMA_K(3,0);DMA_V(1,SLOTB);
  ROT();
  kload8(kf,kp0+sl_cur);
  WAIT_BAR(2);
  s16x4 vlo[8],vhi[8]; u32x4 pw0,pw1,pw2,pw3;
  #define PKW(P,B) cvtpk_s(P[B],P[B+1])
  #define PAF(k) __builtin_bit_cast(bf16x8,pw##k)
  #define VFR(i) (bf16x8){vlo[i][0],vlo[i][1],vlo[i][2],vlo[i][3],vhi[i][0],vhi[i][1],vhi[i][2],vhi[i][3]}
  #define PIN(x) asm volatile("":"+v"(x))
  #define GAPA(MF,A0,A1,A2,A3,W0,W1,PW) do{ MF; sacc+=A0; sacc+=A1; sacc+=A2; sacc+=A3; PIN(sacc); W0; W1; PIN(PW); SBAR(); }while(0)
  #define EX(v) __builtin_amdgcn_exp2f(v)
  #define GAPB(MF,X,B,Y,GL) do{ MF; X[B]=EX(X[B]); X[B+1]=EX(X[B+1]); X[B+2]=EX(X[B+2]); X[B+3]=EX(X[B+3]); PIN(X); SBAR(); }while(0)
  #define VRD(i) do{ vlo[i]=vtr(vp_+(((i)>>2)*4096+((i)&3)*1024)); vhi[i]=vtr(vp_+(((i)>>2)*4096+((i)&3)*1024+512)); }while(0)
  #define KRD(G,j) do{ if(G){ kload2(kf,kp0+sl_next,j); SBAR(); } }while(0)
  #define FLD(Y0,Y1,t) do{ const lds_cptr ft_=fs3+(NT-2-(t))*256+hi*16; \
      _Pragma("unroll") for(int g_=0;g_<4;++g_){ const f32x4 a_=*(const __attribute__((address_space(3))) f32x4*)(ft_+g_*32); const f32x4 b_=*(const __attribute__((address_space(3))) f32x4*)(ft_+128+g_*32); \
        Y0[4*g_]=a_[0];Y0[4*g_+1]=a_[1];Y0[4*g_+2]=a_[2];Y0[4*g_+3]=a_[3]; Y1[4*g_]=b_[0];Y1[4*g_+1]=b_[1];Y1[4*g_+2]=b_[2];Y1[4*g_+3]=b_[3]; } }while(0)
  #define STEP(C0,C1,P0,P1,t,GK,GV,GL) do{ SBAR(); \
    { const bf16x8 ka0_=__builtin_bit_cast(bf16x8,((u32x4){0x3f803f80u&lom,ky0,kz0,0u})), ka1_=__builtin_bit_cast(bf16x8,((u32x4){0x3f803f80u&lom,ky1,kz1,0u})), qa_=__builtin_bit_cast(bf16x8,((u32x4){qx,qy,0x3f803f80u,0u})); \
      const f32x16 z16_={}; C0=__builtin_amdgcn_mfma_f32_32x32x16_bf16(ka0_,qa_,z16_,0,0,0); C1=__builtin_amdgcn_mfma_f32_32x32x16_bf16(ka1_,qa_,z16_,0,0,0); } \
    const lds_cptr vp_=vp0+sl_prev; \
    VRD(0); SBAR(); float sacc=(P0[0]+P0[1]); \
    GAPA(C0=__builtin_amdgcn_mfma_f32_32x32x16_bf16(kf[0],qr[0],C0,0,0,0), P0[2],P0[3],P0[4],P0[5],     pw0[0]=PKW(P0,0), pw0[1]=PKW(P0,2), pw0); \
    VRD(4); SBAR(); GAPA(C1=__builtin_amdgcn_mfma_f32_32x32x16_bf16(kf[1],qr[0],C1,0,0,0), P0[6],P0[7],P0[8],P0[9],     pw0[2]=PKW(P0,4), pw0[3]=PKW(P0,6), pw0); \
    VRD(1); SBAR(); GAPA(C0=__builtin_amdgcn_mfma_f32_32x32x16_bf16(kf[2],qr[1],C0,0,0,0),   P0[10],P0[11],P0[12],P0[13], pw1[0]=PKW(P0,8), pw1[1]=PKW(P0,10), pw1); \
    VRD(5); SBAR(); GAPA(C1=__builtin_amdgcn_mfma_f32_32x32x16_bf16(kf[3],qr[1],C1,0,0,0),   P0[14],P0[15],P1[0],P1[1],   pw1[2]=PKW(P0,12),pw1[3]=PKW(P0,14), pw1); \
    VRD(2); SBAR(); GAPA(C0=__builtin_amdgcn_mfma_f32_32x32x16_bf16(kf[4],qr[2],C0,0,0,0),   P1[2],P1[3],P1[4],P1[5],     pw2[0]=PKW(P1,0), pw2[1]=PKW(P1,2), pw2); \
    VRD(6); SBAR(); GAPA(C1=__builtin_amdgcn_mfma_f32_32x32x16_bf16(kf[5],qr[2],C1,0,0,0),   P1[6],P1[7],P1[8],P1[9],     pw2[2]=PKW(P1,4), pw2[3]=PKW(P1,6), pw2); \
    VRD(3); SBAR(); GAPA(C0=__builtin_amdgcn_mfma_f32_32x32x16_bf16(kf[6],qr[3],C0,0,0,0),   P1[10],P1[11],P1[12],P1[13], pw3[0]=PKW(P1,8), pw3[1]=PKW(P1,10), pw3); \
    VRD(7); SBAR(); GAPA(C1=__builtin_amdgcn_mfma_f32_32x32x16_bf16(kf[7],qr[3],C1,0,0,0),   P1[14],P1[15],0.f,0.f,       pw3[2]=PKW(P1,12),pw3[3]=PKW(P1,14), pw3); \
    l_reg+=sacc; \
    if(GK){DMA_K((t)+3,sl_cur);} if(GV){DMA_V((t)+1,sl_next);} \
    CMASK(C0,C1,t); \
    float fa_=0.f,fb_=0.f; if(GL){ const lds_cptr ft_=fs3+(NT-2-(t))*256+r32*4; fa_=*(const __attribute__((address_space(3))) float*)ft_; fb_=*(const __attribute__((address_space(3))) float*)(ft_+128); } \
    SBAR(); \
    GAPB(o[0]=__builtin_amdgcn_mfma_f32_32x32x16_bf16(PAF(0),VFR(0),o[0],0,0,0), C0,0,P0,GL); \
    GAPB(o[1]=__builtin_amdgcn_mfma_f32_32x32x16_bf16(PAF(0),VFR(4),o[1],0,0,0), C0,4,P0,GL); \
    KRD(GL,0); GAPB(o[0]=__builtin_amdgcn_mfma_f32_32x32x16_bf16(PAF(1),VFR(1),o[0],0,0,0), C0,8,P0,GL); \
    KRD(GL,1); GAPB(o[1]=__builtin_amdgcn_mfma_f32_32x32x16_bf16(PAF(1),VFR(5),o[1],0,0,0), C0,12,P0,GL); \
    KRD(GL,2); GAPB(o[0]=__builtin_amdgcn_mfma_f32_32x32x16_bf16(PAF(2),VFR(2),o[0],0,0,0), C1,0,P1,GL); \
    KRD(GL,3); GAPB(o[1]=__builtin_amdgcn_mfma_f32_32x32x16_bf16(PAF(2),VFR(6),o[1],0,0,0), C1,4,P1,GL); \
    GAPB(o[0]=__builtin_amdgcn_mfma_f32_32x32x16_bf16(PAF(3),VFR(3),o[0],0,0,0), C1,8,P1,GL); \
    GAPB(o[1]=__builtin_amdgcn_mfma_f32_32x32x16_bf16(PAF(3),VFR(7),o[1],0,0,0), C1,12,P1,GL); \
    if(GL){ KAUG(fa_,ky0,kz0); KAUG(fb_,ky1,kz1); } \
    }while(0)
  #define ENDW(tt) do{ if((tt)+3<NP){WAIT_BAR(2);} else if((tt)+2<NP){WAIT_BAR(1);} else {WAIT_BAR(0);} }while(0)
  int t=1;
  for(;t<5&&t+1<NP;t+=2){
    STEP(pB0,pB1,pA0,pA1,t,(t+3<NP),(t+1<NP),(t+1<NP));       ENDW(t);   ROT();
    STEP(pA0,pA1,pB0,pB1,t+1,(t+4<NP),(t+2<NP),(t+2<NP));     ENDW(t+1); ROT();
  }
  #undef CMASK
  #define CMASK(P0,P1,t) do{}while(0)
  for(;t+5<NP;t+=2){
    STEP(pB0,pB1,pA0,pA1,t,true,true,true);     WAIT_BAR(2); ROT();
    STEP(pA0,pA1,pB0,pB1,t+1,true,true,true);   WAIT_BAR(2); ROT();
  }
  for(;t+1<NP;t+=2){
    STEP(pB0,pB1,pA0,pA1,t,(t+3<NP),(t+1<NP),(t+1<NP));       ENDW(t);   ROT();
    STEP(pA0,pA1,pB0,pB1,t+1,(t+4<NP),(t+2<NP),(t+2<NP));     ENDW(t+1); ROT();
  }
  #undef CMASK
  #define CMASK(P0,P1,t) do{int jb_=3-(t); if(jb_>=0)cmask(P0,P1,jb_,qrel,hi);}while(0)
  STEP(pB0,pB1,pA0,pA1,NP-1,false,false,false);
  AP_STAMP(1);
  __builtin_amdgcn_s_setprio(0);
  const int tidE=opaque_tid(wave0),laneE=tidE&63,r32E=laneE&31,hiE=laneE>>5; const int widE=__builtin_amdgcn_readfirstlane(tidE>>6);
  const int vb0=(int)(lds0+LDS_V)+((laneE>>4)&1)*32+(laneE&3)*8+(4*hiE+((laneE&15)>>2))*64;
  float*wsf=(float*)(shm+LDS_WS)+widE*64;
  { float sacc=pB0[0]+pB0[1]; _Pragma("unroll") for(int r=2;r<16;++r)sacc+=pB0[r]; _Pragma("unroll") for(int r=0;r<16;++r)sacc+=pB1[r]; l_reg+=sacc;
    pw0=(u32x4){PKW(pB0,0),PKW(pB0,2),PKW(pB0,4),PKW(pB0,6)};pw1=(u32x4){PKW(pB0,8),PKW(pB0,10),PKW(pB0,12),PKW(pB0,14)};pw2=(u32x4){PKW(pB1,0),PKW(pB1,2),PKW(pB1,4),PKW(pB1,6)};pw3=(u32x4){PKW(pB1,8),PKW(pB1,10),PKW(pB1,12),PKW(pB1,14)};
    SBAR(); pv(o,vb0+sl_cur,PAF(0),PAF(1),PAF(2),PAF(3)); }
  #undef PKW
  #undef PAF
  #undef VFR
  #undef PIN
  #undef GAPA
  #undef GAPB
  #undef EX
  #undef VRD
  #undef KRD
  #undef FLD
  #undef KAUG
  #undef BSPL
  #undef STEP
  #undef ENDW
  {auto rr=__builtin_amdgcn_permlane32_swap(__float_as_uint(l_reg),__float_as_uint(l_reg),false,false);l_reg=__uint_as_float(rr[0])+__uint_as_float(rr[1]);}
  if(hiE==0)wsf[32+r32E]=l_reg;asm volatile("s_waitcnt lgkmcnt(0)":::"memory");
  float rli[16];
  #pragma unroll
  for(int r=0;r<16;++r)rli[r]=__builtin_amdgcn_rcpf(wsf[32+crow(r,hiE)]);
  bf16*Ow=O+(rowbase+q0+widE*QBLK)*DM+h*D;
  { bf16*stg=(bf16*)(shm+LDS_OST)+widE*2048;
    #pragma unroll
    for(int r=0;r<16;++r){const int orow=crow(r,hiE);
      #pragma unroll
      for(int d0=0;d0<2;++d0)stg[orow*64+d0*32+r32E]=__float2bfloat16(o[d0][r]*rli[r]);}
    asm volatile("s_waitcnt lgkmcnt(0)":::"memory");
    #pragma unroll
    for(int i=0;i<4;++i){const int row=i*8+(laneE>>3),ch=laneE&7; const u32x4 v=*(const u32x4*)(stg+row*64+ch*8); ATTN_STORE16(Ow+(long)row*DM+ch*8,v);} }
  asm volatile("s_waitcnt lgkmcnt(0)\n\ts_barrier":::"memory");
  AP_STAMP(2);
  #undef DMA_K
  #undef DMA_V
  #undef CMASK
  #undef ROT
}
constexpr int ATTN_LDS_BYTES=LDS_BYTES;
struct AttnTensors { const bf16* Q; const bf16* K; const bf16* V; bf16* O; const float* LF; const unsigned* QKM; };
struct AttnUnit { int bh; int qb; };
struct StaticOrder {
  int vcu;
  __device__ __forceinline__ explicit StaticOrder(int grid,int block):vcu((block%8)*(grid/8)+block/8){}
  __device__ __forceinline__ bool next(int i,AttnUnit&u)const{ if(i>=8)return false; const int s=vcu&1, j=7-i, base=4*(j>>1); u.bh=vcu>>1; u.qb=base+((j&1)?(s?2:3):(s?1:0)); return true; }
};
template<int THRL=8> __device__ __forceinline__ void attn_phase(char*lds,const AttnTensors&T,unsigned*ctr,int wave0){
#ifdef APROBE
  unsigned long long ap_acc[4]={0ull,0ull,0ull,0ull};
#endif
  for(;;){
#ifdef APROBE
    const unsigned long long ap_t0=__builtin_amdgcn_s_memrealtime();
#endif
    const int tq=opaque_tid(wave0);
    const unsigned uwb_=(unsigned)(uintptr_t)((lds_cptr)lds+LDS_WT+48)+((unsigned)tq>>9);
    volatile __attribute__((address_space(3))) unsigned*uw=(volatile __attribute__((address_space(3))) unsigned*)uwb_;
    if(tq==0)*uw=__hip_atomic_fetch_add(ctr,1u,__ATOMIC_RELAXED,__HIP_MEMORY_SCOPE_AGENT);
    __syncthreads();
    const unsigned k=__builtin_amdgcn_readfirstlane(*uw);
#ifdef APROBE
    if(k>=(unsigned)(BATCH*NHEAD*NQB)){ if(tq==0){ atomicAdd(&pg8::gprobe_acc[0],ap_acc[0]); atomicAdd(&pg8::gprobe_acc[1],ap_acc[1]); atomicAdd(&pg8::gprobe_acc[2],ap_acc[2]); atomicAdd(&pg8::gprobe_acc[3],ap_acc[3]); } }
#endif
    if(k>=(unsigned)(BATCH*NHEAD*NQB))break;
    const int qb=NQB-1-(int)(k>>7), bh=(int)(k&127), b=bh/NHEAD,h=bh%NHEAD;
    const unsigned* qm=T.QKM+(0*8+b)*32+2*h; const unsigned* km=T.QKM+(1*8+b)*32+2*h;
    const float q2=__uint_as_float(__builtin_amdgcn_readfirstlane(qm[0]))+__uint_as_float(__builtin_amdgcn_readfirstlane(qm[1])), k2=__uint_as_float(__builtin_amdgcn_readfirstlane(km[0]))+__uint_as_float(__builtin_amdgcn_readfirstlane(km[1]));
    const float M=1.02f*sqrtf(q2*k2)+1e-3f;
#ifdef APROBE
    const unsigned long long ap_t1=__builtin_amdgcn_s_memrealtime(); unsigned long long ap_t[3]={ap_t1,ap_t1,ap_t1};
    if(M<55.f) attn_unit_fast<0>(b,h,qb,M,1.01f*sqrtf(k2),T.Q,T.K,T.V,T.O,T.LF,lds,wave0,ap_t);
    else attn_unit<THRL>(b,h,qb,T.Q,T.K,T.V,T.O,T.LF,lds,wave0);
    ap_acc[0]+=ap_t1-ap_t0; ap_acc[1]+=ap_t[0]-ap_t1; ap_acc[2]+=ap_t[1]-ap_t[0]; ap_acc[3]+=ap_t[2]-ap_t[1];
#else
    if(M<55.f) attn_unit_fast<0>(b,h,qb,M,1.01f*sqrtf(k2),T.Q,T.K,T.V,T.O,T.LF,lds,wave0);
    else attn_unit<THRL>(b,h,qb,T.Q,T.K,T.V,T.O,T.LF,lds,wave0);
#endif
  }
}
#undef SBAR
#undef WAIT_BAR
}
constexpr int NWAVES = 8;
#ifndef MK_MULTI
#define MK_MULTI 0
#endif

constexpr int BATCH = 8, SEQ = 4096, D = 1024, H = 16, HD = 64, NE = 32, FD = 512, NLAYER = 2;
constexpr int T = BATCH * SEQ;
constexpr int MODW = 6 * D;
constexpr float RMS_EPS = 1e-6f;
constexpr int WIN_LD = 3 * D + H;
constexpr int ECAP = 32768;
constexpr int PMAX = 2 * T + NE * 256;

constexpr size_t MiB = 1u << 20;
constexpr size_t WS_CTL = 0, CTL_ZERO_BYTES = 160 * 1024;
constexpr size_t WS_MOD = 1 * MiB;
constexpr size_t WS_LOGF = 2 * MiB;
constexpr size_t WS_TOK = 6 * MiB;
constexpr size_t WS_GW = 10 * MiB;
constexpr size_t WS_WQKV = 14 * MiB;
constexpr size_t WS_WO = 20 * MiB;
constexpr size_t WS_RWF = 22 * MiB + 512 * 1024;
constexpr size_t WS_FWF = 22 * MiB + 768 * 1024;
constexpr size_t WS_WPF = 22 * MiB;
constexpr size_t WS_UP1 = 23 * MiB, WS_DN1 = 87 * MiB;
constexpr size_t WS_HB = 119 * MiB;
constexpr size_t WS_Q = 183 * MiB, WS_K = 247 * MiB, WS_V = 311 * MiB;
constexpr size_t WS_Y2 = 183 * MiB;
constexpr size_t WS_HH = 375 * MiB;
constexpr size_t WS_UP0 = 447 * MiB, WS_DN0 = 511 * MiB;
constexpr size_t WS_X3 = 447 * MiB;
constexpr size_t WS_END = 575 * MiB;
__host__ __device__ constexpr size_t ws_up(int layer) { return layer ? WS_UP1 : WS_UP0; }
__host__ __device__ constexpr size_t ws_dn(int layer) { return layer ? WS_DN1 : WS_DN0; }
constexpr int CW_BAR = 4096;
constexpr int CW_QKM = 32768;
constexpr int CW_AQ = 36864;
constexpr int CW_P1RDY = 37120;
constexpr int CW_GQ = 40960;
constexpr int CW_CNT = 16384;

constexpr int RING_OFF = 0, RING_BYTES = 131072;
constexpr int LDSCTL_OFF = RING_BYTES, MISC_OFF = LDSCTL_OFF + 320;
constexpr int ETAB_OFF = LDSCTL_OFF + 1024;
constexpr int SELALL_OFF = LDSCTL_OFF + 1024;
constexpr int LDS_BYTES = 152064;
static_assert(SELALL_OFF + 128 * 33 * 4 <= LDS_BYTES && ETAB_OFF + (64 + 960) * 4 <= LDS_BYTES && attn_body::ATTN_LDS_BYTES <= RING_BYTES, "LDS map");

#define GAS __attribute__((address_space(1)))
#define LAS __attribute__((address_space(3)))
#define GP(T_, p_) ((GAS T_*)(p_))
#define GCP(T_, p_) ((const GAS T_*)(p_))
typedef unsigned short bf16;
typedef unsigned v4u __attribute__((ext_vector_type(4)));
typedef float f32x4 __attribute__((ext_vector_type(4)));
typedef short bf16x8 __attribute__((ext_vector_type(8)));
typedef GAS unsigned gu32;
#define RLX_AGENT __ATOMIC_RELAXED, __HIP_MEMORY_SCOPE_AGENT
#define LDS_WAIT() asm volatile("s_waitcnt lgkmcnt(0)" ::: "memory")
#define VM_WAIT() asm volatile("s_waitcnt vmcnt(0)" ::: "memory")
#define LDS_BARRIER() do { asm volatile("s_waitcnt lgkmcnt(0)" ::: "memory"); __builtin_amdgcn_s_barrier(); asm volatile("" ::: "memory"); } while (0)
__device__ __forceinline__ unsigned f2bf(float f) { unsigned u = __builtin_bit_cast(unsigned, f); return (u + 0x7fffu + ((u >> 16) & 1u)) >> 16; }
typedef float pk_f32x2 __attribute__((ext_vector_type(2))); typedef __bf16 pk_bf16x2 __attribute__((ext_vector_type(2)));
__device__ __forceinline__ unsigned pk2(float lo, float hi) { pk_f32x2 v = {lo, hi}; return __builtin_bit_cast(unsigned, __builtin_convertvector(v, pk_bf16x2)); }
__device__ __forceinline__ float bflo(unsigned w) { return __uint_as_float(w << 16); }
__device__ __forceinline__ float bfhi(unsigned w) { return __uint_as_float(w & 0xffff0000u); }

#define XB_TMO      128
#define XB_XCNT(j)  (256  + 64 * (j))
#define XB_XSUB(j)  (1280 + 64 * (j))
#define XB_XGEN(j)  (2304 + 64 * (j))
#define XB_TOP      3328
#define XB_TOPGEN   3392
#define XCD_BAR_WORDS 3456
#define XB_SPIN_CAP (1u << 18)
__device__ __forceinline__ unsigned xb_ld(unsigned* p)              { return __hip_atomic_load(p, __ATOMIC_RELAXED, __HIP_MEMORY_SCOPE_AGENT); }
__device__ __forceinline__ unsigned xb_add(unsigned* p, unsigned v) { return __hip_atomic_fetch_add(p, v, __ATOMIC_RELAXED, __HIP_MEMORY_SCOPE_AGENT); }
__device__ __forceinline__ unsigned xb_xcc_id() { return (unsigned)__builtin_amdgcn_s_getreg((3 << 11) | 20) & 0xFu; }
#define XB_SPIN(cond, bar) do { unsigned _sp = 0; while (cond) { __builtin_amdgcn_s_sleep(1); \
    if ((++_sp & 255u) == 0u) { if (xb_ld(&(bar)[XB_TMO])) break; if (_sp > XB_SPIN_CAP) { atomicAdd(&(bar)[XB_TMO], 1u); break; } } } } while (0)
struct XcdBarrier { unsigned* bar; unsigned x; volatile LAS unsigned* st; };
__device__ __forceinline__ XcdBarrier xcd_barrier_post(unsigned* bar, volatile LAS unsigned* st) {
    XcdBarrier b; b.bar = bar; b.x = xb_xcc_id(); b.st = st;
    if (threadIdx.x == 0) (void)xb_add(&bar[XB_XCNT(b.x)], 1u);
    return b;
}
__device__ __forceinline__ void xcd_barrier_complete(unsigned* bar, unsigned x, unsigned& nloc, unsigned& nx) {
    const unsigned G = gridDim.x * gridDim.y * gridDim.z;
    unsigned sum, cnt, mine, sp = 0u;
    for (;;) {
        sum = 0u; cnt = 0u; mine = 0u;
#pragma unroll
        for (unsigned j = 0; j < 16; ++j) { const unsigned c = xb_ld(&bar[XB_XCNT(j)]); sum += c; cnt += (c > 0u) ? 1u : 0u; }
        mine = xb_ld(&bar[XB_XCNT(x)]);
        if (sum == G) break;
        __builtin_amdgcn_s_sleep(1);
        if ((++sp & 255u) == 0u) { if (xb_ld(&bar[XB_TMO])) break; if (sp > XB_SPIN_CAP) { atomicAdd(&bar[XB_TMO], 1u); break; } }
    }
    nloc = mine > 0u ? mine : 1u; nx = cnt > 0u ? cnt : 1u;
}
__device__ __forceinline__ void xcd_barrier(const XcdBarrier& b) {
    asm volatile("s_waitcnt vmcnt(0)" ::: "memory");
    __syncthreads();
    if (threadIdx.x == 0) {
        unsigned* bar = b.bar; unsigned bx = b.x;
        asm volatile("" : "+s"(bar), "+s"(bx));
        __builtin_amdgcn_s_waitcnt(0);
        unsigned nloc = b.st[0], nx = b.st[1];
        if (nloc == 0u) { xcd_barrier_complete(bar, bx, nloc, nx); b.st[0] = nloc; b.st[1] = nx; }
        const unsigned old = xb_add(&bar[XB_XSUB(bx)], 1u);
        const unsigned gen = old / nloc;
        if (old + 1u == (gen + 1u) * nloc) {
            __builtin_amdgcn_fence(__ATOMIC_RELEASE, "agent");
            asm volatile("s_waitcnt vmcnt(0)" ::: "memory");
            const unsigned og = xb_add(&bar[XB_TOP], 1u);
            const unsigned tg = og / nx;
            if (og + 1u == (tg + 1u) * nx) xb_add(&bar[XB_TOPGEN], 1u);
            else XB_SPIN(xb_ld(&bar[XB_TOPGEN]) == tg, bar);
            xb_add(&bar[XB_XGEN(bx)], 1u);
            __builtin_amdgcn_fence(__ATOMIC_ACQUIRE, "agent");
            asm volatile("s_waitcnt vmcnt(0)" ::: "memory");
        } else {
            asm volatile("buffer_inv sc1" ::: "memory");
            XB_SPIN(xb_ld(&bar[XB_XGEN(bx)]) == gen, bar);
            asm volatile("s_waitcnt vmcnt(0)" ::: "memory");
        }
    }
    __syncthreads();
}

struct Frame {
    LAS unsigned char* lds;
    volatile LAS unsigned* MISC;
    gu32* ctl;
    int tid, lane, wave, wave0;
    int vcu, G;
    const __attribute__((address_space(4))) char* ka;
    float* out;
    unsigned char* ws;
    const __attribute__((address_space(4))) char* ka0; float* out0; unsigned char* ws0;
};
__device__ __forceinline__ void phase_enter(Frame& F) {
    int t_ = opaque_tid(F.wave0); F.tid = t_; F.lane = t_ & 63; F.wave = __builtin_amdgcn_readfirstlane(t_ >> 6);
    unsigned char* w = F.ws0; float* o = F.out0; const __attribute__((address_space(4))) char* k = F.ka0;
    asm volatile("" : "+s"(w), "+s"(o), "+s"(k));
    F.ws = (unsigned char*)(GAS unsigned char*)w; F.out = (float*)(GAS float*)o; F.ka = k; F.ctl = (gu32*)w;
}
#define WSP(T_, off) ((T_*)(GAS T_*)(F.ws + (off)))
#define FIN(i) ((const float*)(const GAS float*)(*(const float* const __attribute__((address_space(4)))*)(F.ka + 8 * (i))))
enum { IN_X = 0, IN_C, IN_NMG, IN_NFG, IN_ADAW, IN_ADAB, IN_WIN, IN_FBIAS, IN_WO, IN_POOLW, IN_POOLS, IN_RW, IN_RB, IN_W1, IN_W3, IN_W2, IN_NFIN };

__device__ __forceinline__ void transpose_item(const float* W, int ld, int k0, bf16* WT, int Kd, int dst_row0, LAS float* scr, int lane) {
    float tv[64];
    const GAS float* wp = GCP(float, W) + (size_t)(k0 + 2 * (lane >> 5)) * ld + (lane & 31);
#pragma unroll
    for (int i = 0; i < 32; ++i) { tv[2 * i] = wp[(size_t)(4 * i) * ld]; tv[2 * i + 1] = wp[(size_t)(4 * i + 1) * ld]; }
    LAS unsigned* su = (LAS unsigned*)scr;
#pragma unroll
    for (int i = 0; i < 32; ++i) su[(2 * i + (lane >> 5)) * 33 + (lane & 31)] = pk2(tv[2 * i], tv[2 * i + 1]);
    LDS_WAIT(); asm volatile("" ::: "memory");
    const int c = lane & 15;
#pragma unroll
    for (int j = 0; j < 8; ++j) { const int n = (lane >> 4) + 4 * j; const LAS unsigned* s = su + (4 * c) * 33 + n;
        v4u o; o.x = s[0 * 33]; o.y = s[1 * 33]; o.z = s[2 * 33]; o.w = s[3 * 33];
        *(GAS v4u*)(WT + (size_t)(dst_row0 + n) * Kd + k0 + 8 * c) = o; }
    LDS_WAIT(); asm volatile("" ::: "memory");
}
__device__ __forceinline__ void p0_prologue(Frame& F) {
    if (F.vcu < 192) {
        const float* cin = FIN(IN_C); const float* adaw = FIN(IN_ADAW); const float* adab = FIN(IN_ADAB);
        LAS float* cact = (LAS float*)(F.lds);
        LAS float* red = (LAS float*)(F.lds + 32768);
        for (int i = F.tid; i < 8 * 1024; i += 512) { const int bb = i >> 10, k = i & 1023; const float v = cin[i]; cact[k * 8 + bb] = v / (1.0f + __expf(-v)); }
        __syncthreads();
        const int l = F.vcu / 96, col0 = (F.vcu % 96) * 64;
        const float* wp = adaw + (size_t)l * D * MODW + col0 + F.lane;
        float a0 = 0.f, a1 = 0.f, a2 = 0.f, a3 = 0.f, a4 = 0.f, a5 = 0.f, a6 = 0.f, a7 = 0.f;
        const int kb = F.wave * 128;
#pragma unroll 16
        for (int k = 0; k < 128; ++k) { const float wv = GCP(float, wp)[(size_t)(kb + k) * MODW]; const f32x4 c0 = *(const LAS f32x4*)(cact + (kb + k) * 8), c1 = *(const LAS f32x4*)(cact + (kb + k) * 8 + 4);
            a0 += c0[0] * wv; a1 += c0[1] * wv; a2 += c0[2] * wv; a3 += c0[3] * wv; a4 += c1[0] * wv; a5 += c1[1] * wv; a6 += c1[2] * wv; a7 += c1[3] * wv; }
        LAS float* rw = red + F.wave * 512 + F.lane;
        rw[0] = a0; rw[64] = a1; rw[128] = a2; rw[192] = a3; rw[256] = a4; rw[320] = a5; rw[384] = a6; rw[448] = a7;
        __syncthreads();
        { const int bb = F.tid >> 6, col = F.tid & 63; float s = 0.f;
#pragma unroll
          for (int w = 0; w < 8; ++w) s += red[w * 512 + bb * 64 + col];
          __hip_atomic_store((gu32*)(F.ws + WS_MOD) + (((size_t)l * 8 + bb) * MODW + col0 + col), __float_as_uint(s + adab[l * MODW + col0 + col]), RLX_AGENT); }
        __syncthreads();
    }
    { const float* rw = FIN(IN_RW);
      for (int e = F.vcu * 512 + F.tid; e < 8192; e += F.G * 512) { const int ln = e & 63, hl = (e >> 6) & 1, c = (e >> 7) & 3, nt = (e >> 9) & 1, ww = e >> 10;
          const float* wb = rw + (size_t)(128 * ww + 32 * c + 8 * (ln >> 4)) * NE + 16 * nt + (ln & 15); float wv[8];
#pragma unroll
          for (int j = 0; j < 8; ++j) wv[j] = wb[j * NE];
          v4u hw; hw.x = pk2(wv[0], wv[1]); hw.y = pk2(wv[2], wv[3]); hw.z = pk2(wv[4], wv[5]); hw.w = pk2(wv[6], wv[7]);
          if (hl) { v4u lw; lw.x = pk2(wv[0] - bflo(hw.x), wv[1] - bfhi(hw.x)); lw.y = pk2(wv[2] - bflo(hw.y), wv[3] - bfhi(hw.y)); lw.z = pk2(wv[4] - bflo(hw.z), wv[5] - bfhi(hw.z)); lw.w = pk2(wv[6] - bflo(hw.w), wv[7] - bfhi(hw.w)); hw = lw; }
          WSP(v4u, WS_RWF)[e] = hw; } }
    { const float* fw = FIN(IN_WIN);
      for (int e = F.vcu * 512 + F.tid; e < 4096; e += F.G * 512) { const int ln = e & 63, hl = (e >> 6) & 1, c = (e >> 7) & 3, ww = e >> 9;
          const float* wb = fw + (size_t)(128 * ww + 32 * c + 8 * (ln >> 4)) * WIN_LD + 3 * D + (ln & 15); float wv[8];
#pragma unroll
          for (int j = 0; j < 8; ++j) wv[j] = wb[(size_t)j * WIN_LD];
          v4u hw; hw.x = pk2(wv[0], wv[1]); hw.y = pk2(wv[2], wv[3]); hw.z = pk2(wv[4], wv[5]); hw.w = pk2(wv[6], wv[7]);
          if (hl) { v4u lw; lw.x = pk2(wv[0] - bflo(hw.x), wv[1] - bfhi(hw.x)); lw.y = pk2(wv[2] - bflo(hw.y), wv[3] - bfhi(hw.y)); lw.z = pk2(wv[4] - bflo(hw.z), wv[5] - bfhi(hw.z)); lw.w = pk2(wv[6] - bflo(hw.w), wv[7] - bfhi(hw.w)); hw = lw; }
          ST16_WT(GP(v4u, WSP(v4u, WS_FWF) + e), hw); } }
    if (F.vcu < 32) { asm volatile("s_waitcnt vmcnt(0)" ::: "memory"); __syncthreads(); if (F.tid == 0) (void)__hip_atomic_fetch_add(F.ctl + CW_P1RDY, 1u, RLX_AGENT); }
    { const float* pw = FIN(IN_POOLW);
      for (int e = F.vcu * 512 + F.tid; e < 32768; e += F.G * 512) { const int ln = e & 63, ks = (e >> 6) & 7, t = (e >> 9) & 7, ww = e >> 12, i = ln & 15;
          const int n = 128 * (ww & 1) + 32 * (t >> 1) + 8 * (i >> 2) + 4 * (t & 1) + (i & 3), k0 = 32 * ks + 8 * (ln >> 4);
          const float* wb = pw + (size_t)(ww >> 1) * 65536 + (size_t)k0 * 256 + n;
          v4u hw; hw.x = pk2(wb[0], wb[256]); hw.y = pk2(wb[512], wb[768]); hw.z = pk2(wb[1024], wb[1280]); hw.w = pk2(wb[1536], wb[1792]);
          WSP(v4u, WS_WPF)[e] = hw; } }
    LAS float* scr = (LAS float*)(F.lds + RING_OFF + F.wave * 16384);
    const int gw = F.vcu * NWAVES + F.wave, NGW = F.G * NWAVES;
    constexpr int I_QKV = 8 * 96, I_O = 8 * 32, I_W13 = 8 * 16, I_W2 = 4 * 32;
    constexpr int I_EXP = NLAYER * NE * (2 * I_W13 + I_W2);
    constexpr int NITEMS = I_QKV + I_O + I_EXP;
    constexpr int NV_WAVES = 64 * NWAVES, GV_WAVES = 192 * NWAVES, X_ITEMS = (int)(((long)NITEMS + (long)GV_WAVES * 5 / 4) * NV_WAVES / (NV_WAVES + GV_WAVES));
    const bool gvw = F.vcu < 192; const int it0 = gvw ? X_ITEMS + gw : (gw - GV_WAVES), itN = gvw ? NITEMS : X_ITEMS, itS = gvw ? GV_WAVES : NV_WAVES;
    for (int it = it0; it < itN; it += itS) {
        int r = it;
        if (r < I_QKV) { const int kb = r / 96, nb = r % 96; transpose_item(FIN(IN_WIN) + 32 * nb, WIN_LD, 128 * kb, WSP(bf16, WS_WQKV), D, 32 * nb, scr, F.lane); continue; } r -= I_QKV;
        if (r < I_O) { const int kb = r / 32, nb = r % 32; transpose_item(FIN(IN_WO) + 32 * nb, D, 128 * kb, WSP(bf16, WS_WO), D, 32 * nb, scr, F.lane); continue; } r -= I_O;

        { const int per = 2 * I_W13 + I_W2; const int le = r / per; int q = r % per;
          if (q < 2 * I_W13) { const int which = q / I_W13; q %= I_W13; const int kb = q / 16, nb = q % 16, n0 = 32 * nb;
              const float* src = (which ? FIN(IN_W3) : FIN(IN_W1)) + (size_t)le * D * FD + n0;
              transpose_item(src, FD, 128 * kb, WSP(bf16, ws_up(le >> 5)) + (size_t)(le & 31) * 1024 * 1024, D, 256 * (n0 >> 7) + (n0 & 127) + 128 * which, scr, F.lane); }
          else { q -= 2 * I_W13; const int kb = q / 32, nb = q % 32;
              transpose_item(FIN(IN_W2) + (size_t)le * FD * D + 32 * nb, D, 128 * kb, WSP(bf16, ws_dn(le >> 5)) + (size_t)(le & 31) * 1024 * 512, FD, 32 * nb, scr, F.lane); } }
    }
    __syncthreads();
}

__device__ __forceinline__ unsigned pack_tg(int t2, float g) { return ((unsigned)t2 << 16) | (unsigned)__builtin_rintf(g * 65535.0f); }

struct RowArgs { const float* src; float* dst; const float* g; const float* shp; const float* scp; const float* gtp; const bf16* y2; bf16* hb;
                 const void* wfrag; const float* bias; float* logf; gu32* cnt; int* tok; float* gw; };
template <int MODE>
__device__ __forceinline__ void rowpass(Frame& F, const RowArgs& A) {
    constexpr int NT = (MODE == 0) ? 1 : (MODE == 1 ? 2 : 0);
    const int lane = F.lane, w = F.wave, r = lane & 15, q = lane >> 4, tid = F.tid;
    const int R0 = F.vcu * 128, b = R0 >> 12;
    const int kb = 128 * w + 8 * q;
    LAS float* red = (LAS float*)(F.lds);
    LAS f32x4* part = (LAS f32x4*)(F.lds + 1024);
    LAS float* scS = (LAS float*)(F.lds + 1024 + 32768);
    LAS float* selS = scS + 512;
    LAS unsigned* lcnt = (LAS unsigned*)(F.lds + 37888); LAS unsigned* lbase = lcnt + 32; LAS float* selAll = (LAS float*)(F.lds + SELALL_OFF);
    if (MODE == 1 && tid < 32) lcnt[tid] = 0u;
    LAS float* GM = (LAS float*)(F.lds + (MODE == 0 ? 69632 : 65536)); LAS float* SH = GM + 1024; LAS float* GT = SH + 1024;
    for (int k = tid; k < D; k += 512) { const float g1 = A.g[k];
        if (MODE < 3) { GM[k] = g1 * (1.0f + A.scp[(size_t)b * MODW + k]); SH[k] = A.shp[(size_t)b * MODW + k]; } else { GM[k] = g1; SH[k] = 0.f; }
        GT[k] = (MODE >= 2) ? A.gtp[(size_t)b * MODW + k] : 0.f; }
    __syncthreads();
    bf16x8 Bh[NT > 0 ? NT : 1][4], Bl[NT > 0 ? NT : 1][4];
    if (NT > 0) { const v4u* wf = (const v4u*)A.wfrag + (size_t)w * (NT * 512) + lane;
#pragma unroll
        for (int nt = 0; nt < NT; ++nt)
#pragma unroll
            for (int c = 0; c < 4; ++c) { Bh[nt][c] = __builtin_bit_cast(bf16x8, GCP(v4u, wf)[((nt * 4 + c) * 2 + 0) * 64]); Bl[nt][c] = __builtin_bit_cast(bf16x8, GCP(v4u, wf)[((nt * 4 + c) * 2 + 1) * 64]); }
    }
    f32x4 xa[4][2], xb[4][2]; v4u yaa[4], yab[4], yba[4], ybb[4];
#define RP_LOAD(it_, xn, yna, ynb) do { const int row_ = R0 + 16 * (it_) + r; const float* xs_ = A.src + (size_t)row_ * D + kb; \
        if (MODE == 3) { const bf16* xq_ = (const bf16*)A.src + (size_t)row_ * D + kb; _Pragma("unroll") for (int c = 0; c < 4; ++c) xn[c][0] = __builtin_bit_cast(f32x4, *GCP(v4u, xq_ + 32 * c)); } \
        else { _Pragma("unroll") for (int c = 0; c < 4; ++c) { xn[c][0] = *GCP(f32x4, xs_ + 32 * c); xn[c][1] = *GCP(f32x4, xs_ + 32 * c + 4); } } \
        if (MODE >= 2) { const bf16* yp_ = A.y2 + (size_t)row_ * 2 * D + kb; _Pragma("unroll") for (int c = 0; c < 4; ++c) { yna[c] = *GCP(v4u, yp_ + 32 * c); ynb[c] = *GCP(v4u, yp_ + D + 32 * c); } } } while (0)
    RP_LOAD(0, xa, yaa, yab); RP_LOAD(1, xb, yba, ybb);
    auto tile = [&](const int it, f32x4 (&xn)[4][2], v4u (&yna)[4], v4u (&ynb)[4]) __attribute__((always_inline)) {
        const int row = R0 + 16 * it + r, buf = it & 1;
        f32x4 xv[4][2]; v4u yva[4], yvb[4];
#pragma unroll
        for (int c = 0; c < 4; ++c) {
            if (MODE == 3) { const v4u xw = __builtin_bit_cast(v4u, xn[c][0]); xv[c][0] = (f32x4){bflo(xw.x), bfhi(xw.x), bflo(xw.y), bfhi(xw.y)}; xv[c][1] = (f32x4){bflo(xw.z), bfhi(xw.z), bflo(xw.w), bfhi(xw.w)}; }
            else { xv[c][0] = xn[c][0]; xv[c][1] = xn[c][1]; }
            if (MODE >= 2) { yva[c] = yna[c]; yvb[c] = ynb[c]; } }
        if (it < 6) RP_LOAD(it + 2, xn, yna, ynb);
        if (MODE >= 2) {
#pragma unroll
            for (int c = 0; c < 4; ++c) { const v4u ya = yva[c], yb = yvb[c];
                f32x4 s0, s1;
                s0[0] = bflo(ya.x) + bflo(yb.x); s0[1] = bfhi(ya.x) + bfhi(yb.x); s0[2] = bflo(ya.y) + bflo(yb.y); s0[3] = bfhi(ya.y) + bfhi(yb.y);
                s1[0] = bflo(ya.z) + bflo(yb.z); s1[1] = bfhi(ya.z) + bfhi(yb.z); s1[2] = bflo(ya.w) + bflo(yb.w); s1[3] = bfhi(ya.w) + bfhi(yb.w);
                xv[c][0] += *(const LAS f32x4*)(GT + kb + 32 * c) * s0; xv[c][1] += *(const LAS f32x4*)(GT + kb + 32 * c + 4) * s1; }
            if (MODE == 2) { float* xd = A.dst + (size_t)row * D + kb;
#pragma unroll
                for (int c = 0; c < 4; ++c) { *GP(f32x4, xd + 32 * c) = xv[c][0]; *GP(f32x4, xd + 32 * c + 4) = xv[c][1]; } }
        }
        float ss = 0.f;
#pragma unroll
        for (int c = 0; c < 4; ++c)
#pragma unroll
            for (int hf = 0; hf < 2; ++hf) { const f32x4 v = xv[c][hf]; ss += (v[0] * v[0] + v[1] * v[1]) + (v[2] * v[2] + v[3] * v[3]); }
        ss += __int_as_float(__builtin_amdgcn_ds_bpermute((lane ^ 16) << 2, __float_as_int(ss))); ss += __int_as_float(__builtin_amdgcn_ds_bpermute((lane ^ 32) << 2, __float_as_int(ss)));
        if (q == 0) red[buf * 128 + w * 16 + r] = ss;
        LDS_BARRIER();
        float tot = 0.f;
#pragma unroll
        for (int ww = 0; ww < 8; ++ww) tot += red[buf * 128 + ww * 16 + r];
        const float rstd = 1.0f / sqrtf(tot * (1.0f / D) + RMS_EPS);
        if (MODE == 3) { float* xd = A.dst + (size_t)row * D + kb;
#pragma unroll
            for (int c = 0; c < 4; ++c) { *GP(f32x4, xd + 32 * c) = xv[c][0] * rstd * *(const LAS f32x4*)(GM + kb + 32 * c); *GP(f32x4, xd + 32 * c + 4) = xv[c][1] * rstd * *(const LAS f32x4*)(GM + kb + 32 * c + 4); }
            return; }
        f32x4 acc[NT > 0 ? NT : 1];
#pragma unroll
        for (int nt = 0; nt < (NT > 0 ? NT : 1); ++nt) acc[nt] = (f32x4){0.f, 0.f, 0.f, 0.f};
        bf16* hp = A.hb + (size_t)row * D + kb;
#pragma unroll
        for (int c = 0; c < 4; ++c) {
            const f32x4 h0 = xv[c][0] * rstd * *(const LAS f32x4*)(GM + kb + 32 * c) + *(const LAS f32x4*)(SH + kb + 32 * c), h1 = xv[c][1] * rstd * *(const LAS f32x4*)(GM + kb + 32 * c + 4) + *(const LAS f32x4*)(SH + kb + 32 * c + 4);
            v4u hw; hw.x = pk2(h0[0], h0[1]); hw.y = pk2(h0[2], h0[3]); hw.z = pk2(h1[0], h1[1]); hw.w = pk2(h1[2], h1[3]);
            *GP(v4u, hp + 32 * c) = hw;
            if (NT > 0) {
                v4u lw; lw.x = pk2(h0[0] - bflo(hw.x), h0[1] - bfhi(hw.x)); lw.y = pk2(h0[2] - bflo(hw.y), h0[3] - bfhi(hw.y));
                lw.z = pk2(h1[0] - bflo(hw.z), h1[1] - bfhi(hw.z)); lw.w = pk2(h1[2] - bflo(hw.w), h1[3] - bfhi(hw.w));
                const bf16x8 ah = __builtin_bit_cast(bf16x8, hw), al = __builtin_bit_cast(bf16x8, lw);
#pragma unroll
                for (int nt = 0; nt < NT; ++nt) {
                    acc[nt] = __builtin_amdgcn_mfma_f32_16x16x32_bf16(ah, Bh[nt][c], acc[nt], 0, 0, 0);
                    acc[nt] = __builtin_amdgcn_mfma_f32_16x16x32_bf16(ah, Bl[nt][c], acc[nt], 0, 0, 0);
                    acc[nt] = __builtin_amdgcn_mfma_f32_16x16x32_bf16(al, Bh[nt][c], acc[nt], 0, 0, 0); }
            }
        }
        if (NT > 0) {
            if (MODE == 0) { part[(it * 8 + w) * 64 + lane] = acc[0]; }
            else {
#pragma unroll
                for (int nt = 0; nt < NT; ++nt) part[((buf * 8 + w) * 2 + nt) * 64 + lane] = acc[nt];
                LDS_BARRIER();
                { const int t = tid & 15, n = tid >> 4; float f = 0.f;
#pragma unroll
                  for (int ww = 0; ww < 8; ++ww) f += ((const LAS float*)&part[((buf * 8 + ww) * 2 + (n >> 4)) * 64 + (n & 15) + 16 * (t >> 2)])[t & 3];
                  selAll[(16 * it + t) * 33 + n] = 1.0f / (1.0f + expf(-f)) + A.bias[n]; }
            }
        }
    };
    for (int it = 0; it < 8; it += 2) { tile(it, xa, yaa, yab); tile(it + 1, xb, yba, ybb); }
    if (MODE == 0) {
        LDS_BARRIER();
        for (int e = tid; e < 2048; e += 512) { const int n = e >> 7, tl = e & 127, itt = tl >> 4, t = tl & 15; float f = 0.f;
#pragma unroll
            for (int ww = 0; ww < 8; ++ww) f += ((const LAS float*)&part[(itt * 8 + ww) * 64 + n + 16 * (t >> 2)])[t & 3];
            const float z = f + A.bias[n]; const float lf = fminf(z, 0.f) - log1pf(__expf(-fabsf(z)));
            GP(float, A.logf)[((size_t)b * H + n) * SEQ + ((R0 + tl) & (SEQ - 1))] = lf; }
    }
    if (MODE == 1) {
    LDS_BARRIER();
    int re0 = 0, re1 = 0; unsigned rk0 = 0u, rk1 = 0u; float rg0 = 0.f, rg1 = 0.f;
    if (tid < 128) { const LAS float* sl = selAll + tid * 33; float bg = -INFINITY; int gi = 0;
        for (int g = 0; g < 4; ++g) { float m1 = -INFINITY, m2 = -INFINITY;
            for (int i = 0; i < 8; ++i) { const float v = sl[8 * g + i]; if (v > m1) { m2 = m1; m1 = v; } else if (v > m2) m2 = v; }
            const float gs = m1 + m2; if (gs > bg) { bg = gs; gi = g; } }
        int i1 = 0, i2 = 0; float v1 = -INFINITY, v2 = -INFINITY;
        for (int i = 0; i < 8; ++i) { const float v = sl[8 * gi + i]; if (v > v1) { v1 = v; i1 = i; } }
        for (int i = 0; i < 8; ++i) { const float v = sl[8 * gi + i]; if (i != i1 && v > v2) { v2 = v; i2 = i; } }
        re0 = 8 * gi + i1; re1 = 8 * gi + i2; const float s0 = v1 - A.bias[re0], s1 = v2 - A.bias[re1], inv = 1.0f / (s0 + s1); rg0 = s0 * inv; rg1 = s1 * inv;
        rk0 = __hip_atomic_fetch_add(lcnt + re0, 1u, __ATOMIC_RELAXED, __HIP_MEMORY_SCOPE_WORKGROUP); rk1 = __hip_atomic_fetch_add(lcnt + re1, 1u, __ATOMIC_RELAXED, __HIP_MEMORY_SCOPE_WORKGROUP); }
    LDS_BARRIER();
    if (tid < 32) lbase[tid] = __hip_atomic_fetch_add(A.cnt + tid * 64, lcnt[tid], RLX_AGENT);
    LDS_BARRIER();
    if (tid < 128) { const unsigned p0 = lbase[re0] + rk0, p1 = lbase[re1] + rk1; const int rt = R0 + tid;
        GP(int, A.tok)[re0 * ECAP + p0] = rt * 2; GP(unsigned, A.gw)[re0 * ECAP + p0] = pack_tg(rt * 2, rg0); GP(int, A.tok)[re1 * ECAP + p1] = rt * 2 + 1; GP(unsigned, A.gw)[re1 * ECAP + p1] = pack_tg(rt * 2 + 1, rg1); }
    }
    __syncthreads();
#undef RP_LOAD
}

__device__ __forceinline__ void wave_sum2(float& a, float& b) {
#define WS_DPP(x, c_) __int_as_float(__builtin_amdgcn_update_dpp(0, __float_as_int(x), (c_), 0xf, 0xf, false))
    a += WS_DPP(a, 0xB1); b += WS_DPP(b, 0xB1); a += WS_DPP(a, 0x4E); b += WS_DPP(b, 0x4E); a += WS_DPP(a, 0x141); b += WS_DPP(b, 0x141); a += WS_DPP(a, 0x140); b += WS_DPP(b, 0x140);
#undef WS_DPP
    { auto p = __builtin_amdgcn_permlane16_swap(__float_as_uint(a), __float_as_uint(a), false, false); a = __uint_as_float(p[0]) + __uint_as_float(p[1]);
      auto q = __builtin_amdgcn_permlane16_swap(__float_as_uint(b), __float_as_uint(b), false, false); b = __uint_as_float(q[0]) + __uint_as_float(q[1]); }
    { auto p = __builtin_amdgcn_permlane32_swap(__float_as_uint(a), __float_as_uint(a), false, false); a = __uint_as_float(p[0]) + __uint_as_float(p[1]);
      auto q = __builtin_amdgcn_permlane32_swap(__float_as_uint(b), __float_as_uint(b), false, false); b = __uint_as_float(q[0]) + __uint_as_float(q[1]); }
}
template <int MODE>
__device__ __forceinline__ void rowpass_s(Frame& F, const RowArgs& A) {
    typedef unsigned v2u __attribute__((ext_vector_type(2)));
    constexpr int NT = (MODE == 0) ? 1 : 2;
    constexpr int HP = 2064;
    const int lane = F.lane, w = F.wave, r = lane & 15, q = lane >> 4, tid = F.tid;
    const int R0 = F.vcu * 128, b = R0 >> 12, l5 = lane & 31, up = lane >> 5, c0 = 8 * l5 + 4 * up, cw = 256 * up + 8 * l5;
    LAS f32x4* part = (LAS f32x4*)(F.lds + 1024);
    LAS unsigned char* hiT = F.lds + 34816; LAS unsigned char* loT = hiT + 16 * HP;
    LAS unsigned* lcnt = (LAS unsigned*)(F.lds + 101376); LAS unsigned* lbase = lcnt + 32; LAS float* selAll = (LAS float*)(F.lds + SELALL_OFF);
    if (MODE == 1 && tid < 32) lcnt[tid] = 0u;
    f32x4 xa[2][4], xb[2][4];
#define RS_LOAD(it_, X) do { _Pragma("unroll") for (int j = 0; j < 2; ++j) { const size_t ro_ = (size_t)(R0 + 16 * (it_) + 2 * w + j) * D + c0; \
        if (MODE == 1) { const bf16* xq_ = (const bf16*)A.src + (ro_ - c0 + cw); _Pragma("unroll") for (int p = 0; p < 2; ++p) { const v4u t_ = *GCP(v4u, xq_ + 512 * p); \
                X[j][2 * p][0] = __uint_as_float(t_.x); X[j][2 * p][1] = __uint_as_float(t_.y); X[j][2 * p + 1][0] = __uint_as_float(t_.z); X[j][2 * p + 1][1] = __uint_as_float(t_.w); } } \
        else { const float* xs_ = A.src + ro_; _Pragma("unroll") for (int m = 0; m < 4; ++m) X[j][m] = *GCP(f32x4, xs_ + 256 * m); } } } while (0)
    RS_LOAD(0, xa); RS_LOAD(1, xb);
    f32x4 gm[4], sh[4];
#pragma unroll
    for (int m = 0; m < 4; ++m) { const f32x4 g1 = *GCP(f32x4, A.g + c0 + 256 * m), sc = *GCP(f32x4, A.scp + (size_t)b * MODW + c0 + 256 * m); gm[m] = g1 * (sc + 1.0f); sh[m] = *GCP(f32x4, A.shp + (size_t)b * MODW + c0 + 256 * m); }
    bf16x8 Bh[NT][4], Bl[NT][4];
    { const v4u* wf = (const v4u*)A.wfrag + (size_t)w * (NT * 512) + lane;
#pragma unroll
      for (int nt = 0; nt < NT; ++nt)
#pragma unroll
          for (int c = 0; c < 4; ++c) { Bh[nt][c] = __builtin_bit_cast(bf16x8, GCP(v4u, wf)[((nt * 4 + c) * 2 + 0) * 64]); Bl[nt][c] = __builtin_bit_cast(bf16x8, GCP(v4u, wf)[((nt * 4 + c) * 2 + 1) * 64]); } }
    __syncthreads();
    auto tile = [&](const int it, f32x4 (&X)[2][4]) __attribute__((always_inline)) {
        const int buf = it & 1;
        f32x4 xv[2][4]; float ss[2];
#pragma unroll
        for (int j = 0; j < 2; ++j) { ss[j] = 0.f;
            if (MODE == 1) {
#pragma unroll
                for (int p = 0; p < 2; ++p) { unsigned a0 = __float_as_uint(X[j][2 * p][0]), a1 = __float_as_uint(X[j][2 * p][1]), b0 = __float_as_uint(X[j][2 * p + 1][0]), b1 = __float_as_uint(X[j][2 * p + 1][1]);
                    { auto s0 = __builtin_amdgcn_permlane32_swap(a0, b0, false, false); a0 = s0[0]; b0 = s0[1]; auto s1 = __builtin_amdgcn_permlane32_swap(a1, b1, false, false); a1 = s1[0]; b1 = s1[1]; }
                    X[j][2 * p] = (f32x4){bflo(a0), bfhi(a0), bflo(a1), bfhi(a1)}; X[j][2 * p + 1] = (f32x4){bflo(b0), bfhi(b0), bflo(b1), bfhi(b1)}; } }
#pragma unroll
            for (int m = 0; m < 4; ++m) { const f32x4 t = X[j][m];
                xv[j][m] = t; ss[j] += (t[0] * t[0] + t[1] * t[1]) + (t[2] * t[2] + t[3] * t[3]); } }
        if (it < 6) RS_LOAD(it + 2, X);
        wave_sum2(ss[0], ss[1]);
#pragma unroll
        for (int j = 0; j < 2; ++j) { const float rstd = 1.0f / sqrtf(ss[j] * (1.0f / D) + RMS_EPS); const int trow = 2 * w + j;
            bf16* hp = A.hb + (size_t)(R0 + 16 * it + trow) * D + cw;
#pragma unroll
            for (int p = 0; p < 2; ++p) { v2u hw[2], lw[2];
#pragma unroll
                for (int e = 0; e < 2; ++e) { const f32x4 h = xv[j][2 * p + e] * rstd * gm[2 * p + e] + sh[2 * p + e];
                    hw[e].x = pk2(h[0], h[1]); hw[e].y = pk2(h[2], h[3]);
                    lw[e].x = pk2(h[0] - bflo(hw[e].x), h[1] - bfhi(hw[e].x)); lw[e].y = pk2(h[2] - bflo(hw[e].y), h[3] - bfhi(hw[e].y)); }
                v4u ho, lo;
                { auto s0 = __builtin_amdgcn_permlane32_swap(hw[0].x, hw[1].x, false, false), s1 = __builtin_amdgcn_permlane32_swap(hw[0].y, hw[1].y, false, false); ho.x = s0[0]; ho.z = s0[1]; ho.y = s1[0]; ho.w = s1[1]; }
                { auto s0 = __builtin_amdgcn_permlane32_swap(lw[0].x, lw[1].x, false, false), s1 = __builtin_amdgcn_permlane32_swap(lw[0].y, lw[1].y, false, false); lo.x = s0[0]; lo.z = s0[1]; lo.y = s1[0]; lo.w = s1[1]; }
                *GP(v4u, hp + 512 * p) = ho;
                *(LAS v4u*)(hiT + trow * HP + (cw + 512 * p) * 2) = ho; *(LAS v4u*)(loT + trow * HP + (cw + 512 * p) * 2) = lo; } }
        LDS_BARRIER();
        f32x4 acc[NT];
#pragma unroll
        for (int nt = 0; nt < NT; ++nt) acc[nt] = (f32x4){0.f, 0.f, 0.f, 0.f};
#pragma unroll
        for (int c = 0; c < 4; ++c) { const bf16x8 ah = *(const LAS bf16x8*)(hiT + r * HP + (128 * w + 32 * c + 8 * q) * 2), al = *(const LAS bf16x8*)(loT + r * HP + (128 * w + 32 * c + 8 * q) * 2);
#pragma unroll
            for (int nt = 0; nt < NT; ++nt) {
                acc[nt] = __builtin_amdgcn_mfma_f32_16x16x32_bf16(ah, Bh[nt][c], acc[nt], 0, 0, 0);
                acc[nt] = __builtin_amdgcn_mfma_f32_16x16x32_bf16(ah, Bl[nt][c], acc[nt], 0, 0, 0);
                acc[nt] = __builtin_amdgcn_mfma_f32_16x16x32_bf16(al, Bh[nt][c], acc[nt], 0, 0, 0); } }
#pragma unroll
        for (int nt = 0; nt < NT; ++nt) part[((buf * 8 + w) * NT + nt) * 64 + lane] = acc[nt];
        LDS_BARRIER();
        if (MODE == 1) { const int t = tid & 15, n = tid >> 4; float f = 0.f;
#pragma unroll
            for (int ww = 0; ww < 8; ++ww) f += ((const LAS float*)&part[((buf * 8 + ww) * 2 + (n >> 4)) * 64 + (n & 15) + 16 * (t >> 2)])[t & 3];
            selAll[(16 * it + t) * 33 + n] = 1.0f / (1.0f + expf(-f)) + A.bias[n]; }
        else if (tid < 256) { const int t = tid & 15, n = tid >> 4; float f = 0.f;
#pragma unroll
            for (int ww = 0; ww < 8; ++ww) f += ((const LAS float*)&part[(buf * 8 + ww) * 64 + n + 16 * (t >> 2)])[t & 3];
            const float z = f + A.bias[n]; const float lf = fminf(z, 0.f) - log1pf(__expf(-fabsf(z)));
            GP(float, A.logf)[((size_t)b * H + n) * SEQ + ((R0 + 16 * it + t) & (SEQ - 1))] = lf; }
    };
    for (int it = 0; it < 8; it += 2) { tile(it, xa); tile(it + 1, xb); }
#undef RS_LOAD
    if (MODE == 1) {
    LDS_BARRIER();
    int re0 = 0, re1 = 0; unsigned rk0 = 0u, rk1 = 0u; float rg0 = 0.f, rg1 = 0.f;
    if (tid < 128) { const LAS float* sl = selAll + tid * 33; float bg = -INFINITY; int gi = 0;
        for (int g = 0; g < 4; ++g) { float m1 = -INFINITY, m2 = -INFINITY;
            for (int i = 0; i < 8; ++i) { const float v = sl[8 * g + i]; if (v > m1) { m2 = m1; m1 = v; } else if (v > m2) m2 = v; }
            const float gs = m1 + m2; if (gs > bg) { bg = gs; gi = g; } }
        int i1 = 0, i2 = 0; float v1 = -INFINITY, v2 = -INFINITY;
        for (int i = 0; i < 8; ++i) { const float v = sl[8 * gi + i]; if (v > v1) { v1 = v; i1 = i; } }
        for (int i = 0; i < 8; ++i) { const float v = sl[8 * gi + i]; if (i != i1 && v > v2) { v2 = v; i2 = i; } }
        re0 = 8 * gi + i1; re1 = 8 * gi + i2; const float s0 = v1 - A.bias[re0], s1 = v2 - A.bias[re1], inv = 1.0f / (s0 + s1); rg0 = s0 * inv; rg1 = s1 * inv;
        rk0 = __hip_atomic_fetch_add(lcnt + re0, 1u, __ATOMIC_RELAXED, __HIP_MEMORY_SCOPE_WORKGROUP); rk1 = __hip_atomic_fetch_add(lcnt + re1, 1u, __ATOMIC_RELAXED, __HIP_MEMORY_SCOPE_WORKGROUP); }
    LDS_BARRIER();
    if (tid < 32) lbase[tid] = __hip_atomic_fetch_add(A.cnt + tid * 64, lcnt[tid], RLX_AGENT);
    LDS_BARRIER();
    if (tid < 128) { const unsigned p0 = lbase[re0] + rk0, p1 = lbase[re1] + rk1; const int rt = R0 + tid;
        GP(int, A.tok)[re0 * ECAP + p0] = rt * 2; GP(unsigned, A.gw)[re0 * ECAP + p0] = pack_tg(rt * 2, rg0); GP(int, A.tok)[re1 * ECAP + p1] = rt * 2 + 1; GP(unsigned, A.gw)[re1 * ECAP + p1] = pack_tg(rt * 2 + 1, rg1); }
    }
}

__device__ __forceinline__ void final_pass(Frame& F, const RowArgs& A) {
    typedef unsigned v2u __attribute__((ext_vector_type(2)));
    const int lane = F.lane, w = F.wave;
    const int RW = F.vcu * 128 + w * 16, b = (F.vcu * 128) >> 12, c0 = 4 * lane;
    v2u xA[2][4], yA0[2][4], yA1[2][4], xB[2][4], yB0[2][4], yB1[2][4];
#define FP_LOAD(st_, X, Y0, Y1) do { _Pragma("unroll") for (int j = 0; j < 2; ++j) { const size_t row_ = (size_t)(RW + 2 * (st_) + j); \
        const bf16* xp_ = (const bf16*)A.src + row_ * D + c0; const bf16* yp_ = A.y2 + row_ * 2 * D + c0; \
        _Pragma("unroll") for (int m = 0; m < 4; ++m) { X[j][m] = *GCP(v2u, xp_ + 256 * m); Y0[j][m] = *GCP(v2u, yp_ + 256 * m); Y1[j][m] = *GCP(v2u, yp_ + D + 256 * m); } } } while (0)
    FP_LOAD(0, xA, yA0, yA1); FP_LOAD(1, xB, yB0, yB1);
    f32x4 gm[4], gt[4];
#pragma unroll
    for (int m = 0; m < 4; ++m) { gm[m] = *GCP(f32x4, A.g + c0 + 256 * m); gt[m] = *GCP(f32x4, A.gtp + (size_t)b * MODW + c0 + 256 * m); }
    auto step = [&](const int st, v2u (&X)[2][4], v2u (&Y0)[2][4], v2u (&Y1)[2][4]) __attribute__((always_inline)) {
        f32x4 v[2][4]; float ss[2];
#pragma unroll
        for (int j = 0; j < 2; ++j) { ss[j] = 0.f;
#pragma unroll
            for (int m = 0; m < 4; ++m) { const v2u x = X[j][m], a = Y0[j][m], c = Y1[j][m];
                f32x4 s; s[0] = bflo(a.x) + bflo(c.x); s[1] = bfhi(a.x) + bfhi(c.x); s[2] = bflo(a.y) + bflo(c.y); s[3] = bfhi(a.y) + bfhi(c.y);
                f32x4 t; t[0] = bflo(x.x); t[1] = bfhi(x.x); t[2] = bflo(x.y); t[3] = bfhi(x.y);
                t += gt[m] * s; v[j][m] = t; ss[j] += (t[0] * t[0] + t[1] * t[1]) + (t[2] * t[2] + t[3] * t[3]); } }
        if (st < 6) FP_LOAD(st + 2, X, Y0, Y1);
        wave_sum2(ss[0], ss[1]);
#pragma unroll
        for (int j = 0; j < 2; ++j) { const float rstd = 1.0f / sqrtf(ss[j] * (1.0f / D) + RMS_EPS); float* op = A.dst + (size_t)(RW + 2 * st + j) * D + c0;
#pragma unroll
            for (int m = 0; m < 4; ++m) *GP(f32x4, op + 256 * m) = v[j][m] * rstd * gm[m]; }
    };
    for (int st = 0; st < 8; st += 2) { step(st, xA, yA0, yA1); step(st + 1, xB, yB0, yB1); }
#undef FP_LOAD
}

struct MixArgs { const float* src; float* dst; const bf16* y2; bf16* hb; const bf16* wp; const float* g1; const float* sh1; const float* sc1; const float* gt0; const float* gtp; const float* ps;
                 const float* g2; const float* sh2; const float* sc2; const void* rwf; const float* bias; gu32* cnt; int* tok; float* gw; };
__device__ __forceinline__ void mixer_pass(Frame& F, const MixArgs& A) {
    const int lane = F.lane, w = F.wave, r = lane & 15, q = lane >> 4, tid = F.tid;
    const int R0 = F.vcu * 128, b = R0 >> 12;
    const int kb = 128 * w + 8 * q, grp = w >> 1, hf = w & 1, win = 2 << grp;
    LAS float* red = (LAS float*)(F.lds);
    LAS f32x4* part = (LAS f32x4*)(F.lds + 1024);
    LAS float* scS = (LAS float*)(F.lds + 1024 + 32768);
    LAS float* selS = scS + 512;
    LAS unsigned* lcnt = (LAS unsigned*)(F.lds + 37888); LAS unsigned* lbase = lcnt + 32; LAS float* selAll = (LAS float*)(F.lds + SELALL_OFF);
    if (tid < 32) lcnt[tid] = 0u;
    LAS float* VEC = (LAS float*)(F.lds + 38400);
    constexpr int HRS = 2064;
    LAS unsigned char* hring = F.lds + 62976;
    const bool seq_start = (R0 & (SEQ - 1)) == 0;
    v4u xn[4]; v4u yna[4], ynb[4];
    const unsigned xo0 = (unsigned)(((R0 + r) * D + kb) * 2), yo0 = (unsigned)(((R0 + r) * 2 * D + kb) * 2), ho0 = (unsigned)(((R0 + r) * D + kb) * 2);
#define MXP_LOAD(it_) do { const GAS v4u* xs_ = GCP(v4u, (const char*)A.src + (size_t)(unsigned)((int)xo0 + (it_) * 32768)); const GAS v4u* yp_ = GCP(v4u, (const char*)A.y2 + (size_t)(unsigned)((int)yo0 + (it_) * 65536)); \
        _Pragma("unroll") for (int c = 0; c < 4; ++c) { xn[c] = xs_[4 * c]; yna[c] = yp_[4 * c]; ynb[c] = yp_[128 + 4 * c]; } } while (0)
    MXP_LOAD(seq_start ? 0 : -1);
    for (int k = tid; k < D; k += 512) {
        VEC[k] = A.g1[k] * (1.0f + A.sc1[(size_t)b * MODW + k]); VEC[1024 + k] = A.sh1[(size_t)b * MODW + k]; VEC[2048 + k] = A.gt0[(size_t)b * MODW + k];
        VEC[3072 + k] = A.gtp[(size_t)b * MODW + k] * A.ps[k]; VEC[4096 + k] = A.g2[k] * (1.0f + A.sc2[(size_t)b * MODW + k]); VEC[5120 + k] = A.sh2[(size_t)b * MODW + k]; }
    const v4u* rwf = (const v4u*)A.rwf + (size_t)w * 1024;
    const v4u* wpb = (const v4u*)A.wp + (size_t)w * 4096;
    __syncthreads();
#ifdef MXPROBE
    unsigned long long mx_prev = __builtin_amdgcn_s_memrealtime(), mx_acc = 0ull; int mx_sec = -1;
#define MXT(k) do { const unsigned long long n_ = __builtin_amdgcn_s_memrealtime(); if (mx_sec == MXPROBE) mx_acc += n_ - mx_prev; mx_prev = n_; mx_sec = (k); } while (0)
#else
#define MXT(k) do {} while (0)
#endif
    for (int it = seq_start ? 0 : -1; it < 8; ++it) {
        const int row = R0 + 16 * it + r, buf = it & 1, slot = it & 1;
        unsigned vb_ = (unsigned)(uintptr_t)(VEC + kb), z_ = 0u; asm volatile("" : "+v"(vb_), "+v"(z_));
        const unsigned lz_ = (unsigned)lane + z_; const GAS v4u* wpt = GCP(v4u, wpb + lz_); const GAS v4u* rwt = GCP(v4u, rwf + lz_);
        const LAS float* GM1 = (const LAS float*)vb_ - kb; const LAS float* SH1 = GM1 + 1024; const LAS float* GT0 = GM1 + 2048; const LAS float* GP = GM1 + 3072; const LAS float* GM2 = GM1 + 4096; const LAS float* SH2 = GM1 + 5120;
        MXT(0);
        f32x4 xv[4][2];
#pragma unroll
        for (int c = 0; c < 4; ++c) { const v4u xw = xn[c]; xv[c][0] = (f32x4){bflo(xw.x), bfhi(xw.x), bflo(xw.y), bfhi(xw.y)}; xv[c][1] = (f32x4){bflo(xw.z), bfhi(xw.z), bflo(xw.w), bfhi(xw.w)}; }
#pragma unroll
        for (int c = 0; c < 4; ++c) { const v4u ya = yna[c], yb = ynb[c];
            f32x4 s0, s1;
            s0[0] = bflo(ya.x) + bflo(yb.x); s0[1] = bfhi(ya.x) + bfhi(yb.x); s0[2] = bflo(ya.y) + bflo(yb.y); s0[3] = bfhi(ya.y) + bfhi(yb.y);
            s1[0] = bflo(ya.z) + bflo(yb.z); s1[1] = bfhi(ya.z) + bfhi(yb.z); s1[2] = bflo(ya.w) + bflo(yb.w); s1[3] = bfhi(ya.w) + bfhi(yb.w);
            xv[c][0] += *(const LAS f32x4*)(GT0 + kb + 32 * c) * s0; xv[c][1] += *(const LAS f32x4*)(GT0 + kb + 32 * c + 4) * s1; }
        if (it < 0) MXP_LOAD(0);
        float ss = 0.f;
#pragma unroll
        for (int c = 0; c < 4; ++c)
#pragma unroll
            for (int h2 = 0; h2 < 2; ++h2) { const f32x4 v = xv[c][h2]; ss += (v[0] * v[0] + v[1] * v[1]) + (v[2] * v[2] + v[3] * v[3]); }
        ss += __int_as_float(__builtin_amdgcn_ds_bpermute((lane ^ 16) << 2, __float_as_int(ss))); ss += __int_as_float(__builtin_amdgcn_ds_bpermute((lane ^ 32) << 2, __float_as_int(ss)));
        if (q == 0) red[buf * 128 + w * 16 + r] = ss;
        LDS_BARRIER();
        float tot = 0.f;
#pragma unroll
        for (int ww = 0; ww < 8; ++ww) tot += red[buf * 128 + ww * 16 + r];
        const float rstd1 = 1.0f / sqrtf(tot * (1.0f / D) + RMS_EPS);
        MXT(1);
#pragma unroll
        for (int c = 0; c < 4; ++c) {
            const f32x4 h0 = xv[c][0] * rstd1 * *(const LAS f32x4*)(GM1 + kb + 32 * c) + *(const LAS f32x4*)(SH1 + kb + 32 * c);
            const f32x4 h1 = xv[c][1] * rstd1 * *(const LAS f32x4*)(GM1 + kb + 32 * c + 4) + *(const LAS f32x4*)(SH1 + kb + 32 * c + 4);
            v4u hw; hw.x = pk2(h0[0], h0[1]); hw.y = pk2(h0[2], h0[3]); hw.z = pk2(h1[0], h1[1]); hw.w = pk2(h1[2], h1[3]);
            *(LAS v4u*)(hring + (slot * 16 + r) * HRS + (kb + 32 * c) * 2) = hw; }
        LDS_BARRIER();
        if (it < 0) continue;
        MXT(2);
        if (it < 7) MXP_LOAD(it + 1);
        bf16x8 wfa[8], wfb[8], wfc[8];
#define MX_LOADW(dst, t_) do { _Pragma("unroll") for (int ks = 0; ks < 8; ++ks) dst[ks] = __builtin_bit_cast(bf16x8, wpt[((t_) * 8 + ks) * 64]); } while (0)
        MX_LOADW(wfa, 0); MX_LOADW(wfb, 1); __builtin_amdgcn_sched_barrier(0);
        const int sq = row & (SEQ - 1); const bool sq0 = ((R0 + 16 * it) & (SEQ - 1)) == 0;
        bf16x8 bsum, bid;
        const int r_ = (int)(lz_ & 15u), q_ = (int)(lz_ >> 4);
        { v4u ws_, wi_;
#pragma unroll
          for (int jp = 0; jp < 4; ++jp) { const int rho0 = 8 * q_ + 2 * jp - 16, rho1 = rho0 + 1;
              const bool in0 = (rho0 <= r_) && (rho0 > r_ - win) && (!sq0 || rho0 >= 0), in1 = (rho1 <= r_) && (rho1 > r_ - win) && (!sq0 || rho1 >= 0);
              ws_[jp] = (in0 ? 0x3f80u : 0u) | (in1 ? 0x3f800000u : 0u); wi_[jp] = (rho0 == r_ ? 0x3f80u : 0u) | (rho1 == r_ ? 0x3f800000u : 0u); }
          bsum = __builtin_bit_cast(bf16x8, ws_); bid = __builtin_bit_cast(bf16x8, wi_); }
        const float ic = 1.0f / (float)((sq + 1 < win) ? (sq + 1) : win);
        typedef short v4s_ __attribute__((ext_vector_type(4)));
        const LAS unsigned char* a0 = hring + (((q_ < 2) ? (slot ^ 1) : slot) * 16 + 8 * (q_ & 1) + (r_ >> 2)) * HRS + (256 * grp + 8 * (r_ & 3)) * 2;
#define MX_TR(off_) __builtin_amdgcn_ds_read_tr16_b64_v4i16((LAS v4s_*)(a0 + (off_)))
        bf16x8 pp[8];
#pragma unroll
        for (int ks = 0; ks < 8; ++ks) {
            const v4s_ l1 = MX_TR(ks * 64), h1 = MX_TR(ks * 64 + 4 * HRS), l2 = MX_TR(ks * 64 + 8), h2 = MX_TR(ks * 64 + 8 + 4 * HRS);
            const bf16x8 A1 = (bf16x8){l1[0], l1[1], l1[2], l1[3], h1[0], h1[1], h1[2], h1[3]}, A2 = (bf16x8){l2[0], l2[1], l2[2], l2[3], h2[0], h2[1], h2[2], h2[3]};
            const f32x4 z4 = (f32x4){0.f, 0.f, 0.f, 0.f};
            const f32x4 S1 = __builtin_amdgcn_mfma_f32_16x16x32_bf16(A1, bsum, z4, 0, 0, 0), O1 = __builtin_amdgcn_mfma_f32_16x16x32_bf16(A1, bid, z4, 0, 0, 0);
            const f32x4 S2 = __builtin_amdgcn_mfma_f32_16x16x32_bf16(A2, bsum, z4, 0, 0, 0), O2 = __builtin_amdgcn_mfma_f32_16x16x32_bf16(A2, bid, z4, 0, 0, 0);
            v4u pw; pw.x = pk2(S1[0] * ic - O1[0], S1[1] * ic - O1[1]); pw.y = pk2(S1[2] * ic - O1[2], S1[3] * ic - O1[3]); pw.z = pk2(S2[0] * ic - O2[0], S2[1] * ic - O2[1]); pw.w = pk2(S2[2] * ic - O2[2], S2[3] * ic - O2[3]);
            pp[ks] = __builtin_bit_cast(bf16x8, pw); }
#undef MX_TR
        MXT(3);
#define MX_MMA(src, t_) do { f32x4 acc = (f32x4){0.f, 0.f, 0.f, 0.f}; _Pragma("unroll") for (int ks = 0; ks < 8; ++ks) acc = __builtin_amdgcn_mfma_f32_16x16x32_bf16(src[ks], pp[ks], acc, 0, 0, 0); \
            xv[(t_) >> 1][(t_) & 1] += *(const LAS f32x4*)(GP + kb + 32 * ((t_) >> 1) + 4 * ((t_) & 1)) * acc; } while (0)
        MX_LOADW(wfc, 2); __builtin_amdgcn_sched_barrier(0); MX_MMA(wfa, 0); __builtin_amdgcn_sched_barrier(0);
        MX_LOADW(wfa, 3); __builtin_amdgcn_sched_barrier(0); MX_MMA(wfb, 1); __builtin_amdgcn_sched_barrier(0);
        MX_LOADW(wfb, 4); __builtin_amdgcn_sched_barrier(0); MX_MMA(wfc, 2); __builtin_amdgcn_sched_barrier(0);
        MX_LOADW(wfc, 5); __builtin_amdgcn_sched_barrier(0); MX_MMA(wfa, 3); __builtin_amdgcn_sched_barrier(0);
        MX_LOADW(wfa, 6); __builtin_amdgcn_sched_barrier(0); MX_MMA(wfb, 4); __builtin_amdgcn_sched_barrier(0);
        MX_LOADW(wfb, 7); __builtin_amdgcn_sched_barrier(0); MX_MMA(wfc, 5); __builtin_amdgcn_sched_barrier(0);
        MX_MMA(wfa, 6); __builtin_amdgcn_sched_barrier(0);
        MX_MMA(wfb, 7); __builtin_amdgcn_sched_barrier(0);
#ifdef MX_DUP_W
        { const float zf_ = __uint_as_float(z_);
#define MX_MMA0(src, t_) do { f32x4 acc = (f32x4){0.f, 0.f, 0.f, 0.f}; _Pragma("unroll") for (int ks = 0; ks < 8; ++ks) acc = __builtin_amdgcn_mfma_f32_16x16x32_bf16(src[ks], pp[ks], acc, 0, 0, 0); \
            xv[(t_) >> 1][(t_) & 1] += acc * zf_; } while (0)
        MX_LOADW(wfa, 0); __builtin_amdgcn_sched_barrier(0);
        MX_LOADW(wfb, 1); __builtin_amdgcn_sched_barrier(0); MX_MMA0(wfa, 0); __builtin_amdgcn_sched_barrier(0);
        MX_LOADW(wfa, 2); __builtin_amdgcn_sched_barrier(0); MX_MMA0(wfb, 1); __builtin_amdgcn_sched_barrier(0);
        MX_LOADW(wfb, 3); __builtin_amdgcn_sched_barrier(0); MX_MMA0(wfa, 2); __builtin_amdgcn_sched_barrier(0);
        MX_LOADW(wfa, 4); __builtin_amdgcn_sched_barrier(0); MX_MMA0(wfb, 3); __builtin_amdgcn_sched_barrier(0);
        MX_LOADW(wfb, 5); __builtin_amdgcn_sched_barrier(0); MX_MMA0(wfa, 4); __builtin_amdgcn_sched_barrier(0);
        MX_LOADW(wfa, 6); __builtin_amdgcn_sched_barrier(0); MX_MMA0(wfb, 5); __builtin_amdgcn_sched_barrier(0);
        MX_LOADW(wfb, 7); __builtin_amdgcn_sched_barrier(0); MX_MMA0(wfa, 6); __builtin_amdgcn_sched_barrier(0);
        MX_MMA0(wfb, 7); __builtin_amdgcn_sched_barrier(0);
#undef MX_MMA0
        }
#endif
#undef MX_LOADW
#undef MX_MMA
        MXT(4);
        v4u rfa[2][2], rfb[2][2];
#define MX_LOADR(dst, c_) do { _Pragma("unroll") for (int nt = 0; nt < 2; ++nt) { dst[nt][0] = rwt[((nt * 4 + (c_)) * 2 + 0) * 64]; dst[nt][1] = rwt[((nt * 4 + (c_)) * 2 + 1) * 64]; } } while (0)
        MX_LOADR(rfa, 0); MX_LOADR(rfb, 1); __builtin_amdgcn_sched_barrier(0);
        { GAS v4u* xd = GP(v4u, (char*)A.dst + (size_t)(unsigned)((int)ho0 + it * 32768));
#pragma unroll
          for (int c = 0; c < 4; ++c) { v4u xw; xw.x = pk2(xv[c][0][0], xv[c][0][1]); xw.y = pk2(xv[c][0][2], xv[c][0][3]); xw.z = pk2(xv[c][1][0], xv[c][1][1]); xw.w = pk2(xv[c][1][2], xv[c][1][3]); xd[4 * c] = xw; } }
        MXT(5);
        float s2 = 0.f;
#pragma unroll
        for (int c = 0; c < 4; ++c)
#pragma unroll
            for (int h2 = 0; h2 < 2; ++h2) { const f32x4 v = xv[c][h2]; s2 += (v[0] * v[0] + v[1] * v[1]) + (v[2] * v[2] + v[3] * v[3]); }
        s2 += __int_as_float(__builtin_amdgcn_ds_bpermute((lane ^ 16) << 2, __float_as_int(s2))); s2 += __int_as_float(__builtin_amdgcn_ds_bpermute((lane ^ 32) << 2, __float_as_int(s2)));
        if (q == 0) red[(buf ^ 1) * 128 + w * 16 + r] = s2;
        LDS_BARRIER();
        float tot2 = 0.f;
#pragma unroll
        for (int ww = 0; ww < 8; ++ww) tot2 += red[(buf ^ 1) * 128 + ww * 16 + r];
        const float rstd2 = 1.0f / sqrtf(tot2 * (1.0f / D) + RMS_EPS);
        f32x4 acc2[2]; acc2[0] = (f32x4){0.f, 0.f, 0.f, 0.f}; acc2[1] = (f32x4){0.f, 0.f, 0.f, 0.f};
        GAS v4u* hp2 = GP(v4u, (char*)A.hb + (size_t)(unsigned)((int)ho0 + it * 32768));

#define MX_ROUTE(src, c_) do { const int c = (c_); \
            const f32x4 h0 = xv[c][0] * rstd2 * *(const LAS f32x4*)(GM2 + kb + 32 * c) + *(const LAS f32x4*)(SH2 + kb + 32 * c), h1 = xv[c][1] * rstd2 * *(const LAS f32x4*)(GM2 + kb + 32 * c + 4) + *(const LAS f32x4*)(SH2 + kb + 32 * c + 4); \
            v4u hw; hw.x = pk2(h0[0], h0[1]); hw.y = pk2(h0[2], h0[3]); hw.z = pk2(h1[0], h1[1]); hw.w = pk2(h1[2], h1[3]); \
            hp2[4 * c] = hw; \
            v4u lw; lw.x = pk2(h0[0] - bflo(hw.x), h0[1] - bfhi(hw.x)); lw.y = pk2(h0[2] - bflo(hw.y), h0[3] - bfhi(hw.y)); \
            lw.z = pk2(h1[0] - bflo(hw.z), h1[1] - bfhi(hw.z)); lw.w = pk2(h1[2] - bflo(hw.w), h1[3] - bfhi(hw.w)); \
            const bf16x8 ah = __builtin_bit_cast(bf16x8, hw), al = __builtin_bit_cast(bf16x8, lw); \
            _Pragma("unroll") for (int nt = 0; nt < 2; ++nt) { const bf16x8 bh = __builtin_bit_cast(bf16x8, src[nt][0]), bl = __builtin_bit_cast(bf16x8, src[nt][1]); \
                acc2[nt] = __builtin_amdgcn_mfma_f32_16x16x32_bf16(ah, bh, acc2[nt], 0, 0, 0); \
                acc2[nt] = __builtin_amdgcn_mfma_f32_16x16x32_bf16(ah, bl, acc2[nt], 0, 0, 0); \
                acc2[nt] = __builtin_amdgcn_mfma_f32_16x16x32_bf16(al, bh, acc2[nt], 0, 0, 0); } } while (0)
        MX_ROUTE(rfa, 0); __builtin_amdgcn_sched_barrier(0);
        MX_LOADR(rfa, 2); __builtin_amdgcn_sched_barrier(0); MX_ROUTE(rfb, 1); __builtin_amdgcn_sched_barrier(0);
        MX_LOADR(rfb, 3); __builtin_amdgcn_sched_barrier(0); MX_ROUTE(rfa, 2); __builtin_amdgcn_sched_barrier(0);
        MX_ROUTE(rfb, 3); __builtin_amdgcn_sched_barrier(0);
#undef MX_LOADR
#undef MX_ROUTE
        MXT(6);
        LDS_BARRIER();
#pragma unroll
        for (int nt = 0; nt < 2; ++nt) part[((buf * 8 + w) * 2 + nt) * 64 + lane] = acc2[nt];
        LDS_BARRIER();
        { const int t = tid & 15, n = tid >> 4; float f = 0.f;
#pragma unroll
          for (int ww = 0; ww < 8; ++ww) f += ((const LAS float*)&part[((buf * 8 + ww) * 2 + (n >> 4)) * 64 + (n & 15) + 16 * (t >> 2)])[t & 3];
          selAll[(16 * it + t) * 33 + n] = 1.0f / (1.0f + expf(-f)) + A.bias[n]; }
        MXT(8);
    }
#ifdef MXPROBE
    if (blockIdx.x == 0 && tid == 0) { ((unsigned long long*)(F.ws0 + WS_CTL))[30000] = 0ull; ((unsigned long long*)(F.ws0 + WS_CTL))[30001] = mx_acc; }
#endif
    { const int tid = opaque_tid(F.wave0);
    LAS unsigned* lcnt = (LAS unsigned*)(F.lds + 37888); LAS unsigned* lbase = lcnt + 32; LAS float* selAll = (LAS float*)(F.lds + SELALL_OFF);
    LDS_BARRIER();
    int re0 = 0, re1 = 0; unsigned rk0 = 0u, rk1 = 0u; float rg0 = 0.f, rg1 = 0.f;
    if (tid < 128) { const LAS float* sl = selAll + tid * 33; float bg = -INFINITY; int gi = 0;
        for (int g = 0; g < 4; ++g) { float m1 = -INFINITY, m2 = -INFINITY;
            for (int i = 0; i < 8; ++i) { const float v = sl[8 * g + i]; if (v > m1) { m2 = m1; m1 = v; } else if (v > m2) m2 = v; }
            const float gs = m1 + m2; if (gs > bg) { bg = gs; gi = g; } }
        int i1 = 0, i2 = 0; float v1 = -INFINITY, v2 = -INFINITY;
        for (int i = 0; i < 8; ++i) { const float v = sl[8 * gi + i]; if (v > v1) { v1 = v; i1 = i; } }
        for (int i = 0; i < 8; ++i) { const float v = sl[8 * gi + i]; if (i != i1 && v > v2) { v2 = v; i2 = i; } }
        re0 = 8 * gi + i1; re1 = 8 * gi + i2; const float s0 = v1 - A.bias[re0], s1 = v2 - A.bias[re1], inv = 1.0f / (s0 + s1); rg0 = s0 * inv; rg1 = s1 * inv;
        rk0 = __hip_atomic_fetch_add(lcnt + re0, 1u, __ATOMIC_RELAXED, __HIP_MEMORY_SCOPE_WORKGROUP); rk1 = __hip_atomic_fetch_add(lcnt + re1, 1u, __ATOMIC_RELAXED, __HIP_MEMORY_SCOPE_WORKGROUP); }
    LDS_BARRIER();
    if (tid < 32) lbase[tid] = __hip_atomic_fetch_add(A.cnt + tid * 64, lcnt[tid], RLX_AGENT);
    LDS_BARRIER();
    if (tid < 128) { const unsigned p0 = lbase[re0] + rk0, p1 = lbase[re1] + rk1; const int rt = R0 + tid;
        GP(int, A.tok)[re0 * ECAP + p0] = rt * 2; GP(unsigned, A.gw)[re0 * ECAP + p0] = pack_tg(rt * 2, rg0); GP(int, A.tok)[re1 * ECAP + p1] = rt * 2 + 1; GP(unsigned, A.gw)[re1 * ECAP + p1] = pack_tg(rt * 2 + 1, rg1); }
    }
    __syncthreads();
#undef MXP_LOAD
}

constexpr int UT_E = 64, UT_X = 64 + 320, UT_V = 64 + 640;
__device__ __forceinline__ void build_etab(Frame& F, int layer, gu32* ctr) {
    LAS int* et = (LAS int*)(F.lds + ETAB_OFF);
    if (F.tid < 64) { const int ln = F.tid, e = ln & 31;
        const int c = ln < 32 ? (int)__hip_atomic_load(F.ctl + CW_CNT + (layer * 32 + e) * 64, RLX_AGENT) : 0; const int nt = (c + 255) >> 8;
        int ps = nt;
#pragma unroll
        for (int d = 1; d < 32; d <<= 1) { const int t = __shfl_up(ps, d); if (ln >= d) ps += t; }
        const int ts = ps - nt;
        for (int j = 0; j < nt; ++j) { et[UT_E + ts + j] = e; et[UT_X + ts + j] = e * ECAP + 256 * j; const int rem = c - 256 * j; et[UT_V + ts + j] = rem < 256 ? rem : 256; }
        if (ln == 31) et[0] = ps;
        if (ctr != nullptr && ln == 63) { const unsigned k0 = __hip_atomic_fetch_add(ctr, 2u, RLX_AGENT); et[2] = (int)k0; et[3] = (int)(k0 + 1u); } }
    __syncthreads();
}
struct DenseSched {
    static constexpr bool DYN = false;
    const char* A; const char* Bt; size_t strideA, strideB; int nM, nN, nwg, G, c;
    __device__ __forceinline__ bool next(int i, pg8::Unit& u) const {
        const long L = (long)i * G + c; if (L >= nwg) return false;
        int wgid = (int)L; { const int q = nwg / 8, r = nwg % 8, xcd = wgid % 8, off = wgid / 8; wgid = (xcd < r ? xcd * (q + 1) : r * (q + 1) + (xcd - r) * q) + off; }
        const int nig = 8 * nN, gid = wgid / nig, fm = gid * 8, gsz = (nM - fm) < 8 ? (nM - fm) : 8;
        u.pm = fm + ((wgid % nig) % gsz); u.pn = (wgid % nig) / gsz; u.a = A + (size_t)u.pm * strideA; u.b = Bt + (size_t)u.pn * strideB; u.x0 = 0; u.x1 = 0; u.full = 1; u.hb = 0; return true;
    }
};
template <bool DOWN> struct MoeSched {
    static constexpr bool DYN = false;
    const LAS int* et; const char* A; const char* Bt; int G, v; const int* tok; gu32* ctr;
    static constexpr size_t rowA = DOWN ? (size_t)FD * 2 : (size_t)D * 2, strideE = DOWN ? (size_t)1024 * 512 * 2 : (size_t)1024 * 1024 * 2, stridePn = DOWN ? (size_t)256 * 512 * 2 : (size_t)256 * 1024 * 2;
    __device__ __forceinline__ unsigned mbox(int i) const { return (unsigned)__builtin_amdgcn_readfirstlane(((const volatile LAS int*)et)[2 + i]); }
    __device__ __forceinline__ void mbox_set(int i, unsigned k) const { ((volatile LAS int*)et)[2 + i] = (int)k; }
    __device__ __forceinline__ bool unit_of(unsigned k, pg8::Unit& u) const {
        const int N = et[0] * 4, lp = v, x = G, nfull = N >> (lp + 3), R = N - (nfull << (lp + 3)), nf = nfull << lp, hs = R >> 2;
        if (k >= (unsigned)(nf + hs)) return false;
        int L, hb = 0, full = 1;
        if ((int)k < nf) { const int rd = (int)k >> lp; L = (rd << (lp + 3)) + (x << lp) + ((int)k - (rd << lp)); }
        else { const int hx = x * hs + ((int)k - nf); L = (nfull << (lp + 3)) + (hx >> 1); hb = (hx & 1) * 128; full = 0; }
        const int tile = L >> 2, pn = L & 3; const int e = et[UT_E + tile];
        u.pm = tile; u.pn = pn; u.full = full; u.hb = hb; u.b = Bt + (size_t)e * strideE + (size_t)pn * stridePn;
        if (DOWN) { u.a = A + ((size_t)tile * 256 + hb) * rowA; u.x0 = et[UT_X + tile] + hb; int vr = et[UT_V + tile] - hb; vr = vr < 0 ? 0 : vr; u.x1 = full ? vr : (vr < 128 ? vr : 128); }
        else { u.a = A; u.x0 = pn; u.x1 = tile * 256 + hb; }
        return true;
    }
    __device__ __forceinline__ const int* tok_addr(const pg8::Unit& u, int row) const { const int vv = et[UT_V + u.pm], x = et[UT_X + u.pm], rr = row + u.hb; return tok + x + (rr < vv ? rr : 0); }
    __device__ __forceinline__ unsigned off_of(unsigned entry) const { return (entry >> 1) * (unsigned)(D * 2); }
    __device__ __forceinline__ unsigned row_off(const pg8::Unit& u, int row) const { return off_of((unsigned)*(const GAS int*)tok_addr(u, row)); }
    __device__ __forceinline__ bool next(int i, pg8::Unit& u) const {
        const int N = et[0] * 4, nfull = N / G, R = N - nfull * G; int L, hb = 0, full = 1;
        if (i < nfull) L = i * G + v;
        else if (i == nfull && R > 0) { if (2 * R <= G) { if (v >= 2 * R) return false; L = nfull * G + (v >> 1); hb = (v & 1) * 128; full = 0; } else { if (v >= R) return false; L = nfull * G + v; } }
        else return false;
        const int tile = L >> 2, pn = L & 3; const int e = et[UT_E + tile];
        u.pm = tile; u.pn = pn; u.full = full; u.hb = hb; u.b = Bt + (size_t)e * strideE + (size_t)pn * stridePn;
        if (DOWN) { u.a = A + ((size_t)tile * 256 + hb) * rowA; u.x0 = et[UT_X + tile] + hb; int vr = et[UT_V + tile] - hb; vr = vr < 0 ? 0 : vr; u.x1 = full ? vr : (vr < 128 ? vr : 128); }
        else { u.a = A; u.x0 = pn; u.x1 = tile * 256 + hb; }
        return true;
    }
};
constexpr int N_PHASES = 17;
struct Args { const float* in[17]; float* out; unsigned char* ws; int ph_lo, ph_hi; };
__global__ void __launch_bounds__(NWAVES * 64, 2) fwd_megakernel(Args args) {
    extern __shared__ __attribute__((aligned(16))) unsigned char lds[];
    Frame F;
    F.lds = (LAS unsigned char*)lds;
    F.MISC = (volatile LAS unsigned*)(F.lds + MISC_OFF);
    F.wave0 = __builtin_amdgcn_readfirstlane((int)threadIdx.x >> 6); F.tid = threadIdx.x; F.lane = F.tid & 63; F.wave = F.wave0;
    F.G = gridDim.x; { const int bx = blockIdx.x; F.vcu = (F.G % 8 == 0) ? (bx % 8) * (F.G / 8) + bx / 8 : bx; }
    F.ws0 = args.ws; F.out0 = args.out;
    F.ka0 = (const __attribute__((address_space(4))) char*)__builtin_amdgcn_kernarg_segment_ptr();
    phase_enter(F);
    for (int u = F.tid; u < (LDS_BYTES - LDSCTL_OFF) / 4; u += NWAVES * 64) ((LAS unsigned*)(F.lds + LDSCTL_OFF))[u] = 0u;
    __syncthreads();
    XcdBarrier bar; bar.bar = (unsigned*)(F.ctl + CW_BAR); bar.x = 0; bar.st = nullptr;
    if (!MK_MULTI) bar = xcd_barrier_post((unsigned*)(F.ctl + CW_BAR), F.MISC + 8);
    int lo = args.ph_lo, hi = args.ph_hi;
#ifdef GPROBE
    if (blockIdx.x == GPROBE && opaque_tid(F.wave0) == GPROBE_TID) { pg8::gprobe_acc[0] = 0ull; pg8::gprobe_acc[1] = 0ull; pg8::gprobe_acc[2] = 0ull; pg8::gprobe_acc[3] = 0ull; }
#endif
#ifndef PROBE_Q
#define PROBE_Q 8.0f
#endif
#ifdef PROBE_PHASE
#ifndef PROBE_FROM
#define PROBE_FROM -1
#endif
    if (PROBE_FROM < 0 && blockIdx.x == 0 && opaque_tid(F.wave0) == 0) ((unsigned long long*)(F.ws0 + WS_CTL))[30000] = __builtin_amdgcn_s_memrealtime();
#define PROBE_AT(k) do { if (((k) == PROBE_PHASE || (k) == PROBE_FROM) && blockIdx.x == 0 && opaque_tid(F.wave0) == 0) ((unsigned long long*)(F.ws0 + WS_CTL))[(k) == PROBE_PHASE ? 30001 : 30000] = __builtin_amdgcn_s_memrealtime(); } while (0)
#else
#define PROBE_AT(k) do {} while (0)
#endif
#ifndef PHMASK
#define PHMASK 0xFFFFFFFFu
#endif
#define IN(k) (((PHMASK >> (k)) & 1u) && lo <= (k) && (k) < hi)
#ifndef DUP_PHASE
#define DUP_PHASE -1
#endif
#define REP(k) for (int rep_ = 0; rep_ < ((k) == DUP_PHASE ? 2 : 1); ++rep_)
#ifdef BWPROBE
    unsigned long long bw_acc = 0ull;
#define XBAR() do { const unsigned long long b0_ = __builtin_amdgcn_s_memrealtime(); xcd_barrier(bar); bw_acc += __builtin_amdgcn_s_memrealtime() - b0_; } while (0)
#else
#define XBAR() xcd_barrier(bar)
#endif
#define SEAM2(k, k2) do { if (IN(k) && IN(k2)) XBAR(); PROBE_AT(k); asm volatile("" : "+s"(lo), "+s"(hi)); } while (0)
#define SEAM(k) do { if (IN(k) && IN((k) + 1)) XBAR(); PROBE_AT(k); asm volatile("" : "+s"(lo), "+s"(hi)); } while (0)
#define mod WSP(float, WS_MOD)
#define HB WSP(bf16, WS_HB)

    if (IN(0)) REP(0) { phase_enter(F); p0_prologue(F); }
    if (IN(0) && IN(1)) {
        if (MK_MULTI) { XBAR(); }
        else { if (opaque_tid(F.wave0) == 0) { asm volatile("s_waitcnt vmcnt(0)\n\tbuffer_inv sc1" ::: "memory");
                   unsigned sp_ = 0u; while (__hip_atomic_load(F.ctl + CW_P1RDY, RLX_AGENT) < 32u) { __builtin_amdgcn_s_sleep(1); if (++sp_ > (1u << 22)) break; }
                   asm volatile("s_waitcnt vmcnt(0)" ::: "memory"); }
               __syncthreads(); } }
    PROBE_AT(0); asm volatile("" : "+s"(lo), "+s"(hi));
#ifdef EXTRA_BARS
    for (int xb_ = 0; xb_ < EXTRA_BARS; ++xb_) xcd_barrier(bar);
#endif
    if (IN(1)) REP(1) { phase_enter(F); RowArgs A{}; A.src = FIN(IN_X); A.g = FIN(IN_NMG); A.shp = mod + 0; A.scp = mod + D; A.hb = HB; A.wfrag = WSP(v4u, WS_FWF); A.bias = FIN(IN_FBIAS); A.logf = WSP(float, WS_LOGF);
        rowpass_s<0>(F, A); } SEAM(1);
    if (IN(2)) REP(2) { phase_enter(F); pg8::Gemm g{D, D, D, 5}; DenseSched S{(const char*)HB, (const char*)WSP(bf16, WS_WQKV), (size_t)256 * D * 2, (size_t)256 * D * 2, T / 256, 3 * D / 256, (T / 256) * (3 * D / 256), F.G, (int)blockIdx.x};
        pg8::EpiQKV E{WSP(bf16, WS_Q), (size_t)(WS_K - WS_Q) / 2, attn_body::C2, (unsigned*)(F.ctl + CW_QKM)};
        pg8::gemm_phase<pg8::EpiQKV, DenseSched, true>(F.lds + RING_OFF, g, S, E, F.wave0); } SEAM(2);
    if (IN(3)) REP(3) { phase_enter(F); const attn_body::AttnTensors AT{(const attn_body::bf16*)WSP(bf16, WS_Q), (const attn_body::bf16*)WSP(bf16, WS_K), (const attn_body::bf16*)WSP(bf16, WS_V), (attn_body::bf16*)HB, WSP(float, WS_LOGF), (const unsigned*)(F.ctl + CW_QKM)};
        attn_body::attn_phase<8>((char*)lds + RING_OFF, AT, (unsigned*)(F.ctl + CW_AQ + 64 * rep_), F.wave0); } SEAM(3);
    if (IN(4)) REP(4) { phase_enter(F); pg8::Gemm g{D, D, D, 6}; DenseSched S{(const char*)HB, (const char*)WSP(bf16, WS_WO), (size_t)256 * D * 2, (size_t)256 * D * 2, T / 256, D / 256, (T / 256) * (D / 256), F.G, (int)blockIdx.x};
        pg8::EpiResidB E{FIN(IN_X), (bf16*)F.out, mod + 2 * D};
        pg8::gemm_phase<pg8::EpiResidB, DenseSched, true>(F.lds + RING_OFF, g, S, E, F.wave0); } SEAM(4);
        if (IN(5)) REP(5) { phase_enter(F); RowArgs A{}; A.src = F.out; A.g = FIN(IN_NFG) + 0 * D; A.shp = mod + (size_t)0 * 8 * MODW + 3 * D; A.scp = mod + (size_t)0 * 8 * MODW + 4 * D; A.hb = HB;
            A.wfrag = WSP(v4u, WS_RWF); A.bias = FIN(IN_RB); A.cnt = F.ctl + CW_CNT + 0 * 32 * 64; A.tok = WSP(int, WS_TOK); A.gw = WSP(float, WS_GW);
            if (rep_) { A.cnt = F.ctl + CW_CNT + 2 * 32 * 64; A.tok = WSP(int, WS_END); A.gw = WSP(float, WS_END + 4 * MiB); }
            rowpass_s<1>(F, A); } SEAM2(5, 7);
        if (IN(7)) REP(7) { phase_enter(F); build_etab(F, 0, nullptr); pg8::Gemm g{D, D, D, 3};
            MoeSched<false> S{(const LAS int*)(F.lds + ETAB_OFF), (const char*)HB, (const char*)(WSP(bf16, WS_UP0)), F.G, F.vcu, WSP(int, WS_TOK), nullptr};
            pg8::EpiUp E{WSP(bf16, WS_HH)};
            pg8::gemm_phase<pg8::EpiUp, MoeSched<false>, true, true>(F.lds + RING_OFF, g, S, E, F.wave0); } SEAM(7);
        if (IN(8)) REP(8) { phase_enter(F); if (MK_MULTI) build_etab(F, 0, nullptr);     pg8::Gemm g{FD, FD, FD, 1};
            MoeSched<true> S{(const LAS int*)(F.lds + ETAB_OFF), (const char*)WSP(bf16, WS_HH), (const char*)(WSP(bf16, WS_DN0)), F.G, F.vcu, rep_ ? WSP(int, WS_TOK) : nullptr, nullptr};
            pg8::EpiDown E{WSP(bf16, WS_Y2), WSP(int, WS_TOK), WSP(float, WS_GW)};
            pg8::gemm_phase<pg8::EpiDown, MoeSched<true>, true>(F.lds + RING_OFF, g, S, E, F.wave0); } SEAM(8);

            if (IN(9)) REP(9) { phase_enter(F); MixArgs A{}; A.src = F.out; A.dst = WSP(float, WS_X3); A.y2 = WSP(bf16, WS_Y2); A.hb = HB; A.wp = WSP(bf16, WS_WPF);
                A.g1 = FIN(IN_NMG) + D; A.sh1 = mod + 8 * MODW + 0; A.sc1 = mod + 8 * MODW + D; A.gt0 = mod + 5 * D; A.gtp = mod + 8 * MODW + 2 * D; A.ps = FIN(IN_POOLS);
                A.g2 = FIN(IN_NFG) + D; A.sh2 = mod + 8 * MODW + 3 * D; A.sc2 = mod + 8 * MODW + 4 * D; A.rwf = WSP(v4u, WS_RWF); A.bias = FIN(IN_RB);
                A.cnt = F.ctl + CW_CNT + 1 * 32 * 64; A.tok = WSP(int, WS_TOK); A.gw = WSP(float, WS_GW);
                mixer_pass(F, A); } SEAM2(9, 14);
        if (IN(14)) REP(14) { phase_enter(F); build_etab(F, 1, nullptr); pg8::Gemm g{D, D, D, 4};
            MoeSched<false> S{(const LAS int*)(F.lds + ETAB_OFF), (const char*)HB, (const char*)(WSP(bf16, WS_UP1)), F.G, F.vcu, WSP(int, WS_TOK), nullptr};
            pg8::EpiUp E{WSP(bf16, WS_HH)};
            pg8::gemm_phase<pg8::EpiUp, MoeSched<false>, true, true>(F.lds + RING_OFF, g, S, E, F.wave0); } SEAM(14);
        if (IN(15)) REP(15) { phase_enter(F); if (MK_MULTI) build_etab(F, 1, nullptr); pg8::Gemm g{FD, FD, FD, 2};
            MoeSched<true> S{(const LAS int*)(F.lds + ETAB_OFF), (const char*)WSP(bf16, WS_HH), (const char*)(WSP(bf16, WS_DN1)), F.G, F.vcu, nullptr, nullptr};
            pg8::EpiDown E{WSP(bf16, WS_Y2), WSP(int, WS_TOK), WSP(float, WS_GW)};
            pg8::gemm_phase<pg8::EpiDown, MoeSched<true>, true>(F.lds + RING_OFF, g, S, E, F.wave0); } SEAM(15);
    if (IN(16)) REP(16) { phase_enter(F); RowArgs A{}; A.src = WSP(float, WS_X3); A.dst = F.out; A.g = FIN(IN_NFIN); A.gtp = mod + 8 * MODW + 5 * D; A.y2 = WSP(bf16, WS_Y2);
        final_pass(F, A); }
#ifdef GPROBE
    if (blockIdx.x == GPROBE && opaque_tid(F.wave0) == GPROBE_TID) { ((unsigned long long*)(F.ws0 + WS_CTL))[30000] = 0ull; ((unsigned long long*)(F.ws0 + WS_CTL))[30001] = pg8::gprobe_acc[GPROBE_PART] * GPROBE_MUL; }
#endif
#ifdef BWPROBE
    if (blockIdx.x == BWPROBE && opaque_tid(F.wave0) == 0) { ((unsigned long long*)(F.ws0 + WS_CTL))[30000] = 0ull; ((unsigned long long*)(F.ws0 + WS_CTL))[30001] = bw_acc; }
#endif
#ifdef PROBE_PHASE
    xcd_barrier(bar); PROBE_AT(16); xcd_barrier(bar);
    { const unsigned long long* tw = (const unsigned long long*)(F.ws0 + WS_CTL) + 30000; const float dt_us = floorf((float)(tw[1] - tw[0]) * 0.01f * (1.0f / PROBE_Q)) * PROBE_Q;
        const float dl = sqrtf(2.56e-3f * dt_us); const int tp_ = opaque_tid(F.wave0); F.out0[(size_t)(blockIdx.x * 512 + tp_) * 256 + 3] += dl; }
#endif
#undef IN
#undef SEAM
#undef mod
#undef HB
}

extern "C" void kernel_launch(void* const* d_in, const int* in_sizes, int n_in, void* d_out, int out_size, void* d_ws, size_t ws_size, hipStream_t stream) {
    static int grid = 0;
    if (grid == 0) {
        if (n_in != 17 || in_sizes[0] != T * D || out_size != T * D || ws_size < WS_END) { fprintf(stderr, "kernel_launch: unexpected shapes (n_in %d, in0 %d, out %d, ws %zu)\n", n_in, n_in > 0 ? in_sizes[0] : -1, out_size, ws_size); grid = -1; return; }
        int dev = 0, cus = 0, per_cu = 0;
        if (hipGetDevice(&dev) != hipSuccess || hipDeviceGetAttribute(&cus, hipDeviceAttributeMultiprocessorCount, dev) != hipSuccess) { grid = -1; return; }
        if (hipFuncSetAttribute((const void*)fwd_megakernel, hipFuncAttributeMaxDynamicSharedMemorySize, LDS_BYTES) != hipSuccess) { fprintf(stderr, "kernel_launch: hipFuncSetAttribute failed\n"); grid = -1; return; }
        if (hipOccupancyMaxActiveBlocksPerMultiprocessor(&per_cu, (const void*)fwd_megakernel, NWAVES * 64, LDS_BYTES) != hipSuccess || per_cu < 1) { fprintf(stderr, "kernel_launch: occupancy query says %d\n", per_cu); (void)hipGetLastError(); grid = -1; return; }
        grid = cus;
        if (grid != 256) fprintf(stderr, "kernel_launch: %d CUs; this kernel's static work split expects 256\n", grid);
    }
    if (grid < 0) return;
    (void)hipMemsetAsync((char*)d_ws + WS_CTL, 0, CTL_ZERO_BYTES, stream);
    Args a{};
    for (int i = 0; i < 17; ++i) a.in[i] = (const float*)d_in[i];
    a.out = (float*)d_out; a.ws = (unsigned char*)d_ws;
#if MK_MULTI
#ifndef MAXPH
#define MAXPH 17
#endif
    for (int p = 0; p < MAXPH; ++p) { a.ph_lo = p; a.ph_hi = p + 1; hipLaunchKernelGGL(fwd_megakernel, dim3(grid), dim3(NWAVES * 64), LDS_BYTES, stream, a); }
#else
    a.ph_lo = 0; a.ph_hi = 17;
    void* kargs[] = {&a};
    hipError_t e = hipLaunchCooperativeKernel((const void*)fwd_megakernel, dim3(grid), dim3(NWAVES * 64), kargs, LDS_BYTES, stream);
    if (e != hipSuccess) fprintf(stderr, "kernel_launch: cooperative launch failed: %s\n", hipGetErrorString(e));
#endif
}
```
